# Optimizing an MI355X kernel written in HIP

```python
import jax, jax.numpy as jnp
from jax import lax
import numpy as np

D_MODEL = 1024
BATCH = 32
SEQ = 2048
DEPTH = 2

N_BRANCH = 4
BRANCH_W = D_MODEL // 2
N_GROUPS = 4
GROUP_W = BRANCH_W // N_GROUPS
POOL_WINDOWS = (2, 4, 8, 16)
CONV_K = 31
SHORT_K = 3
CHUNK = 128
N_PIECES = 12
N_BRANCH_COLS = N_PIECES * BRANCH_W
IN_COLS = N_BRANCH_COLS + N_BRANCH * D_MODEL
RMS_EPS = 1e-6
LN_EPS = 1e-5

kernel_name = "hybrid_gated_parallel_mixers"


def rms_norm(x, g):
    xf = x.astype(jnp.float32)
    y = xf * lax.rsqrt(jnp.mean(xf * xf, axis=-1, keepdims=True) + RMS_EPS)
    return (y * g.astype(jnp.float32)).astype(x.dtype)


def layer_norm(x, g, b):
    xf = x.astype(jnp.float32)
    mu = jnp.mean(xf, axis=-1, keepdims=True)
    var = jnp.mean(jnp.square(xf - mu), axis=-1, keepdims=True)
    y = (xf - mu) * lax.rsqrt(var + LN_EPS)
    return (y * g.astype(jnp.float32) + b.astype(jnp.float32)).astype(x.dtype)


def causal_dwconv(x, w):
    k, c = w.shape
    return lax.conv_general_dilated(
        x, w[:, None, :].astype(x.dtype), window_strides=(1,), padding=[(k - 1, 0)],
        dimension_numbers=("NWC", "WIO", "NWC"), feature_group_count=c)


def pool_mixer(xa, pool_w, pool_scale):
    b, s, _ = xa.shape
    xf = xa.astype(jnp.float32)
    csum = jnp.cumsum(xf, axis=1)
    t = jnp.arange(1, s + 1, dtype=jnp.float32)
    groups = []
    for j, win in enumerate(POOL_WINDOWS):
        cj = csum[..., j * GROUP_W:(j + 1) * GROUP_W]
        prev = jnp.pad(cj, ((0, 0), (win, 0), (0, 0)))[:, :s]
        mean = (cj - prev) / jnp.minimum(t, float(win))[None, :, None]
        groups.append(mean - xf[..., j * GROUP_W:(j + 1) * GROUP_W])
    pooled = jnp.stack(groups, axis=2)
    mixed = jnp.einsum("bsgc,gcd->bsgd", pooled, pool_w.astype(jnp.float32))
    return (mixed.reshape(b, s, BRANCH_W) * pool_scale.astype(jnp.float32)).astype(xa.dtype)


def conformer_conv(a, gb, conv_w, conv_b, ln_g, ln_b):
    y = a * jax.nn.sigmoid(gb)
    y = causal_dwconv(y, conv_w) + conv_b.astype(y.dtype)
    return jax.nn.silu(layer_norm(y, ln_g, ln_b))


def spatial_gating(u, v, ln_g, ln_b, sgu_w, sgu_b):
    b, s, _ = u.shape
    v = layer_norm(v, ln_g, ln_b).reshape(b, s // CHUNK, CHUNK, N_GROUPS, GROUP_W)
    mask = jnp.tril(jnp.ones((CHUNK, CHUNK), dtype=v.dtype))
    ws = sgu_w.astype(v.dtype) * mask[None]
    sp = jnp.einsum("gts,bnsgc->bntgc", ws, v) + sgu_b.T.astype(v.dtype)[None, None, :, :, None]
    return u * sp.reshape(b, s, BRANCH_W)


def short_gated_conv(bg, cg, xs, sc_w):
    return bg * causal_dwconv(cg * xs, sc_w)


def setup_inputs(seed: int = 0) -> dict:
    key = jax.random.key(seed)
    ks = jax.random.split(key, 20)
    f32 = jnp.float32
    nrm = lambda k, shape, scale: jax.random.normal(k, shape, f32) * scale
    return {
        "x": jax.random.normal(ks[0], (BATCH, SEQ, D_MODEL), f32),
        "norm_g": 1.0 + nrm(ks[1], (DEPTH, D_MODEL), 0.02),
        "w_in": nrm(ks[2], (DEPTH, D_MODEL, IN_COLS), D_MODEL ** -0.5),
        "pool_w": nrm(ks[3], (DEPTH, N_GROUPS, GROUP_W, GROUP_W), GROUP_W ** -0.5),
        "pool_scale": 1.0 + nrm(ks[4], (DEPTH, BRANCH_W), 0.02),
        "conv_w": nrm(ks[5], (DEPTH, CONV_K, BRANCH_W), CONV_K ** -0.5),
        "conv_b": nrm(ks[6], (DEPTH, BRANCH_W), 0.01),
        "conv_ln_g": 1.0 + nrm(ks[7], (DEPTH, BRANCH_W), 0.02),
        "conv_ln_b": nrm(ks[8], (DEPTH, BRANCH_W), 0.01),
        "sgu_ln_g": 1.0 + nrm(ks[9], (DEPTH, BRANCH_W), 0.02),
        "sgu_ln_b": nrm(ks[10], (DEPTH, BRANCH_W), 0.01),
        "sgu_w": nrm(ks[11], (DEPTH, N_GROUPS, CHUNK, CHUNK), CHUNK ** -0.5),
        "sgu_b": 1.0 + nrm(ks[12], (DEPTH, N_GROUPS, CHUNK), 0.01),
        "sc_w": nrm(ks[13], (DEPTH, SHORT_K, BRANCH_W), SHORT_K ** -0.5),
        "w_branch": nrm(ks[14], (DEPTH, N_BRANCH, BRANCH_W, D_MODEL), BRANCH_W ** -0.5),
        "w_o": nrm(ks[15], (DEPTH, D_MODEL, D_MODEL), D_MODEL ** -0.5),
        "final_g": 1.0 + nrm(ks[16], (D_MODEL,), 0.02),
    }


def reference(x, norm_g, w_in, pool_w, pool_scale, conv_w, conv_b, conv_ln_g, conv_ln_b,
              sgu_ln_g, sgu_ln_b, sgu_w, sgu_b, sc_w, w_branch, w_o, final_g):
    b, s, d = x.shape
    for l in range(DEPTH):
        h = rms_norm(x, norm_g[l])
        proj = jnp.einsum("bsd,dk->bsk", h, w_in[l].astype(h.dtype))
        (p_x, p_gate, c_a, c_b, c_gate, g_u, g_v, g_gate,
         s_b, s_c, s_x, s_gate) = jnp.split(proj[..., :N_BRANCH_COLS], N_PIECES, axis=-1)
        merge_gates = jax.nn.sigmoid(proj[..., N_BRANCH_COLS:].reshape(b, s, N_BRANCH, d))

        z_pool = pool_mixer(p_x, pool_w[l], pool_scale[l]) * jax.nn.silu(p_gate)
        z_conv = conformer_conv(c_a, c_b, conv_w[l], conv_b[l], conv_ln_g[l], conv_ln_b[l]) * jax.nn.silu(c_gate)
        z_sgu = spatial_gating(g_u, g_v, sgu_ln_g[l], sgu_ln_b[l], sgu_w[l], sgu_b[l]) * jax.nn.silu(g_gate)
        z_sc = short_gated_conv(s_b, s_c, s_x, sc_w[l]) * jax.nn.silu(s_gate)

        z = jnp.stack([z_pool, z_conv, z_sgu, z_sc], axis=2)
        branch_out = jnp.einsum("bsnc,ncd->bsnd", z, w_branch[l].astype(z.dtype))
        merged = jnp.sum(merge_gates * branch_out, axis=2)
        x = x + jnp.einsum("bsd,de->bse", merged, w_o[l].astype(merged.dtype))
    return rms_norm(x, final_g)
```

```cpp
#include <hip/hip_runtime.h>
#include <hip/hip_cooperative_groups.h>
#include <cstdio>
namespace cg = cooperative_groups;

#ifndef MULTI_LAUNCH
#define MULTI_LAUNCH 0
#endif

#define LAS __attribute__((address_space(3)))
typedef unsigned short bf16_t;
typedef short bf16x8 __attribute__((ext_vector_type(8)));
typedef float f32x4 __attribute__((ext_vector_type(4)));
typedef float f32x2 __attribute__((ext_vector_type(2)));
typedef unsigned u32x4 __attribute__((ext_vector_type(4)));
typedef unsigned u32x2 __attribute__((ext_vector_type(2)));

constexpr int DM = 1024, SEQ = 2048, NTOK = 32 * 2048, DEPTH = 2, BWID = 512, INC = 10240, GATE0 = 6144;
constexpr int NS = 2, TS = NTOK / NS;
constexpr int LDS_BYTES = 139264;
constexpr int VP = 1040;

struct Params {
    const float* in[17];
    float* out;
    unsigned char* ws;
    int ts, ns, ph_lo, ph_hi;
    unsigned long long o_win, o_wb, o_wo, o_pw, o_sw, o_h, o_z, o_tmp, o_proj;
};

__device__ __forceinline__ int otid() { int t = threadIdx.x; asm volatile("" : "+v"(t)); return t; }
__device__ __forceinline__ unsigned cvt_pk_bf16(float lo, float hi) { unsigned r; asm volatile("v_cvt_pk_bf16_f32 %0, %1, %2" : "=v"(r) : "v"(lo), "v"(hi)); return r; }
__device__ __forceinline__ bf16_t f2bf(float f) { unsigned u = __float_as_uint(f); u += 0x7FFFu + ((u >> 16) & 1u); return (bf16_t)(u >> 16); }
__device__ __forceinline__ void unpack8(const u32x4 v, float (&f)[8]) {
    f[0] = __uint_as_float(v.x << 16); f[1] = __uint_as_float(v.x & 0xffff0000u); f[2] = __uint_as_float(v.y << 16); f[3] = __uint_as_float(v.y & 0xffff0000u);
    f[4] = __uint_as_float(v.z << 16); f[5] = __uint_as_float(v.z & 0xffff0000u); f[6] = __uint_as_float(v.w << 16); f[7] = __uint_as_float(v.w & 0xffff0000u);
}
__device__ __forceinline__ u32x4 pack8(const float (&f)[8]) { u32x4 r; r.x = cvt_pk_bf16(f[0], f[1]); r.y = cvt_pk_bf16(f[2], f[3]); r.z = cvt_pk_bf16(f[4], f[5]); r.w = cvt_pk_bf16(f[6], f[7]); return r; }
__device__ __forceinline__ void unpack4(const u32x2 v, float (&f)[4]) { f[0] = __uint_as_float(v.x << 16); f[1] = __uint_as_float(v.x & 0xffff0000u); f[2] = __uint_as_float(v.y << 16); f[3] = __uint_as_float(v.y & 0xffff0000u); }
__device__ __forceinline__ float sigm(float x) { return __builtin_amdgcn_rcpf(1.0f + __expf(-x)); }
__device__ __forceinline__ float silu(float x) { return x * sigm(x); }
__device__ __forceinline__ void load8f(const float* p, float (&f)[8]) { const f32x4 a = *(const f32x4*)p, b = *(const f32x4*)(p + 4); f[0] = a[0]; f[1] = a[1]; f[2] = a[2]; f[3] = a[3]; f[4] = b[0]; f[5] = b[1]; f[6] = b[2]; f[7] = b[3]; }
__device__ __forceinline__ float wave_sum(float v) {
#pragma unroll
    for (int o = 32; o >= 1; o >>= 1) v += __shfl_xor(v, o);
    return v;
}
__device__ __forceinline__ u32x2 tr_read(unsigned lds_addr) { u32x2 r; asm volatile("ds_read_b64_tr_b16 %0, %1\n\ts_waitcnt lgkmcnt(0)" : "=&v"(r) : "v"(lds_addr) : "memory"); return r; }

namespace pg8 {
constexpr int BM = 256, BK = 64, HALF = 128, HTB = HALF * BK * 2, STAGE_BYTES = 8 * HTB, NXCD = 8, WGM = 8;
__device__ __forceinline__ int lds_byte(int r, int c) { const int st = (r >> 4) * 2 + (c >> 5), rr = r & 15, cc = c & 31, ob = rr * 64 + cc * 2; return st * 1024 + (ob ^ (((ob >> 9) & 1) << 5)); }
__device__ __forceinline__ void stage_rc(int b, int& R, int& C) { const int st = b / 1024, sb = b % 1024, swz = sb ^ (((sb >> 9) & 1) << 5); R = (st >> 1) * 16 + swz / 64; C = (st & 1) * 32 + (swz % 64) / 2; }
__device__ __forceinline__ int perm32(int rho) { const int n = rho >> 4, i = rho & 15; return 8 * (i >> 2) + 4 * n + (i & 3); }

struct Unit { int pm, pn, br; };
struct Gemm { const bf16_t* A; const bf16_t* Bt; };

template <int NM, int NN, int NBR>
struct Order {
    int G, c;
    __device__ __forceinline__ bool next(int i, Unit& u) const {
        constexpr int nwg = NM * NN;
        const int ti = i / NBR;
        const long L = (long)ti * G + c; if (L >= nwg) return false;
        int wgid = (int)L; { constexpr int q = nwg / NXCD, r = nwg % NXCD; const int xcd = wgid % NXCD, off = wgid / NXCD; wgid = (xcd < r ? xcd * (q + 1) : r * (q + 1) + (xcd - r) * q) + off; }
        constexpr int nig = WGM * NN; const int gid = wgid / nig, fm = gid * WGM, gsz = (NM - fm) < WGM ? (NM - fm) : WGM;
        u.pm = fm + ((wgid % nig) % gsz); u.pn = (wgid % nig) / gsz; u.br = i % NBR; return true;
    }
};

struct EpiProj {
    static constexpr bool PERM = true;
    bf16_t* O; int ldc;
    __device__ __forceinline__ void operator()(const f32x4 (&acc)[2][2][4][2], const Unit& u, int wr, int wc, int fr_, int fq) const {
        int fr = fr_; asm volatile("" : "+v"(fr));
        const int row0 = u.pm * BM + wr * 64 + fr, col0 = u.pn * BM + wc * 32 + 8 * fq;
#pragma unroll
        for (int ai = 0; ai < 2; ++ai)
#pragma unroll
            for (int m = 0; m < 4; ++m) { bf16_t* rowp = O + (size_t)(row0 + ai * HALF + m * 16) * ldc + col0;
#pragma unroll
                for (int bj = 0; bj < 2; ++bj) { const f32x4 v0 = acc[ai][bj][m][0], v1 = acc[ai][bj][m][1];
                    u32x4 w; w.x = cvt_pk_bf16(v0[0], v0[1]); w.y = cvt_pk_bf16(v0[2], v0[3]); w.z = cvt_pk_bf16(v1[0], v1[1]); w.w = cvt_pk_bf16(v1[2], v1[3]);
                    *(u32x4*)(rowp + bj * HALF) = w; } }
    }
};
struct EpiGate {
    static constexpr bool PERM = true;
    const bf16_t* proj; float* tmp; bf16_t* merged;
    __device__ __forceinline__ void operator()(const f32x4 (&acc)[2][2][4][2], const Unit& u, int wr, int wc, int fr_, int fq) const {
        int fr = fr_; asm volatile("" : "+v"(fr));
        const int lrow0 = wr * 64 + fr, lcol0 = wc * 32 + 8 * fq;
        const int br = u.br;
        const bf16_t* gp0 = proj + ((size_t)u.pm * BM + lrow0) * INC + GATE0 + br * DM + u.pn * BM + lcol0;
        float* tp0 = tmp + lrow0 * 256 + lcol0;
        bf16_t* mp0 = merged + ((size_t)u.pm * BM + lrow0) * DM + u.pn * BM + lcol0;
#pragma unroll
        for (int ai = 0; ai < 2; ++ai)
#pragma unroll
            for (int m = 0; m < 4; ++m) {
                const int dr = ai * HALF + m * 16;
#pragma unroll
                for (int bj = 0; bj < 2; ++bj) {
                    const u32x4 gv = *(const u32x4*)(gp0 + (size_t)dr * INC + bj * HALF);
                    float* tp = tp0 + dr * 256 + bj * HALF;
                    f32x4 t0 = (f32x4){0.f, 0.f, 0.f, 0.f}, t1 = t0;
                    if (br != 0) { t0 = *(const f32x4*)tp; t1 = *(const f32x4*)(tp + 4); }
                    float g[8]; unpack8(gv, g);
                    f32x4 v0 = acc[ai][bj][m][0], v1 = acc[ai][bj][m][1];
#pragma unroll
                    for (int j = 0; j < 4; ++j) { v0[j] = t0[j] + sigm(g[j]) * v0[j]; v1[j] = t1[j] + sigm(g[4 + j]) * v1[j]; }
                    if (br != 3) { *(f32x4*)tp = v0; *(f32x4*)(tp + 4) = v1; }
                    else { u32x4 w; w.x = cvt_pk_bf16(v0[0], v0[1]); w.y = cvt_pk_bf16(v0[2], v0[3]); w.z = cvt_pk_bf16(v1[0], v1[1]); w.w = cvt_pk_bf16(v1[2], v1[3]);
                        *(u32x4*)(mp0 + (size_t)dr * DM + bj * HALF) = w; }
                }
            }
    }
};
struct EpiRes {
    static constexpr bool PERM = false;
    const float* res; float* C; int ldc;
    __device__ __forceinline__ void operator()(const f32x4 (&acc)[2][2][4][2], const Unit& u, int wr, int wc, int fr_, int fq) const {
        int fr = fr_; asm volatile("" : "+v"(fr));
        const int row0 = u.pm * BM + wr * 64 + fr, col0 = u.pn * BM + wc * 32 + 4 * fq;
#pragma unroll
        for (int ai = 0; ai < 2; ++ai)
#pragma unroll
            for (int m = 0; m < 4; ++m) { const size_t off = (size_t)(row0 + ai * HALF + m * 16) * ldc + col0;
                f32x4 rv[2][2];
#pragma unroll
                for (int bj = 0; bj < 2; ++bj)
#pragma unroll
                    for (int n = 0; n < 2; ++n) rv[bj][n] = *(const f32x4*)(res + off + bj * HALF + n * 16);
#pragma unroll
                for (int bj = 0; bj < 2; ++bj)
#pragma unroll
                    for (int n = 0; n < 2; ++n) *(f32x4*)(C + off + bj * HALF + n * 16) = acc[ai][bj][m][n] + rv[bj][n]; }
    }
};

template <int K, size_t A_BR, size_t B_BR, class Epi, class Sched>
__device__ __forceinline__ void gemm_phase(LAS unsigned char* lds, const Gemm g, const Sched& S, const Epi& E) {
    const int tid = otid(), wid = __builtin_amdgcn_readfirstlane(tid >> 6), lane = tid & 63, wr = wid >> 2, wc = wid & 3, fr = lane & 15, fq = lane >> 4;
    constexpr int nt = K / BK;
    unsigned voffA[2], voffB[2];
#pragma unroll
    for (int i = 0; i < 2; ++i) { int R, C; stage_rc(tid * 16 + i * 8192, R, C); const int Rb = Epi::PERM ? ((R & ~31) + perm32(R & 31)) : R;
        voffA[i] = (unsigned)(R * K + C) * 2u; voffB[i] = (unsigned)(Rb * K + C) * 2u; }
    constexpr size_t kstep = (size_t)(BK * 2);
    constexpr size_t hstep = (size_t)HALF * K * 2;
    constexpr size_t tstep = 2 * hstep;
    const unsigned ldsw = (unsigned)wid * 1024u;
    const int aoff = lds_byte(wr * 64 + fr, fq * 8), boff = lds_byte(wc * 32 + fr, fq * 8);
#define PG8_SA(b, h) (((b) * 2 + (h)) * HTB)
#define PG8_SB(b, h) ((4 + (b) * 2 + (h)) * HTB)
#define PG8_STAGE(bufoff, gbase, voff) do { _Pragma("unroll") for (int _i = 0; _i < 2; ++_i) \
        __builtin_amdgcn_global_load_lds((const unsigned*)((const char*)(gbase) + (voff)[_i]), (LAS unsigned*)(lds + (bufoff) + ldsw + _i * 8192), 16, 0, 0); } while (0)
#define PG8_LDA(dst, b, h) do { _Pragma("unroll") for (int m = 0; m < 4; ++m) _Pragma("unroll") for (int k = 0; k < 2; ++k) dst[m][k] = *(const LAS bf16x8*)(lds + PG8_SA(b, h) + aoff + m * 2048 + k * 1024); } while (0)
#define PG8_LDB(dst, b, h) do { _Pragma("unroll") for (int n = 0; n < 2; ++n) _Pragma("unroll") for (int k = 0; k < 2; ++k) dst[n][k] = *(const LAS bf16x8*)(lds + PG8_SB(b, h) + boff + n * 2048 + k * 1024); } while (0)
#define PG8_MMA(ai, bj, At, Bt) do { __builtin_amdgcn_s_setprio(1); _Pragma("unroll") for (int m = 0; m < 4; ++m) _Pragma("unroll") for (int n = 0; n < 2; ++n) _Pragma("unroll") for (int k = 0; k < 2; ++k) \
        acc[ai][bj][m][n] = __builtin_amdgcn_mfma_f32_16x16x32_bf16(Bt[n][k], At[m][k], acc[ai][bj][m][n], 0, 0, 0); __builtin_amdgcn_s_setprio(0); } while (0)
#define PG8_WAIT_V(n) asm volatile("s_waitcnt vmcnt(" #n ")" ::: "memory")
#define PG8_WAIT_L(n) asm volatile("s_waitcnt lgkmcnt(" #n ")" ::: "memory")
#define PG8_BAR __builtin_amdgcn_s_barrier()
#define PG8_SCHED __builtin_amdgcn_sched_barrier(0)
    Unit cur, nxt; int ui = 0;
    if (!S.next(0, cur)) return;
    f32x4 acc[2][2][4][2];
#pragma unroll
    for (int a = 0; a < 2; ++a)
#pragma unroll
        for (int b = 0; b < 2; ++b)
#pragma unroll
            for (int m = 0; m < 4; ++m)
#pragma unroll
                for (int n = 0; n < 2; ++n) acc[a][b][m][n] = (f32x4){0.f, 0.f, 0.f, 0.f};
    bf16x8 At[4][2], B0[2][2], B1[2][2];
    const char* cA = (const char*)g.A + (size_t)cur.pm * tstep + (size_t)cur.br * A_BR; const char* cB = (const char*)g.Bt + (size_t)cur.pn * tstep + (size_t)cur.br * B_BR;
    PG8_STAGE(PG8_SB(0, 0), cB, voffB); PG8_STAGE(PG8_SA(0, 0), cA, voffA); PG8_STAGE(PG8_SB(0, 1), cB + hstep, voffB); PG8_STAGE(PG8_SA(0, 1), cA + hstep, voffA);
    if (wr == 1) PG8_BAR;
    PG8_WAIT_V(4); PG8_BAR;
    PG8_STAGE(PG8_SB(1, 0), cB + kstep, voffB); PG8_STAGE(PG8_SA(1, 0), cA + kstep, voffA); PG8_STAGE(PG8_SB(1, 1), cB + hstep + kstep, voffB);
    PG8_WAIT_V(6); PG8_BAR;
    for (;;) {
        const bool has_next = S.next(ui + 1, nxt);
        const char* nA = has_next ? (const char*)g.A + (size_t)nxt.pm * tstep + (size_t)nxt.br * A_BR : cA; const char* nB = has_next ? (const char*)g.Bt + (size_t)nxt.pn * tstep + (size_t)nxt.br * B_BR : cB;
        for (int t = 0; t < nt; t += 2) {
            const bool last = (t == nt - 2);
            const char* a1 = cA + (size_t)(t + 1) * kstep;
            const char* a2 = last ? nA : cA + (size_t)(t + 2) * kstep; const char* b2 = last ? nB : cB + (size_t)(t + 2) * kstep;
            const char* a3 = a2 + kstep; const char* b3 = b2 + kstep;
            PG8_LDB(B0, 0, 0); PG8_SCHED; PG8_LDA(At, 0, 0); PG8_STAGE(PG8_SA(1, 1), a1 + hstep, voffA);
            PG8_WAIT_L(8); PG8_BAR; PG8_WAIT_L(0); PG8_MMA(0, 0, At, B0); PG8_BAR; PG8_SCHED;
            PG8_LDB(B1, 0, 1); PG8_STAGE(PG8_SB(0, 0), b2, voffB);
            PG8_BAR; PG8_WAIT_L(0); PG8_MMA(0, 1, At, B1); PG8_BAR;
            PG8_LDA(At, 0, 1); PG8_STAGE(PG8_SA(0, 0), a2, voffA);
            PG8_BAR; PG8_WAIT_L(0); PG8_MMA(1, 0, At, B0); PG8_BAR; PG8_SCHED;
            PG8_STAGE(PG8_SB(0, 1), b2 + hstep, voffB);
            PG8_WAIT_V(6); PG8_BAR; PG8_MMA(1, 1, At, B1); PG8_BAR;
            PG8_LDB(B0, 1, 0); PG8_SCHED; PG8_LDA(At, 1, 0); PG8_STAGE(PG8_SA(0, 1), a2 + hstep, voffA);
            PG8_WAIT_L(8); PG8_BAR; PG8_WAIT_L(0); PG8_MMA(0, 0, At, B0); PG8_BAR; PG8_SCHED;
            PG8_LDB(B1, 1, 1); PG8_STAGE(PG8_SB(1, 0), b3, voffB);
            PG8_BAR; PG8_WAIT_L(0); PG8_MMA(0, 1, At, B1); PG8_BAR;
            PG8_LDA(At, 1, 1); PG8_STAGE(PG8_SA(1, 0), a3, voffA);
            PG8_BAR; PG8_WAIT_L(0); PG8_MMA(1, 0, At, B0); PG8_BAR; PG8_SCHED;
            PG8_STAGE(PG8_SB(1, 1), b3 + hstep, voffB);
            PG8_WAIT_V(6); PG8_BAR; PG8_MMA(1, 1, At, B1); PG8_BAR;
        }
        E(acc, cur, wr, wc, fr, fq);
        if (!has_next) break;
#pragma unroll
        for (int a = 0; a < 2; ++a)
#pragma unroll
            for (int b = 0; b < 2; ++b)
#pragma unroll
                for (int m = 0; m < 4; ++m)
#pragma unroll
                    for (int n = 0; n < 2; ++n) acc[a][b][m][n] = (f32x4){0.f, 0.f, 0.f, 0.f};
        cur = nxt; cA = nA; cB = nB; ++ui;
    }
    PG8_WAIT_V(0);
    if (wr == 0) PG8_BAR;
    PG8_BAR;
#undef PG8_SA
#undef PG8_SB
#undef PG8_STAGE
#undef PG8_LDA
#undef PG8_LDB
#undef PG8_MMA
#undef PG8_WAIT_V
#undef PG8_WAIT_L
#undef PG8_BAR
#undef PG8_SCHED
}
}

__device__ __forceinline__ void transpose_tile(const float* __restrict__ src, int R, int C, bf16_t* __restrict__ dst, int tr, int tc, LAS float* sm) {
    const int tid = otid();
#pragma unroll
    for (int i = 0; i < 8; ++i) { const int idx = tid + 512 * i, r = idx >> 6, c = idx & 63; sm[r * 65 + c] = src[(size_t)(tr * 64 + r) * C + tc * 64 + c]; }
    __syncthreads();
#pragma unroll
    for (int i = 0; i < 8; ++i) { const int idx = tid + 512 * i, c = idx >> 6, r = idx & 63; dst[(size_t)(tc * 64 + c) * R + tr * 64 + r] = f2bf(sm[r * 65 + c]); }
    __syncthreads();
}
__device__ void phase_prep(const Params& p, LAS unsigned char* lds) {
    LAS float* sm = (LAS float*)lds;
    bf16_t* win = (bf16_t*)(p.ws + p.o_win); bf16_t* wb = (bf16_t*)(p.ws + p.o_wb); bf16_t* wo = (bf16_t*)(p.ws + p.o_wo); bf16_t* pw = (bf16_t*)(p.ws + p.o_pw); bf16_t* sw = (bf16_t*)(p.ws + p.o_sw);
    constexpr int T_WIN = 16 * 160, T_WB = 8 * 16, T_WO = 16 * 16, T_PW = 4;
    constexpr int N0 = DEPTH * T_WIN, N1 = N0 + 8 * T_WB, N2 = N1 + DEPTH * T_WO, N3 = N2 + 8 * T_PW;
    for (int i = blockIdx.x; i < N3; i += gridDim.x) {
        if (i < N0) { const int l = i / T_WIN, t = i % T_WIN; transpose_tile(p.in[2] + (size_t)l * DM * INC, DM, INC, win + (size_t)l * DM * INC, t / 160, t % 160, sm); }
        else if (i < N1) { const int j = i - N0, m = j / T_WB, t = j % T_WB; transpose_tile(p.in[14] + (size_t)m * BWID * DM, BWID, DM, wb + (size_t)m * BWID * DM, t / 16, t % 16, sm); }
        else if (i < N2) { const int j = i - N1, l = j / T_WO, t = j % T_WO; transpose_tile(p.in[15] + (size_t)l * DM * DM, DM, DM, wo + (size_t)l * DM * DM, t / 16, t % 16, sm); }
        else { const int j = i - N2, m = j / T_PW, t = j % T_PW; transpose_tile(p.in[3] + (size_t)m * 128 * 128, 128, 128, pw + (size_t)m * 128 * 128, t / 2, t % 2, sm); }
    }
    const float* sgw = p.in[11];
    for (int i = blockIdx.x * 512 + otid(); i < DEPTH * 4 * 128 * 128; i += gridDim.x * 512) { const int s = i & 127, t = (i >> 7) & 127; sw[i] = (s <= t) ? f2bf(sgw[i]) : (bf16_t)0; }
}

__device__ void phase_norm_bf16(const float* __restrict__ xin, const float* __restrict__ g, bf16_t* __restrict__ h, int rows) {
    const int tid = otid(), lane = tid & 63, w = tid >> 6;
    float gv[2][8];
    load8f(g + 8 * lane, gv[0]); load8f(g + 512 + 8 * lane, gv[1]);
    for (int row = blockIdx.x * 8 + w; row < rows; row += gridDim.x * 8) {
        const float* xr = xin + (size_t)row * DM + 8 * lane;
        float v[2][8]; load8f(xr, v[0]); load8f(xr + 512, v[1]);
        float ss = 0.f;
#pragma unroll
        for (int i = 0; i < 2; ++i)
#pragma unroll
            for (int j = 0; j < 8; ++j) ss += v[i][j] * v[i][j];
        ss = wave_sum(ss);
        const float r = rsqrtf(ss * (1.0f / 1024.0f) + 1e-6f);
#pragma unroll
        for (int i = 0; i < 2; ++i) { float o[8];
#pragma unroll
            for (int j = 0; j < 8; ++j) o[j] = v[i][j] * r * gv[i][j];
            *(u32x4*)(h + (size_t)row * DM + 512 * i + 8 * lane) = pack8(o); }
    }
}
__device__ void phase_norm_final(float* __restrict__ x, const float* __restrict__ g, int rows) {
    const int tid = otid(), lane = tid & 63, w = tid >> 6;
    float gv[2][8];
    load8f(g + 8 * lane, gv[0]); load8f(g + 512 + 8 * lane, gv[1]);
    for (int row = blockIdx.x * 8 + w; row < rows; row += gridDim.x * 8) {
        float* xr = x + (size_t)row * DM + 8 * lane;
        float v[2][8]; load8f(xr, v[0]); load8f(xr + 512, v[1]);
        float ss = 0.f;
#pragma unroll
        for (int i = 0; i < 2; ++i)
#pragma unroll
            for (int j = 0; j < 8; ++j) ss += v[i][j] * v[i][j];
        ss = wave_sum(ss);
        const float r = rsqrtf(ss * (1.0f / 1024.0f) + 1e-6f);
#pragma unroll
        for (int i = 0; i < 2; ++i) {
            f32x4 a, b;
#pragma unroll
            for (int j = 0; j < 4; ++j) { a[j] = v[i][j] * r * gv[i][j]; b[j] = v[i][4 + j] * r * gv[i][4 + j]; }
            *(f32x4*)(xr + 512 * i) = a; *(f32x4*)(xr + 512 * i + 4) = b; }
    }
}

__device__ void mix_sc(const Params& p, int l, const bf16_t* __restrict__ proj, bf16_t* __restrict__ z3, int r0, int pos0) {
    const int tid = otid(), lane = tid & 63, w = tid >> 6, c0 = lane * 8;
    const float* scw = p.in[13] + (size_t)l * 3 * BWID + c0;
    float w0[8], w1[8], w2[8]; load8f(scw, w0); load8f(scw + BWID, w1); load8f(scw + 2 * BWID, w2);
    const int r = r0 + 16 * w, pos = pos0 + 16 * w;
    float p2[8], p1[8];
    if (pos > 0) {
        float a[8], b[8];
        unpack8(*(const u32x4*)(proj + (size_t)(r - 2) * INC + 9 * BWID + c0), a); unpack8(*(const u32x4*)(proj + (size_t)(r - 2) * INC + 10 * BWID + c0), b);
#pragma unroll
        for (int j = 0; j < 8; ++j) p2[j] = a[j] * b[j];
        unpack8(*(const u32x4*)(proj + (size_t)(r - 1) * INC + 9 * BWID + c0), a); unpack8(*(const u32x4*)(proj + (size_t)(r - 1) * INC + 10 * BWID + c0), b);
#pragma unroll
        for (int j = 0; j < 8; ++j) p1[j] = a[j] * b[j];
    } else {
#pragma unroll
        for (int j = 0; j < 8; ++j) { p2[j] = 0.f; p1[j] = 0.f; }
    }
#pragma unroll 4
    for (int jj = 0; jj < 16; ++jj) {
        const bf16_t* pr = proj + (size_t)(r + jj) * INC + c0;
        float vb[8], vc[8], vx[8], vg[8], o[8];
        unpack8(*(const u32x4*)(pr + 8 * BWID), vb); unpack8(*(const u32x4*)(pr + 9 * BWID), vc); unpack8(*(const u32x4*)(pr + 10 * BWID), vx); unpack8(*(const u32x4*)(pr + 11 * BWID), vg);
#pragma unroll
        for (int j = 0; j < 8; ++j) { const float cur = vc[j] * vx[j]; const float cv = w0[j] * p2[j] + w1[j] * p1[j] + w2[j] * cur; o[j] = vb[j] * cv * silu(vg[j]); p2[j] = p1[j]; p1[j] = cur; }
        *(u32x4*)(z3 + (size_t)(r + jj) * BWID + c0) = pack8(o);
    }
}

__device__ void mix_conv(const Params& p, int l, const bf16_t* __restrict__ proj, bf16_t* __restrict__ z1, int r0, int pos0, LAS unsigned char* lds) {
    const int tid = otid(), lane = tid & 63, w = tid >> 6, c0 = lane * 8;
    LAS unsigned char* Y = lds; LAS unsigned char* W = lds + 94 * VP;
    const float* cw = p.in[5] + (size_t)l * 31 * BWID;
    for (int i = tid; i < 31 * 64; i += 512) { const int k = i >> 6, cgp = i & 63; float f[8]; load8f(cw + k * BWID + cgp * 8, f); *(LAS u32x4*)(W + k * 1024 + cgp * 16) = pack8(f); }
    float bias[8], lng[8], lnb[8];
    load8f(p.in[6] + (size_t)l * BWID + c0, bias); load8f(p.in[7] + (size_t)l * BWID + c0, lng); load8f(p.in[8] + (size_t)l * BWID + c0, lnb);
    for (int q = 0; q < 2; ++q) {
        const int tr = r0 + 64 * q, tp = pos0 + 64 * q;
        __syncthreads();
        for (int i = tid; i < 94 * 64; i += 512) {
            const int row = i >> 6, cgp = i & 63; const int tpos = tp - 30 + row;
            u32x4 o = (u32x4){0u, 0u, 0u, 0u};
            if (tpos >= 0) { const bf16_t* pr = proj + (size_t)(tr - 30 + row) * INC + cgp * 8; float a[8], b[8], y[8];
                unpack8(*(const u32x4*)(pr + 2 * BWID), a); unpack8(*(const u32x4*)(pr + 3 * BWID), b);
#pragma unroll
                for (int j = 0; j < 8; ++j) y[j] = a[j] * sigm(b[j]);
                o = pack8(y); }
            *(LAS u32x4*)(Y + row * VP + cgp * 16) = o;
        }
        __syncthreads();
        float acc[8][8];
#pragma unroll
        for (int j = 0; j < 8; ++j)
#pragma unroll
            for (int c = 0; c < 8; ++c) acc[j][c] = bias[c];
#pragma unroll 1
        for (int k = 0; k < 31; ++k) {
            float wv[8]; unpack8(*(const LAS u32x4*)(W + k * 1024 + lane * 16), wv);
#pragma unroll
            for (int j = 0; j < 8; ++j) { float yv[8]; unpack8(*(const LAS u32x4*)(Y + (8 * w + j + k) * VP + lane * 16), yv);
#pragma unroll
                for (int c = 0; c < 8; ++c) acc[j][c] += wv[c] * yv[c]; }
        }
#pragma unroll
        for (int j = 0; j < 8; ++j) {
            float s = 0.f, ss = 0.f;
#pragma unroll
            for (int c = 0; c < 8; ++c) { s += acc[j][c]; ss += acc[j][c] * acc[j][c]; }
            s = wave_sum(s); ss = wave_sum(ss);
            const float mean = s * (1.0f / 512.0f); const float var = fmaxf(ss * (1.0f / 512.0f) - mean * mean, 0.f); const float rstd = rsqrtf(var + 1e-5f);
            const int row = tr + 8 * w + j;
            float gt[8], o[8]; unpack8(*(const u32x4*)(proj + (size_t)row * INC + 4 * BWID + c0), gt);
#pragma unroll
            for (int c = 0; c < 8; ++c) { const float v = (acc[j][c] - mean) * rstd * lng[c] + lnb[c]; o[c] = silu(v) * silu(gt[c]); }
            *(u32x4*)(z1 + (size_t)row * BWID + c0) = pack8(o);
        }
    }
}

__device__ void mix_pool(const Params& p, int l, const bf16_t* __restrict__ proj, bf16_t* __restrict__ z0, int r0, int pos0, LAS unsigned char* lds) {
    const int tid = otid(), lane = tid & 63, w = tid >> 6, c0 = lane * 8;
    LAS unsigned char* P = lds;
    {
        const int win = 2 << (lane >> 4);
        const int r = r0 + 16 * w, pos = pos0 + 16 * w;
        float S[8];
#pragma unroll
        for (int j = 0; j < 8; ++j) S[j] = 0.f;
#pragma unroll 4
        for (int i = 1; i <= 16; ++i) if (i <= win && pos - i >= 0) { float x[8]; unpack8(*(const u32x4*)(proj + (size_t)(r - i) * INC + c0), x);
#pragma unroll
            for (int j = 0; j < 8; ++j) S[j] += x[j]; }
#pragma unroll 4
        for (int jj = 0; jj < 16; ++jj) {
            const int ps = pos + jj; float xv[8], o[8];
            unpack8(*(const u32x4*)(proj + (size_t)(r + jj) * INC + c0), xv);
#pragma unroll
            for (int j = 0; j < 8; ++j) S[j] += xv[j];
            if (ps - win >= 0) { float xo[8]; unpack8(*(const u32x4*)(proj + (size_t)(r + jj - win) * INC + c0), xo);
#pragma unroll
                for (int j = 0; j < 8; ++j) S[j] -= xo[j]; }
            const int cnt = (ps + 1 < win) ? ps + 1 : win; const float inv = 1.0f / (float)cnt;
#pragma unroll
            for (int j = 0; j < 8; ++j) o[j] = S[j] * inv - xv[j];
            *(LAS u32x4*)(P + (16 * w + jj) * VP + lane * 16) = pack8(o);
        }
    }
    __syncthreads();
    {
        const int g = w >> 1, fr = lane & 15, fq = lane >> 4;
        const bf16_t* pwT = (const bf16_t*)(p.ws + p.o_pw) + (size_t)(l * 4 + g) * 128 * 128;
        bf16x8 A[4][4];
#pragma unroll
        for (int dt = 0; dt < 4; ++dt)
#pragma unroll
            for (int kk = 0; kk < 4; ++kk) A[dt][kk] = *(const bf16x8*)(pwT + (size_t)(64 * (w & 1) + 16 * dt + fr) * 128 + 32 * kk + 8 * fq);
        const float* psc = p.in[4] + (size_t)l * BWID;
#pragma unroll 1
        for (int tt = 0; tt < 8; ++tt) {
            bf16x8 Bf[4];
#pragma unroll
            for (int kk = 0; kk < 4; ++kk) Bf[kk] = *(const LAS bf16x8*)(P + (16 * tt + fr) * VP + (128 * g + 32 * kk + 8 * fq) * 2);
            f32x4 acc[4];
#pragma unroll
            for (int dt = 0; dt < 4; ++dt) { acc[dt] = (f32x4){0.f, 0.f, 0.f, 0.f};
#pragma unroll
                for (int kk = 0; kk < 4; ++kk) acc[dt] = __builtin_amdgcn_mfma_f32_16x16x32_bf16(A[dt][kk], Bf[kk], acc[dt], 0, 0, 0); }
            const int row = r0 + 16 * tt + fr;
#pragma unroll
            for (int dt = 0; dt < 4; ++dt) { const int d = 64 * w + 16 * dt + 4 * fq;
                float gt[4]; unpack4(*(const u32x2*)(proj + (size_t)row * INC + 1 * BWID + d), gt); const f32x4 sc = *(const f32x4*)(psc + d);
                u32x2 o; o.x = cvt_pk_bf16(acc[dt][0] * sc[0] * silu(gt[0]), acc[dt][1] * sc[1] * silu(gt[1])); o.y = cvt_pk_bf16(acc[dt][2] * sc[2] * silu(gt[2]), acc[dt][3] * sc[3] * silu(gt[3]));
                *(u32x2*)(z0 + (size_t)row * BWID + d) = o; }
        }
    }
}

__device__ void mix_sgu(const Params& p, int l, const bf16_t* __restrict__ proj, bf16_t* __restrict__ z2, int r0, LAS unsigned char* lds) {
    const int tid = otid(), lane = tid & 63, w = tid >> 6, c0 = lane * 8;
    LAS unsigned char* V = lds;
    {
        float lng[8], lnb[8]; load8f(p.in[9] + (size_t)l * BWID + c0, lng); load8f(p.in[10] + (size_t)l * BWID + c0, lnb);
#pragma unroll 4
        for (int jj = 0; jj < 16; ++jj) {
            const int row = r0 + 16 * w + jj; float x[8], o[8];
            unpack8(*(const u32x4*)(proj + (size_t)row * INC + 6 * BWID + c0), x);
            float s = 0.f, ss = 0.f;
#pragma unroll
            for (int c = 0; c < 8; ++c) { s += x[c]; ss += x[c] * x[c]; }
            s = wave_sum(s); ss = wave_sum(ss);
            const float mean = s * (1.0f / 512.0f); const float var = fmaxf(ss * (1.0f / 512.0f) - mean * mean, 0.f); const float rstd = rsqrtf(var + 1e-5f);
#pragma unroll
            for (int c = 0; c < 8; ++c) o[c] = (x[c] - mean) * rstd * lng[c] + lnb[c];
            *(LAS u32x4*)(V + (16 * w + jj) * VP + lane * 16) = pack8(o);
        }
    }
    __syncthreads();
    {
        const int g = w >> 1, fr = lane & 15, fq = lane >> 4;
        const unsigned vbase = (unsigned)(size_t)V;
        bf16x8 A[4][4];
#pragma unroll
        for (int ct = 0; ct < 4; ++ct)
#pragma unroll
            for (int kk = 0; kk < 4; ++kk) {
                const unsigned a = vbase + (unsigned)((32 * kk + 8 * fq + (fr >> 2)) * VP + (64 * w + 16 * ct + 4 * (fr & 3)) * 2);
                const u32x2 lo = tr_read(a), hi = tr_read(a + 4 * VP);
                u32x4 t; t.x = lo.x; t.y = lo.y; t.z = hi.x; t.w = hi.y;
                A[ct][kk] = __builtin_bit_cast(bf16x8, t);
            }
        const bf16_t* swm = (const bf16_t*)(p.ws + p.o_sw) + (size_t)(l * 4 + g) * 128 * 128;
        const float* sb = p.in[12] + (size_t)(l * 4 + g) * 128;
#pragma unroll 1
        for (int tt = 0; tt < 8; ++tt) {
            const int nk = (tt >> 1) + 1;
            f32x4 acc[4];
#pragma unroll
            for (int ct = 0; ct < 4; ++ct) acc[ct] = (f32x4){0.f, 0.f, 0.f, 0.f};
#pragma unroll
            for (int kk = 0; kk < 4; ++kk) if (kk < nk) {
                const bf16x8 Bf = *(const bf16x8*)(swm + (size_t)(16 * tt + fr) * 128 + 32 * kk + 8 * fq);
#pragma unroll
                for (int ct = 0; ct < 4; ++ct) acc[ct] = __builtin_amdgcn_mfma_f32_16x16x32_bf16(A[ct][kk], Bf, acc[ct], 0, 0, 0);
            }
            const int row = r0 + 16 * tt + fr; const float bias = sb[16 * tt + fr];
#pragma unroll
            for (int ct = 0; ct < 4; ++ct) { const int c = 64 * w + 16 * ct + 4 * fq;
                float u[4], gt[4]; unpack4(*(const u32x2*)(proj + (size_t)row * INC + 5 * BWID + c), u); unpack4(*(const u32x2*)(proj + (size_t)row * INC + 7 * BWID + c), gt);
                u32x2 o; o.x = cvt_pk_bf16(u[0] * (acc[ct][0] + bias) * silu(gt[0]), u[1] * (acc[ct][1] + bias) * silu(gt[1])); o.y = cvt_pk_bf16(u[2] * (acc[ct][2] + bias) * silu(gt[2]), u[3] * (acc[ct][3] + bias) * silu(gt[3]));
                *(u32x2*)(z2 + (size_t)row * BWID + c) = o; }
        }
    }
}

__device__ void phase_mix(const Params& p, int l, const bf16_t* proj, bf16_t* z, LAS unsigned char* lds) {
    constexpr int nchunk = TS / 128;
    constexpr size_t zs = (size_t)TS * BWID;
    for (int i = blockIdx.x; i < 4 * nchunk; i += gridDim.x) {
        const int br = i / nchunk, j = i % nchunk, r0 = j * 128, pos0 = (j & 15) * 128;
        if (br == 0) mix_pool(p, l, proj, z, r0, pos0, lds);
        else if (br == 1) mix_conv(p, l, proj, z + zs, r0, pos0, lds);
        else if (br == 2) mix_sgu(p, l, proj, z + 2 * zs, r0, lds);
        else mix_sc(p, l, proj, z + 3 * zs, r0, pos0);
        __syncthreads();
    }
}

__global__ void __launch_bounds__(512) mk_forward(Params p) {
    extern __shared__ __attribute__((aligned(16))) unsigned char lds_raw[];
    LAS unsigned char* lds = (LAS unsigned char*)lds_raw;
    cg::grid_group grid = cg::this_grid();
    int ph = 0;
#define PHASE_ON (ph >= p.ph_lo && ph < p.ph_hi)
#define PHASE_END do { if (PHASE_ON && ph + 1 < p.ph_hi) grid.sync(); ++ph; } while (0)
    constexpr int ts = TS;
    bf16_t* win = (bf16_t*)(p.ws + p.o_win); bf16_t* wb = (bf16_t*)(p.ws + p.o_wb); bf16_t* wo = (bf16_t*)(p.ws + p.o_wo);
    bf16_t* h = (bf16_t*)(p.ws + p.o_h); bf16_t* z = (bf16_t*)(p.ws + p.o_z); float* tmp = (float*)(p.ws + p.o_tmp); bf16_t* proj = (bf16_t*)(p.ws + p.o_proj);
    bf16_t* merged = h;

    if (PHASE_ON) phase_prep(p, lds);
    PHASE_END;
#pragma unroll 1
    for (int l = 0; l < DEPTH; ++l) {
        const float* xin = (l == 0) ? p.in[0] : p.out;
#pragma unroll 1
        for (int s = 0; s < NS; ++s) {
            const size_t tok0 = (size_t)s * ts;
            if (PHASE_ON) phase_norm_bf16(xin + tok0 * DM, p.in[1] + (size_t)l * DM, h, ts);
            PHASE_END;
            if (PHASE_ON) { pg8::Gemm g{h, win + (size_t)l * DM * INC}; pg8::Order<TS / 256, INC / 256, 1> S{(int)gridDim.x, (int)blockIdx.x}; pg8::EpiProj E{proj, INC}; pg8::gemm_phase<DM, 0, 0>(lds, g, S, E); }
            PHASE_END;
            if (PHASE_ON) phase_mix(p, l, proj, z, lds);
            PHASE_END;
            if (PHASE_ON) { pg8::Gemm g{z, wb + (size_t)l * 4 * BWID * DM}; pg8::Order<TS / 256, DM / 256, 4> S{(int)gridDim.x, (int)blockIdx.x};
                pg8::EpiGate E{proj, tmp + (size_t)blockIdx.x * 65536, merged}; pg8::gemm_phase<BWID, (size_t)TS * BWID * 2, (size_t)BWID * DM * 2>(lds, g, S, E); }
            PHASE_END;
            if (PHASE_ON) { pg8::Gemm g{merged, wo + (size_t)l * DM * DM}; pg8::Order<TS / 256, DM / 256, 1> S{(int)gridDim.x, (int)blockIdx.x};
                pg8::EpiRes E{xin + tok0 * DM, p.out + tok0 * DM, DM}; pg8::gemm_phase<DM, 0, 0>(lds, g, S, E); }
            PHASE_END;
        }
    }
    if (PHASE_ON) phase_norm_final(p.out, p.in[16], NTOK);
    PHASE_END;
}

extern "C" void kernel_launch(void* const* d_in, const int* in_sizes, int n_in, void* d_out, int out_size, void* d_ws, size_t ws_size, hipStream_t stream) {
    static int grid = 0;
    if (grid == 0) {
        int dev = 0, cus = 0, per_cu = 0;
        hipGetDevice(&dev); hipDeviceGetAttribute(&cus, hipDeviceAttributeMultiprocessorCount, dev);
        if (hipFuncSetAttribute((const void*)mk_forward, hipFuncAttributeMaxDynamicSharedMemorySize, LDS_BYTES) != hipSuccess) { fprintf(stderr, "hipFuncSetAttribute failed\n"); grid = -1; return; }
        if (hipOccupancyMaxActiveBlocksPerMultiprocessor(&per_cu, (const void*)mk_forward, 512, LDS_BYTES) != hipSuccess || per_cu < 1) { fprintf(stderr, "occupancy query: %d\n", per_cu); per_cu = 1; }
        (void)hipGetLastError();
        grid = cus * per_cu;
    }
    if (grid < 0) return;
    Params p{};
    for (int i = 0; i < 17; ++i) p.in[i] = (const float*)d_in[i];
    p.out = (float*)d_out; p.ws = (unsigned char*)d_ws;
    p.ns = NS; p.ts = TS;
    size_t o = 0;
    p.o_win = o; o += (size_t)DEPTH * DM * INC * 2;
    p.o_wb = o; o += (size_t)DEPTH * 4 * BWID * DM * 2;
    p.o_wo = o; o += (size_t)DEPTH * DM * DM * 2;
    p.o_pw = o; o += (size_t)DEPTH * 4 * 128 * 128 * 2;
    p.o_sw = o; o += (size_t)DEPTH * 4 * 128 * 128 * 2;
    p.o_tmp = o; o += (size_t)grid * 65536 * 4;
    p.o_h = o; o += (size_t)p.ts * DM * 2;
    p.o_z = o; o += 4 * (size_t)p.ts * BWID * 2;
    p.o_proj = o; o += (size_t)p.ts * INC * 2;
    if (o > ws_size) { fprintf(stderr, "kernel_launch: workspace too small: need %zu, have %zu\n", o, ws_size); return; }
    const int nph = 1 + DEPTH * NS * 5 + 1;
#if MULTI_LAUNCH
    for (int ph = 0; ph < nph; ++ph) { p.ph_lo = ph; p.ph_hi = ph + 1; hipLaunchKernelGGL(mk_forward, dim3(grid), dim3(512), LDS_BYTES, stream, p); }
#else
    p.ph_lo = 0; p.ph_hi = nph;
    void* args[] = {&p};
    hipError_t e = hipLaunchCooperativeKernel((const void*)mk_forward, dim3(grid), dim3(512), args, LDS_BYTES, stream);
    if (e != hipSuccess) fprintf(stderr, "cooperative launch failed: %s (grid %d)\n", hipGetErrorString(e), grid);
#endif
}
```

```cpp
#include <hip/hip_runtime.h>
#include <hip/hip_cooperative_groups.h>
#include <cstdio>
namespace cg = cooperative_groups;

#ifndef MULTI_LAUNCH
#define MULTI_LAUNCH 0
#endif

#ifndef REP_N
#define REP_N 1
#endif
#ifndef REP_A
#define REP_A 1
#endif
#ifndef REP_B
#define REP_B 1
#endif
#ifndef REP_C
#define REP_C 1
#endif
#define LAS __attribute__((address_space(3)))
typedef unsigned short bf16_t;
typedef short bf16x8 __attribute__((ext_vector_type(8)));
typedef float f32x4 __attribute__((ext_vector_type(4)));
typedef float f32x2 __attribute__((ext_vector_type(2)));
typedef unsigned u32x4 __attribute__((ext_vector_type(4)));
typedef unsigned u32x2 __attribute__((ext_vector_type(2)));

constexpr int DM = 1024, SEQ = 2048, NTOK = 32 * 2048, DEPTH = 2, BWID = 512, INC = 10240, GATE0 = 6144;
constexpr int PP = 6144;
constexpr int NS = 2, TS = NTOK / NS;
constexpr int LDS_BYTES = 139264;
constexpr int VP = 1040;

struct Params {
    const float* in[17];
    float* out;
    unsigned char* ws;
    int ts, ns, ph_lo, ph_hi;
    unsigned long long o_win, o_wb, o_wo, o_pw, o_sw, o_h, o_z, o_bar, o_proj;
};

__device__ __forceinline__ int otid() { int t = threadIdx.x; asm volatile("" : "+v"(t)); return t; }
__device__ __forceinline__ unsigned cvt_pk_bf16(float lo, float hi) { unsigned r; asm volatile("v_cvt_pk_bf16_f32 %0, %1, %2" : "=v"(r) : "v"(lo), "v"(hi)); return r; }
__device__ __forceinline__ bf16_t f2bf(float f) { unsigned u = __float_as_uint(f); u += 0x7FFFu + ((u >> 16) & 1u); return (bf16_t)(u >> 16); }
__device__ __forceinline__ void unpack8(const u32x4 v, float (&f)[8]) {
    f[0] = __uint_as_float(v.x << 16); f[1] = __uint_as_float(v.x & 0xffff0000u); f[2] = __uint_as_float(v.y << 16); f[3] = __uint_as_float(v.y & 0xffff0000u);
    f[4] = __uint_as_float(v.z << 16); f[5] = __uint_as_float(v.z & 0xffff0000u); f[6] = __uint_as_float(v.w << 16); f[7] = __uint_as_float(v.w & 0xffff0000u);
}
__device__ __forceinline__ u32x4 pack8(const float (&f)[8]) { u32x4 r; r.x = cvt_pk_bf16(f[0], f[1]); r.y = cvt_pk_bf16(f[2], f[3]); r.z = cvt_pk_bf16(f[4], f[5]); r.w = cvt_pk_bf16(f[6], f[7]); return r; }
__device__ __forceinline__ void unpack4(const u32x2 v, float (&f)[4]) { f[0] = __uint_as_float(v.x << 16); f[1] = __uint_as_float(v.x & 0xffff0000u); f[2] = __uint_as_float(v.y << 16); f[3] = __uint_as_float(v.y & 0xffff0000u); }
__device__ __forceinline__ float sigm(float x) { return __builtin_amdgcn_rcpf(1.0f + __expf(-x)); }
__device__ __forceinline__ float silu(float x) { return x * sigm(x); }
__device__ __forceinline__ void load8f(const float* p, float (&f)[8]) { const f32x4 a = *(const f32x4*)p, b = *(const f32x4*)(p + 4); f[0] = a[0]; f[1] = a[1]; f[2] = a[2]; f[3] = a[3]; f[4] = b[0]; f[5] = b[1]; f[6] = b[2]; f[7] = b[3]; }
__device__ __forceinline__ float wave_sum(float v) {
#pragma unroll
    for (int o = 32; o >= 1; o >>= 1) v += __shfl_xor(v, o);
    return v;
}
__device__ __forceinline__ u32x2 tr_read(unsigned lds_addr) { u32x2 r; asm volatile("ds_read_b64_tr_b16 %0, %1\n\ts_waitcnt lgkmcnt(0)" : "=&v"(r) : "v"(lds_addr) : "memory"); return r; }

namespace pg8 {
constexpr int BM = 256, BK = 64, HALF = 128, HTB = HALF * BK * 2, STAGE_BYTES = 8 * HTB, NXCD = 8, WGM = 8;
__device__ __forceinline__ int lds_byte(int r, int c) { const int st = (r >> 4) * 2 + (c >> 5), rr = r & 15, cc = c & 31, ob = rr * 64 + cc * 2; return st * 1024 + (ob ^ (((ob >> 9) & 1) << 5)); }
__device__ __forceinline__ void stage_rc(int b, int& R, int& C) { const int st = b / 1024, sb = b % 1024, swz = sb ^ (((sb >> 9) & 1) << 5); R = (st >> 1) * 16 + swz / 64; C = (st & 1) * 32 + (swz % 64) / 2; }
__device__ __forceinline__ int perm32(int rho) { const int n = rho >> 4, i = rho & 15; return 8 * (i >> 2) + 4 * n + (i & 3); }

struct Unit { int pm, pn, br; };
struct Gemm { const bf16_t* A; const bf16_t* Bt; };

template <int NM, int NN, int NBR>
struct Order {
    int G, c;
    __device__ __forceinline__ bool next(int i, Unit& u) const {
        constexpr int nwg = NM * NN;
        const int ti = i / NBR;
        const long L = (long)ti * G + c; if (L >= nwg) return false;
        int wgid = (int)L; { constexpr int q = nwg / NXCD, r = nwg % NXCD; const int xcd = wgid % NXCD, off = wgid / NXCD; wgid = (xcd < r ? xcd * (q + 1) : r * (q + 1) + (xcd - r) * q) + off; }
        constexpr int nig = WGM * NN; const int gid = wgid / nig, fm = gid * WGM, gsz = (NM - fm) < WGM ? (NM - fm) : WGM;
        u.pm = fm + ((wgid % nig) % gsz); u.pn = (wgid % nig) / gsz; u.br = i % NBR; return true;
    }
};

struct EpiProj {
    static constexpr bool PERM = true;
    static __device__ __forceinline__ bool zero_after(const Unit&) { return true; }
    bf16_t* O; bf16_t* G;
    __device__ __forceinline__ void operator()(f32x4 (&acc)[2][2][4][2], const Unit& u, int wr, int wc, int fr_, int fq) const {
        int fr = fr_; asm volatile("" : "+v"(fr));
        if (u.pn < GATE0 / BM) {
            const int row0 = u.pm * BM + wr * 64 + fr, col0 = u.pn * BM + wc * 32 + 8 * fq;
#pragma unroll
            for (int ai = 0; ai < 2; ++ai)
#pragma unroll
                for (int m = 0; m < 4; ++m) { bf16_t* rowp = O + (size_t)(row0 + ai * HALF + m * 16) * PP + col0;
#pragma unroll
                    for (int bj = 0; bj < 2; ++bj) { const f32x4 v0 = acc[ai][bj][m][0], v1 = acc[ai][bj][m][1];
                        u32x4 w; w.x = cvt_pk_bf16(v0[0], v0[1]); w.y = cvt_pk_bf16(v0[2], v0[3]); w.z = cvt_pk_bf16(v1[0], v1[1]); w.w = cvt_pk_bf16(v1[2], v1[3]);
                        *(u32x4*)(rowp + bj * HALF) = w; } }
        } else {
            bf16_t* gb = G + ((size_t)u.pm * 16 + (u.pn - GATE0 / BM)) * 65536 + (((wr * 4 + wc) * 4 + fq) * 16 + fr) * 8;
#pragma unroll
            for (int ai = 0; ai < 2; ++ai)
#pragma unroll
                for (int m = 0; m < 4; ++m)
#pragma unroll
                    for (int bj = 0; bj < 2; ++bj) { const f32x4 v0 = acc[ai][bj][m][0], v1 = acc[ai][bj][m][1];
                        u32x4 w; w.x = cvt_pk_bf16(v0[0], v0[1]); w.y = cvt_pk_bf16(v0[2], v0[3]); w.z = cvt_pk_bf16(v1[0], v1[1]); w.w = cvt_pk_bf16(v1[2], v1[3]);
                        *(u32x4*)(gb + ((ai * 4 + m) * 2 + bj) * 4096) = w; }
        }
    }
};
struct EpiGate {
    static constexpr bool PERM = true;
    static __device__ __forceinline__ bool zero_after(const Unit& u) { return u.br == 3; }
    const bf16_t* G; bf16_t* merged;
    __device__ __forceinline__ void operator()(f32x4 (&acc)[2][2][4][2], const Unit& u, int wr, int wc, int fr_, int fq) const {
        int fr = fr_; asm volatile("" : "+v"(fr));
        const int lrow0 = wr * 64 + fr, lcol0 = wc * 32 + 8 * fq;
        const int br = u.br;
        const bf16_t* gp0 = G + ((size_t)u.pm * 16 + br * 4 + u.pn) * 65536 + (((wr * 4 + wc) * 4 + fq) * 16 + fr) * 8;
        bf16_t* mp0 = merged + ((size_t)u.pm * BM + lrow0) * DM + u.pn * BM + lcol0;
        const bool lastb = (br == 3);
        {
            u32x4 gc[2][4][2];
#pragma unroll
            for (int ai = 0; ai < 2; ++ai)
#pragma unroll
                for (int m = 0; m < 4; ++m)
#pragma unroll
                    for (int bj = 0; bj < 2; ++bj) gc[ai][m][bj] = *(const u32x4*)(gp0 + ((ai * 4 + m) * 2 + bj) * 4096);
#pragma unroll
            for (int ai = 0; ai < 2; ++ai)
#pragma unroll
                for (int m = 0; m < 4; ++m)
#pragma unroll
                    for (int bj = 0; bj < 2; ++bj) {
                        float a[8]; unpack8(gc[ai][m][bj], a);
#pragma unroll
                        for (int j = 0; j < 4; ++j) { acc[ai][bj][m][0][j] *= sigm(a[j]); acc[ai][bj][m][1][j] *= sigm(a[4 + j]); }
                        if (lastb) { const f32x4 v0 = acc[ai][bj][m][0], v1 = acc[ai][bj][m][1];
                            u32x4 w; w.x = cvt_pk_bf16(v0[0], v0[1]); w.y = cvt_pk_bf16(v0[2], v0[3]); w.z = cvt_pk_bf16(v1[0], v1[1]); w.w = cvt_pk_bf16(v1[2], v1[3]);
                            *(u32x4*)(mp0 + (size_t)(ai * HALF + m * 16) * DM + bj * HALF) = w; }
                    }
        }
        asm volatile("" ::: "memory");
        if (!lastb) {
            u32x4 gn[2][4][2];
#pragma unroll
            for (int ai = 0; ai < 2; ++ai)
#pragma unroll
                for (int m = 0; m < 4; ++m)
#pragma unroll
                    for (int bj = 0; bj < 2; ++bj) gn[ai][m][bj] = *(const u32x4*)(gp0 + 4 * 65536 + ((ai * 4 + m) * 2 + bj) * 4096);
#pragma unroll
            for (int ai = 0; ai < 2; ++ai)
#pragma unroll
                for (int m = 0; m < 4; ++m)
#pragma unroll
                    for (int bj = 0; bj < 2; ++bj) {
                        float b[8]; unpack8(gn[ai][m][bj], b);
#pragma unroll
                        for (int j = 0; j < 4; ++j) { acc[ai][bj][m][0][j] *= (1.0f + __expf(-b[j])); acc[ai][bj][m][1][j] *= (1.0f + __expf(-b[4 + j])); }
                    }
        }
    }
};
struct EpiRes {
    static constexpr bool PERM = false;
    static __device__ __forceinline__ bool zero_after(const Unit&) { return true; }
    const float* res; float* C; int ldc;
    __device__ __forceinline__ void operator()(const f32x4 (&acc)[2][2][4][2], const Unit& u, int wr, int wc, int fr_, int fq) const {
        int fr = fr_; asm volatile("" : "+v"(fr));
        const int row0 = u.pm * BM + wr * 64 + fr, col0 = u.pn * BM + wc * 32 + 4 * fq;
#pragma unroll
        for (int ai = 0; ai < 2; ++ai)
#pragma unroll
            for (int m = 0; m < 4; ++m) { const size_t off = (size_t)(row0 + ai * HALF + m * 16) * ldc + col0;
                f32x4 rv[2][2];
#pragma unroll
                for (int bj = 0; bj < 2; ++bj)
#pragma unroll
                    for (int n = 0; n < 2; ++n) rv[bj][n] = *(const f32x4*)(res + off + bj * HALF + n * 16);
#pragma unroll
                for (int bj = 0; bj < 2; ++bj)
#pragma unroll
                    for (int n = 0; n < 2; ++n) *(f32x4*)(C + off + bj * HALF + n * 16) = acc[ai][bj][m][n] + rv[bj][n]; }
    }
};

template <int K, size_t A_BR, size_t B_BR, class Epi, class Sched>
__device__ __forceinline__ void gemm_phase(LAS unsigned char* lds, const Gemm g, const Sched& S, const Epi& E) {
    const int tid = otid(), wid = __builtin_amdgcn_readfirstlane(tid >> 6), lane = tid & 63, wr = wid >> 2, wc = wid & 3, fr = lane & 15, fq = lane >> 4;
    constexpr int nt = K / BK;
    unsigned voffA[2], voffB[2];
#pragma unroll
    for (int i = 0; i < 2; ++i) { int R, C; stage_rc(tid * 16 + i * 8192, R, C); const int Rb = Epi::PERM ? ((R & ~31) + perm32(R & 31)) : R;
        voffA[i] = (unsigned)(R * K + C) * 2u; voffB[i] = (unsigned)(Rb * K + C) * 2u; }
    constexpr size_t kstep = (size_t)(BK * 2);
    constexpr size_t hstep = (size_t)HALF * K * 2;
    constexpr size_t tstep = 2 * hstep;
    const unsigned ldsw = (unsigned)wid * 1024u;
    const int aoff = lds_byte(wr * 64 + fr, fq * 8), boff = lds_byte(wc * 32 + fr, fq * 8);
#define PG8_SA(b, h) (((b) * 2 + (h)) * HTB)
#define PG8_SB(b, h) ((4 + (b) * 2 + (h)) * HTB)
#define PG8_STAGE(bufoff, gbase, voff) do { _Pragma("unroll") for (int _i = 0; _i < 2; ++_i) \
        __builtin_amdgcn_global_load_lds((const unsigned*)((const char*)(gbase) + (voff)[_i]), (LAS unsigned*)(lds + (bufoff) + ldsw + _i * 8192), 16, 0, 0); } while (0)
#define PG8_LDA(dst, b, h) do { _Pragma("unroll") for (int m = 0; m < 4; ++m) _Pragma("unroll") for (int k = 0; k < 2; ++k) dst[m][k] = *(const LAS bf16x8*)(lds + PG8_SA(b, h) + aoff + m * 2048 + k * 1024); } while (0)
#define PG8_LDB(dst, b, h) do { _Pragma("unroll") for (int n = 0; n < 2; ++n) _Pragma("unroll") for (int k = 0; k < 2; ++k) dst[n][k] = *(const LAS bf16x8*)(lds + PG8_SB(b, h) + boff + n * 2048 + k * 1024); } while (0)
#define PG8_MMA(ai, bj, At, Bt) do { __builtin_amdgcn_s_setprio(1); _Pragma("unroll") for (int m = 0; m < 4; ++m) _Pragma("unroll") for (int n = 0; n < 2; ++n) _Pragma("unroll") for (int k = 0; k < 2; ++k) \
        acc[ai][bj][m][n] = __builtin_amdgcn_mfma_f32_16x16x32_bf16(Bt[n][k], At[m][k], acc[ai][bj][m][n], 0, 0, 0); __builtin_amdgcn_s_setprio(0); } while (0)
#define PG8_WAIT_V(n) asm volatile("s_waitcnt vmcnt(" #n ")" ::: "memory")
#define PG8_WAIT_L(n) asm volatile("s_waitcnt lgkmcnt(" #n ")" ::: "memory")
#define PG8_BAR __builtin_amdgcn_s_barrier()
#define PG8_SCHED __builtin_amdgcn_sched_barrier(0)
    Unit cur, nxt; int ui = 0;
    if (!S.next(0, cur)) return;
    f32x4 acc[2][2][4][2];
#pragma unroll
    for (int a = 0; a < 2; ++a)
#pragma unroll
        for (int b = 0; b < 2; ++b)
#pragma unroll
            for (int m = 0; m < 4; ++m)
#pragma unroll
                for (int n = 0; n < 2; ++n) acc[a][b][m][n] = (f32x4){0.f, 0.f, 0.f, 0.f};
    bf16x8 At[4][2], B0[2][2], B1[2][2];
    const char* cA = (const char*)g.A + (size_t)cur.pm * tstep + (size_t)cur.br * A_BR; const char* cB = (const char*)g.Bt + (size_t)cur.pn * tstep + (size_t)cur.br * B_BR;
    PG8_STAGE(PG8_SB(0, 0), cB, voffB); PG8_STAGE(PG8_SA(0, 0), cA, voffA); PG8_STAGE(PG8_SB(0, 1), cB + hstep, voffB); PG8_STAGE(PG8_SA(0, 1), cA + hstep, voffA);
    if (wr == 1) PG8_BAR;
    PG8_WAIT_V(4); PG8_BAR;
    PG8_STAGE(PG8_SB(1, 0), cB + kstep, voffB); PG8_STAGE(PG8_SA(1, 0), cA + kstep, voffA); PG8_STAGE(PG8_SB(1, 1), cB + hstep + kstep, voffB);
    PG8_WAIT_V(6); PG8_BAR;
    for (;;) {
        const bool has_next = S.next(ui + 1, nxt);
        const char* nA = has_next ? (const char*)g.A + (size_t)nxt.pm * tstep + (size_t)nxt.br * A_BR : cA; const char* nB = has_next ? (const char*)g.Bt + (size_t)nxt.pn * tstep + (size_t)nxt.br * B_BR : cB;
        for (int t = 0; t < nt; t += 2) {
            const bool last = (t == nt - 2);
            const char* a1 = cA + (size_t)(t + 1) * kstep;
            const char* a2 = last ? nA : cA + (size_t)(t + 2) * kstep; const char* b2 = last ? nB : cB + (size_t)(t + 2) * kstep;
            const char* a3 = a2 + kstep; const char* b3 = b2 + kstep;
            PG8_LDB(B0, 0, 0); PG8_SCHED; PG8_LDA(At, 0, 0); PG8_STAGE(PG8_SA(1, 1), a1 + hstep, voffA);
            PG8_WAIT_L(8); PG8_BAR; PG8_WAIT_L(0); PG8_MMA(0, 0, At, B0); PG8_BAR; PG8_SCHED;
            PG8_LDB(B1, 0, 1); PG8_STAGE(PG8_SB(0, 0), b2, voffB);
            PG8_BAR; PG8_WAIT_L(0); PG8_MMA(0, 1, At, B1); PG8_BAR;
            PG8_LDA(At, 0, 1); PG8_STAGE(PG8_SA(0, 0), a2, voffA);
            PG8_BAR; PG8_WAIT_L(0); PG8_MMA(1, 0, At, B0); PG8_BAR; PG8_SCHED;
            PG8_STAGE(PG8_SB(0, 1), b2 + hstep, voffB);
            PG8_WAIT_V(6); PG8_BAR; PG8_MMA(1, 1, At, B1); PG8_BAR;
            PG8_LDB(B0, 1, 0); PG8_SCHED; PG8_LDA(At, 1, 0); PG8_STAGE(PG8_SA(0, 1), a2 + hstep, voffA);
            PG8_WAIT_L(8); PG8_BAR; PG8_WAIT_L(0); PG8_MMA(0, 0, At, B0); PG8_BAR; PG8_SCHED;
            PG8_LDB(B1, 1, 1); PG8_STAGE(PG8_SB(1, 0), b3, voffB);
            PG8_BAR; PG8_WAIT_L(0); PG8_MMA(0, 1, At, B1); PG8_BAR;
            PG8_LDA(At, 1, 1); PG8_STAGE(PG8_SA(1, 0), a3, voffA);
            PG8_BAR; PG8_WAIT_L(0); PG8_MMA(1, 0, At, B0); PG8_BAR; PG8_SCHED;
            PG8_STAGE(PG8_SB(1, 1), b3 + hstep, voffB);
            PG8_WAIT_V(6); PG8_BAR; PG8_MMA(1, 1, At, B1); PG8_BAR;
        }
        E(acc, cur, wr, wc, fr, fq);
        if (!has_next) break;
        if (Epi::zero_after(cur))
#pragma unroll
        for (int a = 0; a < 2; ++a)
#pragma unroll
            for (int b = 0; b < 2; ++b)
#pragma unroll
                for (int m = 0; m < 4; ++m)
#pragma unroll
                    for (int n = 0; n < 2; ++n) acc[a][b][m][n] = (f32x4){0.f, 0.f, 0.f, 0.f};
        cur = nxt; cA = nA; cB = nB; ++ui;
    }
    PG8_WAIT_V(0);
    if (wr == 0) PG8_BAR;
    PG8_BAR;
#undef PG8_SA
#undef PG8_SB
#undef PG8_STAGE
#undef PG8_LDA
#undef PG8_LDB
#undef PG8_MMA
#undef PG8_WAIT_V
#undef PG8_WAIT_L
#undef PG8_BAR
#undef PG8_SCHED
}
}

__device__ __forceinline__ void transpose_tile(const float* __restrict__ src, int R, int C, bf16_t* __restrict__ dst, int tr, int tc, LAS float* sm) {
    const int tid = otid();
#pragma unroll
    for (int i = 0; i < 8; ++i) { const int idx = tid + 512 * i, r = idx >> 6, c = idx & 63; sm[r * 65 + c] = src[(size_t)(tr * 64 + r) * C + tc * 64 + c]; }
    __syncthreads();
#pragma unroll
    for (int i = 0; i < 8; ++i) { const int idx = tid + 512 * i, c = idx >> 6, r = idx & 63; dst[(size_t)(tc * 64 + c) * R + tr * 64 + r] = f2bf(sm[r * 65 + c]); }
    __syncthreads();
}
__device__ void phase_prep(const Params& p, LAS unsigned char* lds) {
    LAS float* sm = (LAS float*)lds;
    bf16_t* win = (bf16_t*)(p.ws + p.o_win); bf16_t* wb = (bf16_t*)(p.ws + p.o_wb); bf16_t* wo = (bf16_t*)(p.ws + p.o_wo); bf16_t* pw = (bf16_t*)(p.ws + p.o_pw); bf16_t* sw = (bf16_t*)(p.ws + p.o_sw);
    constexpr int T_WIN = 16 * 160, T_WB = 8 * 16, T_WO = 16 * 16, T_PW = 4;
    constexpr int N0 = DEPTH * T_WIN, N1 = N0 + 8 * T_WB, N2 = N1 + DEPTH * T_WO, N3 = N2 + 8 * T_PW;
    for (int i = blockIdx.x; i < N3; i += gridDim.x) {
        if (i < N0) { const int l = i / T_WIN, t = i % T_WIN; transpose_tile(p.in[2] + (size_t)l * DM * INC, DM, INC, win + (size_t)l * DM * INC, t / 160, t % 160, sm); }
        else if (i < N1) { const int j = i - N0, m = j / T_WB, t = j % T_WB; transpose_tile(p.in[14] + (size_t)m * BWID * DM, BWID, DM, wb + (size_t)m * BWID * DM, t / 16, t % 16, sm); }
        else if (i < N2) { const int j = i - N1, l = j / T_WO, t = j % T_WO; transpose_tile(p.in[15] + (size_t)l * DM * DM, DM, DM, wo + (size_t)l * DM * DM, t / 16, t % 16, sm); }
        else { const int j = i - N2, m = j / T_PW, t = j % T_PW; transpose_tile(p.in[3] + (size_t)m * 128 * 128, 128, 128, pw + (size_t)m * 128 * 128, t / 2, t % 2, sm); }
    }
    const float* sgw = p.in[11];
    for (int i = blockIdx.x * 512 + otid(); i < DEPTH * 4 * 128 * 128; i += gridDim.x * 512) { const int s = i & 127, t = (i >> 7) & 127; sw[i] = (s <= t) ? f2bf(sgw[i]) : (bf16_t)0; }
}

__device__ void phase_norm_bf16(const float* __restrict__ xin, const float* __restrict__ g, bf16_t* __restrict__ h, int rows) {
    const int tid = otid(), lane = tid & 63, w = tid >> 6;
    float gv[2][8];
    load8f(g + 8 * lane, gv[0]); load8f(g + 512 + 8 * lane, gv[1]);
    for (int row = blockIdx.x * 8 + w; row < rows; row += gridDim.x * 8) {
        const float* xr = xin + (size_t)row * DM + 8 * lane;
        float v[2][8]; load8f(xr, v[0]); load8f(xr + 512, v[1]);
        float ss = 0.f;
#pragma unroll
        for (int i = 0; i < 2; ++i)
#pragma unroll
            for (int j = 0; j < 8; ++j) ss += v[i][j] * v[i][j];
        ss = wave_sum(ss);
        const float r = rsqrtf(ss * (1.0f / 1024.0f) + 1e-6f);
#pragma unroll
        for (int i = 0; i < 2; ++i) { float o[8];
#pragma unroll
            for (int j = 0; j < 8; ++j) o[j] = v[i][j] * r * gv[i][j];
            *(u32x4*)(h + (size_t)row * DM + 512 * i + 8 * lane) = pack8(o); }
    }
}
__device__ void phase_norm_final(float* __restrict__ x, const float* __restrict__ g, int rows) {
    const int tid = otid(), lane = tid & 63, w = tid >> 6;
    float gv[2][8];
    load8f(g + 8 * lane, gv[0]); load8f(g + 512 + 8 * lane, gv[1]);
    for (int row = blockIdx.x * 8 + w; row < rows; row += gridDim.x * 8) {
        float* xr = x + (size_t)row * DM + 8 * lane;
        float v[2][8]; load8f(xr, v[0]); load8f(xr + 512, v[1]);
        float ss = 0.f;
#pragma unroll
        for (int i = 0; i < 2; ++i)
#pragma unroll
            for (int j = 0; j < 8; ++j) ss += v[i][j] * v[i][j];
        ss = wave_sum(ss);
        const float r = rsqrtf(ss * (1.0f / 1024.0f) + 1e-6f);
#pragma unroll
        for (int i = 0; i < 2; ++i) {
            f32x4 a, b;
#pragma unroll
            for (int j = 0; j < 4; ++j) { a[j] = v[i][j] * r * gv[i][j]; b[j] = v[i][4 + j] * r * gv[i][4 + j]; }
            *(f32x4*)(xr + 512 * i) = a; *(f32x4*)(xr + 512 * i + 4) = b; }
    }
}

__device__ void mix_sc(const Params& p, int l, const bf16_t* __restrict__ proj, bf16_t* __restrict__ z3, int r0, int pos0) {
    const int tid = otid(), lane = tid & 63, w = tid >> 6, c0 = lane * 8;
    const float* scw = p.in[13] + (size_t)l * 3 * BWID + c0;
    float w0[8], w1[8], w2[8]; load8f(scw, w0); load8f(scw + BWID, w1); load8f(scw + 2 * BWID, w2);
    const int r = r0 + 16 * w, pos = pos0 + 16 * w;
    float p2[8], p1[8];
    if (pos > 0) {
        float a[8], b[8];
        unpack8(*(const u32x4*)(proj + (size_t)(r - 2) * PP + 9 * BWID + c0), a); unpack8(*(const u32x4*)(proj + (size_t)(r - 2) * PP + 10 * BWID + c0), b);
#pragma unroll
        for (int j = 0; j < 8; ++j) p2[j] = a[j] * b[j];
        unpack8(*(const u32x4*)(proj + (size_t)(r - 1) * PP + 9 * BWID + c0), a); unpack8(*(const u32x4*)(proj + (size_t)(r - 1) * PP + 10 * BWID + c0), b);
#pragma unroll
        for (int j = 0; j < 8; ++j) p1[j] = a[j] * b[j];
    } else {
#pragma unroll
        for (int j = 0; j < 8; ++j) { p2[j] = 0.f; p1[j] = 0.f; }
    }
#pragma unroll 4
    for (int jj = 0; jj < 16; ++jj) {
        const bf16_t* pr = proj + (size_t)(r + jj) * PP + c0;
        float vb[8], vc[8], vx[8], vg[8], o[8];
        unpack8(*(const u32x4*)(pr + 8 * BWID), vb); unpack8(*(const u32x4*)(pr + 9 * BWID), vc); unpack8(*(const u32x4*)(pr + 10 * BWID), vx); unpack8(*(const u32x4*)(pr + 11 * BWID), vg);
#pragma unroll
        for (int j = 0; j < 8; ++j) { const float cur = vc[j] * vx[j]; const float cv = w0[j] * p2[j] + w1[j] * p1[j] + w2[j] * cur; o[j] = vb[j] * cv * silu(vg[j]); p2[j] = p1[j]; p1[j] = cur; }
        *(u32x4*)(z3 + (size_t)(r + jj) * BWID + c0) = pack8(o);
    }
}

__device__ void mix_conv(const Params& p, int l, const bf16_t* __restrict__ proj, bf16_t* __restrict__ z1, int r0, int pos0, LAS unsigned char* lds) {
    const int tid = otid(), lane = tid & 63, w = tid >> 6, c0 = lane * 8;
    LAS unsigned char* Y = lds; LAS unsigned char* W = lds + 94 * VP;
    const float* cw = p.in[5] + (size_t)l * 31 * BWID;
    for (int i = tid; i < 31 * 64; i += 512) { const int k = i >> 6, cgp = i & 63; float f[8]; load8f(cw + k * BWID + cgp * 8, f); *(LAS u32x4*)(W + k * 1024 + cgp * 16) = pack8(f); }
    float bias[8], lng[8], lnb[8];
    load8f(p.in[6] + (size_t)l * BWID + c0, bias); load8f(p.in[7] + (size_t)l * BWID + c0, lng); load8f(p.in[8] + (size_t)l * BWID + c0, lnb);
    for (int q = 0; q < 2; ++q) {
        const int tr = r0 + 64 * q, tp = pos0 + 64 * q;
        __syncthreads();
        for (int i = tid; i < 94 * 64; i += 512) {
            const int row = i >> 6, cgp = i & 63; const int tpos = tp - 30 + row;
            u32x4 o = (u32x4){0u, 0u, 0u, 0u};
            if (tpos >= 0) { const bf16_t* pr = proj + (size_t)(tr - 30 + row) * PP + cgp * 8; float a[8], b[8], y[8];
                unpack8(*(const u32x4*)(pr + 2 * BWID), a); unpack8(*(const u32x4*)(pr + 3 * BWID), b);
#pragma unroll
                for (int j = 0; j < 8; ++j) y[j] = a[j] * sigm(b[j]);
                o = pack8(y); }
            *(LAS u32x4*)(Y + row * VP + cgp * 16) = o;
        }
        __syncthreads();
        float acc[8][8];
#pragma unroll
        for (int j = 0; j < 8; ++j)
#pragma unroll
            for (int c = 0; c < 8; ++c) acc[j][c] = bias[c];
#pragma unroll 1
        for (int k = 0; k < 31; ++k) {
            float wv[8]; unpack8(*(const LAS u32x4*)(W + k * 1024 + lane * 16), wv);
#pragma unroll
            for (int j = 0; j < 8; ++j) { float yv[8]; unpack8(*(const LAS u32x4*)(Y + (8 * w + j + k) * VP + lane * 16), yv);
#pragma unroll
                for (int c = 0; c < 8; ++c) acc[j][c] += wv[c] * yv[c]; }
        }
#pragma unroll
        for (int j = 0; j < 8; ++j) {
            float s = 0.f, ss = 0.f;
#pragma unroll
            for (int c = 0; c < 8; ++c) { s += acc[j][c]; ss += acc[j][c] * acc[j][c]; }
            s = wave_sum(s); ss = wave_sum(ss);
            const float mean = s * (1.0f / 512.0f); const float var = fmaxf(ss * (1.0f / 512.0f) - mean * mean, 0.f); const float rstd = rsqrtf(var + 1e-5f);
            const int row = tr + 8 * w + j;
            float gt[8], o[8]; unpack8(*(const u32x4*)(proj + (size_t)row * PP + 4 * BWID + c0), gt);
#pragma unroll
            for (int c = 0; c < 8; ++c) { const float v = (acc[j][c] - mean) * rstd * lng[c] + lnb[c]; o[c] = silu(v) * silu(gt[c]); }
            *(u32x4*)(z1 + (size_t)row * BWID + c0) = pack8(o);
        }
    }
}

__device__ void mix_pool(const Params& p, int l, const bf16_t* __restrict__ proj, bf16_t* __restrict__ z0, int r0, int pos0, LAS unsigned char* lds) {
    const int tid = otid(), lane = tid & 63, w = tid >> 6, c0 = lane * 8;
    LAS unsigned char* P = lds;
    {
        const int win = 2 << (lane >> 4);
        const int r = r0 + 16 * w, pos = pos0 + 16 * w;
        float S[8];
#pragma unroll
        for (int j = 0; j < 8; ++j) S[j] = 0.f;
#pragma unroll 4
        for (int i = 1; i <= 16; ++i) if (i <= win && pos - i >= 0) { float x[8]; unpack8(*(const u32x4*)(proj + (size_t)(r - i) * PP + c0), x);
#pragma unroll
            for (int j = 0; j < 8; ++j) S[j] += x[j]; }
#pragma unroll 4
        for (int jj = 0; jj < 16; ++jj) {
            const int ps = pos + jj; float xv[8], o[8];
            unpack8(*(const u32x4*)(proj + (size_t)(r + jj) * PP + c0), xv);
#pragma unroll
            for (int j = 0; j < 8; ++j) S[j] += xv[j];
            if (ps - win >= 0) { float xo[8]; unpack8(*(const u32x4*)(proj + (size_t)(r + jj - win) * PP + c0), xo);
#pragma unroll
                for (int j = 0; j < 8; ++j) S[j] -= xo[j]; }
            const int cnt = (ps + 1 < win) ? ps + 1 : win; const float inv = 1.0f / (float)cnt;
#pragma unroll
            for (int j = 0; j < 8; ++j) o[j] = S[j] * inv - xv[j];
            *(LAS u32x4*)(P + (16 * w + jj) * VP + lane * 16) = pack8(o);
        }
    }
    __syncthreads();
    {
        const int g = w >> 1, fr = lane & 15, fq = lane >> 4;
        const bf16_t* pwT = (const bf16_t*)(p.ws + p.o_pw) + (size_t)(l * 4 + g) * 128 * 128;
        bf16x8 A[4][4];
#pragma unroll
        for (int dt = 0; dt < 4; ++dt)
#pragma unroll
            for (int kk = 0; kk < 4; ++kk) A[dt][kk] = *(const bf16x8*)(pwT + (size_t)(64 * (w & 1) + 16 * dt + fr) * 128 + 32 * kk + 8 * fq);
        const float* psc = p.in[4] + (size_t)l * BWID;
#pragma unroll 1
        for (int tt = 0; tt < 8; ++tt) {
            bf16x8 Bf[4];
#pragma unroll
            for (int kk = 0; kk < 4; ++kk) Bf[kk] = *(const LAS bf16x8*)(P + (16 * tt + fr) * VP + (128 * g + 32 * kk + 8 * fq) * 2);
            f32x4 acc[4];
#pragma unroll
            for (int dt = 0; dt < 4; ++dt) { acc[dt] = (f32x4){0.f, 0.f, 0.f, 0.f};
#pragma unroll
                for (int kk = 0; kk < 4; ++kk) acc[dt] = __builtin_amdgcn_mfma_f32_16x16x32_bf16(A[dt][kk], Bf[kk], acc[dt], 0, 0, 0); }
            const int row = r0 + 16 * tt + fr;
#pragma unroll
            for (int dt = 0; dt < 4; ++dt) { const int d = 64 * w + 16 * dt + 4 * fq;
                float gt[4]; unpack4(*(const u32x2*)(proj + (size_t)row * PP + 1 * BWID + d), gt); const f32x4 sc = *(const f32x4*)(psc + d);
                u32x2 o; o.x = cvt_pk_bf16(acc[dt][0] * sc[0] * silu(gt[0]), acc[dt][1] * sc[1] * silu(gt[1])); o.y = cvt_pk_bf16(acc[dt][2] * sc[2] * silu(gt[2]), acc[dt][3] * sc[3] * silu(gt[3]));
                *(u32x2*)(z0 + (size_t)row * BWID + d) = o; }
        }
    }
}

__device__ void mix_sgu(const Params& p, int l, const bf16_t* __restrict__ proj, bf16_t* __restrict__ z2, int r0, LAS unsigned char* lds) {
    const int tid = otid(), lane = tid & 63, w = tid >> 6, c0 = lane * 8;
    LAS unsigned char* V = lds;
    {
        float lng[8], lnb[8]; load8f(p.in[9] + (size_t)l * BWID + c0, lng); load8f(p.in[10] + (size_t)l * BWID + c0, lnb);
#pragma unroll 4
        for (int jj = 0; jj < 16; ++jj) {
            const int row = r0 + 16 * w + jj; float x[8], o[8];
            unpack8(*(const u32x4*)(proj + (size_t)row * PP + 6 * BWID + c0), x);
            float s = 0.f, ss = 0.f;
#pragma unroll
            for (int c = 0; c < 8; ++c) { s += x[c]; ss += x[c] * x[c]; }
            s = wave_sum(s); ss = wave_sum(ss);
            const float mean = s * (1.0f / 512.0f); const float var = fmaxf(ss * (1.0f / 512.0f) - mean * mean, 0.f); const float rstd = rsqrtf(var + 1e-5f);
#pragma unroll
            for (int c = 0; c < 8; ++c) o[c] = (x[c] - mean) * rstd * lng[c] + lnb[c];
            *(LAS u32x4*)(V + (16 * w + jj) * VP + lane * 16) = pack8(o);
        }
    }
    __syncthreads();
    {
        const int g = w >> 1, fr = lane & 15, fq = lane >> 4;
        const unsigned vbase = (unsigned)(size_t)V;
        bf16x8 A[4][4];
#pragma unroll
        for (int ct = 0; ct < 4; ++ct)
#pragma unroll
            for (int kk = 0; kk < 4; ++kk) {
                const unsigned a = vbase + (unsigned)((32 * kk + 8 * fq + (fr >> 2)) * VP + (64 * w + 16 * ct + 4 * (fr & 3)) * 2);
                const u32x2 lo = tr_read(a), hi = tr_read(a + 4 * VP);
                u32x4 t; t.x = lo.x; t.y = lo.y; t.z = hi.x; t.w = hi.y;
                A[ct][kk] = __builtin_bit_cast(bf16x8, t);
            }
        const bf16_t* swm = (const bf16_t*)(p.ws + p.o_sw) + (size_t)(l * 4 + g) * 128 * 128;
        const float* sb = p.in[12] + (size_t)(l * 4 + g) * 128;
#pragma unroll 1
        for (int tt = 0; tt < 8; ++tt) {
            const int nk = (tt >> 1) + 1;
            f32x4 acc[4];
#pragma unroll
            for (int ct = 0; ct < 4; ++ct) acc[ct] = (f32x4){0.f, 0.f, 0.f, 0.f};
#pragma unroll
            for (int kk = 0; kk < 4; ++kk) if (kk < nk) {
                const bf16x8 Bf = *(const bf16x8*)(swm + (size_t)(16 * tt + fr) * 128 + 32 * kk + 8 * fq);
#pragma unroll
                for (int ct = 0; ct < 4; ++ct) acc[ct] = __builtin_amdgcn_mfma_f32_16x16x32_bf16(A[ct][kk], Bf, acc[ct], 0, 0, 0);
            }
            const int row = r0 + 16 * tt + fr; const float bias = sb[16 * tt + fr];
#pragma unroll
            for (int ct = 0; ct < 4; ++ct) { const int c = 64 * w + 16 * ct + 4 * fq;
                float u[4], gt[4]; unpack4(*(const u32x2*)(proj + (size_t)row * PP + 5 * BWID + c), u); unpack4(*(const u32x2*)(proj + (size_t)row * PP + 7 * BWID + c), gt);
                u32x2 o; o.x = cvt_pk_bf16(u[0] * (acc[ct][0] + bias) * silu(gt[0]), u[1] * (acc[ct][1] + bias) * silu(gt[1])); o.y = cvt_pk_bf16(u[2] * (acc[ct][2] + bias) * silu(gt[2]), u[3] * (acc[ct][3] + bias) * silu(gt[3]));
                *(u32x2*)(z2 + (size_t)row * BWID + c) = o; }
        }
    }
}

__device__ void phase_mix(const Params& p, int l, const bf16_t* proj, bf16_t* z, LAS unsigned char* lds) {
    constexpr int nchunk = TS / 128;
    constexpr size_t zs = (size_t)TS * BWID;
    for (int i = blockIdx.x; i < 4 * nchunk; i += gridDim.x) {
        const int br = i / nchunk, j = i % nchunk, r0 = j * 128, pos0 = (j & 15) * 128;
        if (br == 0) mix_pool(p, l, proj, z, r0, pos0, lds);
        else if (br == 1) mix_conv(p, l, proj, z + zs, r0, pos0, lds);
        else if (br == 2) mix_sgu(p, l, proj, z + 2 * zs, r0, lds);
        else mix_sc(p, l, proj, z + 3 * zs, r0, pos0);
        __syncthreads();
    }
}

#define XB_TMO      128
#define XB_XCNT(j)  (256  + 64 * (j))
#define XB_XSUB(j)  (1280 + 64 * (j))
#define XB_XGEN(j)  (2304 + 64 * (j))
#define XB_TOP      3328
#define XB_TOPGEN   3392
#define XCD_BAR_WORDS 3456
#define XB_SPIN_CAP (1u << 20)
__device__ __forceinline__ unsigned xb_ld(unsigned* p)              { return __hip_atomic_load(p, __ATOMIC_RELAXED, __HIP_MEMORY_SCOPE_AGENT); }
__device__ __forceinline__ unsigned xb_add(unsigned* p, unsigned v) { return __hip_atomic_fetch_add(p, v, __ATOMIC_RELAXED, __HIP_MEMORY_SCOPE_AGENT); }
__device__ __forceinline__ unsigned xb_xcc_id() { return (unsigned)__builtin_amdgcn_s_getreg((3 << 11) | 20) & 0xFu; }
#define XB_SPIN(cond, bar) do { unsigned _sp = 0; while (cond) { __builtin_amdgcn_s_sleep(1); \
    if ((++_sp & 255u) == 0u) { if (xb_ld(&(bar)[XB_TMO])) break; if (_sp > XB_SPIN_CAP) { atomicAdd(&(bar)[XB_TMO], 1u); break; } } } } while (0)
struct XcdBarrier { unsigned* bar; unsigned x; volatile LAS unsigned* st; };
__device__ __forceinline__ XcdBarrier xcd_barrier_post(unsigned* bar, volatile LAS unsigned* st) {
    XcdBarrier b; b.bar = bar; b.x = xb_xcc_id(); b.st = st;
    if (threadIdx.x == 0) (void)xb_add(&bar[XB_XCNT(b.x)], 1u);
    return b;
}
__device__ __forceinline__ void xcd_barrier_complete(unsigned* bar, unsigned x, unsigned& nloc, unsigned& nx) {
    const unsigned G = gridDim.x * gridDim.y * gridDim.z;
    unsigned sum, cnt, mine, sp = 0u;
    for (;;) {
        sum = 0u; cnt = 0u; mine = 0u;
#pragma unroll
        for (unsigned j = 0; j < 16; ++j) { const unsigned c = xb_ld(&bar[XB_XCNT(j)]); sum += c; cnt += (c > 0u) ? 1u : 0u; mine = (j == x) ? c : mine; }
        if (sum == G) break;
        __builtin_amdgcn_s_sleep(1);
        if ((++sp & 255u) == 0u) { if (xb_ld(&bar[XB_TMO])) break; if (sp > XB_SPIN_CAP) { atomicAdd(&bar[XB_TMO], 1u); break; } }
    }
    nloc = mine > 0u ? mine : 1u; nx = cnt > 0u ? cnt : 1u;
}
__device__ __forceinline__ void xcd_barrier(const XcdBarrier& b) {
    asm volatile("s_waitcnt vmcnt(0)" ::: "memory");
    __syncthreads();
    if (threadIdx.x == 0) {
        unsigned* bar = b.bar;
        __builtin_amdgcn_s_waitcnt(0);
        unsigned nloc = b.st[0], nx = b.st[1];
        if (nloc == 0u) { xcd_barrier_complete(bar, b.x, nloc, nx); b.st[0] = nloc; b.st[1] = nx; }
        const unsigned old = xb_add(&bar[XB_XSUB(b.x)], 1u);
        const unsigned gen = old / nloc;
        if (old + 1u == (gen + 1u) * nloc) {
            __builtin_amdgcn_fence(__ATOMIC_RELEASE, "agent");
            asm volatile("s_waitcnt vmcnt(0)" ::: "memory");
            const unsigned og = xb_add(&bar[XB_TOP], 1u);
            const unsigned tg = og / nx;
            if (og + 1u == (tg + 1u) * nx) xb_add(&bar[XB_TOPGEN], 1u);
            else XB_SPIN(xb_ld(&bar[XB_TOPGEN]) == tg, bar);
            __builtin_amdgcn_fence(__ATOMIC_ACQUIRE, "agent");
            xb_add(&bar[XB_XGEN(b.x)], 1u);
            asm volatile("s_waitcnt vmcnt(0)" ::: "memory");
        } else {
            XB_SPIN(xb_ld(&bar[XB_XGEN(b.x)]) == gen, bar);
            __builtin_amdgcn_fence(__ATOMIC_ACQUIRE, "agent");
            asm volatile("s_waitcnt vmcnt(0)" ::: "memory");
        }
    }
    __syncthreads();
}

__global__ void __launch_bounds__(512) mk_forward(Params p) {
    extern __shared__ __attribute__((aligned(16))) unsigned char lds_raw[];
    LAS unsigned char* lds = (LAS unsigned char*)lds_raw;
    cg::grid_group grid = cg::this_grid();
    volatile LAS unsigned* stw = (volatile LAS unsigned*)(lds + LDS_BYTES - 16);
    if (threadIdx.x == 0) { stw[0] = 0u; stw[1] = 0u; }
    __syncthreads();
    const XcdBarrier xbar = xcd_barrier_post((unsigned*)(p.ws + p.o_bar), stw);
    int ph = 0;
#define PHASE_ON (ph >= p.ph_lo && ph < p.ph_hi)
#ifndef XSYNC
#define XSYNC 0
#endif
#define PHASE_END do { if (PHASE_ON && ph + 1 < p.ph_hi) { if (ph == 0) grid.sync(); else xcd_barrier(xbar); for (int xs = 0; xs < XSYNC; ++xs) xcd_barrier(xbar); } ++ph; } while (0)
    constexpr int ts = TS;
    bf16_t* win = (bf16_t*)(p.ws + p.o_win); bf16_t* wb = (bf16_t*)(p.ws + p.o_wb); bf16_t* wo = (bf16_t*)(p.ws + p.o_wo);
    bf16_t* h = (bf16_t*)(p.ws + p.o_h); bf16_t* z = (bf16_t*)(p.ws + p.o_z); bf16_t* proj = (bf16_t*)(p.ws + p.o_proj);
    bf16_t* merged = h;

    if (PHASE_ON) phase_prep(p, lds);
    PHASE_END;
#pragma unroll 1
    for (int l = 0; l < DEPTH; ++l) {
        const float* xin = (l == 0) ? p.in[0] : p.out;
#pragma unroll 1
        for (int s = 0; s < NS; ++s) {
            const size_t tok0 = (size_t)s * ts;
            if (PHASE_ON) for (int rep = 0; rep < REP_N; ++rep) phase_norm_bf16(xin + tok0 * DM, p.in[1] + (size_t)l * DM, h, ts);
            PHASE_END;
            if (PHASE_ON) for (int rep = 0; rep < REP_A; ++rep) { pg8::Gemm g{h, win + (size_t)l * DM * INC}; pg8::Order<TS / 256, INC / 256, 1> S{(int)gridDim.x, (int)blockIdx.x}; pg8::EpiProj E{proj, proj + (size_t)TS * PP}; pg8::gemm_phase<DM, 0, 0>(lds, g, S, E); }
            PHASE_END;
            if (PHASE_ON) for (int rep = 0; rep < REP_B; ++rep) phase_mix(p, l, proj, z, lds);
            PHASE_END;
            if (PHASE_ON) for (int rep = 0; rep < REP_C; ++rep) { pg8::Gemm g{z, wb + (size_t)l * 4 * BWID * DM}; pg8::Order<TS / 256, DM / 256, 4> S{(int)gridDim.x, (int)blockIdx.x};
                pg8::EpiGate E{proj + (size_t)TS * PP, merged}; pg8::gemm_phase<BWID, (size_t)TS * BWID * 2, (size_t)BWID * DM * 2>(lds, g, S, E); }
            PHASE_END;
            if (PHASE_ON) { pg8::Gemm g{merged, wo + (size_t)l * DM * DM}; pg8::Order<TS / 256, DM / 256, 1> S{(int)gridDim.x, (int)blockIdx.x};
                pg8::EpiRes E{xin + tok0 * DM, p.out + tok0 * DM, DM}; pg8::gemm_phase<DM, 0, 0>(lds, g, S, E); }
            PHASE_END;
        }
    }
    if (PHASE_ON) phase_norm_final(p.out, p.in[16], NTOK);
    PHASE_END;
}

extern "C" void kernel_launch(void* const* d_in, const int* in_sizes, int n_in, void* d_out, int out_size, void* d_ws, size_t ws_size, hipStream_t stream) {
    static int grid = 0;
    if (grid == 0) {
        int dev = 0, cus = 0, per_cu = 0;
        hipGetDevice(&dev); hipDeviceGetAttribute(&cus, hipDeviceAttributeMultiprocessorCount, dev);
        if (hipFuncSetAttribute((const void*)mk_forward, hipFuncAttributeMaxDynamicSharedMemorySize, LDS_BYTES) != hipSuccess) { fprintf(stderr, "hipFuncSetAttribute failed\n"); grid = -1; return; }
        if (hipOccupancyMaxActiveBlocksPerMultiprocessor(&per_cu, (const void*)mk_forward, 512, LDS_BYTES) != hipSuccess || per_cu < 1) { fprintf(stderr, "occupancy query: %d\n", per_cu); per_cu = 1; }
        (void)hipGetLastError();
        grid = cus * per_cu;
    }
    if (grid < 0) return;
    Params p{};
    for (int i = 0; i < 17; ++i) p.in[i] = (const float*)d_in[i];
    p.out = (float*)d_out; p.ws = (unsigned char*)d_ws;
    p.ns = NS; p.ts = TS;
    size_t o = 0;
    p.o_win = o; o += (size_t)DEPTH * DM * INC * 2;
    p.o_wb = o; o += (size_t)DEPTH * 4 * BWID * DM * 2;
    p.o_wo = o; o += (size_t)DEPTH * DM * DM * 2;
    p.o_pw = o; o += (size_t)DEPTH * 4 * 128 * 128 * 2;
    p.o_sw = o; o += (size_t)DEPTH * 4 * 128 * 128 * 2;
    p.o_bar = o; o += 16384;
    p.o_h = o; o += (size_t)p.ts * DM * 2;
    p.o_z = o; o += 4 * (size_t)p.ts * BWID * 2;
    p.o_proj = o; o += (size_t)p.ts * INC * 2;
    if (o > ws_size) { fprintf(stderr, "kernel_launch: workspace too small: need %zu, have %zu\n", o, ws_size); return; }
    const int nph = 1 + DEPTH * NS * 5 + 1;
    if (hipMemsetAsync((char*)d_ws + p.o_bar, 0, 16384, stream) != hipSuccess) { fprintf(stderr, "kernel_launch: memset failed\n"); return; }
#if MULTI_LAUNCH
    for (int ph = 0; ph < nph; ++ph) { p.ph_lo = ph; p.ph_hi = ph + 1; hipLaunchKernelGGL(mk_forward, dim3(grid), dim3(512), LDS_BYTES, stream, p); }
#else
    p.ph_lo = 0; p.ph_hi = nph;
    void* args[] = {&p};
    hipError_t e = hipLaunchCooperativeKernel((const void*)mk_forward, dim3(grid), dim3(512), args, LDS_BYTES, stream);
    if (e != hipSuccess) fprintf(stderr, "cooperative launch failed: %s (grid %d)\n", hipGetErrorString(e), grid);
#endif
}
```

```cpp
#include <hip/hip_runtime.h>
#include <hip/hip_cooperative_groups.h>
#include <cstdio>
namespace cg = cooperative_groups;

#ifndef MULTI_LAUNCH
#define MULTI_LAUNCH 0
#endif

#ifndef REP_N
#define REP_N 1
#endif
#ifndef REP_A
#define REP_A 1
#endif
#ifndef REP_B
#define REP_B 1
#endif
#ifndef REP_C
#define REP_C 1
#endif
#define REP_M0 1
#define REP_M1 1
#define REP_M2 1
#define REP_M3 1
#define LAS __attribute__((address_space(3)))
typedef unsigned short bf16_t;
typedef short bf16x8 __attribute__((ext_vector_type(8)));
typedef float f32x4 __attribute__((ext_vector_type(4)));
typedef float f32x2 __attribute__((ext_vector_type(2)));
typedef unsigned u32x4 __attribute__((ext_vector_type(4)));
typedef unsigned u32x2 __attribute__((ext_vector_type(2)));

constexpr int DM = 1024, SEQ = 2048, NTOK = 32 * 2048, DEPTH = 2, BWID = 512, INC = 10240, GATE0 = 6144;
constexpr int PP = 6144;
constexpr int NS = 2, TS = NTOK / NS;
constexpr int LDS_BYTES = 139264;
constexpr int VP = 1040;

struct Params {
    const float* in[17];
    float* out;
    unsigned char* ws;
    int ts, ns, ph_lo, ph_hi;
    unsigned long long o_win, o_wb, o_wo, o_pw, o_sw, o_h, o_z, o_bar, o_proj;
};

__device__ __forceinline__ int otid() { int t = threadIdx.x; asm volatile("" : "+v"(t)); return t; }
__device__ __forceinline__ unsigned cvt_pk_bf16(float lo, float hi) { unsigned r; asm volatile("v_cvt_pk_bf16_f32 %0, %1, %2" : "=v"(r) : "v"(lo), "v"(hi)); return r; }
__device__ __forceinline__ bf16_t f2bf(float f) { unsigned u = __float_as_uint(f); u += 0x7FFFu + ((u >> 16) & 1u); return (bf16_t)(u >> 16); }
__device__ __forceinline__ void unpack8(const u32x4 v, float (&f)[8]) {
    f[0] = __uint_as_float(v.x << 16); f[1] = __uint_as_float(v.x & 0xffff0000u); f[2] = __uint_as_float(v.y << 16); f[3] = __uint_as_float(v.y & 0xffff0000u);
    f[4] = __uint_as_float(v.z << 16); f[5] = __uint_as_float(v.z & 0xffff0000u); f[6] = __uint_as_float(v.w << 16); f[7] = __uint_as_float(v.w & 0xffff0000u);
}
__device__ __forceinline__ u32x4 pack8(const float (&f)[8]) { u32x4 r; r.x = cvt_pk_bf16(f[0], f[1]); r.y = cvt_pk_bf16(f[2], f[3]); r.z = cvt_pk_bf16(f[4], f[5]); r.w = cvt_pk_bf16(f[6], f[7]); return r; }
__device__ __forceinline__ void unpack4(const u32x2 v, float (&f)[4]) { f[0] = __uint_as_float(v.x << 16); f[1] = __uint_as_float(v.x & 0xffff0000u); f[2] = __uint_as_float(v.y << 16); f[3] = __uint_as_float(v.y & 0xffff0000u); }
__device__ __forceinline__ float sigm(float x) { return __builtin_amdgcn_rcpf(1.0f + __expf(-x)); }
__device__ __forceinline__ float silu(float x) { return x * sigm(x); }
__device__ __forceinline__ void load8f(const float* p, float (&f)[8]) { const f32x4 a = *(const f32x4*)p, b = *(const f32x4*)(p + 4); f[0] = a[0]; f[1] = a[1]; f[2] = a[2]; f[3] = a[3]; f[4] = b[0]; f[5] = b[1]; f[6] = b[2]; f[7] = b[3]; }
__device__ __forceinline__ float wave_sum(float v) {
#pragma unroll
    for (int o = 32; o >= 1; o >>= 1) v += __shfl_xor(v, o);
    return v;
}
__device__ __forceinline__ u32x2 tr_read(unsigned lds_addr) { u32x2 r; asm volatile("ds_read_b64_tr_b16 %0, %1\n\ts_waitcnt lgkmcnt(0)" : "=&v"(r) : "v"(lds_addr) : "memory"); return r; }

namespace pg8 {
constexpr int BM = 256, BK = 64, HALF = 128, HTB = HALF * BK * 2, STAGE_BYTES = 8 * HTB, NXCD = 8, WGM = 8;
__device__ __forceinline__ int lds_byte(int r, int c) { const int st = (r >> 4) * 2 + (c >> 5), rr = r & 15, cc = c & 31, ob = rr * 64 + cc * 2; return st * 1024 + (ob ^ (((ob >> 9) & 1) << 5)); }
__device__ __forceinline__ void stage_rc(int b, int& R, int& C) { const int st = b / 1024, sb = b % 1024, swz = sb ^ (((sb >> 9) & 1) << 5); R = (st >> 1) * 16 + swz / 64; C = (st & 1) * 32 + (swz % 64) / 2; }
__device__ __forceinline__ int perm32(int rho) { const int n = rho >> 4, i = rho & 15; return 8 * (i >> 2) + 4 * n + (i & 3); }

struct Unit { int pm, pn, br; };
struct Gemm { const bf16_t* A; const bf16_t* Bt; };

template <int NM, int NN, int NBR>
struct Order {
    int G, c;
    __device__ __forceinline__ bool next(int i, Unit& u) const {
        constexpr int nwg = NM * NN;
        const int ti = i / NBR;
        const long L = (long)ti * G + c; if (L >= nwg) return false;
        int wgid = (int)L; { constexpr int q = nwg / NXCD, r = nwg % NXCD; const int xcd = wgid % NXCD, off = wgid / NXCD; wgid = (xcd < r ? xcd * (q + 1) : r * (q + 1) + (xcd - r) * q) + off; }
        constexpr int nig = WGM * NN; const int gid = wgid / nig, fm = gid * WGM, gsz = (NM - fm) < WGM ? (NM - fm) : WGM;
        u.pm = fm + ((wgid % nig) % gsz); u.pn = (wgid % nig) / gsz; u.br = i % NBR; return true;
    }
};

struct EpiProj {
    static constexpr bool PERM = true;
    static __device__ __forceinline__ bool zero_after(const Unit&) { return true; }
    bf16_t* O; bf16_t* G;
    __device__ __forceinline__ void operator()(f32x4 (&acc)[2][2][4][2], const Unit& u, int wr, int wc, int fr_, int fq) const {
        int fr = fr_; asm volatile("" : "+v"(fr));
        if (u.pn < GATE0 / BM) {
            const int row0 = u.pm * BM + wr * 64 + fr, col0 = (u.pn & 1) * BM + wc * 32 + 8 * fq;
            bf16_t* Op = O + (size_t)(u.pn >> 1) * TS * BWID;
#pragma unroll
            for (int ai = 0; ai < 2; ++ai)
#pragma unroll
                for (int m = 0; m < 4; ++m) { bf16_t* rowp = Op + (size_t)(row0 + ai * HALF + m * 16) * BWID + col0;
#pragma unroll
                    for (int bj = 0; bj < 2; ++bj) { const f32x4 v0 = acc[ai][bj][m][0], v1 = acc[ai][bj][m][1];
                        u32x4 w; w.x = cvt_pk_bf16(v0[0], v0[1]); w.y = cvt_pk_bf16(v0[2], v0[3]); w.z = cvt_pk_bf16(v1[0], v1[1]); w.w = cvt_pk_bf16(v1[2], v1[3]);
                        __builtin_nontemporal_store(w, (u32x4*)(rowp + bj * HALF)); } }
        } else {
            bf16_t* gb = G + ((size_t)u.pm * 16 + (u.pn - GATE0 / BM)) * 65536 + (((wr * 4 + wc) * 4 + fq) * 16 + fr) * 8;
#pragma unroll
            for (int ai = 0; ai < 2; ++ai)
#pragma unroll
                for (int m = 0; m < 4; ++m)
#pragma unroll
                    for (int bj = 0; bj < 2; ++bj) { const f32x4 v0 = acc[ai][bj][m][0], v1 = acc[ai][bj][m][1];
                        u32x4 w; w.x = cvt_pk_bf16(v0[0], v0[1]); w.y = cvt_pk_bf16(v0[2], v0[3]); w.z = cvt_pk_bf16(v1[0], v1[1]); w.w = cvt_pk_bf16(v1[2], v1[3]);
                        __builtin_nontemporal_store(w, (u32x4*)(gb + ((ai * 4 + m) * 2 + bj) * 4096)); }
        }
    }
};
struct EpiGate {
    static constexpr bool PERM = true;
    static __device__ __forceinline__ bool zero_after(const Unit& u) { return u.br == 3; }
    const bf16_t* G; bf16_t* merged;
    __device__ __forceinline__ void operator()(f32x4 (&acc)[2][2][4][2], const Unit& u, int wr, int wc, int fr_, int fq) const {
        int fr = fr_; asm volatile("" : "+v"(fr));
        const int lrow0 = wr * 64 + fr, lcol0 = wc * 32 + 8 * fq;
        const int br = u.br;
        const bf16_t* gp0 = G + ((size_t)u.pm * 16 + br * 4 + u.pn) * 65536 + (((wr * 4 + wc) * 4 + fq) * 16 + fr) * 8;
        bf16_t* mp0 = merged + ((size_t)u.pm * BM + lrow0) * DM + u.pn * BM + lcol0;
        const bool lastb = (br == 3);
        {
            u32x4 gc[2][4][2];
#pragma unroll
            for (int ai = 0; ai < 2; ++ai)
#pragma unroll
                for (int m = 0; m < 4; ++m)
#pragma unroll
                    for (int bj = 0; bj < 2; ++bj) gc[ai][m][bj] = *(const u32x4*)(gp0 + ((ai * 4 + m) * 2 + bj) * 4096);
#pragma unroll
            for (int ai = 0; ai < 2; ++ai)
#pragma unroll
                for (int m = 0; m < 4; ++m)
#pragma unroll
                    for (int bj = 0; bj < 2; ++bj) {
                        float a[8]; unpack8(gc[ai][m][bj], a);
#pragma unroll
                        for (int j = 0; j < 4; ++j) { acc[ai][bj][m][0][j] *= sigm(a[j]); acc[ai][bj][m][1][j] *= sigm(a[4 + j]); }
                        if (lastb) { const f32x4 v0 = acc[ai][bj][m][0], v1 = acc[ai][bj][m][1];
                            u32x4 w; w.x = cvt_pk_bf16(v0[0], v0[1]); w.y = cvt_pk_bf16(v0[2], v0[3]); w.z = cvt_pk_bf16(v1[0], v1[1]); w.w = cvt_pk_bf16(v1[2], v1[3]);
                            *(u32x4*)(mp0 + (size_t)(ai * HALF + m * 16) * DM + bj * HALF) = w; }
                    }
        }
        asm volatile("" ::: "memory");
        if (!lastb) {
            u32x4 gn[2][4][2];
#pragma unroll
            for (int ai = 0; ai < 2; ++ai)
#pragma unroll
                for (int m = 0; m < 4; ++m)
#pragma unroll
                    for (int bj = 0; bj < 2; ++bj) gn[ai][m][bj] = *(const u32x4*)(gp0 + 4 * 65536 + ((ai * 4 + m) * 2 + bj) * 4096);
#pragma unroll
            for (int ai = 0; ai < 2; ++ai)
#pragma unroll
                for (int m = 0; m < 4; ++m)
#pragma unroll
                    for (int bj = 0; bj < 2; ++bj) {
                        float b[8]; unpack8(gn[ai][m][bj], b);
#pragma unroll
                        for (int j = 0; j < 4; ++j) { acc[ai][bj][m][0][j] *= (1.0f + __expf(-b[j])); acc[ai][bj][m][1][j] *= (1.0f + __expf(-b[4 + j])); }
                    }
        }
    }
};
struct EpiRes {
    static constexpr bool PERM = false;
    static __device__ __forceinline__ bool zero_after(const Unit&) { return true; }
    const float* res; float* C; int ldc;
    __device__ __forceinline__ void operator()(const f32x4 (&acc)[2][2][4][2], const Unit& u, int wr, int wc, int fr_, int fq) const {
        int fr = fr_; asm volatile("" : "+v"(fr));
        const int row0 = u.pm * BM + wr * 64 + fr, col0 = u.pn * BM + wc * 32 + 4 * fq;
#pragma unroll
        for (int ai = 0; ai < 2; ++ai)
#pragma unroll
            for (int m = 0; m < 4; ++m) { const size_t off = (size_t)(row0 + ai * HALF + m * 16) * ldc + col0;
                f32x4 rv[2][2];
#pragma unroll
                for (int bj = 0; bj < 2; ++bj)
#pragma unroll
                    for (int n = 0; n < 2; ++n) rv[bj][n] = *(const f32x4*)(res + off + bj * HALF + n * 16);
#pragma unroll
                for (int bj = 0; bj < 2; ++bj)
#pragma unroll
                    for (int n = 0; n < 2; ++n) *(f32x4*)(C + off + bj * HALF + n * 16) = acc[ai][bj][m][n] + rv[bj][n]; }
    }
};

template <int K, size_t A_BR, size_t B_BR, class Epi, class Sched>
__device__ __forceinline__ void gemm_phase(LAS unsigned char* lds, const Gemm g, const Sched& S, const Epi& E) {
    const int tid = otid(), wid = __builtin_amdgcn_readfirstlane(tid >> 6), lane = tid & 63, wr = wid >> 2, wc = wid & 3, fr = lane & 15, fq = lane >> 4;
    constexpr int nt = K / BK;
    unsigned voffA[2], voffB[2];
#pragma unroll
    for (int i = 0; i < 2; ++i) { int R, C; stage_rc(tid * 16 + i * 8192, R, C); const int Rb = Epi::PERM ? ((R & ~31) + perm32(R & 31)) : R;
        voffA[i] = (unsigned)(R * K + C) * 2u; voffB[i] = (unsigned)(Rb * K + C) * 2u; }
    constexpr size_t kstep = (size_t)(BK * 2);
    constexpr size_t hstep = (size_t)HALF * K * 2;
    constexpr size_t tstep = 2 * hstep;
    const unsigned ldsw = (unsigned)wid * 1024u;
    const int aoff = lds_byte(wr * 64 + fr, fq * 8), boff = lds_byte(wc * 32 + fr, fq * 8);
#define PG8_SA(b, h) (((b) * 2 + (h)) * HTB)
#define PG8_SB(b, h) ((4 + (b) * 2 + (h)) * HTB)
#define PG8_STAGE(bufoff, gbase, voff) do { _Pragma("unroll") for (int _i = 0; _i < 2; ++_i) \
        __builtin_amdgcn_global_load_lds((const unsigned*)((const char*)(gbase) + (voff)[_i]), (LAS unsigned*)(lds + (bufoff) + ldsw + _i * 8192), 16, 0, 0); } while (0)
#define PG8_LDA(dst, b, h) do { _Pragma("unroll") for (int m = 0; m < 4; ++m) _Pragma("unroll") for (int k = 0; k < 2; ++k) dst[m][k] = *(const LAS bf16x8*)(lds + PG8_SA(b, h) + aoff + m * 2048 + k * 1024); } while (0)
#define PG8_LDB(dst, b, h) do { _Pragma("unroll") for (int n = 0; n < 2; ++n) _Pragma("unroll") for (int k = 0; k < 2; ++k) dst[n][k] = *(const LAS bf16x8*)(lds + PG8_SB(b, h) + boff + n * 2048 + k * 1024); } while (0)
#define PG8_MMA(ai, bj, At, Bt) do { __builtin_amdgcn_s_setprio(1); _Pragma("unroll") for (int m = 0; m < 4; ++m) _Pragma("unroll") for (int n = 0; n < 2; ++n) _Pragma("unroll") for (int k = 0; k < 2; ++k) \
        acc[ai][bj][m][n] = __builtin_amdgcn_mfma_f32_16x16x32_bf16(Bt[n][k], At[m][k], acc[ai][bj][m][n], 0, 0, 0); __builtin_amdgcn_s_setprio(0); } while (0)
#define PG8_WAIT_V(n) asm volatile("s_waitcnt vmcnt(" #n ")" ::: "memory")
#define PG8_WAIT_L(n) asm volatile("s_waitcnt lgkmcnt(" #n ")" ::: "memory")
#define PG8_BAR __builtin_amdgcn_s_barrier()
#define PG8_SCHED __builtin_amdgcn_sched_barrier(0)
    Unit cur, nxt; int ui = 0;
    if (!S.next(0, cur)) return;
    f32x4 acc[2][2][4][2];
#pragma unroll
    for (int a = 0; a < 2; ++a)
#pragma unroll
        for (int b = 0; b < 2; ++b)
#pragma unroll
            for (int m = 0; m < 4; ++m)
#pragma unroll
                for (int n = 0; n < 2; ++n) acc[a][b][m][n] = (f32x4){0.f, 0.f, 0.f, 0.f};
    bf16x8 At[4][2], B0[2][2], B1[2][2];
    const char* cA = (const char*)g.A + (size_t)cur.pm * tstep + (size_t)cur.br * A_BR; const char* cB = (const char*)g.Bt + (size_t)cur.pn * tstep + (size_t)cur.br * B_BR;
    PG8_STAGE(PG8_SB(0, 0), cB, voffB); PG8_STAGE(PG8_SA(0, 0), cA, voffA); PG8_STAGE(PG8_SB(0, 1), cB + hstep, voffB); PG8_STAGE(PG8_SA(0, 1), cA + hstep, voffA);
    if (wr == 1) PG8_BAR;
    PG8_WAIT_V(4); PG8_BAR;
    PG8_STAGE(PG8_SB(1, 0), cB + kstep, voffB); PG8_STAGE(PG8_SA(1, 0), cA + kstep, voffA); PG8_STAGE(PG8_SB(1, 1), cB + hstep + kstep, voffB);
    PG8_WAIT_V(6); PG8_BAR;
    for (;;) {
        const bool has_next = S.next(ui + 1, nxt);
        const char* nA = has_next ? (const char*)g.A + (size_t)nxt.pm * tstep + (size_t)nxt.br * A_BR : cA; const char* nB = has_next ? (const char*)g.Bt + (size_t)nxt.pn * tstep + (size_t)nxt.br * B_BR : cB;
        for (int t = 0; t < nt; t += 2) {
            const bool last = (t == nt - 2);
            const char* a1 = cA + (size_t)(t + 1) * kstep;
            const char* a2 = last ? nA : cA + (size_t)(t + 2) * kstep; const char* b2 = last ? nB : cB + (size_t)(t + 2) * kstep;
            const char* a3 = a2 + kstep; const char* b3 = b2 + kstep;
            PG8_LDB(B0, 0, 0); PG8_SCHED; PG8_LDA(At, 0, 0); PG8_STAGE(PG8_SA(1, 1), a1 + hstep, voffA);
            PG8_WAIT_L(8); PG8_BAR; PG8_WAIT_L(0); PG8_MMA(0, 0, At, B0); PG8_BAR; PG8_SCHED;
            PG8_LDB(B1, 0, 1); PG8_STAGE(PG8_SB(0, 0), b2, voffB);
            PG8_BAR; PG8_WAIT_L(0); PG8_MMA(0, 1, At, B1); PG8_BAR;
            PG8_LDA(At, 0, 1); PG8_STAGE(PG8_SA(0, 0), a2, voffA);
            PG8_BAR; PG8_WAIT_L(0); PG8_MMA(1, 0, At, B0); PG8_BAR; PG8_SCHED;
            PG8_STAGE(PG8_SB(0, 1), b2 + hstep, voffB);
            PG8_WAIT_V(6); PG8_BAR; PG8_MMA(1, 1, At, B1); PG8_BAR;
            PG8_LDB(B0, 1, 0); PG8_SCHED; PG8_LDA(At, 1, 0); PG8_STAGE(PG8_SA(0, 1), a2 + hstep, voffA);
            PG8_WAIT_L(8); PG8_BAR; PG8_WAIT_L(0); PG8_MMA(0, 0, At, B0); PG8_BAR; PG8_SCHED;
            PG8_LDB(B1, 1, 1); PG8_STAGE(PG8_SB(1, 0), b3, voffB);
            PG8_BAR; PG8_WAIT_L(0); PG8_MMA(0, 1, At, B1); PG8_BAR;
            PG8_LDA(At, 1, 1); PG8_STAGE(PG8_SA(1, 0), a3, voffA);
            PG8_BAR; PG8_WAIT_L(0); PG8_MMA(1, 0, At, B0); PG8_BAR; PG8_SCHED;
            PG8_STAGE(PG8_SB(1, 1), b3 + hstep, voffB);
            PG8_WAIT_V(6); PG8_BAR; PG8_MMA(1, 1, At, B1); PG8_BAR;
        }
        E(acc, cur, wr, wc, fr, fq);
        if (!has_next) break;
        if (Epi::zero_after(cur))
#pragma unroll
        for (int a = 0; a < 2; ++a)
#pragma unroll
            for (int b = 0; b < 2; ++b)
#pragma unroll
                for (int m = 0; m < 4; ++m)
#pragma unroll
                    for (int n = 0; n < 2; ++n) acc[a][b][m][n] = (f32x4){0.f, 0.f, 0.f, 0.f};
        cur = nxt; cA = nA; cB = nB; ++ui;
    }
    PG8_WAIT_V(0);
    if (wr == 0) PG8_BAR;
    PG8_BAR;
#undef PG8_SA
#undef PG8_SB
#undef PG8_STAGE
#undef PG8_LDA
#undef PG8_LDB
#undef PG8_MMA
#undef PG8_WAIT_V
#undef PG8_WAIT_L
#undef PG8_BAR
#undef PG8_SCHED
}
}

__device__ __forceinline__ void transpose_tile(const float* __restrict__ src, int R, int C, bf16_t* __restrict__ dst, int tr, int tc, LAS float* sm) {
    const int tid = otid();
#pragma unroll
    for (int i = 0; i < 8; ++i) { const int idx = tid + 512 * i, r = idx >> 6, c = idx & 63; sm[r * 65 + c] = src[(size_t)(tr * 64 + r) * C + tc * 64 + c]; }
    __syncthreads();
#pragma unroll
    for (int i = 0; i < 8; ++i) { const int idx = tid + 512 * i, c = idx >> 6, r = idx & 63; dst[(size_t)(tc * 64 + c) * R + tr * 64 + r] = f2bf(sm[r * 65 + c]); }
    __syncthreads();
}
__device__ void phase_prep(const Params& p, LAS unsigned char* lds) {
    LAS float* sm = (LAS float*)lds;
    bf16_t* win = (bf16_t*)(p.ws + p.o_win); bf16_t* wb = (bf16_t*)(p.ws + p.o_wb); bf16_t* wo = (bf16_t*)(p.ws + p.o_wo); bf16_t* pw = (bf16_t*)(p.ws + p.o_pw); bf16_t* sw = (bf16_t*)(p.ws + p.o_sw);
    constexpr int T_WIN = 16 * 160, T_WB = 8 * 16, T_WO = 16 * 16, T_PW = 4;
    constexpr int N0 = DEPTH * T_WIN, N1 = N0 + 8 * T_WB, N2 = N1 + DEPTH * T_WO, N3 = N2 + 8 * T_PW;
    for (int i = blockIdx.x; i < N3; i += gridDim.x) {
        if (i < N0) { const int l = i / T_WIN, t = i % T_WIN; transpose_tile(p.in[2] + (size_t)l * DM * INC, DM, INC, win + (size_t)l * DM * INC, t / 160, t % 160, sm); }
        else if (i < N1) { const int j = i - N0, m = j / T_WB, t = j % T_WB; transpose_tile(p.in[14] + (size_t)m * BWID * DM, BWID, DM, wb + (size_t)m * BWID * DM, t / 16, t % 16, sm); }
        else if (i < N2) { const int j = i - N1, l = j / T_WO, t = j % T_WO; transpose_tile(p.in[15] + (size_t)l * DM * DM, DM, DM, wo + (size_t)l * DM * DM, t / 16, t % 16, sm); }
        else { const int j = i - N2, m = j / T_PW, t = j % T_PW; transpose_tile(p.in[3] + (size_t)m * 128 * 128, 128, 128, pw + (size_t)m * 128 * 128, t / 2, t % 2, sm); }
    }
    const float* sgw = p.in[11];
    for (int i = blockIdx.x * 512 + otid(); i < DEPTH * 4 * 128 * 128; i += gridDim.x * 512) { const int s = i & 127, t = (i >> 7) & 127; sw[i] = (s <= t) ? f2bf(sgw[i]) : (bf16_t)0; }
}

__device__ void phase_norm_bf16(const float* __restrict__ xin, const float* __restrict__ g, bf16_t* __restrict__ h, int rows) {
    const int tid = otid(), lane = tid & 63, w = tid >> 6;
    float gv[2][8];
    load8f(g + 8 * lane, gv[0]); load8f(g + 512 + 8 * lane, gv[1]);
    for (int row = blockIdx.x * 8 + w; row < rows; row += gridDim.x * 8) {
        const float* xr = xin + (size_t)row * DM + 8 * lane;
        float v[2][8]; load8f(xr, v[0]); load8f(xr + 512, v[1]);
        float ss = 0.f;
#pragma unroll
        for (int i = 0; i < 2; ++i)
#pragma unroll
            for (int j = 0; j < 8; ++j) ss += v[i][j] * v[i][j];
        ss = wave_sum(ss);
        const float r = rsqrtf(ss * (1.0f / 1024.0f) + 1e-6f);
#pragma unroll
        for (int i = 0; i < 2; ++i) { float o[8];
#pragma unroll
            for (int j = 0; j < 8; ++j) o[j] = v[i][j] * r * gv[i][j];
            *(u32x4*)(h + (size_t)row * DM + 512 * i + 8 * lane) = pack8(o); }
    }
}
__device__ void phase_norm_final(float* __restrict__ x, const float* __restrict__ g, int rows) {
    const int tid = otid(), lane = tid & 63, w = tid >> 6;
    float gv[2][8];
    load8f(g + 8 * lane, gv[0]); load8f(g + 512 + 8 * lane, gv[1]);
    for (int row = blockIdx.x * 8 + w; row < rows; row += gridDim.x * 8) {
        float* xr = x + (size_t)row * DM + 8 * lane;
        float v[2][8]; load8f(xr, v[0]); load8f(xr + 512, v[1]);
        float ss = 0.f;
#pragma unroll
        for (int i = 0; i < 2; ++i)
#pragma unroll
            for (int j = 0; j < 8; ++j) ss += v[i][j] * v[i][j];
        ss = wave_sum(ss);
        const float r = rsqrtf(ss * (1.0f / 1024.0f) + 1e-6f);
#pragma unroll
        for (int i = 0; i < 2; ++i) {
            f32x4 a, b;
#pragma unroll
            for (int j = 0; j < 4; ++j) { a[j] = v[i][j] * r * gv[i][j]; b[j] = v[i][4 + j] * r * gv[i][4 + j]; }
            *(f32x4*)(xr + 512 * i) = a; *(f32x4*)(xr + 512 * i + 4) = b; }
    }
}

#define PO(k) ((size_t)(k) * TS * BWID)
__device__ void mix_sc(const Params& p, int l, const bf16_t* __restrict__ proj, bf16_t* __restrict__ z3, int r0, int pos0) {
    const int tid = otid(), lane = tid & 63, w = tid >> 6, c0 = lane * 8;
    const float* scw = p.in[13] + (size_t)l * 3 * BWID + c0;
    float w0[8], w1[8], w2[8]; load8f(scw, w0); load8f(scw + BWID, w1); load8f(scw + 2 * BWID, w2);
    const int r = r0 + 16 * w, pos = pos0 + 16 * w;
    float p2[8], p1[8];
    if (pos > 0) {
        float a[8], b[8];
        unpack8(*(const u32x4*)(proj + (size_t)(r - 2) * BWID + PO(9) + c0), a); unpack8(*(const u32x4*)(proj + (size_t)(r - 2) * BWID + PO(10) + c0), b);
#pragma unroll
        for (int j = 0; j < 8; ++j) p2[j] = a[j] * b[j];
        unpack8(*(const u32x4*)(proj + (size_t)(r - 1) * BWID + PO(9) + c0), a); unpack8(*(const u32x4*)(proj + (size_t)(r - 1) * BWID + PO(10) + c0), b);
#pragma unroll
        for (int j = 0; j < 8; ++j) p1[j] = a[j] * b[j];
    } else {
#pragma unroll
        for (int j = 0; j < 8; ++j) { p2[j] = 0.f; p1[j] = 0.f; }
    }
#pragma unroll 4
    for (int jj = 0; jj < 16; ++jj) {
        const bf16_t* pr = proj + (size_t)(r + jj) * BWID + c0;
        float vb[8], vc[8], vx[8], vg[8], o[8];
        unpack8(*(const u32x4*)(pr + PO(8)), vb); unpack8(*(const u32x4*)(pr + PO(9)), vc); unpack8(*(const u32x4*)(pr + PO(10)), vx); unpack8(*(const u32x4*)(pr + PO(11)), vg);
#pragma unroll
        for (int j = 0; j < 8; ++j) { const float cur = vc[j] * vx[j]; const float cv = w0[j] * p2[j] + w1[j] * p1[j] + w2[j] * cur; o[j] = vb[j] * cv * silu(vg[j]); p2[j] = p1[j]; p1[j] = cur; }
        *(u32x4*)(z3 + (size_t)(r + jj) * BWID + c0) = pack8(o);
    }
}

__device__ void mix_conv(const Params& p, int l, const bf16_t* __restrict__ proj, bf16_t* __restrict__ z1, int r0, int pos0, LAS unsigned char* lds) {
    const int tid = otid(), lane = tid & 63, w = tid >> 6, c0 = lane * 8;
    LAS unsigned char* Y = lds; LAS unsigned char* W = lds + 94 * VP;
    const float* cw = p.in[5] + (size_t)l * 31 * BWID;
    for (int i = tid; i < 31 * 64; i += 512) { const int k = i >> 6, cgp = i & 63; float f[8]; load8f(cw + k * BWID + cgp * 8, f); *(LAS u32x4*)(W + k * 1024 + cgp * 16) = pack8(f); }
    float bias[8], lng[8], lnb[8];
    load8f(p.in[6] + (size_t)l * BWID + c0, bias); load8f(p.in[7] + (size_t)l * BWID + c0, lng); load8f(p.in[8] + (size_t)l * BWID + c0, lnb);
    for (int q = 0; q < 2; ++q) {
        const int tr = r0 + 64 * q, tp = pos0 + 64 * q;
        __syncthreads();
        {
            u32x4 la[12], lb[12];
#pragma unroll
            for (int i = 0; i < 12; ++i) { const int row = 12 * w + i; const bool valid = (row < 94) && (tp - 30 + row >= 0);
                la[i] = (u32x4){0u, 0u, 0u, 0u}; lb[i] = la[i];
                if (valid) { const bf16_t* pr = proj + (size_t)(tr - 30 + row) * BWID + c0; la[i] = *(const u32x4*)(pr + PO(2)); lb[i] = *(const u32x4*)(pr + PO(3)); } }
#pragma unroll
            for (int i = 0; i < 12; ++i) { const int row = 12 * w + i;
                if (row < 94) { float a[8], b[8], y[8]; unpack8(la[i], a); unpack8(lb[i], b);
#pragma unroll
                    for (int j = 0; j < 8; ++j) y[j] = a[j] * sigm(b[j]);
                    *(LAS u32x4*)(Y + row * VP + lane * 16) = pack8(y); } }
        }
        __syncthreads();
        u32x4 gtv[8];
#pragma unroll
        for (int j = 0; j < 8; ++j) gtv[j] = *(const u32x4*)(proj + (size_t)(tr + 8 * w + j) * BWID + PO(4) + c0);
        float acc[8][8];
#pragma unroll
        for (int j = 0; j < 8; ++j)
#pragma unroll
            for (int c = 0; c < 8; ++c) acc[j][c] = bias[c];
#pragma unroll 1
        for (int k = 0; k < 31; ++k) {
            float wv[8]; unpack8(*(const LAS u32x4*)(W + k * 1024 + lane * 16), wv);
#pragma unroll
            for (int j = 0; j < 8; ++j) { float yv[8]; unpack8(*(const LAS u32x4*)(Y + (8 * w + j + k) * VP + lane * 16), yv);
#pragma unroll
                for (int c = 0; c < 8; ++c) acc[j][c] += wv[c] * yv[c]; }
        }
#pragma unroll
        for (int j = 0; j < 8; ++j) {
            float s = 0.f, ss = 0.f;
#pragma unroll
            for (int c = 0; c < 8; ++c) { s += acc[j][c]; ss += acc[j][c] * acc[j][c]; }
            s = wave_sum(s); ss = wave_sum(ss);
            const float mean = s * (1.0f / 512.0f); const float var = fmaxf(ss * (1.0f / 512.0f) - mean * mean, 0.f); const float rstd = rsqrtf(var + 1e-5f);
            const int row = tr + 8 * w + j;
            float gt[8], o[8]; unpack8(gtv[j], gt);
#pragma unroll
            for (int c = 0; c < 8; ++c) { const float v = (acc[j][c] - mean) * rstd * lng[c] + lnb[c]; o[c] = silu(v) * silu(gt[c]); }
            *(u32x4*)(z1 + (size_t)row * BWID + c0) = pack8(o);
        }
    }
}

__device__ __forceinline__ u32x4 sel4(bool c, const u32x4 a, const u32x4 b) { u32x4 r; r.x = c ? a.x : b.x; r.y = c ? a.y : b.y; r.z = c ? a.z : b.z; r.w = c ? a.w : b.w; return r; }

__device__ void mix_pool(const Params& p, int l, const bf16_t* __restrict__ proj, bf16_t* __restrict__ z0, int r0, int pos0, LAS unsigned char* lds) {
    const int tid = otid(), lane = tid & 63, w = tid >> 6, c0 = lane * 8;
    LAS unsigned char* P = lds;
    {
        const int g4 = lane >> 4, win = 2 << g4;
        const int r = r0 + 16 * w, pos = pos0 + 16 * w;
        u32x4 R[32];
#pragma unroll
        for (int i = 0; i < 16; ++i) { R[i] = (u32x4){0u, 0u, 0u, 0u}; if (pos > 0) R[i] = *(const u32x4*)(proj + (size_t)(r - 16 + i) * BWID + c0); }
#pragma unroll
        for (int i = 0; i < 16; ++i) R[16 + i] = *(const u32x4*)(proj + (size_t)(r + i) * BWID + c0);
        float S[8];
#pragma unroll
        for (int j = 0; j < 8; ++j) S[j] = 0.f;
#pragma unroll
        for (int i = 1; i <= 16; ++i) { float x[8]; unpack8(R[16 - i], x); const float mk = (i <= win) ? 1.0f : 0.0f;
#pragma unroll
            for (int j = 0; j < 8; ++j) S[j] += mk * x[j]; }
#pragma unroll
        for (int jj = 0; jj < 16; ++jj) {
            const int ps = pos + jj; float xv[8], xo[8], o[8];
            unpack8(R[16 + jj], xv);
            const u32x4 ro = sel4(g4 < 2, sel4(g4 == 0, R[16 + jj - 2], R[16 + jj - 4]), sel4(g4 == 2, R[16 + jj - 8], R[jj]));
            unpack8(ro, xo);
            const int cnt = (ps + 1 < win) ? ps + 1 : win; const float inv = 1.0f / (float)cnt;
#pragma unroll
            for (int j = 0; j < 8; ++j) { S[j] += xv[j] - xo[j]; o[j] = S[j] * inv - xv[j]; }
            *(LAS u32x4*)(P + (16 * w + jj) * VP + lane * 16) = pack8(o);
        }
    }
    __syncthreads();
    {
        const int g = w >> 1, fr = lane & 15, fq = lane >> 4;
        const bf16_t* pwT = (const bf16_t*)(p.ws + p.o_pw) + (size_t)(l * 4 + g) * 128 * 128;
        u32x2 gtv[8][4];
#pragma unroll
        for (int tt = 0; tt < 8; ++tt)
#pragma unroll
            for (int dt = 0; dt < 4; ++dt) gtv[tt][dt] = *(const u32x2*)(proj + (size_t)(r0 + 16 * tt + fr) * BWID + PO(1) + 64 * w + 16 * dt + 4 * fq);
        bf16x8 A[4][4];
#pragma unroll
        for (int dt = 0; dt < 4; ++dt)
#pragma unroll
            for (int kk = 0; kk < 4; ++kk) A[dt][kk] = *(const bf16x8*)(pwT + (size_t)(64 * (w & 1) + 16 * dt + fr) * 128 + 32 * kk + 8 * fq);
        const float* psc = p.in[4] + (size_t)l * BWID;
        f32x4 sc[4];
#pragma unroll
        for (int dt = 0; dt < 4; ++dt) sc[dt] = *(const f32x4*)(psc + 64 * w + 16 * dt + 4 * fq);
#pragma unroll
        for (int tt = 0; tt < 8; ++tt) {
            bf16x8 Bf[4];
#pragma unroll
            for (int kk = 0; kk < 4; ++kk) Bf[kk] = *(const LAS bf16x8*)(P + (16 * tt + fr) * VP + (128 * g + 32 * kk + 8 * fq) * 2);
            f32x4 acc[4];
#pragma unroll
            for (int dt = 0; dt < 4; ++dt) { acc[dt] = (f32x4){0.f, 0.f, 0.f, 0.f};
#pragma unroll
                for (int kk = 0; kk < 4; ++kk) acc[dt] = __builtin_amdgcn_mfma_f32_16x16x32_bf16(A[dt][kk], Bf[kk], acc[dt], 0, 0, 0); }
            const int row = r0 + 16 * tt + fr;
#pragma unroll
            for (int dt = 0; dt < 4; ++dt) { const int d = 64 * w + 16 * dt + 4 * fq;
                float gt[4]; unpack4(gtv[tt][dt], gt);
                u32x2 o; o.x = cvt_pk_bf16(acc[dt][0] * sc[dt][0] * silu(gt[0]), acc[dt][1] * sc[dt][1] * silu(gt[1])); o.y = cvt_pk_bf16(acc[dt][2] * sc[dt][2] * silu(gt[2]), acc[dt][3] * sc[dt][3] * silu(gt[3]));
                *(u32x2*)(z0 + (size_t)row * BWID + d) = o; }
        }
    }
}

__device__ void mix_sgu(const Params& p, int l, const bf16_t* __restrict__ proj, bf16_t* __restrict__ z2, int r0, LAS unsigned char* lds) {
    const int tid = otid(), lane = tid & 63, w = tid >> 6, c0 = lane * 8;
    LAS unsigned char* V = lds;
    {
        float lng[8], lnb[8]; load8f(p.in[9] + (size_t)l * BWID + c0, lng); load8f(p.in[10] + (size_t)l * BWID + c0, lnb);
        u32x4 R[16];
#pragma unroll
        for (int jj = 0; jj < 16; ++jj) R[jj] = *(const u32x4*)(proj + (size_t)(r0 + 16 * w + jj) * BWID + PO(6) + c0);
#pragma unroll
        for (int jj = 0; jj < 16; ++jj) {
            float x[8], o[8]; unpack8(R[jj], x);
            float s = 0.f, ss = 0.f;
#pragma unroll
            for (int c = 0; c < 8; ++c) { s += x[c]; ss += x[c] * x[c]; }
            s = wave_sum(s); ss = wave_sum(ss);
            const float mean = s * (1.0f / 512.0f); const float var = fmaxf(ss * (1.0f / 512.0f) - mean * mean, 0.f); const float rstd = rsqrtf(var + 1e-5f);
#pragma unroll
            for (int c = 0; c < 8; ++c) o[c] = (x[c] - mean) * rstd * lng[c] + lnb[c];
            *(LAS u32x4*)(V + (16 * w + jj) * VP + lane * 16) = pack8(o);
        }
    }
    __syncthreads();
    {
        const int g = w >> 1, fr = lane & 15, fq = lane >> 4;
        const unsigned vbase = (unsigned)(size_t)V;
        bf16x8 A[4][4];
#pragma unroll
        for (int ct = 0; ct < 4; ++ct)
#pragma unroll
            for (int kk = 0; kk < 4; ++kk) {
                const unsigned a = vbase + (unsigned)((32 * kk + 8 * fq + (fr >> 2)) * VP + (64 * w + 16 * ct + 4 * (fr & 3)) * 2);
                const u32x2 lo = tr_read(a), hi = tr_read(a + 4 * VP);
                u32x4 t; t.x = lo.x; t.y = lo.y; t.z = hi.x; t.w = hi.y;
                A[ct][kk] = __builtin_bit_cast(bf16x8, t);
            }
        const bf16_t* swm = (const bf16_t*)(p.ws + p.o_sw) + (size_t)(l * 4 + g) * 128 * 128;
        const float* sb = p.in[12] + (size_t)(l * 4 + g) * 128;
#pragma unroll
        for (int hb = 0; hb < 2; ++hb) {
            u32x2 uu[4][4], gg[4][4]; bf16x8 Wf[4][4]; float bias[4];
#pragma unroll
            for (int t4 = 0; t4 < 4; ++t4) { const int tt = hb * 4 + t4; const bf16_t* pr = proj + (size_t)(r0 + 16 * tt + fr) * BWID + 64 * w + 4 * fq;
#pragma unroll
                for (int ct = 0; ct < 4; ++ct) { uu[t4][ct] = *(const u32x2*)(pr + PO(5) + 16 * ct); gg[t4][ct] = *(const u32x2*)(pr + PO(7) + 16 * ct); }
#pragma unroll
                for (int kk = 0; kk < 4; ++kk) if (kk < (tt >> 1) + 1) Wf[t4][kk] = *(const bf16x8*)(swm + (size_t)(16 * tt + fr) * 128 + 32 * kk + 8 * fq);
                bias[t4] = sb[16 * tt + fr]; }
#pragma unroll
            for (int t4 = 0; t4 < 4; ++t4) { const int tt = hb * 4 + t4;
                f32x4 acc[4];
#pragma unroll
                for (int ct = 0; ct < 4; ++ct) acc[ct] = (f32x4){0.f, 0.f, 0.f, 0.f};
#pragma unroll
                for (int kk = 0; kk < 4; ++kk) if (kk < (tt >> 1) + 1) {
#pragma unroll
                    for (int ct = 0; ct < 4; ++ct) acc[ct] = __builtin_amdgcn_mfma_f32_16x16x32_bf16(A[ct][kk], Wf[t4][kk], acc[ct], 0, 0, 0); }
                const int row = r0 + 16 * tt + fr;
#pragma unroll
                for (int ct = 0; ct < 4; ++ct) { const int c = 64 * w + 16 * ct + 4 * fq;
                    float u[4], gt[4]; unpack4(uu[t4][ct], u); unpack4(gg[t4][ct], gt);
                    u32x2 o; o.x = cvt_pk_bf16(u[0] * (acc[ct][0] + bias[t4]) * silu(gt[0]), u[1] * (acc[ct][1] + bias[t4]) * silu(gt[1])); o.y = cvt_pk_bf16(u[2] * (acc[ct][2] + bias[t4]) * silu(gt[2]), u[3] * (acc[ct][3] + bias[t4]) * silu(gt[3]));
                    *(u32x2*)(z2 + (size_t)row * BWID + c) = o; }
            }
        }
    }
}

__device__ void phase_mix(const Params& p, int l, const bf16_t* proj, bf16_t* z, LAS unsigned char* lds) {
    constexpr int nchunk = TS / 128;
    constexpr size_t zs = (size_t)TS * BWID;
    for (int i = blockIdx.x; i < 4 * nchunk; i += gridDim.x) {
        const int br = i / nchunk, j = i % nchunk, r0 = j * 128, pos0 = (j & 15) * 128;
        if (br == 0) for (int rr = 0; rr < REP_M0; ++rr) { mix_pool(p, l, proj, z, r0, pos0, lds); __syncthreads(); }
        else if (br == 1) for (int rr = 0; rr < REP_M1; ++rr) { mix_conv(p, l, proj, z + zs, r0, pos0, lds); __syncthreads(); }
        else if (br == 2) for (int rr = 0; rr < REP_M2; ++rr) { mix_sgu(p, l, proj, z + 2 * zs, r0, lds); __syncthreads(); }
        else for (int rr = 0; rr < REP_M3; ++rr) { mix_sc(p, l, proj, z + 3 * zs, r0, pos0); __syncthreads(); }
    }
}

#define XB_TMO      128
#define XB_XCNT(j)  (256  + 64 * (j))
#define XB_XSUB(j)  (1280 + 64 * (j))
#define XB_XGEN(j)  (2304 + 64 * (j))
#define XB_TOP      3328
#define XB_TOPGEN   3392
#define XCD_BAR_WORDS 3456
#define XB_SPIN_CAP (1u << 20)
__device__ __forceinline__ unsigned xb_ld(unsigned* p)              { return __hip_atomic_load(p, __ATOMIC_RELAXED, __HIP_MEMORY_SCOPE_AGENT); }
__device__ __forceinline__ unsigned xb_add(unsigned* p, unsigned v) { return __hip_atomic_fetch_add(p, v, __ATOMIC_RELAXED, __HIP_MEMORY_SCOPE_AGENT); }
__device__ __forceinline__ unsigned xb_xcc_id() { return (unsigned)__builtin_amdgcn_s_getreg((3 << 11) | 20) & 0xFu; }
#define XB_SPIN(cond, bar) do { unsigned _sp = 0; while (cond) { __builtin_amdgcn_s_sleep(1); \
    if ((++_sp & 255u) == 0u) { if (xb_ld(&(bar)[XB_TMO])) break; if (_sp > XB_SPIN_CAP) { atomicAdd(&(bar)[XB_TMO], 1u); break; } } } } while (0)
struct XcdBarrier { unsigned* bar; unsigned x; volatile LAS unsigned* st; };
__device__ __forceinline__ XcdBarrier xcd_barrier_post(unsigned* bar, volatile LAS unsigned* st) {
    XcdBarrier b; b.bar = bar; b.x = xb_xcc_id(); b.st = st;
    if (threadIdx.x == 0) (void)xb_add(&bar[XB_XCNT(b.x)], 1u);
    return b;
}
__device__ __forceinline__ void xcd_barrier_complete(unsigned* bar, unsigned x, unsigned& nloc, unsigned& nx) {
    const unsigned G = gridDim.x * gridDim.y * gridDim.z;
    unsigned sum, cnt, mine, sp = 0u;
    for (;;) {
        sum = 0u; cnt = 0u; mine = 0u;
#pragma unroll
        for (unsigned j = 0; j < 16; ++j) { const unsigned c = xb_ld(&bar[XB_XCNT(j)]); sum += c; cnt += (c > 0u) ? 1u : 0u; mine = (j == x) ? c : mine; }
        if (sum == G) break;
        __builtin_amdgcn_s_sleep(1);
        if ((++sp & 255u) == 0u) { if (xb_ld(&bar[XB_TMO])) break; if (sp > XB_SPIN_CAP) { atomicAdd(&bar[XB_TMO], 1u); break; } }
    }
    nloc = mine > 0u ? mine : 1u; nx = cnt > 0u ? cnt : 1u;
}
__device__ __forceinline__ void xcd_barrier(const XcdBarrier& b) {
    asm volatile("s_waitcnt vmcnt(0)" ::: "memory");
    __syncthreads();
    if (threadIdx.x == 0) {
        unsigned* bar = b.bar;
        __builtin_amdgcn_s_waitcnt(0);
        unsigned nloc = b.st[0], nx = b.st[1];
        if (nloc == 0u) { xcd_barrier_complete(bar, b.x, nloc, nx); b.st[0] = nloc; b.st[1] = nx; }
        const unsigned old = xb_add(&bar[XB_XSUB(b.x)], 1u);
        const unsigned gen = old / nloc;
        if (old + 1u == (gen + 1u) * nloc) {
            __builtin_amdgcn_fence(__ATOMIC_RELEASE, "agent");
            asm volatile("s_waitcnt vmcnt(0)" ::: "memory");
            const unsigned og = xb_add(&bar[XB_TOP], 1u);
            const unsigned tg = og / nx;
            if (og + 1u == (tg + 1u) * nx) xb_add(&bar[XB_TOPGEN], 1u);
            else XB_SPIN(xb_ld(&bar[XB_TOPGEN]) == tg, bar);
            __builtin_amdgcn_fence(__ATOMIC_ACQUIRE, "agent");
            xb_add(&bar[XB_XGEN(b.x)], 1u);
            asm volatile("s_waitcnt vmcnt(0)" ::: "memory");
        } else {
            XB_SPIN(xb_ld(&bar[XB_XGEN(b.x)]) == gen, bar);
            __builtin_amdgcn_fence(__ATOMIC_ACQUIRE, "agent");
            asm volatile("s_waitcnt vmcnt(0)" ::: "memory");
        }
    }
    __syncthreads();
}

__global__ void __launch_bounds__(512) mk_forward(Params p) {
    extern __shared__ __attribute__((aligned(16))) unsigned char lds_raw[];
    LAS unsigned char* lds = (LAS unsigned char*)lds_raw;
    cg::grid_group grid = cg::this_grid();
    volatile LAS unsigned* stw = (volatile LAS unsigned*)(lds + LDS_BYTES - 16);
    if (threadIdx.x == 0) { stw[0] = 0u; stw[1] = 0u; }
    __syncthreads();
    const XcdBarrier xbar = xcd_barrier_post((unsigned*)(p.ws + p.o_bar), stw);
    int ph = 0;
#define PHASE_ON (ph >= p.ph_lo && ph < p.ph_hi)
#ifndef XSYNC
#define XSYNC 0
#endif
#define PHASE_END do { if (PHASE_ON && ph + 1 < p.ph_hi) { if (ph == 0) grid.sync(); else xcd_barrier(xbar); for (int xs = 0; xs < XSYNC; ++xs) xcd_barrier(xbar); } ++ph; } while (0)
    constexpr int ts = TS;
    bf16_t* win = (bf16_t*)(p.ws + p.o_win); bf16_t* wb = (bf16_t*)(p.ws + p.o_wb); bf16_t* wo = (bf16_t*)(p.ws + p.o_wo);
    bf16_t* h = (bf16_t*)(p.ws + p.o_h); bf16_t* z = (bf16_t*)(p.ws + p.o_z); bf16_t* proj = (bf16_t*)(p.ws + p.o_proj);
    bf16_t* merged = h;

    if (PHASE_ON) phase_prep(p, lds);
    PHASE_END;
#pragma unroll 1
    for (int l = 0; l < DEPTH; ++l) {
        const float* xin = (l == 0) ? p.in[0] : p.out;
#pragma unroll 1
        for (int s = 0; s < NS; ++s) {
            const size_t tok0 = (size_t)s * ts;
            if (PHASE_ON) for (int rep = 0; rep < REP_N; ++rep) phase_norm_bf16(xin + tok0 * DM, p.in[1] + (size_t)l * DM, h, ts);
            PHASE_END;
            if (PHASE_ON) for (int rep = 0; rep < REP_A; ++rep) { pg8::Gemm g{h, win + (size_t)l * DM * INC}; pg8::Order<TS / 256, INC / 256, 1> S{(int)gridDim.x, (int)blockIdx.x}; pg8::EpiProj E{proj, proj + (size_t)TS * PP}; pg8::gemm_phase<DM, 0, 0>(lds, g, S, E); }
            PHASE_END;
            if (PHASE_ON) for (int rep = 0; rep < REP_B; ++rep) phase_mix(p, l, proj, z, lds);
            PHASE_END;
            if (PHASE_ON) for (int rep = 0; rep < REP_C; ++rep) { pg8::Gemm g{z, wb + (size_t)l * 4 * BWID * DM}; pg8::Order<TS / 256, DM / 256, 4> S{(int)gridDim.x, (int)blockIdx.x};
                pg8::EpiGate E{proj + (size_t)TS * PP, merged}; pg8::gemm_phase<BWID, (size_t)TS * BWID * 2, (size_t)BWID * DM * 2>(lds, g, S, E); }
            PHASE_END;
            if (PHASE_ON) { pg8::Gemm g{merged, wo + (size_t)l * DM * DM}; pg8::Order<TS / 256, DM / 256, 1> S{(int)gridDim.x, (int)blockIdx.x};
                pg8::EpiRes E{xin + tok0 * DM, p.out + tok0 * DM, DM}; pg8::gemm_phase<DM, 0, 0>(lds, g, S, E); }
            PHASE_END;
        }
    }
    if (PHASE_ON) phase_norm_final(p.out, p.in[16], NTOK);
    PHASE_END;
}

extern "C" void kernel_launch(void* const* d_in, const int* in_sizes, int n_in, void* d_out, int out_size, void* d_ws, size_t ws_size, hipStream_t stream) {
    static int grid = 0;
    if (grid == 0) {
        int dev = 0, cus = 0, per_cu = 0;
        hipGetDevice(&dev); hipDeviceGetAttribute(&cus, hipDeviceAttributeMultiprocessorCount, dev);
        if (hipFuncSetAttribute((const void*)mk_forward, hipFuncAttributeMaxDynamicSharedMemorySize, LDS_BYTES) != hipSuccess) { fprintf(stderr, "hipFuncSetAttribute failed\n"); grid = -1; return; }
        if (hipOccupancyMaxActiveBlocksPerMultiprocessor(&per_cu, (const void*)mk_forward, 512, LDS_BYTES) != hipSuccess || per_cu < 1) { fprintf(stderr, "occupancy query: %d\n", per_cu); per_cu = 1; }
        (void)hipGetLastError();
        grid = cus * per_cu;
    }
    if (grid < 0) return;
    Params p{};
    for (int i = 0; i < 17; ++i) p.in[i] = (const float*)d_in[i];
    p.out = (float*)d_out; p.ws = (unsigned char*)d_ws;
    p.ns = NS; p.ts = TS;
    size_t o = 0;
    p.o_win = o; o += (size_t)DEPTH * DM * INC * 2;
    p.o_wb = o; o += (size_t)DEPTH * 4 * BWID * DM * 2;
    p.o_wo = o; o += (size_t)DEPTH * DM * DM * 2;
    p.o_pw = o; o += (size_t)DEPTH * 4 * 128 * 128 * 2;
    p.o_sw = o; o += (size_t)DEPTH * 4 * 128 * 128 * 2;
    p.o_bar = o; o += 16384;
    p.o_h = o; o += (size_t)p.ts * DM * 2;
    p.o_z = o; o += 4 * (size_t)p.ts * BWID * 2;
    p.o_proj = o; o += (size_t)p.ts * INC * 2;
    if (o > ws_size) { fprintf(stderr, "kernel_launch: workspace too small: need %zu, have %zu\n", o, ws_size); return; }
    const int nph = 1 + DEPTH * NS * 5 + 1;
    if (hipMemsetAsync((char*)d_ws + p.o_bar, 0, 16384, stream) != hipSuccess) { fprintf(stderr, "kernel_launch: memset failed\n"); return; }
#if MULTI_LAUNCH
    for (int ph = 0; ph < nph; ++ph) { p.ph_lo = ph; p.ph_hi = ph + 1; hipLaunchKernelGGL(mk_forward, dim3(grid), dim3(512), LDS_BYTES, stream, p); }
#else
    p.ph_lo = 0; p.ph_hi = nph;
    void* args[] = {&p};
    hipError_t e = hipLaunchCooperativeKernel((const void*)mk_forward, dim3(grid), dim3(512), args, LDS_BYTES, stream);
    if (e != hipSuccess) fprintf(stderr, "cooperative launch failed: %s (grid %d)\n", hipGetErrorString(e), grid);
#endif
}
```

```cpp
#include <hip/hip_runtime.h>
#include <hip/hip_cooperative_groups.h>
#include <cstdio>
namespace cg = cooperative_groups;

#ifndef MULTI_LAUNCH
#define MULTI_LAUNCH 0
#endif

#ifndef REP_N
#define REP_N 1
#endif
#ifndef REP_A
#define REP_A 1
#endif
#ifndef REP_B
#define REP_B 1
#endif
#ifndef REP_C
#define REP_C 1
#endif
#define REP_M0 1
#define REP_M1 1
#define REP_M2 1
#define REP_M3 1
#define LAS __attribute__((address_space(3)))
typedef unsigned short bf16_t;
typedef short bf16x8 __attribute__((ext_vector_type(8)));
typedef float f32x4 __attribute__((ext_vector_type(4)));
typedef float f32x2 __attribute__((ext_vector_type(2)));
typedef unsigned u32x4 __attribute__((ext_vector_type(4)));
typedef unsigned u32x2 __attribute__((ext_vector_type(2)));

constexpr int DM = 1024, SEQ = 2048, NTOK = 32 * 2048, DEPTH = 2, BWID = 512, INC = 10240, GATE0 = 6144;
constexpr int PP = 6144;
constexpr int NS = 2, TS = NTOK / NS;
constexpr int LDS_BYTES = 139264;
constexpr int VP = 1040;

struct Params {
    const float* in[17];
    float* out;
    unsigned char* ws;
    int ts, ns, ph_lo, ph_hi;
    unsigned long long o_win, o_wb, o_wo, o_pw, o_sw, o_h, o_z, o_bar, o_proj;
};

__device__ __forceinline__ int otid() { int t = threadIdx.x; asm volatile("" : "+v"(t)); return t; }
__device__ __forceinline__ unsigned cvt_pk_bf16(float lo, float hi) { unsigned r; asm volatile("v_cvt_pk_bf16_f32 %0, %1, %2" : "=v"(r) : "v"(lo), "v"(hi)); return r; }
__device__ __forceinline__ bf16_t f2bf(float f) { unsigned u = __float_as_uint(f); u += 0x7FFFu + ((u >> 16) & 1u); return (bf16_t)(u >> 16); }
__device__ __forceinline__ void unpack8(const u32x4 v, float (&f)[8]) {
    f[0] = __uint_as_float(v.x << 16); f[1] = __uint_as_float(v.x & 0xffff0000u); f[2] = __uint_as_float(v.y << 16); f[3] = __uint_as_float(v.y & 0xffff0000u);
    f[4] = __uint_as_float(v.z << 16); f[5] = __uint_as_float(v.z & 0xffff0000u); f[6] = __uint_as_float(v.w << 16); f[7] = __uint_as_float(v.w & 0xffff0000u);
}
__device__ __forceinline__ u32x4 pack8(const float (&f)[8]) { u32x4 r; r.x = cvt_pk_bf16(f[0], f[1]); r.y = cvt_pk_bf16(f[2], f[3]); r.z = cvt_pk_bf16(f[4], f[5]); r.w = cvt_pk_bf16(f[6], f[7]); return r; }
__device__ __forceinline__ void unpack4(const u32x2 v, float (&f)[4]) { f[0] = __uint_as_float(v.x << 16); f[1] = __uint_as_float(v.x & 0xffff0000u); f[2] = __uint_as_float(v.y << 16); f[3] = __uint_as_float(v.y & 0xffff0000u); }
__device__ __forceinline__ float sigm(float x) { return __builtin_amdgcn_rcpf(1.0f + __expf(-x)); }
__device__ __forceinline__ float silu(float x) { return x * sigm(x); }
__device__ __forceinline__ void load8f(const float* p, float (&f)[8]) { const f32x4 a = *(const f32x4*)p, b = *(const f32x4*)(p + 4); f[0] = a[0]; f[1] = a[1]; f[2] = a[2]; f[3] = a[3]; f[4] = b[0]; f[5] = b[1]; f[6] = b[2]; f[7] = b[3]; }
__device__ __forceinline__ float wave_sum(float v) {
#pragma unroll
    for (int o = 32; o >= 1; o >>= 1) v += __shfl_xor(v, o);
    return v;
}
__device__ __forceinline__ u32x2 tr_read(unsigned lds_addr) { u32x2 r; asm volatile("ds_read_b64_tr_b16 %0, %1\n\ts_waitcnt lgkmcnt(0)" : "=&v"(r) : "v"(lds_addr) : "memory"); return r; }

namespace pg8 {
constexpr int BM = 256, BK = 64, HALF = 128, HTB = HALF * BK * 2, STAGE_BYTES = 8 * HTB, NXCD = 8, WGM = 8;
__device__ __forceinline__ int lds_byte(int r, int c) { const int st = (r >> 4) * 2 + (c >> 5), rr = r & 15, cc = c & 31, ob = rr * 64 + cc * 2; return st * 1024 + (ob ^ (((ob >> 9) & 1) << 5)); }
__device__ __forceinline__ void stage_rc(int b, int& R, int& C) { const int st = b / 1024, sb = b % 1024, swz = sb ^ (((sb >> 9) & 1) << 5); R = (st >> 1) * 16 + swz / 64; C = (st & 1) * 32 + (swz % 64) / 2; }
__device__ __forceinline__ int perm32(int rho) { const int n = rho >> 4, i = rho & 15; return 8 * (i >> 2) + 4 * n + (i & 3); }

struct Unit { int pm, pn, br; };
struct Gemm { const bf16_t* A; const bf16_t* Bt; };

template <int NM, int NN, int NBR>
struct Order {
    int G, c;
    __device__ __forceinline__ bool next(int i, Unit& u) const {
        constexpr int nwg = NM * NN;
        const int ti = i / NBR;
        const long L = (long)ti * G + c; if (L >= nwg) return false;
        int wgid = (int)L; { constexpr int q = nwg / NXCD, r = nwg % NXCD; const int xcd = wgid % NXCD, off = wgid / NXCD; wgid = (xcd < r ? xcd * (q + 1) : r * (q + 1) + (xcd - r) * q) + off; }
        constexpr int nig = WGM * NN; const int gid = wgid / nig, fm = gid * WGM, gsz = (NM - fm) < WGM ? (NM - fm) : WGM;
        u.pm = fm + ((wgid % nig) % gsz); u.pn = (wgid % nig) / gsz; u.br = i % NBR; return true;
    }
};

struct EpiProj {
    static constexpr bool PERM = true;
    static __device__ __forceinline__ bool zero_after(const Unit&) { return true; }
    bf16_t* O; bf16_t* G;
    __device__ __forceinline__ void operator()(f32x4 (&acc)[2][2][4][2], const Unit& u, int wr, int wc, int fr_, int fq) const {
        int fr = fr_; asm volatile("" : "+v"(fr));
        if (u.pn < GATE0 / BM) {
            const int row0 = u.pm * BM + wr * 64 + fr, col0 = (u.pn & 1) * BM + wc * 32 + 8 * fq;
            bf16_t* Op = O + (size_t)(u.pn >> 1) * TS * BWID;
#pragma unroll
            for (int ai = 0; ai < 2; ++ai)
#pragma unroll
                for (int m = 0; m < 4; ++m) { bf16_t* rowp = Op + (size_t)(row0 + ai * HALF + m * 16) * BWID + col0;
#pragma unroll
                    for (int bj = 0; bj < 2; ++bj) { const f32x4 v0 = acc[ai][bj][m][0], v1 = acc[ai][bj][m][1];
                        u32x4 w; w.x = cvt_pk_bf16(v0[0], v0[1]); w.y = cvt_pk_bf16(v0[2], v0[3]); w.z = cvt_pk_bf16(v1[0], v1[1]); w.w = cvt_pk_bf16(v1[2], v1[3]);
                        __builtin_nontemporal_store(w, (u32x4*)(rowp + bj * HALF)); } }
        } else {
            bf16_t* gb = G + ((size_t)u.pm * 16 + (u.pn - GATE0 / BM)) * 65536 + (((wr * 4 + wc) * 4 + fq) * 16 + fr) * 8;
#pragma unroll
            for (int ai = 0; ai < 2; ++ai)
#pragma unroll
                for (int m = 0; m < 4; ++m)
#pragma unroll
                    for (int bj = 0; bj < 2; ++bj) { const f32x4 v0 = acc[ai][bj][m][0], v1 = acc[ai][bj][m][1];
                        u32x4 w; w.x = cvt_pk_bf16(v0[0], v0[1]); w.y = cvt_pk_bf16(v0[2], v0[3]); w.z = cvt_pk_bf16(v1[0], v1[1]); w.w = cvt_pk_bf16(v1[2], v1[3]);
                        __builtin_nontemporal_store(w, (u32x4*)(gb + ((ai * 4 + m) * 2 + bj) * 4096)); }
        }
    }
};
struct EpiGate {
    static constexpr bool PERM = true;
    static __device__ __forceinline__ bool zero_after(const Unit& u) { return u.br == 3; }
    const bf16_t* G; bf16_t* merged;
    __device__ __forceinline__ void operator()(f32x4 (&acc)[2][2][4][2], const Unit& u, int wr, int wc, int fr_, int fq) const {
        int fr = fr_; asm volatile("" : "+v"(fr));
        const int lrow0 = wr * 64 + fr, lcol0 = wc * 32 + 8 * fq;
        const int br = u.br;
        const bf16_t* gp0 = G + ((size_t)u.pm * 16 + br * 4 + u.pn) * 65536 + (((wr * 4 + wc) * 4 + fq) * 16 + fr) * 8;
        const bool lastb = (br == 3);
        u32x4 t0[4][2], t1[4][2], t2[2][2];
#define GLD(dst, doff, base, ai, m0, cnt) do { _Pragma("unroll") for (int m = 0; m < (cnt); ++m) _Pragma("unroll") for (int bj = 0; bj < 2; ++bj) dst[(doff) + m][bj] = *(const u32x4*)((base) + (((ai) * 4 + (m0) + m) * 2 + bj) * 4096); } while (0)
#define GMUL1(src, ai) do { _Pragma("unroll") for (int m = 0; m < 4; ++m) _Pragma("unroll") for (int bj = 0; bj < 2; ++bj) { float a[8]; unpack8(src[m][bj], a); \
            _Pragma("unroll") for (int j = 0; j < 4; ++j) { acc[ai][bj][m][0][j] *= sigm(a[j]); acc[ai][bj][m][1][j] *= sigm(a[4 + j]); } \
            if (lastb) { const f32x4 v0 = acc[ai][bj][m][0], v1 = acc[ai][bj][m][1]; u32x4 w; w.x = cvt_pk_bf16(v0[0], v0[1]); w.y = cvt_pk_bf16(v0[2], v0[3]); w.z = cvt_pk_bf16(v1[0], v1[1]); w.w = cvt_pk_bf16(v1[2], v1[3]); \
                *(u32x4*)(merged + ((size_t)u.pm * BM + lrow0 + (ai) * HALF + m * 16) * DM + u.pn * BM + lcol0 + bj * HALF) = w; } } } while (0)
#define GMUL2(src, soff, ai, m0, cnt) do { _Pragma("unroll") for (int m = 0; m < (cnt); ++m) _Pragma("unroll") for (int bj = 0; bj < 2; ++bj) { float b[8]; unpack8(src[(soff) + m][bj], b); \
            _Pragma("unroll") for (int j = 0; j < 4; ++j) { acc[ai][bj][(m0) + m][0][j] *= (1.0f + __expf(-b[j])); acc[ai][bj][(m0) + m][1][j] *= (1.0f + __expf(-b[4 + j])); } } } while (0)
        const bf16_t* gnp = lastb ? gp0 : gp0 + 4 * 65536;
        GLD(t0, 0, gp0, 0, 0, 4); GLD(t1, 0, gp0, 1, 0, 4); GLD(t2, 0, gnp, 0, 0, 2);
        asm volatile("" ::: "memory");
        GMUL1(t0, 0);
        asm volatile("" ::: "memory");
        GLD(t0, 0, gnp, 0, 2, 2); GLD(t0, 2, gnp, 1, 0, 2);
        asm volatile("" ::: "memory");
        GMUL1(t1, 1);
        asm volatile("" ::: "memory");
        GLD(t1, 0, gnp, 1, 2, 2);
        asm volatile("" ::: "memory");
        if (!lastb) { GMUL2(t2, 0, 0, 0, 2); GMUL2(t0, 0, 0, 2, 2); GMUL2(t0, 2, 1, 0, 2); GMUL2(t1, 0, 1, 2, 2); }
#undef GLD
#undef GMUL1
#undef GMUL2
    }
};
struct EpiRes {
    static constexpr bool PERM = false;
    static __device__ __forceinline__ bool zero_after(const Unit&) { return true; }
    const float* res; float* C; int ldc;
    __device__ __forceinline__ void operator()(const f32x4 (&acc)[2][2][4][2], const Unit& u, int wr, int wc, int fr_, int fq) const {
        int fr = fr_; asm volatile("" : "+v"(fr));
        const int row0 = u.pm * BM + wr * 64 + fr, col0 = u.pn * BM + wc * 32 + 4 * fq;
#pragma unroll
        for (int ai = 0; ai < 2; ++ai)
#pragma unroll
            for (int m = 0; m < 4; ++m) { const size_t off = (size_t)(row0 + ai * HALF + m * 16) * ldc + col0;
                f32x4 rv[2][2];
#pragma unroll
                for (int bj = 0; bj < 2; ++bj)
#pragma unroll
                    for (int n = 0; n < 2; ++n) rv[bj][n] = *(const f32x4*)(res + off + bj * HALF + n * 16);
#pragma unroll
                for (int bj = 0; bj < 2; ++bj)
#pragma unroll
                    for (int n = 0; n < 2; ++n) *(f32x4*)(C + off + bj * HALF + n * 16) = acc[ai][bj][m][n] + rv[bj][n]; }
    }
};

template <int K, size_t A_BR, size_t B_BR, class Epi, class Sched>
__device__ __forceinline__ void gemm_phase(LAS unsigned char* lds, const Gemm g, const Sched& S, const Epi& E) {
    const int tid = otid(), wid = __builtin_amdgcn_readfirstlane(tid >> 6), lane = tid & 63, wr = wid >> 2, wc = wid & 3, fr = lane & 15, fq = lane >> 4;
    constexpr int nt = K / BK;
    unsigned voffA[2], voffB[2];
#pragma unroll
    for (int i = 0; i < 2; ++i) { int R, C; stage_rc(tid * 16 + i * 8192, R, C); const int Rb = Epi::PERM ? ((R & ~31) + perm32(R & 31)) : R;
        voffA[i] = (unsigned)(R * K + C) * 2u; voffB[i] = (unsigned)(Rb * K + C) * 2u; }
    constexpr size_t kstep = (size_t)(BK * 2);
    constexpr size_t hstep = (size_t)HALF * K * 2;
    constexpr size_t tstep = 2 * hstep;
    const unsigned ldsw = (unsigned)wid * 1024u;
    const int aoff = lds_byte(wr * 64 + fr, fq * 8), boff = lds_byte(wc * 32 + fr, fq * 8);
#define PG8_SA(b, h) (((b) * 2 + (h)) * HTB)
#define PG8_SB(b, h) ((4 + (b) * 2 + (h)) * HTB)
#define PG8_STAGE(bufoff, gbase, voff) do { _Pragma("unroll") for (int _i = 0; _i < 2; ++_i) \
        __builtin_amdgcn_global_load_lds((const unsigned*)((const char*)(gbase) + (voff)[_i]), (LAS unsigned*)(lds + (bufoff) + ldsw + _i * 8192), 16, 0, 0); } while (0)
#define PG8_LDA(dst, b, h) do { _Pragma("unroll") for (int m = 0; m < 4; ++m) _Pragma("unroll") for (int k = 0; k < 2; ++k) dst[m][k] = *(const LAS bf16x8*)(lds + PG8_SA(b, h) + aoff + m * 2048 + k * 1024); } while (0)
#define PG8_LDB(dst, b, h) do { _Pragma("unroll") for (int n = 0; n < 2; ++n) _Pragma("unroll") for (int k = 0; k < 2; ++k) dst[n][k] = *(const LAS bf16x8*)(lds + PG8_SB(b, h) + boff + n * 2048 + k * 1024); } while (0)
#define PG8_MMA(ai, bj, At, Bt) do { __builtin_amdgcn_s_setprio(1); _Pragma("unroll") for (int m = 0; m < 4; ++m) _Pragma("unroll") for (int n = 0; n < 2; ++n) _Pragma("unroll") for (int k = 0; k < 2; ++k) \
        acc[ai][bj][m][n] = __builtin_amdgcn_mfma_f32_16x16x32_bf16(Bt[n][k], At[m][k], acc[ai][bj][m][n], 0, 0, 0); __builtin_amdgcn_s_setprio(0); } while (0)
#define PG8_WAIT_V(n) asm volatile("s_waitcnt vmcnt(" #n ")" ::: "memory")
#define PG8_WAIT_L(n) asm volatile("s_waitcnt lgkmcnt(" #n ")" ::: "memory")
#define PG8_BAR __builtin_amdgcn_s_barrier()
#define PG8_SCHED __builtin_amdgcn_sched_barrier(0)
    Unit cur, nxt; int ui = 0;
    if (!S.next(0, cur)) return;
    f32x4 acc[2][2][4][2];
#pragma unroll
    for (int a = 0; a < 2; ++a)
#pragma unroll
        for (int b = 0; b < 2; ++b)
#pragma unroll
            for (int m = 0; m < 4; ++m)
#pragma unroll
                for (int n = 0; n < 2; ++n) acc[a][b][m][n] = (f32x4){0.f, 0.f, 0.f, 0.f};
    bf16x8 At[4][2], B0[2][2], B1[2][2];
    const char* cA = (const char*)g.A + (size_t)cur.pm * tstep + (size_t)cur.br * A_BR; const char* cB = (const char*)g.Bt + (size_t)cur.pn * tstep + (size_t)cur.br * B_BR;
    PG8_STAGE(PG8_SB(0, 0), cB, voffB); PG8_STAGE(PG8_SA(0, 0), cA, voffA); PG8_STAGE(PG8_SB(0, 1), cB + hstep, voffB); PG8_STAGE(PG8_SA(0, 1), cA + hstep, voffA);
    if (wr == 1) PG8_BAR;
    PG8_WAIT_V(4); PG8_BAR;
    PG8_STAGE(PG8_SB(1, 0), cB + kstep, voffB); PG8_STAGE(PG8_SA(1, 0), cA + kstep, voffA); PG8_STAGE(PG8_SB(1, 1), cB + hstep + kstep, voffB);
    PG8_WAIT_V(6); PG8_BAR;
    for (;;) {
        const bool has_next = S.next(ui + 1, nxt);
        const char* nA = has_next ? (const char*)g.A + (size_t)nxt.pm * tstep + (size_t)nxt.br * A_BR : cA; const char* nB = has_next ? (const char*)g.Bt + (size_t)nxt.pn * tstep + (size_t)nxt.br * B_BR : cB;
        for (int t = 0; t < nt; t += 2) {
            const bool last = (t == nt - 2);
            const char* a1 = cA + (size_t)(t + 1) * kstep;
            const char* a2 = last ? nA : cA + (size_t)(t + 2) * kstep; const char* b2 = last ? nB : cB + (size_t)(t + 2) * kstep;
            const char* a3 = a2 + kstep; const char* b3 = b2 + kstep;
            PG8_LDB(B0, 0, 0); PG8_SCHED; PG8_LDA(At, 0, 0); PG8_STAGE(PG8_SA(1, 1), a1 + hstep, voffA);
            PG8_WAIT_L(8); PG8_BAR; PG8_WAIT_L(0); PG8_MMA(0, 0, At, B0); PG8_BAR; PG8_SCHED;
            PG8_LDB(B1, 0, 1); PG8_STAGE(PG8_SB(0, 0), b2, voffB);
            PG8_BAR; PG8_WAIT_L(0); PG8_MMA(0, 1, At, B1); PG8_BAR;
            PG8_LDA(At, 0, 1); PG8_STAGE(PG8_SA(0, 0), a2, voffA);
            PG8_BAR; PG8_WAIT_L(0); PG8_MMA(1, 0, At, B0); PG8_BAR; PG8_SCHED;
            PG8_STAGE(PG8_SB(0, 1), b2 + hstep, voffB);
            PG8_WAIT_V(6); PG8_BAR; PG8_MMA(1, 1, At, B1); PG8_BAR;
            PG8_LDB(B0, 1, 0); PG8_SCHED; PG8_LDA(At, 1, 0); PG8_STAGE(PG8_SA(0, 1), a2 + hstep, voffA);
            PG8_WAIT_L(8); PG8_BAR; PG8_WAIT_L(0); PG8_MMA(0, 0, At, B0); PG8_BAR; PG8_SCHED;
            PG8_LDB(B1, 1, 1); PG8_STAGE(PG8_SB(1, 0), b3, voffB);
            PG8_BAR; PG8_WAIT_L(0); PG8_MMA(0, 1, At, B1); PG8_BAR;
            PG8_LDA(At, 1, 1); PG8_STAGE(PG8_SA(1, 0), a3, voffA);
            PG8_BAR; PG8_WAIT_L(0); PG8_MMA(1, 0, At, B0); PG8_BAR; PG8_SCHED;
            PG8_STAGE(PG8_SB(1, 1), b3 + hstep, voffB);
            PG8_WAIT_V(6); PG8_BAR; PG8_MMA(1, 1, At, B1); PG8_BAR;
        }
        E(acc, cur, wr, wc, fr, fq);
        if (!has_next) break;
        if (Epi::zero_after(cur))
#pragma unroll
        for (int a = 0; a < 2; ++a)
#pragma unroll
            for (int b = 0; b < 2; ++b)
#pragma unroll
                for (int m = 0; m < 4; ++m)
#pragma unroll
                    for (int n = 0; n < 2; ++n) acc[a][b][m][n] = (f32x4){0.f, 0.f, 0.f, 0.f};
        cur = nxt; cA = nA; cB = nB; ++ui;
    }
    PG8_WAIT_V(0);
    if (wr == 0) PG8_BAR;
    PG8_BAR;
#undef PG8_SA
#undef PG8_SB
#undef PG8_STAGE
#undef PG8_LDA
#undef PG8_LDB
#undef PG8_MMA
#undef PG8_WAIT_V
#undef PG8_WAIT_L
#undef PG8_BAR
#undef PG8_SCHED
}
}

__device__ void phase_norm_bf16(const float* __restrict__ xin, const float* __restrict__ g, bf16_t* __restrict__ h, int rows);
struct TJob { const float* src; bf16_t* dst; int R, C, tr, tc; };
__device__ __forceinline__ TJob prep_job(const Params& p, int i) {
    bf16_t* win = (bf16_t*)(p.ws + p.o_win); bf16_t* wb = (bf16_t*)(p.ws + p.o_wb); bf16_t* wo = (bf16_t*)(p.ws + p.o_wo); bf16_t* pw = (bf16_t*)(p.ws + p.o_pw);
    constexpr int T_WIN = 16 * 160, T_WB = 8 * 16, T_WO = 16 * 16, T_PW = 4;
    constexpr int N0 = DEPTH * T_WIN, N1 = N0 + 8 * T_WB, N2 = N1 + DEPTH * T_WO;
    TJob j;
    if (i < N0) { const int l = i / T_WIN, t = i % T_WIN; j.src = p.in[2] + (size_t)l * DM * INC; j.dst = win + (size_t)l * DM * INC; j.R = DM; j.C = INC; j.tr = t / 160; j.tc = t % 160; }
    else if (i < N1) { const int k = i - N0, m = k / T_WB, t = k % T_WB; j.src = p.in[14] + (size_t)m * BWID * DM; j.dst = wb + (size_t)m * BWID * DM; j.R = BWID; j.C = DM; j.tr = t / 16; j.tc = t % 16; }
    else if (i < N2) { const int k = i - N1, l = k / T_WO, t = k % T_WO; j.src = p.in[15] + (size_t)l * DM * DM; j.dst = wo + (size_t)l * DM * DM; j.R = DM; j.C = DM; j.tr = t / 16; j.tc = t % 16; }
    else { const int k = i - N2, m = k / T_PW, t = k % T_PW; j.src = p.in[3] + (size_t)m * 128 * 128; j.dst = pw + (size_t)m * 128 * 128; j.R = 128; j.C = 128; j.tr = t / 2; j.tc = t % 2; }
    return j;
}
__device__ void phase_prep(const Params& p, LAS unsigned char* lds) {
    LAS float* sm = (LAS float*)lds;
    const int tid = otid();
    constexpr int NT = DEPTH * 16 * 160 + 8 * 8 * 16 + DEPTH * 16 * 16 + 8 * 4;
    const int lr = tid >> 4, lc = (tid & 15) * 4;
    f32x4 v0, v1;
    int i = blockIdx.x;
    if (i < NT) { const TJob j = prep_job(p, i); const float* sp = j.src + (size_t)(j.tr * 64 + lr) * j.C + j.tc * 64 + lc; v0 = *(const f32x4*)sp; v1 = *(const f32x4*)(sp + (size_t)32 * j.C); }
    for (; i < NT; i += gridDim.x) {
        const TJob j = prep_job(p, i);
#pragma unroll
        for (int e = 0; e < 4; ++e) { sm[lr * 65 + lc + e] = v0[e]; sm[(lr + 32) * 65 + lc + e] = v1[e]; }
        __syncthreads();
        const int in = i + gridDim.x;
        if (in < NT) { const TJob jn = prep_job(p, in); const float* sp = jn.src + (size_t)(jn.tr * 64 + lr) * jn.C + jn.tc * 64 + lc; v0 = *(const f32x4*)sp; v1 = *(const f32x4*)(sp + (size_t)32 * jn.C); }
        { const int c = tid >> 3, r8 = (tid & 7) * 8; float o[8];
#pragma unroll
          for (int e = 0; e < 8; ++e) o[e] = sm[(r8 + e) * 65 + c];
          *(u32x4*)(j.dst + (size_t)(j.tc * 64 + c) * j.R + j.tr * 64 + r8) = pack8(o); }
        __syncthreads();
    }
    const float* sgw = p.in[11]; bf16_t* sw = (bf16_t*)(p.ws + p.o_sw);
    for (int k = blockIdx.x * 512 + tid; k < DEPTH * 4 * 128 * 128; k += gridDim.x * 512) { const int s_ = k & 127, t = (k >> 7) & 127; sw[k] = (s_ <= t) ? f2bf(sgw[k]) : (bf16_t)0; }
    phase_norm_bf16(p.in[0], p.in[1], (bf16_t*)(p.ws + p.o_h), NTOK);
}

__device__ void phase_norm_bf16(const float* __restrict__ xin, const float* __restrict__ g, bf16_t* __restrict__ h, int rows) {
    const int tid = otid(), lane = tid & 63, w = tid >> 6;
    float gv[2][8];
    load8f(g + 8 * lane, gv[0]); load8f(g + 512 + 8 * lane, gv[1]);
    for (int row = blockIdx.x * 8 + w; row < rows; row += gridDim.x * 8) {
        const float* xr = xin + (size_t)row * DM + 8 * lane;
        float v[2][8]; load8f(xr, v[0]); load8f(xr + 512, v[1]);
        float ss = 0.f;
#pragma unroll
        for (int i = 0; i < 2; ++i)
#pragma unroll
            for (int j = 0; j < 8; ++j) ss += v[i][j] * v[i][j];
        ss = wave_sum(ss);
        const float r = rsqrtf(ss * (1.0f / 1024.0f) + 1e-6f);
#pragma unroll
        for (int i = 0; i < 2; ++i) { float o[8];
#pragma unroll
            for (int j = 0; j < 8; ++j) o[j] = v[i][j] * r * gv[i][j];
            *(u32x4*)(h + (size_t)row * DM + 512 * i + 8 * lane) = pack8(o); }
    }
}
__device__ void phase_norm_final(float* __restrict__ x, const float* __restrict__ g, int rows) {
    const int tid = otid(), lane = tid & 63, w = tid >> 6;
    float gv[2][8];
    load8f(g + 8 * lane, gv[0]); load8f(g + 512 + 8 * lane, gv[1]);
    for (int row = blockIdx.x * 8 + w; row < rows; row += gridDim.x * 8) {
        float* xr = x + (size_t)row * DM + 8 * lane;
        float v[2][8]; load8f(xr, v[0]); load8f(xr + 512, v[1]);
        float ss = 0.f;
#pragma unroll
        for (int i = 0; i < 2; ++i)
#pragma unroll
            for (int j = 0; j < 8; ++j) ss += v[i][j] * v[i][j];
        ss = wave_sum(ss);
        const float r = rsqrtf(ss * (1.0f / 1024.0f) + 1e-6f);
#pragma unroll
        for (int i = 0; i < 2; ++i) {
            f32x4 a, b;
#pragma unroll
            for (int j = 0; j < 4; ++j) { a[j] = v[i][j] * r * gv[i][j]; b[j] = v[i][4 + j] * r * gv[i][4 + j]; }
            *(f32x4*)(xr + 512 * i) = a; *(f32x4*)(xr + 512 * i + 4) = b; }
    }
}

#define PO(k) ((size_t)(k) * TS * BWID)
__device__ void mix_sc(const Params& p, int l, const bf16_t* __restrict__ proj, bf16_t* __restrict__ z3, int r0, int pos0) {
    const int tid = otid(), lane = tid & 63, w = tid >> 6, c0 = lane * 8;
    const float* scw = p.in[13] + (size_t)l * 3 * BWID + c0;
    float w0[8], w1[8], w2[8]; load8f(scw, w0); load8f(scw + BWID, w1); load8f(scw + 2 * BWID, w2);
    const int r = r0 + 16 * w, pos = pos0 + 16 * w;
    float p2[8], p1[8];
    if (pos > 0) {
        float a[8], b[8];
        unpack8(*(const u32x4*)(proj + (size_t)(r - 2) * BWID + PO(9) + c0), a); unpack8(*(const u32x4*)(proj + (size_t)(r - 2) * BWID + PO(10) + c0), b);
#pragma unroll
        for (int j = 0; j < 8; ++j) p2[j] = a[j] * b[j];
        unpack8(*(const u32x4*)(proj + (size_t)(r - 1) * BWID + PO(9) + c0), a); unpack8(*(const u32x4*)(proj + (size_t)(r - 1) * BWID + PO(10) + c0), b);
#pragma unroll
        for (int j = 0; j < 8; ++j) p1[j] = a[j] * b[j];
    } else {
#pragma unroll
        for (int j = 0; j < 8; ++j) { p2[j] = 0.f; p1[j] = 0.f; }
    }
#pragma unroll 4
    for (int jj = 0; jj < 16; ++jj) {
        const bf16_t* pr = proj + (size_t)(r + jj) * BWID + c0;
        float vb[8], vc[8], vx[8], vg[8], o[8];
        unpack8(*(const u32x4*)(pr + PO(8)), vb); unpack8(*(const u32x4*)(pr + PO(9)), vc); unpack8(*(const u32x4*)(pr + PO(10)), vx); unpack8(*(const u32x4*)(pr + PO(11)), vg);
#pragma unroll
        for (int j = 0; j < 8; ++j) { const float cur = vc[j] * vx[j]; const float cv = w0[j] * p2[j] + w1[j] * p1[j] + w2[j] * cur; o[j] = vb[j] * cv * silu(vg[j]); p2[j] = p1[j]; p1[j] = cur; }
        *(u32x4*)(z3 + (size_t)(r + jj) * BWID + c0) = pack8(o);
    }
}

__device__ void mix_conv(const Params& p, int l, const bf16_t* __restrict__ proj, bf16_t* __restrict__ z1, int r0, int pos0, LAS unsigned char* lds) {
    const int tid = otid(), lane = tid & 63, w = tid >> 6, c0 = lane * 8;
    LAS unsigned char* Y = lds; LAS unsigned char* W = lds + 94 * VP;
    const float* cw = p.in[5] + (size_t)l * 31 * BWID;
    for (int i = tid; i < 31 * 64; i += 512) { const int k = i >> 6, cgp = i & 63; float f[8]; load8f(cw + k * BWID + cgp * 8, f); *(LAS u32x4*)(W + k * 1024 + cgp * 16) = pack8(f); }
    float bias[8], lng[8], lnb[8];
    load8f(p.in[6] + (size_t)l * BWID + c0, bias); load8f(p.in[7] + (size_t)l * BWID + c0, lng); load8f(p.in[8] + (size_t)l * BWID + c0, lnb);
    for (int q = 0; q < 2; ++q) {
        const int tr = r0 + 64 * q, tp = pos0 + 64 * q;
        __syncthreads();
        {
            u32x4 la[12], lb[12];
#pragma unroll
            for (int i = 0; i < 12; ++i) { const int row = 12 * w + i; const bool valid = (row < 94) && (tp - 30 + row >= 0);
                la[i] = (u32x4){0u, 0u, 0u, 0u}; lb[i] = la[i];
                if (valid) { const bf16_t* pr = proj + (size_t)(tr - 30 + row) * BWID + c0; la[i] = *(const u32x4*)(pr + PO(2)); lb[i] = *(const u32x4*)(pr + PO(3)); } }
#pragma unroll
            for (int i = 0; i < 12; ++i) { const int row = 12 * w + i;
                if (row < 94) { float a[8], b[8], y[8]; unpack8(la[i], a); unpack8(lb[i], b);
#pragma unroll
                    for (int j = 0; j < 8; ++j) y[j] = a[j] * sigm(b[j]);
                    *(LAS u32x4*)(Y + row * VP + lane * 16) = pack8(y); } }
        }
        __syncthreads();
        u32x4 gtv[8];
#pragma unroll
        for (int j = 0; j < 8; ++j) gtv[j] = *(const u32x4*)(proj + (size_t)(tr + 8 * w + j) * BWID + PO(4) + c0);
        float acc[8][8];
#pragma unroll
        for (int j = 0; j < 8; ++j)
#pragma unroll
            for (int c = 0; c < 8; ++c) acc[j][c] = bias[c];
#pragma unroll 1
        for (int k = 0; k < 31; ++k) {
            float wv[8]; unpack8(*(const LAS u32x4*)(W + k * 1024 + lane * 16), wv);
#pragma unroll
            for (int j = 0; j < 8; ++j) { float yv[8]; unpack8(*(const LAS u32x4*)(Y + (8 * w + j + k) * VP + lane * 16), yv);
#pragma unroll
                for (int c = 0; c < 8; ++c) acc[j][c] += wv[c] * yv[c]; }
        }
#pragma unroll
        for (int j = 0; j < 8; ++j) {
            float s = 0.f, ss = 0.f;
#pragma unroll
            for (int c = 0; c < 8; ++c) { s += acc[j][c]; ss += acc[j][c] * acc[j][c]; }
            s = wave_sum(s); ss = wave_sum(ss);
            const float mean = s * (1.0f / 512.0f); const float var = fmaxf(ss * (1.0f / 512.0f) - mean * mean, 0.f); const float rstd = rsqrtf(var + 1e-5f);
            const int row = tr + 8 * w + j;
            float gt[8], o[8]; unpack8(gtv[j], gt);
#pragma unroll
            for (int c = 0; c < 8; ++c) { const float v = (acc[j][c] - mean) * rstd * lng[c] + lnb[c]; o[c] = silu(v) * silu(gt[c]); }
            *(u32x4*)(z1 + (size_t)row * BWID + c0) = pack8(o);
        }
    }
}

__device__ __forceinline__ u32x4 sel4(bool c, const u32x4 a, const u32x4 b) { u32x4 r; r.x = c ? a.x : b.x; r.y = c ? a.y : b.y; r.z = c ? a.z : b.z; r.w = c ? a.w : b.w; return r; }

__device__ void mix_pool(const Params& p, int l, const bf16_t* __restrict__ proj, bf16_t* __restrict__ z0, int r0, int pos0, LAS unsigned char* lds) {
    const int tid = otid(), lane = tid & 63, w = tid >> 6, c0 = lane * 8;
    LAS unsigned char* P = lds;
    {
        const int g4 = lane >> 4, win = 2 << g4;
        const int r = r0 + 16 * w, pos = pos0 + 16 * w;
        u32x4 R[32];
#pragma unroll
        for (int i = 0; i < 16; ++i) { R[i] = (u32x4){0u, 0u, 0u, 0u}; if (pos > 0) R[i] = *(const u32x4*)(proj + (size_t)(r - 16 + i) * BWID + c0); }
#pragma unroll
        for (int i = 0; i < 16; ++i) R[16 + i] = *(const u32x4*)(proj + (size_t)(r + i) * BWID + c0);
        float S[8];
#pragma unroll
        for (int j = 0; j < 8; ++j) S[j] = 0.f;
#pragma unroll
        for (int i = 1; i <= 16; ++i) { float x[8]; unpack8(R[16 - i], x); const float mk = (i <= win) ? 1.0f : 0.0f;
#pragma unroll
            for (int j = 0; j < 8; ++j) S[j] += mk * x[j]; }
#pragma unroll
        for (int jj = 0; jj < 16; ++jj) {
            const int ps = pos + jj; float xv[8], xo[8], o[8];
            unpack8(R[16 + jj], xv);
            const u32x4 ro = sel4(g4 < 2, sel4(g4 == 0, R[16 + jj - 2], R[16 + jj - 4]), sel4(g4 == 2, R[16 + jj - 8], R[jj]));
            unpack8(ro, xo);
            const int cnt = (ps + 1 < win) ? ps + 1 : win; const float inv = 1.0f / (float)cnt;
#pragma unroll
            for (int j = 0; j < 8; ++j) { S[j] += xv[j] - xo[j]; o[j] = S[j] * inv - xv[j]; }
            *(LAS u32x4*)(P + (16 * w + jj) * VP + lane * 16) = pack8(o);
        }
    }
    __syncthreads();
    {
        const int g = w >> 1, fr = lane & 15, fq = lane >> 4;
        const bf16_t* pwT = (const bf16_t*)(p.ws + p.o_pw) + (size_t)(l * 4 + g) * 128 * 128;
        u32x2 gtv[8][4];
#pragma unroll
        for (int tt = 0; tt < 8; ++tt)
#pragma unroll
            for (int dt = 0; dt < 4; ++dt) gtv[tt][dt] = *(const u32x2*)(proj + (size_t)(r0 + 16 * tt + fr) * BWID + PO(1) + 64 * w + 16 * dt + 4 * fq);
        bf16x8 A[4][4];
#pragma unroll
        for (int dt = 0; dt < 4; ++dt)
#pragma unroll
            for (int kk = 0; kk < 4; ++kk) A[dt][kk] = *(const bf16x8*)(pwT + (size_t)(64 * (w & 1) + 16 * dt + fr) * 128 + 32 * kk + 8 * fq);
        const float* psc = p.in[4] + (size_t)l * BWID;
        f32x4 sc[4];
#pragma unroll
        for (int dt = 0; dt < 4; ++dt) sc[dt] = *(const f32x4*)(psc + 64 * w + 16 * dt + 4 * fq);
#pragma unroll
        for (int tt = 0; tt < 8; ++tt) {
            bf16x8 Bf[4];
#pragma unroll
            for (int kk = 0; kk < 4; ++kk) Bf[kk] = *(const LAS bf16x8*)(P + (16 * tt + fr) * VP + (128 * g + 32 * kk + 8 * fq) * 2);
            f32x4 acc[4];
#pragma unroll
            for (int dt = 0; dt < 4; ++dt) { acc[dt] = (f32x4){0.f, 0.f, 0.f, 0.f};
#pragma unroll
                for (int kk = 0; kk < 4; ++kk) acc[dt] = __builtin_amdgcn_mfma_f32_16x16x32_bf16(A[dt][kk], Bf[kk], acc[dt], 0, 0, 0); }
            const int row = r0 + 16 * tt + fr;
#pragma unroll
            for (int dt = 0; dt < 4; ++dt) { const int d = 64 * w + 16 * dt + 4 * fq;
                float gt[4]; unpack4(gtv[tt][dt], gt);
                u32x2 o; o.x = cvt_pk_bf16(acc[dt][0] * sc[dt][0] * silu(gt[0]), acc[dt][1] * sc[dt][1] * silu(gt[1])); o.y = cvt_pk_bf16(acc[dt][2] * sc[dt][2] * silu(gt[2]), acc[dt][3] * sc[dt][3] * silu(gt[3]));
                *(u32x2*)(z0 + (size_t)row * BWID + d) = o; }
        }
    }
}

__device__ void mix_sgu(const Params& p, int l, const bf16_t* __restrict__ proj, bf16_t* __restrict__ z2, int r0, LAS unsigned char* lds) {
    const int tid = otid(), lane = tid & 63, w = tid >> 6, c0 = lane * 8;
    LAS unsigned char* V = lds;
    {
        float lng[8], lnb[8]; load8f(p.in[9] + (size_t)l * BWID + c0, lng); load8f(p.in[10] + (size_t)l * BWID + c0, lnb);
        u32x4 R[16];
#pragma unroll
        for (int jj = 0; jj < 16; ++jj) R[jj] = *(const u32x4*)(proj + (size_t)(r0 + 16 * w + jj) * BWID + PO(6) + c0);
#pragma unroll
        for (int jj = 0; jj < 16; ++jj) {
            float x[8], o[8]; unpack8(R[jj], x);
            float s = 0.f, ss = 0.f;
#pragma unroll
            for (int c = 0; c < 8; ++c) { s += x[c]; ss += x[c] * x[c]; }
            s = wave_sum(s); ss = wave_sum(ss);
            const float mean = s * (1.0f / 512.0f); const float var = fmaxf(ss * (1.0f / 512.0f) - mean * mean, 0.f); const float rstd = rsqrtf(var + 1e-5f);
#pragma unroll
            for (int c = 0; c < 8; ++c) o[c] = (x[c] - mean) * rstd * lng[c] + lnb[c];
            *(LAS u32x4*)(V + (16 * w + jj) * VP + lane * 16) = pack8(o);
        }
    }
    __syncthreads();
    {
        const int g = w >> 1, fr = lane & 15, fq = lane >> 4;
        const unsigned vbase = (unsigned)(size_t)V;
        bf16x8 A[4][4];
#pragma unroll
        for (int ct = 0; ct < 4; ++ct)
#pragma unroll
            for (int kk = 0; kk < 4; ++kk) {
                const unsigned a = vbase + (unsigned)((32 * kk + 8 * fq + (fr >> 2)) * VP + (64 * w + 16 * ct + 4 * (fr & 3)) * 2);
                const u32x2 lo = tr_read(a), hi = tr_read(a + 4 * VP);
                u32x4 t; t.x = lo.x; t.y = lo.y; t.z = hi.x; t.w = hi.y;
                A[ct][kk] = __builtin_bit_cast(bf16x8, t);
            }
        const bf16_t* swm = (const bf16_t*)(p.ws + p.o_sw) + (size_t)(l * 4 + g) * 128 * 128;
        const float* sb = p.in[12] + (size_t)(l * 4 + g) * 128;
#pragma unroll
        for (int hb = 0; hb < 2; ++hb) {
            u32x2 uu[4][4], gg[4][4]; bf16x8 Wf[4][4]; float bias[4];
#pragma unroll
            for (int t4 = 0; t4 < 4; ++t4) { const int tt = hb * 4 + t4; const bf16_t* pr = proj + (size_t)(r0 + 16 * tt + fr) * BWID + 64 * w + 4 * fq;
#pragma unroll
                for (int ct = 0; ct < 4; ++ct) { uu[t4][ct] = *(const u32x2*)(pr + PO(5) + 16 * ct); gg[t4][ct] = *(const u32x2*)(pr + PO(7) + 16 * ct); }
#pragma unroll
                for (int kk = 0; kk < 4; ++kk) if (kk < (tt >> 1) + 1) Wf[t4][kk] = *(const bf16x8*)(swm + (size_t)(16 * tt + fr) * 128 + 32 * kk + 8 * fq);
                bias[t4] = sb[16 * tt + fr]; }
#pragma unroll
            for (int t4 = 0; t4 < 4; ++t4) { const int tt = hb * 4 + t4;
                f32x4 acc[4];
#pragma unroll
                for (int ct = 0; ct < 4; ++ct) acc[ct] = (f32x4){0.f, 0.f, 0.f, 0.f};
#pragma unroll
                for (int kk = 0; kk < 4; ++kk) if (kk < (tt >> 1) + 1) {
#pragma unroll
                    for (int ct = 0; ct < 4; ++ct) acc[ct] = __builtin_amdgcn_mfma_f32_16x16x32_bf16(A[ct][kk], Wf[t4][kk], acc[ct], 0, 0, 0); }
                const int row = r0 + 16 * tt + fr;
#pragma unroll
                for (int ct = 0; ct < 4; ++ct) { const int c = 64 * w + 16 * ct + 4 * fq;
                    float u[4], gt[4]; unpack4(uu[t4][ct], u); unpack4(gg[t4][ct], gt);
                    u32x2 o; o.x = cvt_pk_bf16(u[0] * (acc[ct][0] + bias[t4]) * silu(gt[0]), u[1] * (acc[ct][1] + bias[t4]) * silu(gt[1])); o.y = cvt_pk_bf16(u[2] * (acc[ct][2] + bias[t4]) * silu(gt[2]), u[3] * (acc[ct][3] + bias[t4]) * silu(gt[3]));
                    *(u32x2*)(z2 + (size_t)row * BWID + c) = o; }
            }
        }
    }
}

__device__ void phase_mix(const Params& p, int l, const bf16_t* proj, bf16_t* z, LAS unsigned char* lds) {
    constexpr int nchunk = TS / 128;
    constexpr size_t zs = (size_t)TS * BWID;
    for (int i = blockIdx.x; i < 4 * nchunk; i += gridDim.x) {
        const int br = i / nchunk, j = i % nchunk, r0 = j * 128, pos0 = (j & 15) * 128;
        if (br == 0) for (int rr = 0; rr < REP_M0; ++rr) { mix_pool(p, l, proj, z, r0, pos0, lds); __syncthreads(); }
        else if (br == 1) for (int rr = 0; rr < REP_M1; ++rr) { mix_conv(p, l, proj, z + zs, r0, pos0, lds); __syncthreads(); }
        else if (br == 2) for (int rr = 0; rr < REP_M2; ++rr) { mix_sgu(p, l, proj, z + 2 * zs, r0, lds); __syncthreads(); }
        else for (int rr = 0; rr < REP_M3; ++rr) { mix_sc(p, l, proj, z + 3 * zs, r0, pos0); __syncthreads(); }
    }
}

#define XB_TMO      128
#define XB_XCNT(j)  (256  + 64 * (j))
#define XB_XSUB(j)  (1280 + 64 * (j))
#define XB_XGEN(j)  (2304 + 64 * (j))
#define XB_TOP      3328
#define XB_TOPGEN   3392
#define XCD_BAR_WORDS 3456
#define XB_SPIN_CAP (1u << 20)
__device__ __forceinline__ unsigned xb_ld(unsigned* p)              { return __hip_atomic_load(p, __ATOMIC_RELAXED, __HIP_MEMORY_SCOPE_AGENT); }
__device__ __forceinline__ unsigned xb_add(unsigned* p, unsigned v) { return __hip_atomic_fetch_add(p, v, __ATOMIC_RELAXED, __HIP_MEMORY_SCOPE_AGENT); }
__device__ __forceinline__ unsigned xb_xcc_id() { return (unsigned)__builtin_amdgcn_s_getreg((3 << 11) | 20) & 0xFu; }
#define XB_SPIN(cond, bar) do { unsigned _sp = 0; while (cond) { __builtin_amdgcn_s_sleep(1); \
    if ((++_sp & 255u) == 0u) { if (xb_ld(&(bar)[XB_TMO])) break; if (_sp > XB_SPIN_CAP) { atomicAdd(&(bar)[XB_TMO], 1u); break; } } } } while (0)
struct XcdBarrier { unsigned* bar; unsigned x; volatile LAS unsigned* st; };
__device__ __forceinline__ XcdBarrier xcd_barrier_post(unsigned* bar, volatile LAS unsigned* st) {
    XcdBarrier b; b.bar = bar; b.x = xb_xcc_id(); b.st = st;
    if (threadIdx.x == 0) (void)xb_add(&bar[XB_XCNT(b.x)], 1u);
    return b;
}
__device__ __forceinline__ void xcd_barrier_complete(unsigned* bar, unsigned x, unsigned& nloc, unsigned& nx) {
    const unsigned G = gridDim.x * gridDim.y * gridDim.z;
    unsigned sum, cnt, mine, sp = 0u;
    for (;;) {
        sum = 0u; cnt = 0u; mine = 0u;
#pragma unroll
        for (unsigned j = 0; j < 16; ++j) { const unsigned c = xb_ld(&bar[XB_XCNT(j)]); sum += c; cnt += (c > 0u) ? 1u : 0u; mine = (j == x) ? c : mine; }
        if (sum == G) break;
        __builtin_amdgcn_s_sleep(1);
        if ((++sp & 255u) == 0u) { if (xb_ld(&bar[XB_TMO])) break; if (sp > XB_SPIN_CAP) { atomicAdd(&bar[XB_TMO], 1u); break; } }
    }
    nloc = mine > 0u ? mine : 1u; nx = cnt > 0u ? cnt : 1u;
}
__device__ __forceinline__ void xcd_barrier(const XcdBarrier& b) {
    asm volatile("s_waitcnt vmcnt(0)" ::: "memory");
    __syncthreads();
    if (threadIdx.x == 0) {
        unsigned* bar = b.bar;
        __builtin_amdgcn_s_waitcnt(0);
        unsigned nloc = b.st[0], nx = b.st[1];
        if (nloc == 0u) { xcd_barrier_complete(bar, b.x, nloc, nx); b.st[0] = nloc; b.st[1] = nx; }
        const unsigned old = xb_add(&bar[XB_XSUB(b.x)], 1u);
        const unsigned gen = old / nloc;
        if (old + 1u == (gen + 1u) * nloc) {
            __builtin_amdgcn_fence(__ATOMIC_RELEASE, "agent");
            asm volatile("s_waitcnt vmcnt(0)" ::: "memory");
            const unsigned og = xb_add(&bar[XB_TOP], 1u);
            const unsigned tg = og / nx;
            if (og + 1u == (tg + 1u) * nx) xb_add(&bar[XB_TOPGEN], 1u);
            else XB_SPIN(xb_ld(&bar[XB_TOPGEN]) == tg, bar);
            __builtin_amdgcn_fence(__ATOMIC_ACQUIRE, "agent");
            xb_add(&bar[XB_XGEN(b.x)], 1u);
            asm volatile("s_waitcnt vmcnt(0)" ::: "memory");
        } else {
            XB_SPIN(xb_ld(&bar[XB_XGEN(b.x)]) == gen, bar);
            __builtin_amdgcn_fence(__ATOMIC_ACQUIRE, "agent");
            asm volatile("s_waitcnt vmcnt(0)" ::: "memory");
        }
    }
    __syncthreads();
}

__global__ void __launch_bounds__(512) mk_forward(Params p) {
    extern __shared__ __attribute__((aligned(16))) unsigned char lds_raw[];
    LAS unsigned char* lds = (LAS unsigned char*)lds_raw;
    cg::grid_group grid = cg::this_grid();
    volatile LAS unsigned* stw = (volatile LAS unsigned*)(lds + LDS_BYTES - 16);
    if (threadIdx.x == 0) { stw[0] = 0u; stw[1] = 0u; }
    __syncthreads();
    const XcdBarrier xbar = xcd_barrier_post((unsigned*)(p.ws + p.o_bar), stw);
    int ph = 0;
#define PHASE_ON (ph >= p.ph_lo && ph < p.ph_hi)
#ifndef XSYNC
#define XSYNC 0
#endif
#define PHASE_END do { if (PHASE_ON && ph + 1 < p.ph_hi) { if (ph == 0) grid.sync(); else xcd_barrier(xbar); for (int xs = 0; xs < XSYNC; ++xs) xcd_barrier(xbar); } ++ph; } while (0)
    constexpr int ts = TS;
    bf16_t* win = (bf16_t*)(p.ws + p.o_win); bf16_t* wb = (bf16_t*)(p.ws + p.o_wb); bf16_t* wo = (bf16_t*)(p.ws + p.o_wo);
    bf16_t* h0 = (bf16_t*)(p.ws + p.o_h); bf16_t* z = (bf16_t*)(p.ws + p.o_z); bf16_t* proj = (bf16_t*)(p.ws + p.o_proj);

    if (PHASE_ON) phase_prep(p, lds);
    PHASE_END;
#pragma unroll 1
    for (int l = 0; l < DEPTH; ++l) {
        const float* xin = (l == 0) ? p.in[0] : p.out;
#pragma unroll 1
        for (int s = 0; s < NS; ++s) {
            const size_t tok0 = (size_t)s * ts;
            bf16_t* h = h0 + tok0 * DM; bf16_t* merged = h;
            if (l > 0) { if (PHASE_ON) phase_norm_bf16(xin + tok0 * DM, p.in[1] + (size_t)l * DM, h, ts);
                PHASE_END; }
            if (PHASE_ON) for (int rep = 0; rep < REP_A; ++rep) { pg8::Gemm g{h, win + (size_t)l * DM * INC}; pg8::Order<TS / 256, INC / 256, 1> S{(int)gridDim.x, (int)blockIdx.x}; pg8::EpiProj E{proj, proj + (size_t)TS * PP}; pg8::gemm_phase<DM, 0, 0>(lds, g, S, E); }
            PHASE_END;
            if (PHASE_ON) for (int rep = 0; rep < REP_B; ++rep) phase_mix(p, l, proj, z, lds);
            PHASE_END;
            if (PHASE_ON) for (int rep = 0; rep < REP_C; ++rep) { pg8::Gemm g{z, wb + (size_t)l * 4 * BWID * DM}; pg8::Order<TS / 256, DM / 256, 4> S{(int)gridDim.x, (int)blockIdx.x};
                pg8::EpiGate E{proj + (size_t)TS * PP, merged}; pg8::gemm_phase<BWID, (size_t)TS * BWID * 2, (size_t)BWID * DM * 2>(lds, g, S, E); }
            PHASE_END;
            if (PHASE_ON) { pg8::Gemm g{merged, wo + (size_t)l * DM * DM}; pg8::Order<TS / 256, DM / 256, 1> S{(int)gridDim.x, (int)blockIdx.x};
                pg8::EpiRes E{xin + tok0 * DM, p.out + tok0 * DM, DM}; pg8::gemm_phase<DM, 0, 0>(lds, g, S, E); }
            PHASE_END;
        }
    }
    if (PHASE_ON) phase_norm_final(p.out, p.in[16], NTOK);
    PHASE_END;
}

extern "C" void kernel_launch(void* const* d_in, const int* in_sizes, int n_in, void* d_out, int out_size, void* d_ws, size_t ws_size, hipStream_t stream) {
    static int grid = 0;
    if (grid == 0) {
        int dev = 0, cus = 0, per_cu = 0;
        hipGetDevice(&dev); hipDeviceGetAttribute(&cus, hipDeviceAttributeMultiprocessorCount, dev);
        if (hipFuncSetAttribute((const void*)mk_forward, hipFuncAttributeMaxDynamicSharedMemorySize, LDS_BYTES) != hipSuccess) { fprintf(stderr, "hipFuncSetAttribute failed\n"); grid = -1; return; }
        if (hipOccupancyMaxActiveBlocksPerMultiprocessor(&per_cu, (const void*)mk_forward, 512, LDS_BYTES) != hipSuccess || per_cu < 1) { fprintf(stderr, "occupancy query: %d\n", per_cu); per_cu = 1; }
        (void)hipGetLastError();
        grid = cus * per_cu;
    }
    if (grid < 0) return;
    Params p{};
    for (int i = 0; i < 17; ++i) p.in[i] = (const float*)d_in[i];
    p.out = (float*)d_out; p.ws = (unsigned char*)d_ws;
    p.ns = NS; p.ts = TS;
    size_t o = 0;
    p.o_win = o; o += (size_t)DEPTH * DM * INC * 2;
    p.o_wb = o; o += (size_t)DEPTH * 4 * BWID * DM * 2;
    p.o_wo = o; o += (size_t)DEPTH * DM * DM * 2;
    p.o_pw = o; o += (size_t)DEPTH * 4 * 128 * 128 * 2;
    p.o_sw = o; o += (size_t)DEPTH * 4 * 128 * 128 * 2;
    p.o_bar = o; o += 16384;
    p.o_h = o; o += (size_t)NTOK * DM * 2;
    p.o_z = o; o += 4 * (size_t)p.ts * BWID * 2;
    p.o_proj = o; o += (size_t)p.ts * INC * 2;
    if (o > ws_size) { fprintf(stderr, "kernel_launch: workspace too small: need %zu, have %zu\n", o, ws_size); return; }
    const int nph = 1 + NS * 4 + (DEPTH - 1) * NS * 5 + 1;
    if (hipMemsetAsync((char*)d_ws + p.o_bar, 0, 16384, stream) != hipSuccess) { fprintf(stderr, "kernel_launch: memset failed\n"); return; }
#if MULTI_LAUNCH
    for (int ph = 0; ph < nph; ++ph) { p.ph_lo = ph; p.ph_hi = ph + 1; hipLaunchKernelGGL(mk_forward, dim3(grid), dim3(512), LDS_BYTES, stream, p); }
#else
    p.ph_lo = 0; p.ph_hi = nph;
    void* args[] = {&p};
    hipError_t e = hipLaunchCooperativeKernel((const void*)mk_forward, dim3(grid), dim3(512), args, LDS_BYTES, stream);
    if (e != hipSuccess) fprintf(stderr, "cooperative launch failed: %s (grid %d)\n", hipGetErrorString(e), grid);
#endif
}
```

```cpp
#include <hip/hip_runtime.h>
#include <hip/hip_cooperative_groups.h>
#include <cstdio>
namespace cg = cooperative_groups;

#ifndef MULTI_LAUNCH
#define MULTI_LAUNCH 0
#endif

#ifndef REP_N
#define REP_N 1
#endif
#ifndef REP_A
#define REP_A 1
#endif
#ifndef REP_B
#define REP_B 1
#endif
#ifndef REP_C
#define REP_C 1
#endif
#define REP_M0 1
#define REP_M1 1
#define REP_M2 1
#define REP_M3 1
#define LAS __attribute__((address_space(3)))
typedef unsigned short bf16_t;
typedef short bf16x8 __attribute__((ext_vector_type(8)));
typedef float f32x4 __attribute__((ext_vector_type(4)));
typedef float f32x2 __attribute__((ext_vector_type(2)));
typedef unsigned u32x4 __attribute__((ext_vector_type(4)));
typedef unsigned u32x2 __attribute__((ext_vector_type(2)));

constexpr int DM = 1024, SEQ = 2048, NTOK = 32 * 2048, DEPTH = 2, BWID = 512, INC = 10240, GATE0 = 6144;
constexpr int PP = 6144;
constexpr int NS = 2, TS = NTOK / NS;
constexpr int LDS_BYTES = 139264;
constexpr int VP = 1040;

struct Params {
    const float* in[17];
    float* out;
    unsigned char* ws;
    int ts, ns, ph_lo, ph_hi;
    unsigned long long o_win, o_wb, o_wo, o_pw, o_sw, o_h, o_z, o_bar, o_proj;
};

__device__ __forceinline__ int otid() { int t = threadIdx.x; asm volatile("" : "+v"(t)); return t; }
__device__ __forceinline__ unsigned cvt_pk_bf16(float lo, float hi) { unsigned r; asm volatile("v_cvt_pk_bf16_f32 %0, %1, %2" : "=v"(r) : "v"(lo), "v"(hi)); return r; }
__device__ __forceinline__ bf16_t f2bf(float f) { unsigned u = __float_as_uint(f); u += 0x7FFFu + ((u >> 16) & 1u); return (bf16_t)(u >> 16); }
__device__ __forceinline__ void unpack8(const u32x4 v, float (&f)[8]) {
    f[0] = __uint_as_float(v.x << 16); f[1] = __uint_as_float(v.x & 0xffff0000u); f[2] = __uint_as_float(v.y << 16); f[3] = __uint_as_float(v.y & 0xffff0000u);
    f[4] = __uint_as_float(v.z << 16); f[5] = __uint_as_float(v.z & 0xffff0000u); f[6] = __uint_as_float(v.w << 16); f[7] = __uint_as_float(v.w & 0xffff0000u);
}
__device__ __forceinline__ u32x4 pack8(const float (&f)[8]) { u32x4 r; r.x = cvt_pk_bf16(f[0], f[1]); r.y = cvt_pk_bf16(f[2], f[3]); r.z = cvt_pk_bf16(f[4], f[5]); r.w = cvt_pk_bf16(f[6], f[7]); return r; }
__device__ __forceinline__ void unpack4(const u32x2 v, float (&f)[4]) { f[0] = __uint_as_float(v.x << 16); f[1] = __uint_as_float(v.x & 0xffff0000u); f[2] = __uint_as_float(v.y << 16); f[3] = __uint_as_float(v.y & 0xffff0000u); }
__device__ __forceinline__ float sigm(float x) { return __builtin_amdgcn_rcpf(1.0f + __expf(-x)); }
__device__ __forceinline__ float silu(float x) { return x * sigm(x); }
__device__ __forceinline__ void load8f(const float* p, float (&f)[8]) { const f32x4 a = *(const f32x4*)p, b = *(const f32x4*)(p + 4); f[0] = a[0]; f[1] = a[1]; f[2] = a[2]; f[3] = a[3]; f[4] = b[0]; f[5] = b[1]; f[6] = b[2]; f[7] = b[3]; }
__device__ __forceinline__ float wave_sum(float v) {
#pragma unroll
    for (int o = 32; o >= 1; o >>= 1) v += __shfl_xor(v, o);
    return v;
}
__device__ __forceinline__ u32x2 tr_read(unsigned lds_addr) { u32x2 r; asm volatile("ds_read_b64_tr_b16 %0, %1\n\ts_waitcnt lgkmcnt(0)" : "=&v"(r) : "v"(lds_addr) : "memory"); return r; }

namespace pg8 {
constexpr int BM = 256, BK = 64, HALF = 128, HTB = HALF * BK * 2, STAGE_BYTES = 8 * HTB, NXCD = 8, WGM = 8;
__device__ __forceinline__ int lds_byte(int r, int c) { const int st = (r >> 4) * 2 + (c >> 5), rr = r & 15, cc = c & 31, ob = rr * 64 + cc * 2; return st * 1024 + (ob ^ (((ob >> 9) & 1) << 5)); }
__device__ __forceinline__ void stage_rc(int b, int& R, int& C) { const int st = b / 1024, sb = b % 1024, swz = sb ^ (((sb >> 9) & 1) << 5); R = (st >> 1) * 16 + swz / 64; C = (st & 1) * 32 + (swz % 64) / 2; }
__device__ __forceinline__ int perm32(int rho) { const int n = rho >> 4, i = rho & 15; return 8 * (i >> 2) + 4 * n + (i & 3); }

struct Unit { int pm, pn, br; };
struct Gemm { const bf16_t* A; const bf16_t* Bt; };

template <int NM, int NN, int NBR>
struct Order {
    int G, c;
    __device__ __forceinline__ bool next(int i, Unit& u) const {
        constexpr int nwg = NM * NN;
        const int ti = i / NBR;
        const long L = (long)ti * G + c; if (L >= nwg) return false;
        int wgid = (int)L; { constexpr int q = nwg / NXCD, r = nwg % NXCD; const int xcd = wgid % NXCD, off = wgid / NXCD; wgid = (xcd < r ? xcd * (q + 1) : r * (q + 1) + (xcd - r) * q) + off; }
        constexpr int nig = WGM * NN; const int gid = wgid / nig, fm = gid * WGM, gsz = (NM - fm) < WGM ? (NM - fm) : WGM;
        u.pm = fm + ((wgid % nig) % gsz); u.pn = (wgid % nig) / gsz; u.br = i % NBR; return true;
    }
};

struct EpiProj {
    static constexpr bool PERM = true;
    static __device__ __forceinline__ bool zero_after(const Unit&) { return true; }
    bf16_t* O; bf16_t* G;
    __device__ __forceinline__ void operator()(f32x4 (&acc)[2][2][4][2], const Unit& u, int wr, int wc, int fr_, int fq) const {
        int fr = fr_; asm volatile("" : "+v"(fr));
        if (u.pn < GATE0 / BM) {
            const int row0 = u.pm * BM + wr * 64 + fr, col0 = (u.pn & 1) * BM + wc * 32 + 8 * fq;
            bf16_t* Op = O + (size_t)(u.pn >> 1) * TS * BWID;
#pragma unroll
            for (int ai = 0; ai < 2; ++ai)
#pragma unroll
                for (int m = 0; m < 4; ++m) { bf16_t* rowp = Op + (size_t)(row0 + ai * HALF + m * 16) * BWID + col0;
#pragma unroll
                    for (int bj = 0; bj < 2; ++bj) { const f32x4 v0 = acc[ai][bj][m][0], v1 = acc[ai][bj][m][1];
                        u32x4 w; w.x = cvt_pk_bf16(v0[0], v0[1]); w.y = cvt_pk_bf16(v0[2], v0[3]); w.z = cvt_pk_bf16(v1[0], v1[1]); w.w = cvt_pk_bf16(v1[2], v1[3]);
                        __builtin_nontemporal_store(w, (u32x4*)(rowp + bj * HALF)); } }
        } else {
            unsigned char* gb = (unsigned char*)G + ((size_t)u.pm * 16 + (u.pn - GATE0 / BM)) * 65536 + (((wr * 4 + wc) * 4 + fq) * 16 + fr) * 16;
#pragma unroll
            for (int ai = 0; ai < 2; ++ai)
#pragma unroll
                for (int m = 0; m < 4; ++m) {
                    u32x4 w;
#pragma unroll
                    for (int bj = 0; bj < 2; ++bj)
#pragma unroll
                        for (int n = 0; n < 2; ++n) { unsigned q = 0u;
#pragma unroll
                            for (int j = 0; j < 4; ++j) q = __builtin_amdgcn_cvt_pk_u8_f32(fmaxf(255.0f * sigm(acc[ai][bj][m][n][j]), 1.0f), j, q);
                            w[bj * 2 + n] = q; }
                    __builtin_nontemporal_store(w, (u32x4*)(gb + (ai * 4 + m) * 8192)); }
        }
    }
};
struct EpiGate {
    static constexpr bool PERM = true;
    static __device__ __forceinline__ bool zero_after(const Unit& u) { return u.br == 3; }
    const bf16_t* G; bf16_t* merged;
    __device__ __forceinline__ void operator()(f32x4 (&acc)[2][2][4][2], const Unit& u, int wr, int wc, int fr_, int fq) const {
        int fr = fr_; asm volatile("" : "+v"(fr));
        const int lrow0 = wr * 64 + fr, lcol0 = wc * 32 + 8 * fq;
        const int br = u.br;
        const bool lastb = (br == 3);
        const unsigned char* gp0 = (const unsigned char*)G + ((size_t)u.pm * 16 + br * 4 + u.pn) * 65536 + (((wr * 4 + wc) * 4 + fq) * 16 + fr) * 16;
        const unsigned char* gnp = lastb ? gp0 : gp0 + 4 * 65536;
        u32x4 gc[2][4], gn[2][4];
#pragma unroll
        for (int ai = 0; ai < 2; ++ai)
#pragma unroll
            for (int m = 0; m < 4; ++m) { gc[ai][m] = *(const u32x4*)(gp0 + (ai * 4 + m) * 8192); gn[ai][m] = *(const u32x4*)(gnp + (ai * 4 + m) * 8192); }
#pragma unroll
        for (int ai = 0; ai < 2; ++ai)
#pragma unroll
            for (int m = 0; m < 4; ++m)
#pragma unroll
                for (int bj = 0; bj < 2; ++bj) {
#pragma unroll
                    for (int n = 0; n < 2; ++n) {
                        const unsigned c = gc[ai][m][bj * 2 + n], d = gn[ai][m][bj * 2 + n];
                        float fc[4], fd[4];
                        fc[0] = (float)(c & 0xffu); fc[1] = (float)((c >> 8) & 0xffu); fc[2] = (float)((c >> 16) & 0xffu); fc[3] = (float)(c >> 24);
                        fd[0] = (float)(d & 0xffu); fd[1] = (float)((d >> 8) & 0xffu); fd[2] = (float)((d >> 16) & 0xffu); fd[3] = (float)(d >> 24);
#pragma unroll
                        for (int j = 0; j < 4; ++j) acc[ai][bj][m][n][j] *= fc[j] * (lastb ? (1.0f / 255.0f) : __builtin_amdgcn_rcpf(fd[j]));
                    }
                    if (lastb) { const f32x4 v0 = acc[ai][bj][m][0], v1 = acc[ai][bj][m][1];
                        u32x4 w; w.x = cvt_pk_bf16(v0[0], v0[1]); w.y = cvt_pk_bf16(v0[2], v0[3]); w.z = cvt_pk_bf16(v1[0], v1[1]); w.w = cvt_pk_bf16(v1[2], v1[3]);
                        *(u32x4*)(merged + ((size_t)u.pm * BM + lrow0 + ai * HALF + m * 16) * DM + u.pn * BM + lcol0 + bj * HALF) = w; }
                }
    }
};
struct EpiRes {
    static constexpr bool PERM = false;
    static __device__ __forceinline__ bool zero_after(const Unit&) { return true; }
    const float* res; float* C; int ldc;
    __device__ __forceinline__ void operator()(const f32x4 (&acc)[2][2][4][2], const Unit& u, int wr, int wc, int fr_, int fq) const {
        int fr = fr_; asm volatile("" : "+v"(fr));
        const int row0 = u.pm * BM + wr * 64 + fr, col0 = u.pn * BM + wc * 32 + 4 * fq;
#pragma unroll
        for (int ai = 0; ai < 2; ++ai)
#pragma unroll
            for (int m = 0; m < 4; ++m) { const size_t off = (size_t)(row0 + ai * HALF + m * 16) * ldc + col0;
                f32x4 rv[2][2];
#pragma unroll
                for (int bj = 0; bj < 2; ++bj)
#pragma unroll
                    for (int n = 0; n < 2; ++n) rv[bj][n] = *(const f32x4*)(res + off + bj * HALF + n * 16);
#pragma unroll
                for (int bj = 0; bj < 2; ++bj)
#pragma unroll
                    for (int n = 0; n < 2; ++n) *(f32x4*)(C + off + bj * HALF + n * 16) = acc[ai][bj][m][n] + rv[bj][n]; }
    }
};

template <int K, size_t A_BR, size_t B_BR, class Epi, class Sched>
__device__ __forceinline__ void gemm_phase(LAS unsigned char* lds, const Gemm g, const Sched& S, const Epi& E) {
    const int tid = otid(), wid = __builtin_amdgcn_readfirstlane(tid >> 6), lane = tid & 63, wr = wid >> 2, wc = wid & 3, fr = lane & 15, fq = lane >> 4;
    constexpr int nt = K / BK;
    unsigned voffA[2], voffB[2];
#pragma unroll
    for (int i = 0; i < 2; ++i) { int R, C; stage_rc(tid * 16 + i * 8192, R, C); const int Rb = Epi::PERM ? ((R & ~31) + perm32(R & 31)) : R;
        voffA[i] = (unsigned)(R * K + C) * 2u; voffB[i] = (unsigned)(Rb * K + C) * 2u; }
    constexpr size_t kstep = (size_t)(BK * 2);
    constexpr size_t hstep = (size_t)HALF * K * 2;
    constexpr size_t tstep = 2 * hstep;
    const unsigned ldsw = (unsigned)wid * 1024u;
    const int aoff = lds_byte(wr * 64 + fr, fq * 8), boff = lds_byte(wc * 32 + fr, fq * 8);
#define PG8_SA(b, h) (((b) * 2 + (h)) * HTB)
#define PG8_SB(b, h) ((4 + (b) * 2 + (h)) * HTB)
#define PG8_STAGE(bufoff, gbase, voff) do { _Pragma("unroll") for (int _i = 0; _i < 2; ++_i) \
        __builtin_amdgcn_global_load_lds((const unsigned*)((const char*)(gbase) + (voff)[_i]), (LAS unsigned*)(lds + (bufoff) + ldsw + _i * 8192), 16, 0, 0); } while (0)
#define PG8_LDA(dst, b, h) do { _Pragma("unroll") for (int m = 0; m < 4; ++m) _Pragma("unroll") for (int k = 0; k < 2; ++k) dst[m][k] = *(const LAS bf16x8*)(lds + PG8_SA(b, h) + aoff + m * 2048 + k * 1024); } while (0)
#define PG8_LDB(dst, b, h) do { _Pragma("unroll") for (int n = 0; n < 2; ++n) _Pragma("unroll") for (int k = 0; k < 2; ++k) dst[n][k] = *(const LAS bf16x8*)(lds + PG8_SB(b, h) + boff + n * 2048 + k * 1024); } while (0)
#define PG8_MMA(ai, bj, At, Bt) do { __builtin_amdgcn_s_setprio(1); _Pragma("unroll") for (int m = 0; m < 4; ++m) _Pragma("unroll") for (int n = 0; n < 2; ++n) _Pragma("unroll") for (int k = 0; k < 2; ++k) \
        acc[ai][bj][m][n] = __builtin_amdgcn_mfma_f32_16x16x32_bf16(Bt[n][k], At[m][k], acc[ai][bj][m][n], 0, 0, 0); __builtin_amdgcn_s_setprio(0); } while (0)
#define PG8_WAIT_V(n) asm volatile("s_waitcnt vmcnt(" #n ")" ::: "memory")
#define PG8_WAIT_L(n) asm volatile("s_waitcnt lgkmcnt(" #n ")" ::: "memory")
#define PG8_BAR __builtin_amdgcn_s_barrier()
#define PG8_SCHED __builtin_amdgcn_sched_barrier(0)
    Unit cur, nxt; int ui = 0;
    if (!S.next(0, cur)) return;
    f32x4 acc[2][2][4][2];
#pragma unroll
    for (int a = 0; a < 2; ++a)
#pragma unroll
        for (int b = 0; b < 2; ++b)
#pragma unroll
            for (int m = 0; m < 4; ++m)
#pragma unroll
                for (int n = 0; n < 2; ++n) acc[a][b][m][n] = (f32x4){0.f, 0.f, 0.f, 0.f};
    bf16x8 At[4][2], B0[2][2], B1[2][2];
    const char* cA = (const char*)g.A + (size_t)cur.pm * tstep + (size_t)cur.br * A_BR; const char* cB = (const char*)g.Bt + (size_t)cur.pn * tstep + (size_t)cur.br * B_BR;
    PG8_STAGE(PG8_SB(0, 0), cB, voffB); PG8_STAGE(PG8_SA(0, 0), cA, voffA); PG8_STAGE(PG8_SB(0, 1), cB + hstep, voffB); PG8_STAGE(PG8_SA(0, 1), cA + hstep, voffA);
    if (wr == 1) PG8_BAR;
    PG8_WAIT_V(4); PG8_BAR;
    PG8_STAGE(PG8_SB(1, 0), cB + kstep, voffB); PG8_STAGE(PG8_SA(1, 0), cA + kstep, voffA); PG8_STAGE(PG8_SB(1, 1), cB + hstep + kstep, voffB);
    PG8_WAIT_V(6); PG8_BAR;
    for (;;) {
        const bool has_next = S.next(ui + 1, nxt);
        const char* nA = has_next ? (const char*)g.A + (size_t)nxt.pm * tstep + (size_t)nxt.br * A_BR : cA; const char* nB = has_next ? (const char*)g.Bt + (size_t)nxt.pn * tstep + (size_t)nxt.br * B_BR : cB;
        for (int t = 0; t < nt; t += 2) {
            const bool last = (t == nt - 2);
            const char* a1 = cA + (size_t)(t + 1) * kstep;
            const char* a2 = last ? nA : cA + (size_t)(t + 2) * kstep; const char* b2 = last ? nB : cB + (size_t)(t + 2) * kstep;
            const char* a3 = a2 + kstep; const char* b3 = b2 + kstep;
            PG8_LDB(B0, 0, 0); PG8_SCHED; PG8_LDA(At, 0, 0); PG8_STAGE(PG8_SA(1, 1), a1 + hstep, voffA);
            PG8_WAIT_L(8); PG8_BAR; PG8_WAIT_L(0); PG8_MMA(0, 0, At, B0); PG8_BAR; PG8_SCHED;
            PG8_LDB(B1, 0, 1); PG8_STAGE(PG8_SB(0, 0), b2, voffB);
            PG8_BAR; PG8_WAIT_L(0); PG8_MMA(0, 1, At, B1); PG8_BAR;
            PG8_LDA(At, 0, 1); PG8_STAGE(PG8_SA(0, 0), a2, voffA);
            PG8_BAR; PG8_WAIT_L(0); PG8_MMA(1, 0, At, B0); PG8_BAR; PG8_SCHED;
            PG8_STAGE(PG8_SB(0, 1), b2 + hstep, voffB);
            PG8_WAIT_V(6); PG8_BAR; PG8_MMA(1, 1, At, B1); PG8_BAR;
            PG8_LDB(B0, 1, 0); PG8_SCHED; PG8_LDA(At, 1, 0); PG8_STAGE(PG8_SA(0, 1), a2 + hstep, voffA);
            PG8_WAIT_L(8); PG8_BAR; PG8_WAIT_L(0); PG8_MMA(0, 0, At, B0); PG8_BAR; PG8_SCHED;
            PG8_LDB(B1, 1, 1); PG8_STAGE(PG8_SB(1, 0), b3, voffB);
            PG8_BAR; PG8_WAIT_L(0); PG8_MMA(0, 1, At, B1); PG8_BAR;
            PG8_LDA(At, 1, 1); PG8_STAGE(PG8_SA(1, 0), a3, voffA);
            PG8_BAR; PG8_WAIT_L(0); PG8_MMA(1, 0, At, B0); PG8_BAR; PG8_SCHED;
            PG8_STAGE(PG8_SB(1, 1), b3 + hstep, voffB);
            PG8_WAIT_V(6); PG8_BAR; PG8_MMA(1, 1, At, B1); PG8_BAR;
        }
        E(acc, cur, wr, wc, fr, fq);
        if (!has_next) break;
        if (Epi::zero_after(cur))
#pragma unroll
        for (int a = 0; a < 2; ++a)
#pragma unroll
            for (int b = 0; b < 2; ++b)
#pragma unroll
                for (int m = 0; m < 4; ++m)
#pragma unroll
                    for (int n = 0; n < 2; ++n) acc[a][b][m][n] = (f32x4){0.f, 0.f, 0.f, 0.f};
        cur = nxt; cA = nA; cB = nB; ++ui;
    }
    PG8_WAIT_V(0);
    if (wr == 0) PG8_BAR;
    PG8_BAR;
#undef PG8_SA
#undef PG8_SB
#undef PG8_STAGE
#undef PG8_LDA
#undef PG8_LDB
#undef PG8_MMA
#undef PG8_WAIT_V
#undef PG8_WAIT_L
#undef PG8_BAR
#undef PG8_SCHED
}
}

__device__ void phase_norm_bf16(const float* __restrict__ xin, const float* __restrict__ g, bf16_t* __restrict__ h, int rows);
struct TJob { const float* src; bf16_t* dst; int R, C, tr, tc; };
__device__ __forceinline__ TJob prep_job(const Params& p, int i) {
    bf16_t* win = (bf16_t*)(p.ws + p.o_win); bf16_t* wb = (bf16_t*)(p.ws + p.o_wb); bf16_t* wo = (bf16_t*)(p.ws + p.o_wo); bf16_t* pw = (bf16_t*)(p.ws + p.o_pw);
    constexpr int T_WIN = 16 * 160, T_WB = 8 * 16, T_WO = 16 * 16, T_PW = 4;
    constexpr int N0 = DEPTH * T_WIN, N1 = N0 + 8 * T_WB, N2 = N1 + DEPTH * T_WO;
    TJob j;
    if (i < N0) { const int l = i / T_WIN, t = i % T_WIN; j.src = p.in[2] + (size_t)l * DM * INC; j.dst = win + (size_t)l * DM * INC; j.R = DM; j.C = INC; j.tr = t / 160; j.tc = t % 160; }
    else if (i < N1) { const int k = i - N0, m = k / T_WB, t = k % T_WB; j.src = p.in[14] + (size_t)m * BWID * DM; j.dst = wb + (size_t)m * BWID * DM; j.R = BWID; j.C = DM; j.tr = t / 16; j.tc = t % 16; }
    else if (i < N2) { const int k = i - N1, l = k / T_WO, t = k % T_WO; j.src = p.in[15] + (size_t)l * DM * DM; j.dst = wo + (size_t)l * DM * DM; j.R = DM; j.C = DM; j.tr = t / 16; j.tc = t % 16; }
    else { const int k = i - N2, m = k / T_PW, t = k % T_PW; j.src = p.in[3] + (size_t)m * 128 * 128; j.dst = pw + (size_t)m * 128 * 128; j.R = 128; j.C = 128; j.tr = t / 2; j.tc = t % 2; }
    return j;
}
__device__ void phase_prep(const Params& p, LAS unsigned char* lds) {
    LAS float* sm = (LAS float*)lds;
    const int tid = otid();
    constexpr int NT = DEPTH * 16 * 160 + 8 * 8 * 16 + DEPTH * 16 * 16 + 8 * 4;
    const int lr = tid >> 4, lc = (tid & 15) * 4;
    f32x4 v0, v1;
    int i = blockIdx.x;
    if (i < NT) { const TJob j = prep_job(p, i); const float* sp = j.src + (size_t)(j.tr * 64 + lr) * j.C + j.tc * 64 + lc; v0 = *(const f32x4*)sp; v1 = *(const f32x4*)(sp + (size_t)32 * j.C); }
    for (; i < NT; i += gridDim.x) {
        const TJob j = prep_job(p, i);
#pragma unroll
        for (int e = 0; e < 4; ++e) { sm[lr * 65 + lc + e] = v0[e]; sm[(lr + 32) * 65 + lc + e] = v1[e]; }
        __syncthreads();
        const int in = i + gridDim.x;
        if (in < NT) { const TJob jn = prep_job(p, in); const float* sp = jn.src + (size_t)(jn.tr * 64 + lr) * jn.C + jn.tc * 64 + lc; v0 = *(const f32x4*)sp; v1 = *(const f32x4*)(sp + (size_t)32 * jn.C); }
        { const int c = tid >> 3, r8 = (tid & 7) * 8; float o[8];
#pragma unroll
          for (int e = 0; e < 8; ++e) o[e] = sm[(r8 + e) * 65 + c];
          *(u32x4*)(j.dst + (size_t)(j.tc * 64 + c) * j.R + j.tr * 64 + r8) = pack8(o); }
        __syncthreads();
    }
    const float* sgw = p.in[11]; bf16_t* sw = (bf16_t*)(p.ws + p.o_sw);
    for (int k = blockIdx.x * 512 + tid; k < DEPTH * 4 * 128 * 128; k += gridDim.x * 512) { const int s_ = k & 127, t = (k >> 7) & 127; sw[k] = (s_ <= t) ? f2bf(sgw[k]) : (bf16_t)0; }
    phase_norm_bf16(p.in[0], p.in[1], (bf16_t*)(p.ws + p.o_h), NTOK);
}

__device__ void phase_norm_bf16(const float* __restrict__ xin, const float* __restrict__ g, bf16_t* __restrict__ h, int rows) {
    const int tid = otid(), lane = tid & 63, w = tid >> 6;
    float gv[2][8];
    load8f(g + 8 * lane, gv[0]); load8f(g + 512 + 8 * lane, gv[1]);
    for (int row = blockIdx.x * 8 + w; row < rows; row += gridDim.x * 8) {
        const float* xr = xin + (size_t)row * DM + 8 * lane;
        float v[2][8]; load8f(xr, v[0]); load8f(xr + 512, v[1]);
        float ss = 0.f;
#pragma unroll
        for (int i = 0; i < 2; ++i)
#pragma unroll
            for (int j = 0; j < 8; ++j) ss += v[i][j] * v[i][j];
        ss = wave_sum(ss);
        const float r = rsqrtf(ss * (1.0f / 1024.0f) + 1e-6f);
#pragma unroll
        for (int i = 0; i < 2; ++i) { float o[8];
#pragma unroll
            for (int j = 0; j < 8; ++j) o[j] = v[i][j] * r * gv[i][j];
            *(u32x4*)(h + (size_t)row * DM + 512 * i + 8 * lane) = pack8(o); }
    }
}
__device__ void phase_norm_final(float* __restrict__ x, const float* __restrict__ g, int rows) {
    const int tid = otid(), lane = tid & 63, w = tid >> 6;
    float gv[2][8];
    load8f(g + 8 * lane, gv[0]); load8f(g + 512 + 8 * lane, gv[1]);
    for (int row = blockIdx.x * 8 + w; row < rows; row += gridDim.x * 8) {
        float* xr = x + (size_t)row * DM + 8 * lane;
        float v[2][8]; load8f(xr, v[0]); load8f(xr + 512, v[1]);
        float ss = 0.f;
#pragma unroll
        for (int i = 0; i < 2; ++i)
#pragma unroll
            for (int j = 0; j < 8; ++j) ss += v[i][j] * v[i][j];
        ss = wave_sum(ss);
        const float r = rsqrtf(ss * (1.0f / 1024.0f) + 1e-6f);
#pragma unroll
        for (int i = 0; i < 2; ++i) {
            f32x4 a, b;
#pragma unroll
            for (int j = 0; j < 4; ++j) { a[j] = v[i][j] * r * gv[i][j]; b[j] = v[i][4 + j] * r * gv[i][4 + j]; }
            *(f32x4*)(xr + 512 * i) = a; *(f32x4*)(xr + 512 * i + 4) = b; }
    }
}

#define PO(k) ((size_t)(k) * TS * BWID)
__device__ void mix_sc(const Params& p, int l, const bf16_t* __restrict__ proj, bf16_t* __restrict__ z3, int r0, int pos0) {
    const int tid = otid(), lane = tid & 63, w = tid >> 6, c0 = lane * 8;
    const float* scw = p.in[13] + (size_t)l * 3 * BWID + c0;
    float w0[8], w1[8], w2[8]; load8f(scw, w0); load8f(scw + BWID, w1); load8f(scw + 2 * BWID, w2);
    const int r = r0 + 16 * w, pos = pos0 + 16 * w;
    float p2[8], p1[8];
    if (pos > 0) {
        float a[8], b[8];
        unpack8(*(const u32x4*)(proj + (size_t)(r - 2) * BWID + PO(9) + c0), a); unpack8(*(const u32x4*)(proj + (size_t)(r - 2) * BWID + PO(10) + c0), b);
#pragma unroll
        for (int j = 0; j < 8; ++j) p2[j] = a[j] * b[j];
        unpack8(*(const u32x4*)(proj + (size_t)(r - 1) * BWID + PO(9) + c0), a); unpack8(*(const u32x4*)(proj + (size_t)(r - 1) * BWID + PO(10) + c0), b);
#pragma unroll
        for (int j = 0; j < 8; ++j) p1[j] = a[j] * b[j];
    } else {
#pragma unroll
        for (int j = 0; j < 8; ++j) { p2[j] = 0.f; p1[j] = 0.f; }
    }
#pragma unroll 4
    for (int jj = 0; jj < 16; ++jj) {
        const bf16_t* pr = proj + (size_t)(r + jj) * BWID + c0;
        float vb[8], vc[8], vx[8], vg[8], o[8];
        unpack8(*(const u32x4*)(pr + PO(8)), vb); unpack8(*(const u32x4*)(pr + PO(9)), vc); unpack8(*(const u32x4*)(pr + PO(10)), vx); unpack8(*(const u32x4*)(pr + PO(11)), vg);
#pragma unroll
        for (int j = 0; j < 8; ++j) { const float cur = vc[j] * vx[j]; const float cv = w0[j] * p2[j] + w1[j] * p1[j] + w2[j] * cur; o[j] = vb[j] * cv * silu(vg[j]); p2[j] = p1[j]; p1[j] = cur; }
        *(u32x4*)(z3 + (size_t)(r + jj) * BWID + c0) = pack8(o);
    }
}

__device__ void mix_conv(const Params& p, int l, const bf16_t* __restrict__ proj, bf16_t* __restrict__ z1, int r0, int pos0, LAS unsigned char* lds) {
    const int tid = otid(), lane = tid & 63, w = tid >> 6, c0 = lane * 8;
    LAS unsigned char* Y = lds; LAS unsigned char* W = lds + 94 * VP;
    const float* cw = p.in[5] + (size_t)l * 31 * BWID;
    for (int i = tid; i < 31 * 64; i += 512) { const int k = i >> 6, cgp = i & 63; float f[8]; load8f(cw + k * BWID + cgp * 8, f); *(LAS u32x4*)(W + k * 1024 + cgp * 16) = pack8(f); }
    float bias[8], lng[8], lnb[8];
    load8f(p.in[6] + (size_t)l * BWID + c0, bias); load8f(p.in[7] + (size_t)l * BWID + c0, lng); load8f(p.in[8] + (size_t)l * BWID + c0, lnb);
    for (int q = 0; q < 2; ++q) {
        const int tr = r0 + 64 * q, tp = pos0 + 64 * q;
        __syncthreads();
        {
            u32x4 la[12], lb[12];
#pragma unroll
            for (int i = 0; i < 12; ++i) { const int row = 12 * w + i; const bool valid = (row < 94) && (tp - 30 + row >= 0);
                la[i] = (u32x4){0u, 0u, 0u, 0u}; lb[i] = la[i];
                if (valid) { const bf16_t* pr = proj + (size_t)(tr - 30 + row) * BWID + c0; la[i] = *(const u32x4*)(pr + PO(2)); lb[i] = *(const u32x4*)(pr + PO(3)); } }
#pragma unroll
            for (int i = 0; i < 12; ++i) { const int row = 12 * w + i;
                if (row < 94) { float a[8], b[8], y[8]; unpack8(la[i], a); unpack8(lb[i], b);
#pragma unroll
                    for (int j = 0; j < 8; ++j) y[j] = a[j] * sigm(b[j]);
                    *(LAS u32x4*)(Y + row * VP + lane * 16) = pack8(y); } }
        }
        __syncthreads();
        u32x4 gtv[8];
#pragma unroll
        for (int j = 0; j < 8; ++j) gtv[j] = *(const u32x4*)(proj + (size_t)(tr + 8 * w + j) * BWID + PO(4) + c0);
        float acc[8][8];
#pragma unroll
        for (int j = 0; j < 8; ++j)
#pragma unroll
            for (int c = 0; c < 8; ++c) acc[j][c] = bias[c];
#pragma unroll 1
        for (int k = 0; k < 31; ++k) {
            float wv[8]; unpack8(*(const LAS u32x4*)(W + k * 1024 + lane * 16), wv);
#pragma unroll
            for (int j = 0; j < 8; ++j) { float yv[8]; unpack8(*(const LAS u32x4*)(Y + (8 * w + j + k) * VP + lane * 16), yv);
#pragma unroll
                for (int c = 0; c < 8; ++c) acc[j][c] += wv[c] * yv[c]; }
        }
#pragma unroll
        for (int j = 0; j < 8; ++j) {
            float s = 0.f, ss = 0.f;
#pragma unroll
            for (int c = 0; c < 8; ++c) { s += acc[j][c]; ss += acc[j][c] * acc[j][c]; }
            s = wave_sum(s); ss = wave_sum(ss);
            const float mean = s * (1.0f / 512.0f); const float var = fmaxf(ss * (1.0f / 512.0f) - mean * mean, 0.f); const float rstd = rsqrtf(var + 1e-5f);
            const int row = tr + 8 * w + j;
            float gt[8], o[8]; unpack8(gtv[j], gt);
#pragma unroll
            for (int c = 0; c < 8; ++c) { const float v = (acc[j][c] - mean) * rstd * lng[c] + lnb[c]; o[c] = silu(v) * silu(gt[c]); }
            *(u32x4*)(z1 + (size_t)row * BWID + c0) = pack8(o);
        }
    }
}

__device__ __forceinline__ u32x4 sel4(bool c, const u32x4 a, const u32x4 b) { u32x4 r; r.x = c ? a.x : b.x; r.y = c ? a.y : b.y; r.z = c ? a.z : b.z; r.w = c ? a.w : b.w; return r; }

__device__ void mix_pool(const Params& p, int l, const bf16_t* __restrict__ proj, bf16_t* __restrict__ z0, int r0, int pos0, LAS unsigned char* lds) {
    const int tid = otid(), lane = tid & 63, w = tid >> 6, c0 = lane * 8;
    LAS unsigned char* P = lds;
    {
        const int g4 = lane >> 4, win = 2 << g4;
        const int r = r0 + 16 * w, pos = pos0 + 16 * w;
        u32x4 R[32];
#pragma unroll
        for (int i = 0; i < 16; ++i) { R[i] = (u32x4){0u, 0u, 0u, 0u}; if (pos > 0) R[i] = *(const u32x4*)(proj + (size_t)(r - 16 + i) * BWID + c0); }
#pragma unroll
        for (int i = 0; i < 16; ++i) R[16 + i] = *(const u32x4*)(proj + (size_t)(r + i) * BWID + c0);
        float S[8];
#pragma unroll
        for (int j = 0; j < 8; ++j) S[j] = 0.f;
#pragma unroll
        for (int i = 1; i <= 16; ++i) { float x[8]; unpack8(R[16 - i], x); const float mk = (i <= win) ? 1.0f : 0.0f;
#pragma unroll
            for (int j = 0; j < 8; ++j) S[j] += mk * x[j]; }
#pragma unroll
        for (int jj = 0; jj < 16; ++jj) {
            const int ps = pos + jj; float xv[8], xo[8], o[8];
            unpack8(R[16 + jj], xv);
            const u32x4 ro = sel4(g4 < 2, sel4(g4 == 0, R[16 + jj - 2], R[16 + jj - 4]), sel4(g4 == 2, R[16 + jj - 8], R[jj]));
            unpack8(ro, xo);
            const int cnt = (ps + 1 < win) ? ps + 1 : win; const float inv = 1.0f / (float)cnt;
#pragma unroll
            for (int j = 0; j < 8; ++j) { S[j] += xv[j] - xo[j]; o[j] = S[j] * inv - xv[j]; }
            *(LAS u32x4*)(P + (16 * w + jj) * VP + lane * 16) = pack8(o);
        }
    }
    __syncthreads();
    {
        const int g = w >> 1, fr = lane & 15, fq = lane >> 4;
        const bf16_t* pwT = (const bf16_t*)(p.ws + p.o_pw) + (size_t)(l * 4 + g) * 128 * 128;
        u32x2 gtv[8][4];
#pragma unroll
        for (int tt = 0; tt < 8; ++tt)
#pragma unroll
            for (int dt = 0; dt < 4; ++dt) gtv[tt][dt] = *(const u32x2*)(proj + (size_t)(r0 + 16 * tt + fr) * BWID + PO(1) + 64 * w + 16 * dt + 4 * fq);
        bf16x8 A[4][4];
#pragma unroll
        for (int dt = 0; dt < 4; ++dt)
#pragma unroll
            for (int kk = 0; kk < 4; ++kk) A[dt][kk] = *(const bf16x8*)(pwT + (size_t)(64 * (w & 1) + 16 * dt + fr) * 128 + 32 * kk + 8 * fq);
        const float* psc = p.in[4] + (size_t)l * BWID;
        f32x4 sc[4];
#pragma unroll
        for (int dt = 0; dt < 4; ++dt) sc[dt] = *(const f32x4*)(psc + 64 * w + 16 * dt + 4 * fq);
#pragma unroll
        for (int tt = 0; tt < 8; ++tt) {
            bf16x8 Bf[4];
#pragma unroll
            for (int kk = 0; kk < 4; ++kk) Bf[kk] = *(const LAS bf16x8*)(P + (16 * tt + fr) * VP + (128 * g + 32 * kk + 8 * fq) * 2);
            f32x4 acc[4];
#pragma unroll
            for (int dt = 0; dt < 4; ++dt) { acc[dt] = (f32x4){0.f, 0.f, 0.f, 0.f};
#pragma unroll
                for (int kk = 0; kk < 4; ++kk) acc[dt] = __builtin_amdgcn_mfma_f32_16x16x32_bf16(A[dt][kk], Bf[kk], acc[dt], 0, 0, 0); }
            const int row = r0 + 16 * tt + fr;
#pragma unroll
            for (int dt = 0; dt < 4; ++dt) { const int d = 64 * w + 16 * dt + 4 * fq;
                float gt[4]; unpack4(gtv[tt][dt], gt);
                u32x2 o; o.x = cvt_pk_bf16(acc[dt][0] * sc[dt][0] * silu(gt[0]), acc[dt][1] * sc[dt][1] * silu(gt[1])); o.y = cvt_pk_bf16(acc[dt][2] * sc[dt][2] * silu(gt[2]), acc[dt][3] * sc[dt][3] * silu(gt[3]));
                *(u32x2*)(z0 + (size_t)row * BWID + d) = o; }
        }
    }
}

__device__ void mix_sgu(const Params& p, int l, const bf16_t* __restrict__ proj, bf16_t* __restrict__ z2, int r0, LAS unsigned char* lds) {
    const int tid = otid(), lane = tid & 63, w = tid >> 6, c0 = lane * 8;
    LAS unsigned char* V = lds;
    {
        float lng[8], lnb[8]; load8f(p.in[9] + (size_t)l * BWID + c0, lng); load8f(p.in[10] + (size_t)l * BWID + c0, lnb);
        u32x4 R[16];
#pragma unroll
        for (int jj = 0; jj < 16; ++jj) R[jj] = *(const u32x4*)(proj + (size_t)(r0 + 16 * w + jj) * BWID + PO(6) + c0);
#pragma unroll
        for (int jj = 0; jj < 16; ++jj) {
            float x[8], o[8]; unpack8(R[jj], x);
            float s = 0.f, ss = 0.f;
#pragma unroll
            for (int c = 0; c < 8; ++c) { s += x[c]; ss += x[c] * x[c]; }
            s = wave_sum(s); ss = wave_sum(ss);
            const float mean = s * (1.0f / 512.0f); const float var = fmaxf(ss * (1.0f / 512.0f) - mean * mean, 0.f); const float rstd = rsqrtf(var + 1e-5f);
#pragma unroll
            for (int c = 0; c < 8; ++c) o[c] = (x[c] - mean) * rstd * lng[c] + lnb[c];
            *(LAS u32x4*)(V + (16 * w + jj) * VP + lane * 16) = pack8(o);
        }
    }
    __syncthreads();
    {
        const int g = w >> 1, fr = lane & 15, fq = lane >> 4;
        const unsigned vbase = (unsigned)(size_t)V;
        bf16x8 A[4][4];
#pragma unroll
        for (int ct = 0; ct < 4; ++ct)
#pragma unroll
            for (int kk = 0; kk < 4; ++kk) {
                const unsigned a = vbase + (unsigned)((32 * kk + 8 * fq + (fr >> 2)) * VP + (64 * w + 16 * ct + 4 * (fr & 3)) * 2);
                const u32x2 lo = tr_read(a), hi = tr_read(a + 4 * VP);
                u32x4 t; t.x = lo.x; t.y = lo.y; t.z = hi.x; t.w = hi.y;
                A[ct][kk] = __builtin_bit_cast(bf16x8, t);
            }
        const bf16_t* swm = (const bf16_t*)(p.ws + p.o_sw) + (size_t)(l * 4 + g) * 128 * 128;
        const float* sb = p.in[12] + (size_t)(l * 4 + g) * 128;
#pragma unroll
        for (int hb = 0; hb < 2; ++hb) {
            u32x2 uu[4][4], gg[4][4]; bf16x8 Wf[4][4]; float bias[4];
#pragma unroll
            for (int t4 = 0; t4 < 4; ++t4) { const int tt = hb * 4 + t4; const bf16_t* pr = proj + (size_t)(r0 + 16 * tt + fr) * BWID + 64 * w + 4 * fq;
#pragma unroll
                for (int ct = 0; ct < 4; ++ct) { uu[t4][ct] = *(const u32x2*)(pr + PO(5) + 16 * ct); gg[t4][ct] = *(const u32x2*)(pr + PO(7) + 16 * ct); }
#pragma unroll
                for (int kk = 0; kk < 4; ++kk) if (kk < (tt >> 1) + 1) Wf[t4][kk] = *(const bf16x8*)(swm + (size_t)(16 * tt + fr) * 128 + 32 * kk + 8 * fq);
                bias[t4] = sb[16 * tt + fr]; }
#pragma unroll
            for (int t4 = 0; t4 < 4; ++t4) { const int tt = hb * 4 + t4;
                f32x4 acc[4];
#pragma unroll
                for (int ct = 0; ct < 4; ++ct) acc[ct] = (f32x4){0.f, 0.f, 0.f, 0.f};
#pragma unroll
                for (int kk = 0; kk < 4; ++kk) if (kk < (tt >> 1) + 1) {
#pragma unroll
                    for (int ct = 0; ct < 4; ++ct) acc[ct] = __builtin_amdgcn_mfma_f32_16x16x32_bf16(A[ct][kk], Wf[t4][kk], acc[ct], 0, 0, 0); }
                const int row = r0 + 16 * tt + fr;
#pragma unroll
                for (int ct = 0; ct < 4; ++ct) { const int c = 64 * w + 16 * ct + 4 * fq;
                    float u[4], gt[4]; unpack4(uu[t4][ct], u); unpack4(gg[t4][ct], gt);
                    u32x2 o; o.x = cvt_pk_bf16(u[0] * (acc[ct][0] + bias[t4]) * silu(gt[0]), u[1] * (acc[ct][1] + bias[t4]) * silu(gt[1])); o.y = cvt_pk_bf16(u[2] * (acc[ct][2] + bias[t4]) * silu(gt[2]), u[3] * (acc[ct][3] + bias[t4]) * silu(gt[3]));
                    *(u32x2*)(z2 + (size_t)row * BWID + c) = o; }
            }
        }
    }
}

__device__ void phase_mix(const Params& p, int l, const bf16_t* proj, bf16_t* z, LAS unsigned char* lds) {
    constexpr int nchunk = TS / 128;
    constexpr size_t zs = (size_t)TS * BWID;
    for (int i = blockIdx.x; i < 4 * nchunk; i += gridDim.x) {
        const int br = i / nchunk, j = i % nchunk, r0 = j * 128, pos0 = (j & 15) * 128;
        if (br == 0) for (int rr = 0; rr < REP_M0; ++rr) { mix_pool(p, l, proj, z, r0, pos0, lds); __syncthreads(); }
        else if (br == 1) for (int rr = 0; rr < REP_M1; ++rr) { mix_conv(p, l, proj, z + zs, r0, pos0, lds); __syncthreads(); }
        else if (br == 2) for (int rr = 0; rr < REP_M2; ++rr) { mix_sgu(p, l, proj, z + 2 * zs, r0, lds); __syncthreads(); }
        else for (int rr = 0; rr < REP_M3; ++rr) { mix_sc(p, l, proj, z + 3 * zs, r0, pos0); __syncthreads(); }
    }
}

#define XB_TMO      128
#define XB_XCNT(j)  (256  + 64 * (j))
#define XB_XSUB(j)  (1280 + 64 * (j))
#define XB_XGEN(j)  (2304 + 64 * (j))
#define XB_TOP      3328
#define XB_TOPGEN   3392
#define XCD_BAR_WORDS 3456
#define XB_SPIN_CAP (1u << 20)
__device__ __forceinline__ unsigned xb_ld(unsigned* p)              { return __hip_atomic_load(p, __ATOMIC_RELAXED, __HIP_MEMORY_SCOPE_AGENT); }
__device__ __forceinline__ unsigned xb_add(unsigned* p, unsigned v) { return __hip_atomic_fetch_add(p, v, __ATOMIC_RELAXED, __HIP_MEMORY_SCOPE_AGENT); }
__device__ __forceinline__ unsigned xb_xcc_id() { return (unsigned)__builtin_amdgcn_s_getreg((3 << 11) | 20) & 0xFu; }
#define XB_SPIN(cond, bar) do { unsigned _sp = 0; while (cond) { __builtin_amdgcn_s_sleep(1); \
    if ((++_sp & 255u) == 0u) { if (xb_ld(&(bar)[XB_TMO])) break; if (_sp > XB_SPIN_CAP) { atomicAdd(&(bar)[XB_TMO], 1u); break; } } } } while (0)
struct XcdBarrier { unsigned* bar; unsigned x; volatile LAS unsigned* st; };
__device__ __forceinline__ XcdBarrier xcd_barrier_post(unsigned* bar, volatile LAS unsigned* st) {
    XcdBarrier b; b.bar = bar; b.x = xb_xcc_id(); b.st = st;
    if (threadIdx.x == 0) (void)xb_add(&bar[XB_XCNT(b.x)], 1u);
    return b;
}
__device__ __forceinline__ void xcd_barrier_complete(unsigned* bar, unsigned x, unsigned& nloc, unsigned& nx) {
    const unsigned G = gridDim.x * gridDim.y * gridDim.z;
    unsigned sum, cnt, mine, sp = 0u;
    for (;;) {
        sum = 0u; cnt = 0u; mine = 0u;
#pragma unroll
        for (unsigned j = 0; j < 16; ++j) { const unsigned c = xb_ld(&bar[XB_XCNT(j)]); sum += c; cnt += (c > 0u) ? 1u : 0u; mine = (j == x) ? c : mine; }
        if (sum == G) break;
        __builtin_amdgcn_s_sleep(1);
        if ((++sp & 255u) == 0u) { if (xb_ld(&bar[XB_TMO])) break; if (sp > XB_SPIN_CAP) { atomicAdd(&bar[XB_TMO], 1u); break; } }
    }
    nloc = mine > 0u ? mine : 1u; nx = cnt > 0u ? cnt : 1u;
}
__device__ __forceinline__ void xcd_barrier(const XcdBarrier& b) {
    asm volatile("s_waitcnt vmcnt(0)" ::: "memory");
    __syncthreads();
    if (threadIdx.x == 0) {
        unsigned* bar = b.bar;
        __builtin_amdgcn_s_waitcnt(0);
        unsigned nloc = b.st[0], nx = b.st[1];
        if (nloc == 0u) { xcd_barrier_complete(bar, b.x, nloc, nx); b.st[0] = nloc; b.st[1] = nx; }
        const unsigned old = xb_add(&bar[XB_XSUB(b.x)], 1u);
        const unsigned gen = old / nloc;
        if (old + 1u == (gen + 1u) * nloc) {
            __builtin_amdgcn_fence(__ATOMIC_RELEASE, "agent");
            asm volatile("s_waitcnt vmcnt(0)" ::: "memory");
            const unsigned og = xb_add(&bar[XB_TOP], 1u);
            const unsigned tg = og / nx;
            if (og + 1u == (tg + 1u) * nx) xb_add(&bar[XB_TOPGEN], 1u);
            else XB_SPIN(xb_ld(&bar[XB_TOPGEN]) == tg, bar);
            __builtin_amdgcn_fence(__ATOMIC_ACQUIRE, "agent");
            xb_add(&bar[XB_XGEN(b.x)], 1u);
            asm volatile("s_waitcnt vmcnt(0)" ::: "memory");
        } else {
            XB_SPIN(xb_ld(&bar[XB_XGEN(b.x)]) == gen, bar);
            __builtin_amdgcn_fence(__ATOMIC_ACQUIRE, "agent");
            asm volatile("s_waitcnt vmcnt(0)" ::: "memory");
        }
    }
    __syncthreads();
}

__global__ void __launch_bounds__(512) mk_forward(Params p) {
    extern __shared__ __attribute__((aligned(16))) unsigned char lds_raw[];
    LAS unsigned char* lds = (LAS unsigned char*)lds_raw;
    cg::grid_group grid = cg::this_grid();
    volatile LAS unsigned* stw = (volatile LAS unsigned*)(lds + LDS_BYTES - 16);
    if (threadIdx.x == 0) { stw[0] = 0u; stw[1] = 0u; }
    __syncthreads();
    const XcdBarrier xbar = xcd_barrier_post((unsigned*)(p.ws + p.o_bar), stw);
    int ph = 0;
#define PHASE_ON (ph >= p.ph_lo && ph < p.ph_hi)
#ifndef XSYNC
#define XSYNC 0
#endif
#define PHASE_END do { if (PHASE_ON && ph + 1 < p.ph_hi) { if (ph == 0) grid.sync(); else xcd_barrier(xbar); for (int xs = 0; xs < XSYNC; ++xs) xcd_barrier(xbar); } ++ph; } while (0)
    constexpr int ts = TS;
    bf16_t* win = (bf16_t*)(p.ws + p.o_win); bf16_t* wb = (bf16_t*)(p.ws + p.o_wb); bf16_t* wo = (bf16_t*)(p.ws + p.o_wo);
    bf16_t* h0 = (bf16_t*)(p.ws + p.o_h); bf16_t* z = (bf16_t*)(p.ws + p.o_z); bf16_t* proj = (bf16_t*)(p.ws + p.o_proj);

    if (PHASE_ON) phase_prep(p, lds);
    PHASE_END;
#pragma unroll 1
    for (int l = 0; l < DEPTH; ++l) {
        const float* xin = (l == 0) ? p.in[0] : p.out;
#pragma unroll 1
        for (int s = 0; s < NS; ++s) {
            const size_t tok0 = (size_t)s * ts;
            bf16_t* h = h0 + tok0 * DM; bf16_t* merged = h;
            if (l > 0) { if (PHASE_ON) phase_norm_bf16(xin + tok0 * DM, p.in[1] + (size_t)l * DM, h, ts);
                PHASE_END; }
            if (PHASE_ON) for (int rep = 0; rep < REP_A; ++rep) { pg8::Gemm g{h, win + (size_t)l * DM * INC}; pg8::Order<TS / 256, INC / 256, 1> S{(int)gridDim.x, (int)blockIdx.x}; pg8::EpiProj E{proj, proj + (size_t)TS * PP}; pg8::gemm_phase<DM, 0, 0>(lds, g, S, E); }
            PHASE_END;
            if (PHASE_ON) for (int rep = 0; rep < REP_B; ++rep) phase_mix(p, l, proj, z, lds);
            PHASE_END;
            if (PHASE_ON) for (int rep = 0; rep < REP_C; ++rep) { pg8::Gemm g{z, wb + (size_t)l * 4 * BWID * DM}; pg8::Order<TS / 256, DM / 256, 4> S{(int)gridDim.x, (int)blockIdx.x};
                pg8::EpiGate E{proj + (size_t)TS * PP, merged}; pg8::gemm_phase<BWID, (size_t)TS * BWID * 2, (size_t)BWID * DM * 2>(lds, g, S, E); }
            PHASE_END;
            if (PHASE_ON) { pg8::Gemm g{merged, wo + (size_t)l * DM * DM}; pg8::Order<TS / 256, DM / 256, 1> S{(int)gridDim.x, (int)blockIdx.x};
                pg8::EpiRes E{xin + tok0 * DM, p.out + tok0 * DM, DM}; pg8::gemm_phase<DM, 0, 0>(lds, g, S, E); }
            PHASE_END;
        }
    }
    if (PHASE_ON) phase_norm_final(p.out, p.in[16], NTOK);
    PHASE_END;
}

extern "C" void kernel_launch(void* const* d_in, const int* in_sizes, int n_in, void* d_out, int out_size, void* d_ws, size_t ws_size, hipStream_t stream) {
    static int grid = 0;
    if (grid == 0) {
        int dev = 0, cus = 0, per_cu = 0;
        hipGetDevice(&dev); hipDeviceGetAttribute(&cus, hipDeviceAttributeMultiprocessorCount, dev);
        if (hipFuncSetAttribute((const void*)mk_forward, hipFuncAttributeMaxDynamicSharedMemorySize, LDS_BYTES) != hipSuccess) { fprintf(stderr, "hipFuncSetAttribute failed\n"); grid = -1; return; }
        if (hipOccupancyMaxActiveBlocksPerMultiprocessor(&per_cu, (const void*)mk_forward, 512, LDS_BYTES) != hipSuccess || per_cu < 1) { fprintf(stderr, "occupancy query: %d\n", per_cu); per_cu = 1; }
        (void)hipGetLastError();
        grid = cus * per_cu;
    }
    if (grid < 0) return;
    Params p{};
    for (int i = 0; i < 17; ++i) p.in[i] = (const float*)d_in[i];
    p.out = (float*)d_out; p.ws = (unsigned char*)d_ws;
    p.ns = NS; p.ts = TS;
    size_t o = 0;
    p.o_win = o; o += (size_t)DEPTH * DM * INC * 2;
    p.o_wb = o; o += (size_t)DEPTH * 4 * BWID * DM * 2;
    p.o_wo = o; o += (size_t)DEPTH * DM * DM * 2;
    p.o_pw = o; o += (size_t)DEPTH * 4 * 128 * 128 * 2;
    p.o_sw = o; o += (size_t)DEPTH * 4 * 128 * 128 * 2;
    p.o_bar = o; o += 16384;
    p.o_h = o; o += (size_t)NTOK * DM * 2;
    p.o_z = o; o += 4 * (size_t)p.ts * BWID * 2;
    p.o_proj = o; o += (size_t)p.ts * INC * 2;
    if (o > ws_size) { fprintf(stderr, "kernel_launch: workspace too small: need %zu, have %zu\n", o, ws_size); return; }
    const int nph = 1 + NS * 4 + (DEPTH - 1) * NS * 5 + 1;
    if (hipMemsetAsync((char*)d_ws + p.o_bar, 0, 16384, stream) != hipSuccess) { fprintf(stderr, "kernel_launch: memset failed\n"); return; }
#if MULTI_LAUNCH
    for (int ph = 0; ph < nph; ++ph) { p.ph_lo = ph; p.ph_hi = ph + 1; hipLaunchKernelGGL(mk_forward, dim3(grid), dim3(512), LDS_BYTES, stream, p); }
#else
    p.ph_lo = 0; p.ph_hi = nph;
    void* args[] = {&p};
    hipError_t e = hipLaunchCooperativeKernel((const void*)mk_forward, dim3(grid), dim3(512), args, LDS_BYTES, stream);
    if (e != hipSuccess) fprintf(stderr, "cooperative launch failed: %s (grid %d)\n", hipGetErrorString(e), grid);
#endif
}
```

```cpp
#include <hip/hip_runtime.h>
#include <hip/hip_cooperative_groups.h>
#include <cstdio>
namespace cg = cooperative_groups;

#ifndef MULTI_LAUNCH
#define MULTI_LAUNCH 0
#endif

#ifndef REP_N
#define REP_N 1
#endif
#ifndef REP_A
#define REP_A 1
#endif
#ifndef REP_B
#define REP_B 1
#endif
#ifndef REP_C
#define REP_C 1
#endif
#define REP_M0 1
#define REP_M1 1
#define REP_M2 1
#define REP_M3 1
#define LAS __attribute__((address_space(3)))
typedef unsigned short bf16_t;
typedef short bf16x8 __attribute__((ext_vector_type(8)));
typedef float f32x4 __attribute__((ext_vector_type(4)));
typedef float f32x2 __attribute__((ext_vector_type(2)));
typedef unsigned u32x4 __attribute__((ext_vector_type(4)));
typedef unsigned u32x2 __attribute__((ext_vector_type(2)));

constexpr int DM = 1024, SEQ = 2048, NTOK = 32 * 2048, DEPTH = 2, BWID = 512, INC = 10240, GATE0 = 6144;
constexpr int PP = 6144;
constexpr int NS = 2, TS = NTOK / NS;
constexpr int LDS_BYTES = 139264;
constexpr int VP = 1040;

struct Params {
    const float* in[17];
    float* out;
    unsigned char* ws;
    int ts, ns, ph_lo, ph_hi;
    unsigned long long o_win, o_wb, o_wo, o_pw, o_sw, o_h, o_z, o_bar, o_proj;
};

__device__ __forceinline__ int otid() { int t = threadIdx.x; asm volatile("" : "+v"(t)); return t; }
__device__ __forceinline__ unsigned cvt_pk_bf16(float lo, float hi) { unsigned r; asm volatile("v_cvt_pk_bf16_f32 %0, %1, %2" : "=v"(r) : "v"(lo), "v"(hi)); return r; }
__device__ __forceinline__ bf16_t f2bf(float f) { unsigned u = __float_as_uint(f); u += 0x7FFFu + ((u >> 16) & 1u); return (bf16_t)(u >> 16); }
__device__ __forceinline__ void unpack8(const u32x4 v, float (&f)[8]) {
    f[0] = __uint_as_float(v.x << 16); f[1] = __uint_as_float(v.x & 0xffff0000u); f[2] = __uint_as_float(v.y << 16); f[3] = __uint_as_float(v.y & 0xffff0000u);
    f[4] = __uint_as_float(v.z << 16); f[5] = __uint_as_float(v.z & 0xffff0000u); f[6] = __uint_as_float(v.w << 16); f[7] = __uint_as_float(v.w & 0xffff0000u);
}
__device__ __forceinline__ u32x4 pack8(const float (&f)[8]) { u32x4 r; r.x = cvt_pk_bf16(f[0], f[1]); r.y = cvt_pk_bf16(f[2], f[3]); r.z = cvt_pk_bf16(f[4], f[5]); r.w = cvt_pk_bf16(f[6], f[7]); return r; }
__device__ __forceinline__ void unpack4(const u32x2 v, float (&f)[4]) { f[0] = __uint_as_float(v.x << 16); f[1] = __uint_as_float(v.x & 0xffff0000u); f[2] = __uint_as_float(v.y << 16); f[3] = __uint_as_float(v.y & 0xffff0000u); }
__device__ __forceinline__ float sigm(float x) { return __builtin_amdgcn_rcpf(1.0f + __expf(-x)); }
__device__ __forceinline__ float silu(float x) { return x * sigm(x); }
__device__ __forceinline__ void load8f(const float* p, float (&f)[8]) { const f32x4 a = *(const f32x4*)p, b = *(const f32x4*)(p + 4); f[0] = a[0]; f[1] = a[1]; f[2] = a[2]; f[3] = a[3]; f[4] = b[0]; f[5] = b[1]; f[6] = b[2]; f[7] = b[3]; }
__device__ __forceinline__ float wave_sum(float v) {
#pragma unroll
    for (int o = 32; o >= 1; o >>= 1) v += __shfl_xor(v, o);
    return v;
}
__device__ __forceinline__ u32x2 tr_read(unsigned lds_addr) { u32x2 r; asm volatile("ds_read_b64_tr_b16 %0, %1\n\ts_waitcnt lgkmcnt(0)" : "=&v"(r) : "v"(lds_addr) : "memory"); return r; }

namespace pg8 {
constexpr int BM = 256, BK = 64, HALF = 128, HTB = HALF * BK * 2, STAGE_BYTES = 8 * HTB, NXCD = 8, WGM = 8;
__device__ __forceinline__ int lds_byte(int r, int c) { const int st = (r >> 4) * 2 + (c >> 5), rr = r & 15, cc = c & 31, ob = rr * 64 + cc * 2; return st * 1024 + (ob ^ (((ob >> 9) & 1) << 5)); }
__device__ __forceinline__ void stage_rc(int b, int& R, int& C) { const int st = b / 1024, sb = b % 1024, swz = sb ^ (((sb >> 9) & 1) << 5); R = (st >> 1) * 16 + swz / 64; C = (st & 1) * 32 + (swz % 64) / 2; }
__device__ __forceinline__ int perm32(int rho) { const int n = rho >> 4, i = rho & 15; return 8 * (i >> 2) + 4 * n + (i & 3); }

struct Unit { int pm, pn, br; };
struct Gemm { const bf16_t* A; const bf16_t* Bt; };

template <int NM, int NN, int NBR>
struct Order {
    int G, c;
    __device__ __forceinline__ bool next(int i, Unit& u) const {
        constexpr int nwg = NM * NN;
        const int ti = i / NBR;
        const long L = (long)ti * G + c; if (L >= nwg) return false;
        int wgid = (int)L; { constexpr int q = nwg / NXCD, r = nwg % NXCD; const int xcd = wgid % NXCD, off = wgid / NXCD; wgid = (xcd < r ? xcd * (q + 1) : r * (q + 1) + (xcd - r) * q) + off; }
        constexpr int nig = WGM * NN; const int gid = wgid / nig, fm = gid * WGM, gsz = (NM - fm) < WGM ? (NM - fm) : WGM;
        u.pm = fm + ((wgid % nig) % gsz); u.pn = (wgid % nig) / gsz; u.br = i % NBR; return true;
    }
    __device__ __forceinline__ void brow(const Unit& u, int& r0, int& r1) const { r0 = u.pn * BM; r1 = r0 + HALF; }
};
struct OrderA : Order<TS / 256, INC / 256, 1> {
    __device__ __forceinline__ void brow(const Unit& u, int& r0, int& r1) const {
        const int pn = u.pn;
        if (pn < 8) { const int pc = pn >> 1; const int piece = (pc == 0) ? 0 : (pc == 1) ? 1 : (pc == 2) ? 4 : 6; r0 = piece * 512 + (pn & 1) * 256; r1 = r0 + HALF; }
        else if (pn < 24) { const int q = (pn - 8) >> 2, sub = (pn - 8) & 3; const int pa = (q == 0) ? 2 : (q == 1) ? 9 : (q == 2) ? 8 : 5, pb = (q == 0) ? 3 : (q == 1) ? 10 : (q == 2) ? 11 : 7;
            r0 = pa * 512 + HALF * sub; r1 = pb * 512 + HALF * sub; }
        else { r0 = pn * BM; r1 = r0 + HALF; }
    }
};

struct EpiProj {
    static constexpr bool PERM = true;
    static __device__ __forceinline__ bool zero_after(const Unit&) { return true; }
    bf16_t* O; bf16_t* G;
    __device__ __forceinline__ void operator()(f32x4 (&acc)[2][2][4][2], const Unit& u, int wr, int wc, int fr_, int fq) const {
        int fr = fr_; asm volatile("" : "+v"(fr));
        if (u.pn < 8) {
            const int pc = u.pn >> 1; const int slot = (pc == 0) ? 0 : (pc == 1) ? 1 : (pc == 2) ? 3 : 5;
            const int row0 = u.pm * BM + wr * 64 + fr, col0 = (u.pn & 1) * BM + wc * 32 + 8 * fq;
            bf16_t* Op = O + (size_t)slot * TS * BWID;
#pragma unroll
            for (int ai = 0; ai < 2; ++ai)
#pragma unroll
                for (int m = 0; m < 4; ++m) { bf16_t* rowp = Op + (size_t)(row0 + ai * HALF + m * 16) * BWID + col0;
#pragma unroll
                    for (int bj = 0; bj < 2; ++bj) { const f32x4 v0 = acc[ai][bj][m][0], v1 = acc[ai][bj][m][1];
                        u32x4 w; w.x = cvt_pk_bf16(v0[0], v0[1]); w.y = cvt_pk_bf16(v0[2], v0[3]); w.z = cvt_pk_bf16(v1[0], v1[1]); w.w = cvt_pk_bf16(v1[2], v1[3]);
                        __builtin_nontemporal_store(w, (u32x4*)(rowp + bj * HALF)); } }
        } else if (u.pn < GATE0 / BM) {
            const int q = (u.pn - 8) >> 2, sub = (u.pn - 8) & 3; const int slot = (q == 0) ? 2 : (q == 1) ? 7 : (q == 2) ? 6 : 4;
            const int row0 = u.pm * BM + wr * 64 + fr, col0 = sub * HALF + wc * 32 + 8 * fq;
            bf16_t* Op = O + (size_t)slot * TS * BWID;
#pragma unroll
            for (int ai = 0; ai < 2; ++ai)
#pragma unroll
                for (int m = 0; m < 4; ++m) {
                    float f[8];
#pragma unroll
                    for (int n = 0; n < 2; ++n)
#pragma unroll
                        for (int j = 0; j < 4; ++j) { const float av = acc[ai][0][m][n][j], bv = acc[ai][1][m][n][j]; const float sg = sigm(bv);
                            f[n * 4 + j] = av * ((q == 1) ? bv : (q == 0) ? sg : bv * sg); }
                    __builtin_nontemporal_store(pack8(f), (u32x4*)(Op + (size_t)(row0 + ai * HALF + m * 16) * BWID + col0)); }
        } else {
            unsigned char* gb = (unsigned char*)G + ((size_t)u.pm * 16 + (u.pn - GATE0 / BM)) * 65536 + (((wr * 4 + wc) * 4 + fq) * 16 + fr) * 16;
#pragma unroll
            for (int ai = 0; ai < 2; ++ai)
#pragma unroll
                for (int m = 0; m < 4; ++m) {
                    u32x4 w;
#pragma unroll
                    for (int bj = 0; bj < 2; ++bj)
#pragma unroll
                        for (int n = 0; n < 2; ++n) { unsigned q = 0u;
#pragma unroll
                            for (int j = 0; j < 4; ++j) q = __builtin_amdgcn_cvt_pk_u8_f32(fmaxf(255.0f * sigm(acc[ai][bj][m][n][j]), 1.0f), j, q);
                            w[bj * 2 + n] = q; }
                    __builtin_nontemporal_store(w, (u32x4*)(gb + (ai * 4 + m) * 8192)); }
        }
    }
};
struct EpiGate {
    static constexpr bool PERM = true;
    static __device__ __forceinline__ bool zero_after(const Unit& u) { return u.br == 3; }
    const bf16_t* G; bf16_t* merged;
    __device__ __forceinline__ void operator()(f32x4 (&acc)[2][2][4][2], const Unit& u, int wr, int wc, int fr_, int fq) const {
        int fr = fr_; asm volatile("" : "+v"(fr));
        const int lrow0 = wr * 64 + fr, lcol0 = wc * 32 + 8 * fq;
        const int br = u.br;
        const bool lastb = (br == 3);
        const unsigned char* gp0 = (const unsigned char*)G + ((size_t)u.pm * 16 + br * 4 + u.pn) * 65536 + (((wr * 4 + wc) * 4 + fq) * 16 + fr) * 16;
        const unsigned char* gnp = lastb ? gp0 : gp0 + 4 * 65536;
        u32x4 gc[2][4], gn[2][4];
#pragma unroll
        for (int ai = 0; ai < 2; ++ai)
#pragma unroll
            for (int m = 0; m < 4; ++m) { gc[ai][m] = *(const u32x4*)(gp0 + (ai * 4 + m) * 8192); gn[ai][m] = *(const u32x4*)(gnp + (ai * 4 + m) * 8192); }
#pragma unroll
        for (int ai = 0; ai < 2; ++ai)
#pragma unroll
            for (int m = 0; m < 4; ++m)
#pragma unroll
                for (int bj = 0; bj < 2; ++bj) {
#pragma unroll
                    for (int n = 0; n < 2; ++n) {
                        const unsigned c = gc[ai][m][bj * 2 + n], d = gn[ai][m][bj * 2 + n];
                        float fc[4], fd[4];
                        fc[0] = (float)(c & 0xffu); fc[1] = (float)((c >> 8) & 0xffu); fc[2] = (float)((c >> 16) & 0xffu); fc[3] = (float)(c >> 24);
                        fd[0] = (float)(d & 0xffu); fd[1] = (float)((d >> 8) & 0xffu); fd[2] = (float)((d >> 16) & 0xffu); fd[3] = (float)(d >> 24);
#pragma unroll
                        for (int j = 0; j < 4; ++j) acc[ai][bj][m][n][j] *= fc[j] * (lastb ? (1.0f / 255.0f) : __builtin_amdgcn_rcpf(fd[j]));
                    }
                    if (lastb) { const f32x4 v0 = acc[ai][bj][m][0], v1 = acc[ai][bj][m][1];
                        u32x4 w; w.x = cvt_pk_bf16(v0[0], v0[1]); w.y = cvt_pk_bf16(v0[2], v0[3]); w.z = cvt_pk_bf16(v1[0], v1[1]); w.w = cvt_pk_bf16(v1[2], v1[3]);
                        *(u32x4*)(merged + ((size_t)u.pm * BM + lrow0 + ai * HALF + m * 16) * DM + u.pn * BM + lcol0 + bj * HALF) = w; }
                }
    }
};
struct EpiRes {
    static constexpr bool PERM = false;
    static __device__ __forceinline__ bool zero_after(const Unit&) { return true; }
    const float* res; float* C; int ldc;
    __device__ __forceinline__ void operator()(const f32x4 (&acc)[2][2][4][2], const Unit& u, int wr, int wc, int fr_, int fq) const {
        int fr = fr_; asm volatile("" : "+v"(fr));
        const int row0 = u.pm * BM + wr * 64 + fr, col0 = u.pn * BM + wc * 32 + 4 * fq;
#pragma unroll
        for (int ai = 0; ai < 2; ++ai)
#pragma unroll
            for (int m = 0; m < 4; ++m) { const size_t off = (size_t)(row0 + ai * HALF + m * 16) * ldc + col0;
                f32x4 rv[2][2];
#pragma unroll
                for (int bj = 0; bj < 2; ++bj)
#pragma unroll
                    for (int n = 0; n < 2; ++n) rv[bj][n] = *(const f32x4*)(res + off + bj * HALF + n * 16);
#pragma unroll
                for (int bj = 0; bj < 2; ++bj)
#pragma unroll
                    for (int n = 0; n < 2; ++n) *(f32x4*)(C + off + bj * HALF + n * 16) = acc[ai][bj][m][n] + rv[bj][n]; }
    }
};

template <int K, size_t A_BR, size_t B_BR, class Epi, class Sched>
__device__ __forceinline__ void gemm_phase(LAS unsigned char* lds, const Gemm g, const Sched& S, const Epi& E) {
    const int tid = otid(), wid = __builtin_amdgcn_readfirstlane(tid >> 6), lane = tid & 63, wr = wid >> 2, wc = wid & 3, fr = lane & 15, fq = lane >> 4;
    constexpr int nt = K / BK;
    unsigned voffA[2], voffB[2];
#pragma unroll
    for (int i = 0; i < 2; ++i) { int R, C; stage_rc(tid * 16 + i * 8192, R, C); const int Rb = Epi::PERM ? ((R & ~31) + perm32(R & 31)) : R;
        voffA[i] = (unsigned)(R * K + C) * 2u; voffB[i] = (unsigned)(Rb * K + C) * 2u; }
    constexpr size_t kstep = (size_t)(BK * 2);
    constexpr size_t hstep = (size_t)HALF * K * 2;
    constexpr size_t tstep = 2 * hstep;
    const unsigned ldsw = (unsigned)wid * 1024u;
    const int aoff = lds_byte(wr * 64 + fr, fq * 8), boff = lds_byte(wc * 32 + fr, fq * 8);
#define PG8_SA(b, h) (((b) * 2 + (h)) * HTB)
#define PG8_SB(b, h) ((4 + (b) * 2 + (h)) * HTB)
#define PG8_STAGE(bufoff, gbase, voff) do { _Pragma("unroll") for (int _i = 0; _i < 2; ++_i) \
        __builtin_amdgcn_global_load_lds((const unsigned*)((const char*)(gbase) + (voff)[_i]), (LAS unsigned*)(lds + (bufoff) + ldsw + _i * 8192), 16, 0, 0); } while (0)
#define PG8_LDA(dst, b, h) do { _Pragma("unroll") for (int m = 0; m < 4; ++m) _Pragma("unroll") for (int k = 0; k < 2; ++k) dst[m][k] = *(const LAS bf16x8*)(lds + PG8_SA(b, h) + aoff + m * 2048 + k * 1024); } while (0)
#define PG8_LDB(dst, b, h) do { _Pragma("unroll") for (int n = 0; n < 2; ++n) _Pragma("unroll") for (int k = 0; k < 2; ++k) dst[n][k] = *(const LAS bf16x8*)(lds + PG8_SB(b, h) + boff + n * 2048 + k * 1024); } while (0)
#define PG8_MMA(ai, bj, At, Bt) do { __builtin_amdgcn_s_setprio(1); _Pragma("unroll") for (int m = 0; m < 4; ++m) _Pragma("unroll") for (int n = 0; n < 2; ++n) _Pragma("unroll") for (int k = 0; k < 2; ++k) \
        acc[ai][bj][m][n] = __builtin_amdgcn_mfma_f32_16x16x32_bf16(Bt[n][k], At[m][k], acc[ai][bj][m][n], 0, 0, 0); __builtin_amdgcn_s_setprio(0); } while (0)
#define PG8_WAIT_V(n) asm volatile("s_waitcnt vmcnt(" #n ")" ::: "memory")
#define PG8_WAIT_L(n) asm volatile("s_waitcnt lgkmcnt(" #n ")" ::: "memory")
#define PG8_BAR __builtin_amdgcn_s_barrier()
#define PG8_SCHED __builtin_amdgcn_sched_barrier(0)
    Unit cur, nxt; int ui = 0;
    if (!S.next(0, cur)) return;
    f32x4 acc[2][2][4][2];
#pragma unroll
    for (int a = 0; a < 2; ++a)
#pragma unroll
        for (int b = 0; b < 2; ++b)
#pragma unroll
            for (int m = 0; m < 4; ++m)
#pragma unroll
                for (int n = 0; n < 2; ++n) acc[a][b][m][n] = (f32x4){0.f, 0.f, 0.f, 0.f};
    bf16x8 At[4][2], B0[2][2], B1[2][2];
    const char* cA = (const char*)g.A + (size_t)cur.pm * tstep + (size_t)cur.br * A_BR; int rb0, rb1; S.brow(cur, rb0, rb1);
    const char* cB = (const char*)g.Bt + (size_t)rb0 * (K * 2) + (size_t)cur.br * B_BR; const char* cBh = (const char*)g.Bt + (size_t)rb1 * (K * 2) + (size_t)cur.br * B_BR;
    PG8_STAGE(PG8_SB(0, 0), cB, voffB); PG8_STAGE(PG8_SA(0, 0), cA, voffA); PG8_STAGE(PG8_SB(0, 1), cBh, voffB); PG8_STAGE(PG8_SA(0, 1), cA + hstep, voffA);
    if (wr == 1) PG8_BAR;
    PG8_WAIT_V(4); PG8_BAR;
    PG8_STAGE(PG8_SB(1, 0), cB + kstep, voffB); PG8_STAGE(PG8_SA(1, 0), cA + kstep, voffA); PG8_STAGE(PG8_SB(1, 1), cBh + kstep, voffB);
    PG8_WAIT_V(6); PG8_BAR;
    for (;;) {
        const bool has_next = S.next(ui + 1, nxt);
        const char* nA = has_next ? (const char*)g.A + (size_t)nxt.pm * tstep + (size_t)nxt.br * A_BR : cA; int rn0 = 0, rn1 = 0; if (has_next) S.brow(nxt, rn0, rn1);
        const char* nB = has_next ? (const char*)g.Bt + (size_t)rn0 * (K * 2) + (size_t)nxt.br * B_BR : cB; const char* nBh = has_next ? (const char*)g.Bt + (size_t)rn1 * (K * 2) + (size_t)nxt.br * B_BR : cBh;
        for (int t = 0; t < nt; t += 2) {
            const bool last = (t == nt - 2);
            const char* a1 = cA + (size_t)(t + 1) * kstep;
            const char* a2 = last ? nA : cA + (size_t)(t + 2) * kstep; const char* b2 = last ? nB : cB + (size_t)(t + 2) * kstep; const char* b2h = last ? nBh : cBh + (size_t)(t + 2) * kstep;
            const char* a3 = a2 + kstep; const char* b3 = b2 + kstep; const char* b3h = b2h + kstep;
            PG8_LDB(B0, 0, 0); PG8_SCHED; PG8_LDA(At, 0, 0); PG8_STAGE(PG8_SA(1, 1), a1 + hstep, voffA);
            PG8_WAIT_L(8); PG8_BAR; PG8_WAIT_L(0); PG8_MMA(0, 0, At, B0); PG8_BAR; PG8_SCHED;
            PG8_LDB(B1, 0, 1); PG8_STAGE(PG8_SB(0, 0), b2, voffB);
            PG8_BAR; PG8_WAIT_L(0); PG8_MMA(0, 1, At, B1); PG8_BAR;
            PG8_LDA(At, 0, 1); PG8_STAGE(PG8_SA(0, 0), a2, voffA);
            PG8_BAR; PG8_WAIT_L(0); PG8_MMA(1, 0, At, B0); PG8_BAR; PG8_SCHED;
            PG8_STAGE(PG8_SB(0, 1), b2h, voffB);
            PG8_WAIT_V(6); PG8_BAR; PG8_MMA(1, 1, At, B1); PG8_BAR;
            PG8_LDB(B0, 1, 0); PG8_SCHED; PG8_LDA(At, 1, 0); PG8_STAGE(PG8_SA(0, 1), a2 + hstep, voffA);
            PG8_WAIT_L(8); PG8_BAR; PG8_WAIT_L(0); PG8_MMA(0, 0, At, B0); PG8_BAR; PG8_SCHED;
            PG8_LDB(B1, 1, 1); PG8_STAGE(PG8_SB(1, 0), b3, voffB);
            PG8_BAR; PG8_WAIT_L(0); PG8_MMA(0, 1, At, B1); PG8_BAR;
            PG8_LDA(At, 1, 1); PG8_STAGE(PG8_SA(1, 0), a3, voffA);
            PG8_BAR; PG8_WAIT_L(0); PG8_MMA(1, 0, At, B0); PG8_BAR; PG8_SCHED;
            PG8_STAGE(PG8_SB(1, 1), b3h, voffB);
            PG8_WAIT_V(6); PG8_BAR; PG8_MMA(1, 1, At, B1); PG8_BAR;
        }
        E(acc, cur, wr, wc, fr, fq);
        if (!has_next) break;
        if (Epi::zero_after(cur))
#pragma unroll
        for (int a = 0; a < 2; ++a)
#pragma unroll
            for (int b = 0; b < 2; ++b)
#pragma unroll
                for (int m = 0; m < 4; ++m)
#pragma unroll
                    for (int n = 0; n < 2; ++n) acc[a][b][m][n] = (f32x4){0.f, 0.f, 0.f, 0.f};
        cur = nxt; cA = nA; cB = nB; cBh = nBh; ++ui;
    }
    PG8_WAIT_V(0);
    if (wr == 0) PG8_BAR;
    PG8_BAR;
#undef PG8_SA
#undef PG8_SB
#undef PG8_STAGE
#undef PG8_LDA
#undef PG8_LDB
#undef PG8_MMA
#undef PG8_WAIT_V
#undef PG8_WAIT_L
#undef PG8_BAR
#undef PG8_SCHED
}
}

__device__ void phase_norm_bf16(const float* __restrict__ xin, const float* __restrict__ g, bf16_t* __restrict__ h, int rows);
struct TJob { const float* src; bf16_t* dst; int R, C, tr, tc; };
__device__ __forceinline__ TJob prep_job(const Params& p, int i) {
    bf16_t* win = (bf16_t*)(p.ws + p.o_win); bf16_t* wb = (bf16_t*)(p.ws + p.o_wb); bf16_t* wo = (bf16_t*)(p.ws + p.o_wo); bf16_t* pw = (bf16_t*)(p.ws + p.o_pw);
    constexpr int T_WIN = 16 * 160, T_WB = 8 * 16, T_WO = 16 * 16, T_PW = 4;
    constexpr int N0 = DEPTH * T_WIN, N1 = N0 + 8 * T_WB, N2 = N1 + DEPTH * T_WO;
    TJob j;
    if (i < N0) { const int l = i / T_WIN, t = i % T_WIN; j.src = p.in[2] + (size_t)l * DM * INC; j.dst = win + (size_t)l * DM * INC; j.R = DM; j.C = INC; j.tr = t / 160; j.tc = t % 160; }
    else if (i < N1) { const int k = i - N0, m = k / T_WB, t = k % T_WB; j.src = p.in[14] + (size_t)m * BWID * DM; j.dst = wb + (size_t)m * BWID * DM; j.R = BWID; j.C = DM; j.tr = t / 16; j.tc = t % 16; }
    else if (i < N2) { const int k = i - N1, l = k / T_WO, t = k % T_WO; j.src = p.in[15] + (size_t)l * DM * DM; j.dst = wo + (size_t)l * DM * DM; j.R = DM; j.C = DM; j.tr = t / 16; j.tc = t % 16; }
    else { const int k = i - N2, m = k / T_PW, t = k % T_PW; j.src = p.in[3] + (size_t)m * 128 * 128; j.dst = pw + (size_t)m * 128 * 128; j.R = 128; j.C = 128; j.tr = t / 2; j.tc = t % 2; }
    return j;
}
__device__ void phase_prep(const Params& p, LAS unsigned char* lds) {
    LAS float* sm = (LAS float*)lds;
    const int tid = otid();
    constexpr int NT = DEPTH * 16 * 160 + 8 * 8 * 16 + DEPTH * 16 * 16 + 8 * 4;
    const int lr = tid >> 4, lc = (tid & 15) * 4;
    f32x4 v0, v1;
    int i = blockIdx.x;
    if (i < NT) { const TJob j = prep_job(p, i); const float* sp = j.src + (size_t)(j.tr * 64 + lr) * j.C + j.tc * 64 + lc; v0 = *(const f32x4*)sp; v1 = *(const f32x4*)(sp + (size_t)32 * j.C); }
    for (; i < NT; i += gridDim.x) {
        const TJob j = prep_job(p, i);
#pragma unroll
        for (int e = 0; e < 4; ++e) { sm[lr * 65 + lc + e] = v0[e]; sm[(lr + 32) * 65 + lc + e] = v1[e]; }
        __syncthreads();
        const int in = i + gridDim.x;
        if (in < NT) { const TJob jn = prep_job(p, in); const float* sp = jn.src + (size_t)(jn.tr * 64 + lr) * jn.C + jn.tc * 64 + lc; v0 = *(const f32x4*)sp; v1 = *(const f32x4*)(sp + (size_t)32 * jn.C); }
        { const int c = tid >> 3, r8 = (tid & 7) * 8; float o[8];
#pragma unroll
          for (int e = 0; e < 8; ++e) o[e] = sm[(r8 + e) * 65 + c];
          *(u32x4*)(j.dst + (size_t)(j.tc * 64 + c) * j.R + j.tr * 64 + r8) = pack8(o); }
        __syncthreads();
    }
    const float* sgw = p.in[11]; bf16_t* sw = (bf16_t*)(p.ws + p.o_sw);
    for (int k = blockIdx.x * 512 + tid; k < DEPTH * 4 * 128 * 128; k += gridDim.x * 512) { const int s_ = k & 127, t = (k >> 7) & 127; sw[k] = (s_ <= t) ? f2bf(sgw[k]) : (bf16_t)0; }
    phase_norm_bf16(p.in[0], p.in[1], (bf16_t*)(p.ws + p.o_h), NTOK);
}

__device__ void phase_norm_bf16(const float* __restrict__ xin, const float* __restrict__ g, bf16_t* __restrict__ h, int rows) {
    const int tid = otid(), lane = tid & 63, w = tid >> 6;
    float gv[2][8];
    load8f(g + 8 * lane, gv[0]); load8f(g + 512 + 8 * lane, gv[1]);
    for (int row = blockIdx.x * 8 + w; row < rows; row += gridDim.x * 8) {
        const float* xr = xin + (size_t)row * DM + 8 * lane;
        float v[2][8]; load8f(xr, v[0]); load8f(xr + 512, v[1]);
        float ss = 0.f;
#pragma unroll
        for (int i = 0; i < 2; ++i)
#pragma unroll
            for (int j = 0; j < 8; ++j) ss += v[i][j] * v[i][j];
        ss = wave_sum(ss);
        const float r = rsqrtf(ss * (1.0f / 1024.0f) + 1e-6f);
#pragma unroll
        for (int i = 0; i < 2; ++i) { float o[8];
#pragma unroll
            for (int j = 0; j < 8; ++j) o[j] = v[i][j] * r * gv[i][j];
            *(u32x4*)(h + (size_t)row * DM + 512 * i + 8 * lane) = pack8(o); }
    }
}
__device__ void phase_norm_final(float* __restrict__ x, const float* __restrict__ g, int rows) {
    const int tid = otid(), lane = tid & 63, w = tid >> 6;
    float gv[2][8];
    load8f(g + 8 * lane, gv[0]); load8f(g + 512 + 8 * lane, gv[1]);
    for (int row = blockIdx.x * 8 + w; row < rows; row += gridDim.x * 8) {
        float* xr = x + (size_t)row * DM + 8 * lane;
        float v[2][8]; load8f(xr, v[0]); load8f(xr + 512, v[1]);
        float ss = 0.f;
#pragma unroll
        for (int i = 0; i < 2; ++i)
#pragma unroll
            for (int j = 0; j < 8; ++j) ss += v[i][j] * v[i][j];
        ss = wave_sum(ss);
        const float r = rsqrtf(ss * (1.0f / 1024.0f) + 1e-6f);
#pragma unroll
        for (int i = 0; i < 2; ++i) {
            f32x4 a, b;
#pragma unroll
            for (int j = 0; j < 4; ++j) { a[j] = v[i][j] * r * gv[i][j]; b[j] = v[i][4 + j] * r * gv[i][4 + j]; }
            *(f32x4*)(xr + 512 * i) = a; *(f32x4*)(xr + 512 * i + 4) = b; }
    }
}

#define PO(k) ((size_t)(k) * TS * BWID)
__device__ void mix_sc(const Params& p, int l, const bf16_t* __restrict__ proj, bf16_t* __restrict__ z3, int r0, int pos0) {
    const int tid = otid(), lane = tid & 63, w = tid >> 6, c0 = lane * 8;
    const float* scw = p.in[13] + (size_t)l * 3 * BWID + c0;
    float w0[8], w1[8], w2[8]; load8f(scw, w0); load8f(scw + BWID, w1); load8f(scw + 2 * BWID, w2);
    const int r = r0 + 16 * w, pos = pos0 + 16 * w;
    const bf16_t* bgp = proj + PO(6) + c0; const bf16_t* cxp = proj + PO(7) + c0;
    u32x4 vb[16], vc[18];
    vc[0] = (u32x4){0u, 0u, 0u, 0u}; vc[1] = vc[0];
    if (pos > 0) { vc[0] = *(const u32x4*)(cxp + (size_t)(r - 2) * BWID); vc[1] = *(const u32x4*)(cxp + (size_t)(r - 1) * BWID); }
#pragma unroll
    for (int jj = 0; jj < 16; ++jj) { vb[jj] = *(const u32x4*)(bgp + (size_t)(r + jj) * BWID); vc[2 + jj] = *(const u32x4*)(cxp + (size_t)(r + jj) * BWID); }
    float p2[8], p1[8];
    unpack8(vc[0], p2); unpack8(vc[1], p1);
#pragma unroll
    for (int jj = 0; jj < 16; ++jj) {
        float b[8], cur[8], o[8]; unpack8(vb[jj], b); unpack8(vc[2 + jj], cur);
#pragma unroll
        for (int j = 0; j < 8; ++j) { o[j] = b[j] * (w0[j] * p2[j] + w1[j] * p1[j] + w2[j] * cur[j]); p2[j] = p1[j]; p1[j] = cur[j]; }
        *(u32x4*)(z3 + (size_t)(r + jj) * BWID + c0) = pack8(o);
    }
}

__device__ void mix_conv(const Params& p, int l, const bf16_t* __restrict__ proj, bf16_t* __restrict__ z1, int r0, int pos0, LAS unsigned char* lds) {
    const int tid = otid(), lane = tid & 63, w = tid >> 6, c0 = lane * 8;
    LAS unsigned char* Y = lds; LAS unsigned char* W = lds + 94 * VP;
    const float* cw = p.in[5] + (size_t)l * 31 * BWID;
    for (int i = tid; i < 31 * 64; i += 512) { const int k = i >> 6, cgp = i & 63; float f[8]; load8f(cw + k * BWID + cgp * 8, f); *(LAS u32x4*)(W + k * 1024 + cgp * 16) = pack8(f); }
    float bias[8], lng[8], lnb[8];
    load8f(p.in[6] + (size_t)l * BWID + c0, bias); load8f(p.in[7] + (size_t)l * BWID + c0, lng); load8f(p.in[8] + (size_t)l * BWID + c0, lnb);
    for (int q = 0; q < 2; ++q) {
        const int tr = r0 + 64 * q, tp = pos0 + 64 * q;
        __syncthreads();
        {
            u32x4 la[12];
#pragma unroll
            for (int i = 0; i < 12; ++i) { const int row = 12 * w + i; const bool valid = (row < 94) && (tp - 30 + row >= 0);
                la[i] = (u32x4){0u, 0u, 0u, 0u};
                if (valid) la[i] = *(const u32x4*)(proj + (size_t)(tr - 30 + row) * BWID + PO(2) + c0); }
#pragma unroll
            for (int i = 0; i < 12; ++i) { const int row = 12 * w + i; if (row < 94) *(LAS u32x4*)(Y + row * VP + lane * 16) = la[i]; }
        }
        __syncthreads();
        u32x4 gtv[8];
#pragma unroll
        for (int j = 0; j < 8; ++j) gtv[j] = *(const u32x4*)(proj + (size_t)(tr + 8 * w + j) * BWID + PO(3) + c0);
        float acc[8][8];
#pragma unroll
        for (int j = 0; j < 8; ++j)
#pragma unroll
            for (int c = 0; c < 8; ++c) acc[j][c] = bias[c];
#pragma unroll 1
        for (int k = 0; k < 31; ++k) {
            float wv[8]; unpack8(*(const LAS u32x4*)(W + k * 1024 + lane * 16), wv);
#pragma unroll
            for (int j = 0; j < 8; ++j) { float yv[8]; unpack8(*(const LAS u32x4*)(Y + (8 * w + j + k) * VP + lane * 16), yv);
#pragma unroll
                for (int c = 0; c < 8; ++c) acc[j][c] += wv[c] * yv[c]; }
        }
#pragma unroll
        for (int j = 0; j < 8; ++j) {
            float s = 0.f, ss = 0.f;
#pragma unroll
            for (int c = 0; c < 8; ++c) { s += acc[j][c]; ss += acc[j][c] * acc[j][c]; }
            s = wave_sum(s); ss = wave_sum(ss);
            const float mean = s * (1.0f / 512.0f); const float var = fmaxf(ss * (1.0f / 512.0f) - mean * mean, 0.f); const float rstd = rsqrtf(var + 1e-5f);
            const int row = tr + 8 * w + j;
            float gt[8], o[8]; unpack8(gtv[j], gt);
#pragma unroll
            for (int c = 0; c < 8; ++c) { const float v = (acc[j][c] - mean) * rstd * lng[c] + lnb[c]; o[c] = silu(v) * silu(gt[c]); }
            *(u32x4*)(z1 + (size_t)row * BWID + c0) = pack8(o);
        }
    }
}

__device__ __forceinline__ u32x4 sel4(bool c, const u32x4 a, const u32x4 b) { u32x4 r; r.x = c ? a.x : b.x; r.y = c ? a.y : b.y; r.z = c ? a.z : b.z; r.w = c ? a.w : b.w; return r; }

__device__ void mix_pool(const Params& p, int l, const bf16_t* __restrict__ proj, bf16_t* __restrict__ z0, int r0, int pos0, LAS unsigned char* lds) {
    const int tid = otid(), lane = tid & 63, w = tid >> 6, c0 = lane * 8;
    LAS unsigned char* P = lds;
    {
        const int g4 = lane >> 4, win = 2 << g4;
        const int r = r0 + 16 * w, pos = pos0 + 16 * w;
        u32x4 R[32];
#pragma unroll
        for (int i = 0; i < 16; ++i) { R[i] = (u32x4){0u, 0u, 0u, 0u}; if (pos > 0) R[i] = *(const u32x4*)(proj + (size_t)(r - 16 + i) * BWID + c0); }
#pragma unroll
        for (int i = 0; i < 16; ++i) R[16 + i] = *(const u32x4*)(proj + (size_t)(r + i) * BWID + c0);
        float S[8];
#pragma unroll
        for (int j = 0; j < 8; ++j) S[j] = 0.f;
#pragma unroll
        for (int i = 1; i <= 16; ++i) { float x[8]; unpack8(R[16 - i], x); const float mk = (i <= win) ? 1.0f : 0.0f;
#pragma unroll
            for (int j = 0; j < 8; ++j) S[j] += mk * x[j]; }
#pragma unroll
        for (int jj = 0; jj < 16; ++jj) {
            const int ps = pos + jj; float xv[8], xo[8], o[8];
            unpack8(R[16 + jj], xv);
            const u32x4 ro = sel4(g4 < 2, sel4(g4 == 0, R[16 + jj - 2], R[16 + jj - 4]), sel4(g4 == 2, R[16 + jj - 8], R[jj]));
            unpack8(ro, xo);
            const int cnt = (ps + 1 < win) ? ps + 1 : win; const float inv = 1.0f / (float)cnt;
#pragma unroll
            for (int j = 0; j < 8; ++j) { S[j] += xv[j] - xo[j]; o[j] = S[j] * inv - xv[j]; }
            *(LAS u32x4*)(P + (16 * w + jj) * VP + lane * 16) = pack8(o);
        }
    }
    __syncthreads();
    {
        const int g = w >> 1, fr = lane & 15, fq = lane >> 4;
        const bf16_t* pwT = (const bf16_t*)(p.ws + p.o_pw) + (size_t)(l * 4 + g) * 128 * 128;
        u32x2 gtv[8][4];
#pragma unroll
        for (int tt = 0; tt < 8; ++tt)
#pragma unroll
            for (int dt = 0; dt < 4; ++dt) gtv[tt][dt] = *(const u32x2*)(proj + (size_t)(r0 + 16 * tt + fr) * BWID + PO(1) + 64 * w + 16 * dt + 4 * fq);
        bf16x8 A[4][4];
#pragma unroll
        for (int dt = 0; dt < 4; ++dt)
#pragma unroll
            for (int kk = 0; kk < 4; ++kk) A[dt][kk] = *(const bf16x8*)(pwT + (size_t)(64 * (w & 1) + 16 * dt + fr) * 128 + 32 * kk + 8 * fq);
        const float* psc = p.in[4] + (size_t)l * BWID;
        f32x4 sc[4];
#pragma unroll
        for (int dt = 0; dt < 4; ++dt) sc[dt] = *(const f32x4*)(psc + 64 * w + 16 * dt + 4 * fq);
#pragma unroll
        for (int tt = 0; tt < 8; ++tt) {
            bf16x8 Bf[4];
#pragma unroll
            for (int kk = 0; kk < 4; ++kk) Bf[kk] = *(const LAS bf16x8*)(P + (16 * tt + fr) * VP + (128 * g + 32 * kk + 8 * fq) * 2);
            f32x4 acc[4];
#pragma unroll
            for (int dt = 0; dt < 4; ++dt) { acc[dt] = (f32x4){0.f, 0.f, 0.f, 0.f};
#pragma unroll
                for (int kk = 0; kk < 4; ++kk) acc[dt] = __builtin_amdgcn_mfma_f32_16x16x32_bf16(A[dt][kk], Bf[kk], acc[dt], 0, 0, 0); }
            const int row = r0 + 16 * tt + fr;
#pragma unroll
            for (int dt = 0; dt < 4; ++dt) { const int d = 64 * w + 16 * dt + 4 * fq;
                float gt[4]; unpack4(gtv[tt][dt], gt);
                u32x2 o; o.x = cvt_pk_bf16(acc[dt][0] * sc[dt][0] * silu(gt[0]), acc[dt][1] * sc[dt][1] * silu(gt[1])); o.y = cvt_pk_bf16(acc[dt][2] * sc[dt][2] * silu(gt[2]), acc[dt][3] * sc[dt][3] * silu(gt[3]));
                *(u32x2*)(z0 + (size_t)row * BWID + d) = o; }
        }
    }
}

__device__ void mix_sgu(const Params& p, int l, const bf16_t* __restrict__ proj, bf16_t* __restrict__ z2, int r0, LAS unsigned char* lds) {
    const int tid = otid(), lane = tid & 63, w = tid >> 6, c0 = lane * 8;
    LAS unsigned char* V = lds;
    {
        float lng[8], lnb[8]; load8f(p.in[9] + (size_t)l * BWID + c0, lng); load8f(p.in[10] + (size_t)l * BWID + c0, lnb);
        u32x4 R[16];
#pragma unroll
        for (int jj = 0; jj < 16; ++jj) R[jj] = *(const u32x4*)(proj + (size_t)(r0 + 16 * w + jj) * BWID + PO(5) + c0);
#pragma unroll
        for (int jj = 0; jj < 16; ++jj) {
            float x[8], o[8]; unpack8(R[jj], x);
            float s = 0.f, ss = 0.f;
#pragma unroll
            for (int c = 0; c < 8; ++c) { s += x[c]; ss += x[c] * x[c]; }
            s = wave_sum(s); ss = wave_sum(ss);
            const float mean = s * (1.0f / 512.0f); const float var = fmaxf(ss * (1.0f / 512.0f) - mean * mean, 0.f); const float rstd = rsqrtf(var + 1e-5f);
#pragma unroll
            for (int c = 0; c < 8; ++c) o[c] = (x[c] - mean) * rstd * lng[c] + lnb[c];
            *(LAS u32x4*)(V + (16 * w + jj) * VP + lane * 16) = pack8(o);
        }
    }
    __syncthreads();
    {
        const int g = w >> 1, fr = lane & 15, fq = lane >> 4;
        const unsigned vbase = (unsigned)(size_t)V;
        bf16x8 A[4][4];
#pragma unroll
        for (int ct = 0; ct < 4; ++ct)
#pragma unroll
            for (int kk = 0; kk < 4; ++kk) {
                const unsigned a = vbase + (unsigned)((32 * kk + 8 * fq + (fr >> 2)) * VP + (64 * w + 16 * ct + 4 * (fr & 3)) * 2);
                const u32x2 lo = tr_read(a), hi = tr_read(a + 4 * VP);
                u32x4 t; t.x = lo.x; t.y = lo.y; t.z = hi.x; t.w = hi.y;
                A[ct][kk] = __builtin_bit_cast(bf16x8, t);
            }
        const bf16_t* swm = (const bf16_t*)(p.ws + p.o_sw) + (size_t)(l * 4 + g) * 128 * 128;
        const float* sb = p.in[12] + (size_t)(l * 4 + g) * 128;
#pragma unroll
        for (int hb = 0; hb < 2; ++hb) {
            u32x2 uu[4][4]; bf16x8 Wf[4][4]; float bias[4];
#pragma unroll
            for (int t4 = 0; t4 < 4; ++t4) { const int tt = hb * 4 + t4; const bf16_t* pr = proj + (size_t)(r0 + 16 * tt + fr) * BWID + 64 * w + 4 * fq;
#pragma unroll
                for (int ct = 0; ct < 4; ++ct) uu[t4][ct] = *(const u32x2*)(pr + PO(4) + 16 * ct);
#pragma unroll
                for (int kk = 0; kk < 4; ++kk) if (kk < (tt >> 1) + 1) Wf[t4][kk] = *(const bf16x8*)(swm + (size_t)(16 * tt + fr) * 128 + 32 * kk + 8 * fq);
                bias[t4] = sb[16 * tt + fr]; }
#pragma unroll
            for (int t4 = 0; t4 < 4; ++t4) { const int tt = hb * 4 + t4;
                f32x4 acc[4];
#pragma unroll
                for (int ct = 0; ct < 4; ++ct) acc[ct] = (f32x4){0.f, 0.f, 0.f, 0.f};
#pragma unroll
                for (int kk = 0; kk < 4; ++kk) if (kk < (tt >> 1) + 1) {
#pragma unroll
                    for (int ct = 0; ct < 4; ++ct) acc[ct] = __builtin_amdgcn_mfma_f32_16x16x32_bf16(A[ct][kk], Wf[t4][kk], acc[ct], 0, 0, 0); }
                const int row = r0 + 16 * tt + fr;
#pragma unroll
                for (int ct = 0; ct < 4; ++ct) { const int c = 64 * w + 16 * ct + 4 * fq;
                    float u[4]; unpack4(uu[t4][ct], u);
                    u32x2 o; o.x = cvt_pk_bf16(u[0] * (acc[ct][0] + bias[t4]), u[1] * (acc[ct][1] + bias[t4])); o.y = cvt_pk_bf16(u[2] * (acc[ct][2] + bias[t4]), u[3] * (acc[ct][3] + bias[t4]));
                    *(u32x2*)(z2 + (size_t)row * BWID + c) = o; }
            }
        }
    }
}

__device__ void phase_mix(const Params& p, int l, const bf16_t* proj, bf16_t* z, LAS unsigned char* lds) {
    constexpr int nchunk = TS / 128;
    constexpr size_t zs = (size_t)TS * BWID;
    for (int i = blockIdx.x; i < 4 * nchunk; i += gridDim.x) {
        const int br = i / nchunk, j = i % nchunk, r0 = j * 128, pos0 = (j & 15) * 128;
        if (br == 0) for (int rr = 0; rr < REP_M0; ++rr) { mix_pool(p, l, proj, z, r0, pos0, lds); __syncthreads(); }
        else if (br == 1) for (int rr = 0; rr < REP_M1; ++rr) { mix_conv(p, l, proj, z + zs, r0, pos0, lds); __syncthreads(); }
        else if (br == 2) for (int rr = 0; rr < REP_M2; ++rr) { mix_sgu(p, l, proj, z + 2 * zs, r0, lds); __syncthreads(); }
        else for (int rr = 0; rr < REP_M3; ++rr) { mix_sc(p, l, proj, z + 3 * zs, r0, pos0); __syncthreads(); }
    }
}

#define XB_TMO      128
#define XB_XCNT(j)  (256  + 64 * (j))
#define XB_XSUB(j)  (1280 + 64 * (j))
#define XB_XGEN(j)  (2304 + 64 * (j))
#define XB_TOP      3328
#define XB_TOPGEN   3392
#define XCD_BAR_WORDS 3456
#define XB_SPIN_CAP (1u << 20)
__device__ __forceinline__ unsigned xb_ld(unsigned* p)              { return __hip_atomic_load(p, __ATOMIC_RELAXED, __HIP_MEMORY_SCOPE_AGENT); }
__device__ __forceinline__ unsigned xb_add(unsigned* p, unsigned v) { return __hip_atomic_fetch_add(p, v, __ATOMIC_RELAXED, __HIP_MEMORY_SCOPE_AGENT); }
__device__ __forceinline__ unsigned xb_xcc_id() { return (unsigned)__builtin_amdgcn_s_getreg((3 << 11) | 20) & 0xFu; }
#define XB_SPIN(cond, bar) do { unsigned _sp = 0; while (cond) { __builtin_amdgcn_s_sleep(1); \
    if ((++_sp & 255u) == 0u) { if (xb_ld(&(bar)[XB_TMO])) break; if (_sp > XB_SPIN_CAP) { atomicAdd(&(bar)[XB_TMO], 1u); break; } } } } while (0)
struct XcdBarrier { unsigned* bar; unsigned x; volatile LAS unsigned* st; };
__device__ __forceinline__ XcdBarrier xcd_barrier_post(unsigned* bar, volatile LAS unsigned* st) {
    XcdBarrier b; b.bar = bar; b.x = xb_xcc_id(); b.st = st;
    if (threadIdx.x == 0) (void)xb_add(&bar[XB_XCNT(b.x)], 1u);
    return b;
}
__device__ __forceinline__ void xcd_barrier_complete(unsigned* bar, unsigned x, unsigned& nloc, unsigned& nx) {
    const unsigned G = gridDim.x * gridDim.y * gridDim.z;
    unsigned sum, cnt, mine, sp = 0u;
    for (;;) {
        sum = 0u; cnt = 0u; mine = 0u;
#pragma unroll
        for (unsigned j = 0; j < 16; ++j) { const unsigned c = xb_ld(&bar[XB_XCNT(j)]); sum += c; cnt += (c > 0u) ? 1u : 0u; mine = (j == x) ? c : mine; }
        if (sum == G) break;
        __builtin_amdgcn_s_sleep(1);
        if ((++sp & 255u) == 0u) { if (xb_ld(&bar[XB_TMO])) break; if (sp > XB_SPIN_CAP) { atomicAdd(&bar[XB_TMO], 1u); break; } }
    }
    nloc = mine > 0u ? mine : 1u; nx = cnt > 0u ? cnt : 1u;
}
__device__ __forceinline__ void xcd_barrier(const XcdBarrier& b) {
    asm volatile("s_waitcnt vmcnt(0)" ::: "memory");
    __syncthreads();
    if (threadIdx.x == 0) {
        unsigned* bar = b.bar;
        __builtin_amdgcn_s_waitcnt(0);
        unsigned nloc = b.st[0], nx = b.st[1];
        if (nloc == 0u) { xcd_barrier_complete(bar, b.x, nloc, nx); b.st[0] = nloc; b.st[1] = nx; }
        const unsigned old = xb_add(&bar[XB_XSUB(b.x)], 1u);
        const unsigned gen = old / nloc;
        if (old + 1u == (gen + 1u) * nloc) {
            __builtin_amdgcn_fence(__ATOMIC_RELEASE, "agent");
            asm volatile("s_waitcnt vmcnt(0)" ::: "memory");
            const unsigned og = xb_add(&bar[XB_TOP], 1u);
            const unsigned tg = og / nx;
            if (og + 1u == (tg + 1u) * nx) xb_add(&bar[XB_TOPGEN], 1u);
            else XB_SPIN(xb_ld(&bar[XB_TOPGEN]) == tg, bar);
            __builtin_amdgcn_fence(__ATOMIC_ACQUIRE, "agent");
            xb_add(&bar[XB_XGEN(b.x)], 1u);
            asm volatile("s_waitcnt vmcnt(0)" ::: "memory");
        } else {
            XB_SPIN(xb_ld(&bar[XB_XGEN(b.x)]) == gen, bar);
            __builtin_amdgcn_fence(__ATOMIC_ACQUIRE, "agent");
            asm volatile("s_waitcnt vmcnt(0)" ::: "memory");
        }
    }
    __syncthreads();
}

__global__ void __launch_bounds__(512) mk_forward(Params p) {
    extern __shared__ __attribute__((aligned(16))) unsigned char lds_raw[];
    LAS unsigned char* lds = (LAS unsigned char*)lds_raw;
    cg::grid_group grid = cg::this_grid();
    volatile LAS unsigned* stw = (volatile LAS unsigned*)(lds + LDS_BYTES - 16);
    if (threadIdx.x == 0) { stw[0] = 0u; stw[1] = 0u; }
    __syncthreads();
    const XcdBarrier xbar = xcd_barrier_post((unsigned*)(p.ws + p.o_bar), stw);
    int ph = 0;
#define PHASE_ON (ph >= p.ph_lo && ph < p.ph_hi)
#ifndef XSYNC
#define XSYNC 0
#endif
#define PHASE_END do { if (PHASE_ON && ph + 1 < p.ph_hi) { if (ph == 0) grid.sync(); else xcd_barrier(xbar); for (int xs = 0; xs < XSYNC; ++xs) xcd_barrier(xbar); } ++ph; } while (0)
    constexpr int ts = TS;
    bf16_t* win = (bf16_t*)(p.ws + p.o_win); bf16_t* wb = (bf16_t*)(p.ws + p.o_wb); bf16_t* wo = (bf16_t*)(p.ws + p.o_wo);
    bf16_t* h0 = (bf16_t*)(p.ws + p.o_h); bf16_t* z = (bf16_t*)(p.ws + p.o_z); bf16_t* proj = (bf16_t*)(p.ws + p.o_proj);

    if (PHASE_ON) phase_prep(p, lds);
    PHASE_END;
#pragma unroll 1
    for (int l = 0; l < DEPTH; ++l) {
        const float* xin = (l == 0) ? p.in[0] : p.out;
#pragma unroll 1
        for (int s = 0; s < NS; ++s) {
            const size_t tok0 = (size_t)s * ts;
            bf16_t* h = h0 + tok0 * DM; bf16_t* merged = h;
            if (l > 0) { if (PHASE_ON) phase_norm_bf16(xin + tok0 * DM, p.in[1] + (size_t)l * DM, h, ts);
                PHASE_END; }
            if (PHASE_ON) for (int rep = 0; rep < REP_A; ++rep) { pg8::Gemm g{h, win + (size_t)l * DM * INC}; pg8::OrderA S; S.G = (int)gridDim.x; S.c = (int)blockIdx.x; pg8::EpiProj E{proj, proj + (size_t)8 * TS * BWID}; pg8::gemm_phase<DM, 0, 0>(lds, g, S, E); }
            PHASE_END;
            if (PHASE_ON) for (int rep = 0; rep < REP_B; ++rep) phase_mix(p, l, proj, z, lds);
            PHASE_END;
            if (PHASE_ON) for (int rep = 0; rep < REP_C; ++rep) { pg8::Gemm g{z, wb + (size_t)l * 4 * BWID * DM}; pg8::Order<TS / 256, DM / 256, 4> S{(int)gridDim.x, (int)blockIdx.x};
                pg8::EpiGate E{proj + (size_t)8 * TS * BWID, merged}; pg8::gemm_phase<BWID, (size_t)TS * BWID * 2, (size_t)BWID * DM * 2>(lds, g, S, E); }
            PHASE_END;
            if (PHASE_ON) { pg8::Gemm g{merged, wo + (size_t)l * DM * DM}; pg8::Order<TS / 256, DM / 256, 1> S{(int)gridDim.x, (int)blockIdx.x};
                pg8::EpiRes E{xin + tok0 * DM, p.out + tok0 * DM, DM}; pg8::gemm_phase<DM, 0, 0>(lds, g, S, E); }
            PHASE_END;
        }
    }
    if (PHASE_ON) phase_norm_final(p.out, p.in[16], NTOK);
    PHASE_END;
}

extern "C" void kernel_launch(void* const* d_in, const int* in_sizes, int n_in, void* d_out, int out_size, void* d_ws, size_t ws_size, hipStream_t stream) {
    static int grid = 0;
    if (grid == 0) {
        int dev = 0, cus = 0, per_cu = 0;
        hipGetDevice(&dev); hipDeviceGetAttribute(&cus, hipDeviceAttributeMultiprocessorCount, dev);
        if (hipFuncSetAttribute((const void*)mk_forward, hipFuncAttributeMaxDynamicSharedMemorySize, LDS_BYTES) != hipSuccess) { fprintf(stderr, "hipFuncSetAttribute failed\n"); grid = -1; return; }
        if (hipOccupancyMaxActiveBlocksPerMultiprocessor(&per_cu, (const void*)mk_forward, 512, LDS_BYTES) != hipSuccess || per_cu < 1) { fprintf(stderr, "occupancy query: %d\n", per_cu); per_cu = 1; }
        (void)hipGetLastError();
        grid = cus * per_cu;
    }
    if (grid < 0) return;
    Params p{};
    for (int i = 0; i < 17; ++i) p.in[i] = (const float*)d_in[i];
    p.out = (float*)d_out; p.ws = (unsigned char*)d_ws;
    p.ns = NS; p.ts = TS;
    size_t o = 0;
    p.o_win = o; o += (size_t)DEPTH * DM * INC * 2;
    p.o_wb = o; o += (size_t)DEPTH * 4 * BWID * DM * 2;
    p.o_wo = o; o += (size_t)DEPTH * DM * DM * 2;
    p.o_pw = o; o += (size_t)DEPTH * 4 * 128 * 128 * 2;
    p.o_sw = o; o += (size_t)DEPTH * 4 * 128 * 128 * 2;
    p.o_bar = o; o += 16384;
    p.o_h = o; o += (size_t)NTOK * DM * 2;
    p.o_z = o; o += 4 * (size_t)p.ts * BWID * 2;
    p.o_proj = o; o += (size_t)p.ts * (8 * BWID * 2 + 4096);
    if (o > ws_size) { fprintf(stderr, "kernel_launch: workspace too small: need %zu, have %zu\n", o, ws_size); return; }
    const int nph = 1 + NS * 4 + (DEPTH - 1) * NS * 5 + 1;
    if (hipMemsetAsync((char*)d_ws + p.o_bar, 0, 16384, stream) != hipSuccess) { fprintf(stderr, "kernel_launch: memset failed\n"); return; }
#if MULTI_LAUNCH
    for (int ph = 0; ph < nph; ++ph) { p.ph_lo = ph; p.ph_hi = ph + 1; hipLaunchKernelGGL(mk_forward, dim3(grid), dim3(512), LDS_BYTES, stream, p); }
#else
    p.ph_lo = 0; p.ph_hi = nph;
    void* args[] = {&p};
    hipError_t e = hipLaunchCooperativeKernel((const void*)mk_forward, dim3(grid), dim3(512), args, LDS_BYTES, stream);
    if (e != hipSuccess) fprintf(stderr, "cooperative launch failed: %s (grid %d)\n", hipGetErrorString(e), grid);
#endif
}
```

```cpp
#include <hip/hip_runtime.h>
#include <hip/hip_cooperative_groups.h>
#include <cstdio>
namespace cg = cooperative_groups;

#ifndef MULTI_LAUNCH
#define MULTI_LAUNCH 0
#endif

#ifndef REP_N
#define REP_N 1
#endif
#ifndef REP_A
#define REP_A 1
#endif
#ifndef REP_B
#define REP_B 1
#endif
#ifndef REP_C
#define REP_C 1
#endif
#define REP_M0 1
#define REP_M1 1
#define REP_M2 1
#define REP_M3 1
#define LAS __attribute__((address_space(3)))
typedef unsigned short bf16_t;
typedef short bf16x8 __attribute__((ext_vector_type(8)));
typedef float f32x4 __attribute__((ext_vector_type(4)));
typedef float f32x2 __attribute__((ext_vector_type(2)));
typedef unsigned u32x4 __attribute__((ext_vector_type(4)));
typedef unsigned u32x2 __attribute__((ext_vector_type(2)));

constexpr int DM = 1024, SEQ = 2048, NTOK = 32 * 2048, DEPTH = 2, BWID = 512, INC = 10240, GATE0 = 6144;
constexpr int PP = 6144;
constexpr int NS = 1, TS = NTOK / NS;
constexpr int LDS_BYTES = 139264;
constexpr int VP = 1040;

struct Params {
    const float* in[17];
    float* out;
    unsigned char* ws;
    int ts, ns, ph_lo, ph_hi;
    unsigned long long o_win, o_wb, o_wo, o_pw, o_sw, o_h, o_z, o_bar, o_proj;
};

__device__ __forceinline__ int otid() { int t = threadIdx.x; asm volatile("" : "+v"(t)); return t; }
__device__ __forceinline__ unsigned cvt_pk_bf16(float lo, float hi) { unsigned r; asm volatile("v_cvt_pk_bf16_f32 %0, %1, %2" : "=v"(r) : "v"(lo), "v"(hi)); return r; }
__device__ __forceinline__ bf16_t f2bf(float f) { unsigned u = __float_as_uint(f); u += 0x7FFFu + ((u >> 16) & 1u); return (bf16_t)(u >> 16); }
__device__ __forceinline__ void unpack8(const u32x4 v, float (&f)[8]) {
    f[0] = __uint_as_float(v.x << 16); f[1] = __uint_as_float(v.x & 0xffff0000u); f[2] = __uint_as_float(v.y << 16); f[3] = __uint_as_float(v.y & 0xffff0000u);
    f[4] = __uint_as_float(v.z << 16); f[5] = __uint_as_float(v.z & 0xffff0000u); f[6] = __uint_as_float(v.w << 16); f[7] = __uint_as_float(v.w & 0xffff0000u);
}
__device__ __forceinline__ u32x4 pack8(const float (&f)[8]) { u32x4 r; r.x = cvt_pk_bf16(f[0], f[1]); r.y = cvt_pk_bf16(f[2], f[3]); r.z = cvt_pk_bf16(f[4], f[5]); r.w = cvt_pk_bf16(f[6], f[7]); return r; }
__device__ __forceinline__ void unpack4(const u32x2 v, float (&f)[4]) { f[0] = __uint_as_float(v.x << 16); f[1] = __uint_as_float(v.x & 0xffff0000u); f[2] = __uint_as_float(v.y << 16); f[3] = __uint_as_float(v.y & 0xffff0000u); }
__device__ __forceinline__ float sigm(float x) { return __builtin_amdgcn_rcpf(1.0f + __expf(-x)); }
__device__ __forceinline__ float silu(float x) { return x * sigm(x); }
__device__ __forceinline__ void load8f(const float* p, float (&f)[8]) { const f32x4 a = *(const f32x4*)p, b = *(const f32x4*)(p + 4); f[0] = a[0]; f[1] = a[1]; f[2] = a[2]; f[3] = a[3]; f[4] = b[0]; f[5] = b[1]; f[6] = b[2]; f[7] = b[3]; }
__device__ __forceinline__ float wave_sum(float v) {
#pragma unroll
    for (int o = 32; o >= 1; o >>= 1) v += __shfl_xor(v, o);
    return v;
}
__device__ __forceinline__ u32x2 tr_read(unsigned lds_addr) { u32x2 r; asm volatile("ds_read_b64_tr_b16 %0, %1\n\ts_waitcnt lgkmcnt(0)" : "=&v"(r) : "v"(lds_addr) : "memory"); return r; }

namespace pg8 {
constexpr int BM = 256, BK = 64, HALF = 128, HTB = HALF * BK * 2, STAGE_BYTES = 8 * HTB, NXCD = 8, WGM = 8;
__device__ __forceinline__ int lds_byte(int r, int c) { const int st = (r >> 4) * 2 + (c >> 5), rr = r & 15, cc = c & 31, ob = rr * 64 + cc * 2; return st * 1024 + (ob ^ (((ob >> 9) & 1) << 5)); }
__device__ __forceinline__ void stage_rc(int b, int& R, int& C) { const int st = b / 1024, sb = b % 1024, swz = sb ^ (((sb >> 9) & 1) << 5); R = (st >> 1) * 16 + swz / 64; C = (st & 1) * 32 + (swz % 64) / 2; }
__device__ __forceinline__ int perm32(int rho) { const int n = rho >> 4, i = rho & 15; return 8 * (i >> 2) + 4 * n + (i & 3); }

struct Unit { int pm, pn, br; };
struct Gemm { const bf16_t* A; const bf16_t* Bt; };

template <int NM, int NN, int NBR>
struct Order {
    int G, c;
    __device__ __forceinline__ bool next(int i, Unit& u) const {
        constexpr int nwg = NM * NN;
        const int ti = i / NBR;
        const long L = (long)ti * G + c; if (L >= nwg) return false;
        int wgid = (int)L; { constexpr int q = nwg / NXCD, r = nwg % NXCD; const int xcd = wgid % NXCD, off = wgid / NXCD; wgid = (xcd < r ? xcd * (q + 1) : r * (q + 1) + (xcd - r) * q) + off; }
        constexpr int nig = WGM * NN; const int gid = wgid / nig, fm = gid * WGM, gsz = (NM - fm) < WGM ? (NM - fm) : WGM;
        u.pm = fm + ((wgid % nig) % gsz); u.pn = (wgid % nig) / gsz; u.br = i % NBR; return true;
    }
    __device__ __forceinline__ void brow(const Unit& u, int& r0, int& r1) const { r0 = u.pn * BM; r1 = r0 + HALF; }
    __device__ __forceinline__ size_t aoff(const Unit&) const { return 0; }
};
struct OrderC : Order<TS / 256, DM / 256, 4> {
    __device__ __forceinline__ size_t aoff(const Unit& u) const { const int slot = (u.br == 0) ? 1 : (u.br == 1) ? 3 : (u.br == 2) ? 4 : 6; return (size_t)slot * TS * BWID * 2; }
};
struct OrderA : Order<TS / 256, INC / 256, 1> {
    __device__ __forceinline__ void brow(const Unit& u, int& r0, int& r1) const {
        const int pn = u.pn;
        if (pn < 8) { const int pc = pn >> 1; const int piece = (pc == 0) ? 0 : (pc == 1) ? 1 : (pc == 2) ? 4 : 6; r0 = piece * 512 + (pn & 1) * 256; r1 = r0 + HALF; }
        else if (pn < 24) { const int q = (pn - 8) >> 2, sub = (pn - 8) & 3; const int pa = (q == 0) ? 2 : (q == 1) ? 9 : (q == 2) ? 8 : 5, pb = (q == 0) ? 3 : (q == 1) ? 10 : (q == 2) ? 11 : 7;
            r0 = pa * 512 + HALF * sub; r1 = pb * 512 + HALF * sub; }
        else { r0 = pn * BM; r1 = r0 + HALF; }
    }
};

struct EpiProj {
    static constexpr bool PERM = true;
    static __device__ __forceinline__ bool zero_after(const Unit&) { return true; }
    bf16_t* O; bf16_t* G;
    __device__ __forceinline__ void operator()(f32x4 (&acc)[2][2][4][2], const Unit& u, int wr, int wc, int fr_, int fq) const {
        int fr = fr_; asm volatile("" : "+v"(fr));
        if (u.pn < 8) {
            const int pc = u.pn >> 1; const int slot = (pc == 0) ? 0 : (pc == 1) ? 1 : (pc == 2) ? 3 : 5;
            const int row0 = u.pm * BM + wr * 64 + fr, col0 = (u.pn & 1) * BM + wc * 32 + 8 * fq;
            bf16_t* Op = O + (size_t)slot * TS * BWID;
#pragma unroll
            for (int ai = 0; ai < 2; ++ai)
#pragma unroll
                for (int m = 0; m < 4; ++m) { bf16_t* rowp = Op + (size_t)(row0 + ai * HALF + m * 16) * BWID + col0;
#pragma unroll
                    for (int bj = 0; bj < 2; ++bj) { const f32x4 v0 = acc[ai][bj][m][0], v1 = acc[ai][bj][m][1];
                        u32x4 w; w.x = cvt_pk_bf16(v0[0], v0[1]); w.y = cvt_pk_bf16(v0[2], v0[3]); w.z = cvt_pk_bf16(v1[0], v1[1]); w.w = cvt_pk_bf16(v1[2], v1[3]);
                        __builtin_nontemporal_store(w, (u32x4*)(rowp + bj * HALF)); } }
        } else if (u.pn < GATE0 / BM) {
            const int q = (u.pn - 8) >> 2, sub = (u.pn - 8) & 3; const int slot = (q == 0) ? 2 : (q == 1) ? 7 : (q == 2) ? 6 : 4;
            const int row0 = u.pm * BM + wr * 64 + fr, col0 = sub * HALF + wc * 32 + 8 * fq;
            bf16_t* Op = O + (size_t)slot * TS * BWID;
#pragma unroll
            for (int ai = 0; ai < 2; ++ai)
#pragma unroll
                for (int m = 0; m < 4; ++m) {
                    float f[8];
#pragma unroll
                    for (int n = 0; n < 2; ++n)
#pragma unroll
                        for (int j = 0; j < 4; ++j) { const float av = acc[ai][0][m][n][j], bv = acc[ai][1][m][n][j]; const float sg = sigm(bv);
                            f[n * 4 + j] = av * ((q == 1) ? bv : (q == 0) ? sg : bv * sg); }
                    __builtin_nontemporal_store(pack8(f), (u32x4*)(Op + (size_t)(row0 + ai * HALF + m * 16) * BWID + col0)); }
        } else {
            unsigned char* gb = (unsigned char*)G + ((size_t)u.pm * 16 + (u.pn - GATE0 / BM)) * 65536 + (((wr * 4 + wc) * 4 + fq) * 16 + fr) * 16;
#pragma unroll
            for (int ai = 0; ai < 2; ++ai)
#pragma unroll
                for (int m = 0; m < 4; ++m) {
                    u32x4 w;
#pragma unroll
                    for (int bj = 0; bj < 2; ++bj)
#pragma unroll
                        for (int n = 0; n < 2; ++n) { unsigned q = 0u;
#pragma unroll
                            for (int j = 0; j < 4; ++j) q = __builtin_amdgcn_cvt_pk_u8_f32(fmaxf(255.0f * sigm(acc[ai][bj][m][n][j]), 1.0f), j, q);
                            w[bj * 2 + n] = q; }
                    __builtin_nontemporal_store(w, (u32x4*)(gb + (ai * 4 + m) * 8192)); }
        }
    }
};
struct EpiGate {
    static constexpr bool PERM = true;
    static __device__ __forceinline__ bool zero_after(const Unit& u) { return u.br == 3; }
    const bf16_t* G; bf16_t* merged;
    __device__ __forceinline__ void operator()(f32x4 (&acc)[2][2][4][2], const Unit& u, int wr, int wc, int fr_, int fq) const {
        int fr = fr_; asm volatile("" : "+v"(fr));
        const int lrow0 = wr * 64 + fr, lcol0 = wc * 32 + 8 * fq;
        const int br = u.br;
        const bool lastb = (br == 3);
        const unsigned char* gp0 = (const unsigned char*)G + ((size_t)u.pm * 16 + br * 4 + u.pn) * 65536 + (((wr * 4 + wc) * 4 + fq) * 16 + fr) * 16;
        const unsigned char* gnp = lastb ? gp0 : gp0 + 4 * 65536;
        u32x4 gc[2][4], gn[2][4];
#pragma unroll
        for (int ai = 0; ai < 2; ++ai)
#pragma unroll
            for (int m = 0; m < 4; ++m) { gc[ai][m] = *(const u32x4*)(gp0 + (ai * 4 + m) * 8192); gn[ai][m] = *(const u32x4*)(gnp + (ai * 4 + m) * 8192); }
#pragma unroll
        for (int ai = 0; ai < 2; ++ai)
#pragma unroll
            for (int m = 0; m < 4; ++m)
#pragma unroll
                for (int bj = 0; bj < 2; ++bj) {
#pragma unroll
                    for (int n = 0; n < 2; ++n) {
                        const unsigned c = gc[ai][m][bj * 2 + n], d = gn[ai][m][bj * 2 + n];
                        float fc[4], fd[4];
                        fc[0] = (float)(c & 0xffu); fc[1] = (float)((c >> 8) & 0xffu); fc[2] = (float)((c >> 16) & 0xffu); fc[3] = (float)(c >> 24);
                        fd[0] = (float)(d & 0xffu); fd[1] = (float)((d >> 8) & 0xffu); fd[2] = (float)((d >> 16) & 0xffu); fd[3] = (float)(d >> 24);
#pragma unroll
                        for (int j = 0; j < 4; ++j) acc[ai][bj][m][n][j] *= fc[j] * (lastb ? (1.0f / 255.0f) : __builtin_amdgcn_rcpf(fd[j]));
                    }
                    if (lastb) { const f32x4 v0 = acc[ai][bj][m][0], v1 = acc[ai][bj][m][1];
                        u32x4 w; w.x = cvt_pk_bf16(v0[0], v0[1]); w.y = cvt_pk_bf16(v0[2], v0[3]); w.z = cvt_pk_bf16(v1[0], v1[1]); w.w = cvt_pk_bf16(v1[2], v1[3]);
                        *(u32x4*)(merged + ((size_t)u.pm * BM + lrow0 + ai * HALF + m * 16) * DM + u.pn * BM + lcol0 + bj * HALF) = w; }
                }
    }
};
struct EpiRes {
    static constexpr bool PERM = false;
    static __device__ __forceinline__ bool zero_after(const Unit&) { return true; }
    const float* res; float* C; int ldc;
    __device__ __forceinline__ void operator()(const f32x4 (&acc)[2][2][4][2], const Unit& u, int wr, int wc, int fr_, int fq) const {
        int fr = fr_; asm volatile("" : "+v"(fr));
        const int row0 = u.pm * BM + wr * 64 + fr, col0 = u.pn * BM + wc * 32 + 4 * fq;
#pragma unroll
        for (int ai = 0; ai < 2; ++ai)
#pragma unroll
            for (int m = 0; m < 4; ++m) { const size_t off = (size_t)(row0 + ai * HALF + m * 16) * ldc + col0;
                f32x4 rv[2][2];
#pragma unroll
                for (int bj = 0; bj < 2; ++bj)
#pragma unroll
                    for (int n = 0; n < 2; ++n) rv[bj][n] = *(const f32x4*)(res + off + bj * HALF + n * 16);
#pragma unroll
                for (int bj = 0; bj < 2; ++bj)
#pragma unroll
                    for (int n = 0; n < 2; ++n) *(f32x4*)(C + off + bj * HALF + n * 16) = acc[ai][bj][m][n] + rv[bj][n]; }
    }
};

template <int K, size_t B_BR, class Epi, class Sched>
__device__ __forceinline__ void gemm_phase(LAS unsigned char* lds, const Gemm g, const Sched& S, const Epi& E) {
    const int tid = otid(), wid = __builtin_amdgcn_readfirstlane(tid >> 6), lane = tid & 63, wr = wid >> 2, wc = wid & 3, fr = lane & 15, fq = lane >> 4;
    constexpr int nt = K / BK;
    unsigned voffA[2], voffB[2];
#pragma unroll
    for (int i = 0; i < 2; ++i) { int R, C; stage_rc(tid * 16 + i * 8192, R, C); const int Rb = Epi::PERM ? ((R & ~31) + perm32(R & 31)) : R;
        voffA[i] = (unsigned)(R * K + C) * 2u; voffB[i] = (unsigned)(Rb * K + C) * 2u; }
    constexpr size_t kstep = (size_t)(BK * 2);
    constexpr size_t hstep = (size_t)HALF * K * 2;
    constexpr size_t tstep = 2 * hstep;
    const unsigned ldsw = (unsigned)wid * 1024u;
    const int aoff = lds_byte(wr * 64 + fr, fq * 8), boff = lds_byte(wc * 32 + fr, fq * 8);
#define PG8_SA(b, h) (((b) * 2 + (h)) * HTB)
#define PG8_SB(b, h) ((4 + (b) * 2 + (h)) * HTB)
#define PG8_STAGE(bufoff, gbase, voff) do { _Pragma("unroll") for (int _i = 0; _i < 2; ++_i) \
        __builtin_amdgcn_global_load_lds((const unsigned*)((const char*)(gbase) + (voff)[_i]), (LAS unsigned*)(lds + (bufoff) + ldsw + _i * 8192), 16, 0, 0); } while (0)
#define PG8_LDA(dst, b, h) do { _Pragma("unroll") for (int m = 0; m < 4; ++m) _Pragma("unroll") for (int k = 0; k < 2; ++k) dst[m][k] = *(const LAS bf16x8*)(lds + PG8_SA(b, h) + aoff + m * 2048 + k * 1024); } while (0)
#define PG8_LDB(dst, b, h) do { _Pragma("unroll") for (int n = 0; n < 2; ++n) _Pragma("unroll") for (int k = 0; k < 2; ++k) dst[n][k] = *(const LAS bf16x8*)(lds + PG8_SB(b, h) + boff + n * 2048 + k * 1024); } while (0)
#define PG8_MMA(ai, bj, At, Bt) do { __builtin_amdgcn_s_setprio(1); _Pragma("unroll") for (int m = 0; m < 4; ++m) _Pragma("unroll") for (int n = 0; n < 2; ++n) _Pragma("unroll") for (int k = 0; k < 2; ++k) \
        acc[ai][bj][m][n] = __builtin_amdgcn_mfma_f32_16x16x32_bf16(Bt[n][k], At[m][k], acc[ai][bj][m][n], 0, 0, 0); __builtin_amdgcn_s_setprio(0); } while (0)
#define PG8_WAIT_V(n) asm volatile("s_waitcnt vmcnt(" #n ")" ::: "memory")
#define PG8_WAIT_L(n) asm volatile("s_waitcnt lgkmcnt(" #n ")" ::: "memory")
#define PG8_BAR __builtin_amdgcn_s_barrier()
#define PG8_SCHED __builtin_amdgcn_sched_barrier(0)
    Unit cur, nxt; int ui = 0;
    if (!S.next(0, cur)) return;
    f32x4 acc[2][2][4][2];
#pragma unroll
    for (int a = 0; a < 2; ++a)
#pragma unroll
        for (int b = 0; b < 2; ++b)
#pragma unroll
            for (int m = 0; m < 4; ++m)
#pragma unroll
                for (int n = 0; n < 2; ++n) acc[a][b][m][n] = (f32x4){0.f, 0.f, 0.f, 0.f};
    bf16x8 At[4][2], B0[2][2], B1[2][2];
    const char* cA = (const char*)g.A + (size_t)cur.pm * tstep + S.aoff(cur); int rb0, rb1; S.brow(cur, rb0, rb1);
    const char* cB = (const char*)g.Bt + (size_t)rb0 * (K * 2) + (size_t)cur.br * B_BR; const char* cBh = (const char*)g.Bt + (size_t)rb1 * (K * 2) + (size_t)cur.br * B_BR;
    PG8_STAGE(PG8_SB(0, 0), cB, voffB); PG8_STAGE(PG8_SA(0, 0), cA, voffA); PG8_STAGE(PG8_SB(0, 1), cBh, voffB); PG8_STAGE(PG8_SA(0, 1), cA + hstep, voffA);
    if (wr == 1) PG8_BAR;
    PG8_WAIT_V(4); PG8_BAR;
    PG8_STAGE(PG8_SB(1, 0), cB + kstep, voffB); PG8_STAGE(PG8_SA(1, 0), cA + kstep, voffA); PG8_STAGE(PG8_SB(1, 1), cBh + kstep, voffB);
    PG8_WAIT_V(6); PG8_BAR;
    for (;;) {
        const bool has_next = S.next(ui + 1, nxt);
        const char* nA = has_next ? (const char*)g.A + (size_t)nxt.pm * tstep + S.aoff(nxt) : cA; int rn0 = 0, rn1 = 0; if (has_next) S.brow(nxt, rn0, rn1);
        const char* nB = has_next ? (const char*)g.Bt + (size_t)rn0 * (K * 2) + (size_t)nxt.br * B_BR : cB; const char* nBh = has_next ? (const char*)g.Bt + (size_t)rn1 * (K * 2) + (size_t)nxt.br * B_BR : cBh;
        for (int t = 0; t < nt; t += 2) {
            const bool last = (t == nt - 2);
            const char* a1 = cA + (size_t)(t + 1) * kstep;
            const char* a2 = last ? nA : cA + (size_t)(t + 2) * kstep; const char* b2 = last ? nB : cB + (size_t)(t + 2) * kstep; const char* b2h = last ? nBh : cBh + (size_t)(t + 2) * kstep;
            const char* a3 = a2 + kstep; const char* b3 = b2 + kstep; const char* b3h = b2h + kstep;
            PG8_LDB(B0, 0, 0); PG8_SCHED; PG8_LDA(At, 0, 0); PG8_STAGE(PG8_SA(1, 1), a1 + hstep, voffA);
            PG8_WAIT_L(8); PG8_BAR; PG8_WAIT_L(0); PG8_MMA(0, 0, At, B0); PG8_BAR; PG8_SCHED;
            PG8_LDB(B1, 0, 1); PG8_STAGE(PG8_SB(0, 0), b2, voffB);
            PG8_BAR; PG8_WAIT_L(0); PG8_MMA(0, 1, At, B1); PG8_BAR;
            PG8_LDA(At, 0, 1); PG8_STAGE(PG8_SA(0, 0), a2, voffA);
            PG8_BAR; PG8_WAIT_L(0); PG8_MMA(1, 0, At, B0); PG8_BAR; PG8_SCHED;
            PG8_STAGE(PG8_SB(0, 1), b2h, voffB);
            PG8_WAIT_V(6); PG8_BAR; PG8_MMA(1, 1, At, B1); PG8_BAR;
            PG8_LDB(B0, 1, 0); PG8_SCHED; PG8_LDA(At, 1, 0); PG8_STAGE(PG8_SA(0, 1), a2 + hstep, voffA);
            PG8_WAIT_L(8); PG8_BAR; PG8_WAIT_L(0); PG8_MMA(0, 0, At, B0); PG8_BAR; PG8_SCHED;
            PG8_LDB(B1, 1, 1); PG8_STAGE(PG8_SB(1, 0), b3, voffB);
            PG8_BAR; PG8_WAIT_L(0); PG8_MMA(0, 1, At, B1); PG8_BAR;
            PG8_LDA(At, 1, 1); PG8_STAGE(PG8_SA(1, 0), a3, voffA);
            PG8_BAR; PG8_WAIT_L(0); PG8_MMA(1, 0, At, B0); PG8_BAR; PG8_SCHED;
            PG8_STAGE(PG8_SB(1, 1), b3h, voffB);
            PG8_WAIT_V(6); PG8_BAR; PG8_MMA(1, 1, At, B1); PG8_BAR;
        }
        E(acc, cur, wr, wc, fr, fq);
        if (!has_next) break;
        if (Epi::zero_after(cur))
#pragma unroll
        for (int a = 0; a < 2; ++a)
#pragma unroll
            for (int b = 0; b < 2; ++b)
#pragma unroll
                for (int m = 0; m < 4; ++m)
#pragma unroll
                    for (int n = 0; n < 2; ++n) acc[a][b][m][n] = (f32x4){0.f, 0.f, 0.f, 0.f};
        cur = nxt; cA = nA; cB = nB; cBh = nBh; ++ui;
    }
    PG8_WAIT_V(0);
    if (wr == 0) PG8_BAR;
    PG8_BAR;
#undef PG8_SA
#undef PG8_SB
#undef PG8_STAGE
#undef PG8_LDA
#undef PG8_LDB
#undef PG8_MMA
#undef PG8_WAIT_V
#undef PG8_WAIT_L
#undef PG8_BAR
#undef PG8_SCHED
}
}

__device__ void phase_norm_bf16(const float* __restrict__ xin, const float* __restrict__ g, bf16_t* __restrict__ h, int rows);
struct TJob { const float* src; bf16_t* dst; int R, C, tr, tc; };
__device__ __forceinline__ TJob prep_job(const Params& p, int i) {
    bf16_t* win = (bf16_t*)(p.ws + p.o_win); bf16_t* wb = (bf16_t*)(p.ws + p.o_wb); bf16_t* wo = (bf16_t*)(p.ws + p.o_wo); bf16_t* pw = (bf16_t*)(p.ws + p.o_pw);
    constexpr int T_WIN = 16 * 160, T_WB = 8 * 16, T_WO = 16 * 16, T_PW = 4;
    constexpr int N0 = DEPTH * T_WIN, N1 = N0 + 8 * T_WB, N2 = N1 + DEPTH * T_WO;
    TJob j;
    if (i < N0) { const int l = i / T_WIN, t = i % T_WIN; j.src = p.in[2] + (size_t)l * DM * INC; j.dst = win + (size_t)l * DM * INC; j.R = DM; j.C = INC; j.tr = t / 160; j.tc = t % 160; }
    else if (i < N1) { const int k = i - N0, m = k / T_WB, t = k % T_WB; j.src = p.in[14] + (size_t)m * BWID * DM; j.dst = wb + (size_t)m * BWID * DM; j.R = BWID; j.C = DM; j.tr = t / 16; j.tc = t % 16; }
    else if (i < N2) { const int k = i - N1, l = k / T_WO, t = k % T_WO; j.src = p.in[15] + (size_t)l * DM * DM; j.dst = wo + (size_t)l * DM * DM; j.R = DM; j.C = DM; j.tr = t / 16; j.tc = t % 16; }
    else { const int k = i - N2, m = k / T_PW, t = k % T_PW; j.src = p.in[3] + (size_t)m * 128 * 128; j.dst = pw + (size_t)m * 128 * 128; j.R = 128; j.C = 128; j.tr = t / 2; j.tc = t % 2; }
    return j;
}
__device__ void phase_prep(const Params& p, LAS unsigned char* lds) {
    LAS float* sm = (LAS float*)lds;
    const int tid = otid();
    constexpr int NT = DEPTH * 16 * 160 + 8 * 8 * 16 + DEPTH * 16 * 16 + 8 * 4;
    const int lr = tid >> 4, lc = (tid & 15) * 4;
    f32x4 v0, v1;
    int i = blockIdx.x;
    if (i < NT) { const TJob j = prep_job(p, i); const float* sp = j.src + (size_t)(j.tr * 64 + lr) * j.C + j.tc * 64 + lc; v0 = *(const f32x4*)sp; v1 = *(const f32x4*)(sp + (size_t)32 * j.C); }
    for (; i < NT; i += gridDim.x) {
        const TJob j = prep_job(p, i);
#pragma unroll
        for (int e = 0; e < 4; ++e) { sm[lr * 65 + lc + e] = v0[e]; sm[(lr + 32) * 65 + lc + e] = v1[e]; }
        __syncthreads();
        const int in = i + gridDim.x;
        if (in < NT) { const TJob jn = prep_job(p, in); const float* sp = jn.src + (size_t)(jn.tr * 64 + lr) * jn.C + jn.tc * 64 + lc; v0 = *(const f32x4*)sp; v1 = *(const f32x4*)(sp + (size_t)32 * jn.C); }
        { const int c = tid >> 3, r8 = (tid & 7) * 8; float o[8];
#pragma unroll
          for (int e = 0; e < 8; ++e) o[e] = sm[(r8 + e) * 65 + c];
          *(u32x4*)(j.dst + (size_t)(j.tc * 64 + c) * j.R + j.tr * 64 + r8) = pack8(o); }
        __syncthreads();
    }
    const float* sgw = p.in[11]; bf16_t* sw = (bf16_t*)(p.ws + p.o_sw);
    for (int k = blockIdx.x * 512 + tid; k < DEPTH * 4 * 128 * 128; k += gridDim.x * 512) { const int s_ = k & 127, t = (k >> 7) & 127; sw[k] = (s_ <= t) ? f2bf(sgw[k]) : (bf16_t)0; }
    phase_norm_bf16(p.in[0], p.in[1], (bf16_t*)(p.ws + p.o_h), NTOK);
}

__device__ void phase_norm_bf16(const float* __restrict__ xin, const float* __restrict__ g, bf16_t* __restrict__ h, int rows) {
    const int tid = otid(), lane = tid & 63, w = tid >> 6;
    float gv[2][8];
    load8f(g + 8 * lane, gv[0]); load8f(g + 512 + 8 * lane, gv[1]);
    for (int row = blockIdx.x * 8 + w; row < rows; row += gridDim.x * 8) {
        const float* xr = xin + (size_t)row * DM + 8 * lane;
        float v[2][8]; load8f(xr, v[0]); load8f(xr + 512, v[1]);
        float ss = 0.f;
#pragma unroll
        for (int i = 0; i < 2; ++i)
#pragma unroll
            for (int j = 0; j < 8; ++j) ss += v[i][j] * v[i][j];
        ss = wave_sum(ss);
        const float r = rsqrtf(ss * (1.0f / 1024.0f) + 1e-6f);
#pragma unroll
        for (int i = 0; i < 2; ++i) { float o[8];
#pragma unroll
            for (int j = 0; j < 8; ++j) o[j] = v[i][j] * r * gv[i][j];
            *(u32x4*)(h + (size_t)row * DM + 512 * i + 8 * lane) = pack8(o); }
    }
}
__device__ void phase_norm_final(float* __restrict__ x, const float* __restrict__ g, int rows) {
    const int tid = otid(), lane = tid & 63, w = tid >> 6;
    float gv[2][8];
    load8f(g + 8 * lane, gv[0]); load8f(g + 512 + 8 * lane, gv[1]);
    for (int row = blockIdx.x * 8 + w; row < rows; row += gridDim.x * 8) {
        float* xr = x + (size_t)row * DM + 8 * lane;
        float v[2][8]; load8f(xr, v[0]); load8f(xr + 512, v[1]);
        float ss = 0.f;
#pragma unroll
        for (int i = 0; i < 2; ++i)
#pragma unroll
            for (int j = 0; j < 8; ++j) ss += v[i][j] * v[i][j];
        ss = wave_sum(ss);
        const float r = rsqrtf(ss * (1.0f / 1024.0f) + 1e-6f);
#pragma unroll
        for (int i = 0; i < 2; ++i) {
            f32x4 a, b;
#pragma unroll
            for (int j = 0; j < 4; ++j) { a[j] = v[i][j] * r * gv[i][j]; b[j] = v[i][4 + j] * r * gv[i][4 + j]; }
            *(f32x4*)(xr + 512 * i) = a; *(f32x4*)(xr + 512 * i + 4) = b; }
    }
}

#define PO(k) ((size_t)(k) * TS * BWID)
__device__ void mix_sc(const Params& p, int l, const bf16_t* proj, bf16_t* z3, int r0, int pos0) {
    const int tid = otid(), lane = tid & 63, w = tid >> 6, c0 = lane * 8;
    const float* scw = p.in[13] + (size_t)l * 3 * BWID + c0;
    float w0[8], w1[8], w2[8]; load8f(scw, w0); load8f(scw + BWID, w1); load8f(scw + 2 * BWID, w2);
    const int r = r0 + 16 * w, pos = pos0 + 16 * w;
    const bf16_t* bgp = proj + PO(6) + c0; const bf16_t* cxp = proj + PO(7) + c0;
    u32x4 vb[16], vc[18];
    vc[0] = (u32x4){0u, 0u, 0u, 0u}; vc[1] = vc[0];
    if (pos > 0) { vc[0] = *(const u32x4*)(cxp + (size_t)(r - 2) * BWID); vc[1] = *(const u32x4*)(cxp + (size_t)(r - 1) * BWID); }
#pragma unroll
    for (int jj = 0; jj < 16; ++jj) { vb[jj] = *(const u32x4*)(bgp + (size_t)(r + jj) * BWID); vc[2 + jj] = *(const u32x4*)(cxp + (size_t)(r + jj) * BWID); }
    float p2[8], p1[8];
    unpack8(vc[0], p2); unpack8(vc[1], p1);
#pragma unroll
    for (int jj = 0; jj < 16; ++jj) {
        float b[8], cur[8], o[8]; unpack8(vb[jj], b); unpack8(vc[2 + jj], cur);
#pragma unroll
        for (int j = 0; j < 8; ++j) { o[j] = b[j] * (w0[j] * p2[j] + w1[j] * p1[j] + w2[j] * cur[j]); p2[j] = p1[j]; p1[j] = cur[j]; }
        *(u32x4*)(z3 + (size_t)(r + jj) * BWID + c0) = pack8(o);
    }
}

__device__ void mix_conv(const Params& p, int l, const bf16_t* proj, bf16_t* z1, int r0, int pos0, LAS unsigned char* lds) {
    const int tid = otid(), lane = tid & 63, w = tid >> 6, c0 = lane * 8;
    LAS unsigned char* Y = lds; LAS unsigned char* W = lds + 94 * VP;
    const float* cw = p.in[5] + (size_t)l * 31 * BWID;
    for (int i = tid; i < 31 * 64; i += 512) { const int k = i >> 6, cgp = i & 63; float f[8]; load8f(cw + k * BWID + cgp * 8, f); *(LAS u32x4*)(W + k * 1024 + cgp * 16) = pack8(f); }
    float bias[8], lng[8], lnb[8];
    load8f(p.in[6] + (size_t)l * BWID + c0, bias); load8f(p.in[7] + (size_t)l * BWID + c0, lng); load8f(p.in[8] + (size_t)l * BWID + c0, lnb);
    for (int q = 0; q < 2; ++q) {
        const int tr = r0 + 64 * q, tp = pos0 + 64 * q;
        __syncthreads();
        {
            u32x4 la[12];
#pragma unroll
            for (int i = 0; i < 12; ++i) { const int row = 12 * w + i; const bool valid = (row < 94) && (tp - 30 + row >= 0);
                la[i] = (u32x4){0u, 0u, 0u, 0u};
                if (valid) la[i] = *(const u32x4*)(proj + (size_t)(tr - 30 + row) * BWID + PO(2) + c0); }
#pragma unroll
            for (int i = 0; i < 12; ++i) { const int row = 12 * w + i; if (row < 94) *(LAS u32x4*)(Y + row * VP + lane * 16) = la[i]; }
        }
        __syncthreads();
        u32x4 gtv[8];
#pragma unroll
        for (int j = 0; j < 8; ++j) gtv[j] = *(const u32x4*)(proj + (size_t)(tr + 8 * w + j) * BWID + PO(3) + c0);
        float acc[8][8];
#pragma unroll
        for (int j = 0; j < 8; ++j)
#pragma unroll
            for (int c = 0; c < 8; ++c) acc[j][c] = bias[c];
#pragma unroll 1
        for (int k = 0; k < 31; ++k) {
            float wv[8]; unpack8(*(const LAS u32x4*)(W + k * 1024 + lane * 16), wv);
#pragma unroll
            for (int j = 0; j < 8; ++j) { float yv[8]; unpack8(*(const LAS u32x4*)(Y + (8 * w + j + k) * VP + lane * 16), yv);
#pragma unroll
                for (int c = 0; c < 8; ++c) acc[j][c] += wv[c] * yv[c]; }
        }
#pragma unroll
        for (int j = 0; j < 8; ++j) {
            float s = 0.f, ss = 0.f;
#pragma unroll
            for (int c = 0; c < 8; ++c) { s += acc[j][c]; ss += acc[j][c] * acc[j][c]; }
            s = wave_sum(s); ss = wave_sum(ss);
            const float mean = s * (1.0f / 512.0f); const float var = fmaxf(ss * (1.0f / 512.0f) - mean * mean, 0.f); const float rstd = rsqrtf(var + 1e-5f);
            const int row = tr + 8 * w + j;
            float gt[8], o[8]; unpack8(gtv[j], gt);
#pragma unroll
            for (int c = 0; c < 8; ++c) { const float v = (acc[j][c] - mean) * rstd * lng[c] + lnb[c]; o[c] = silu(v) * silu(gt[c]); }
            *(u32x4*)(z1 + (size_t)row * BWID + c0) = pack8(o);
        }
    }
}

__device__ __forceinline__ u32x4 sel4(bool c, const u32x4 a, const u32x4 b) { u32x4 r; r.x = c ? a.x : b.x; r.y = c ? a.y : b.y; r.z = c ? a.z : b.z; r.w = c ? a.w : b.w; return r; }

__device__ void mix_pool(const Params& p, int l, const bf16_t* proj, bf16_t* z0, int r0, int pos0, LAS unsigned char* lds) {
    const int tid = otid(), lane = tid & 63, w = tid >> 6, c0 = lane * 8;
    LAS unsigned char* P = lds;
    {
        const int g4 = lane >> 4, win = 2 << g4;
        const int r = r0 + 16 * w, pos = pos0 + 16 * w;
        u32x4 R[32];
#pragma unroll
        for (int i = 0; i < 16; ++i) { R[i] = (u32x4){0u, 0u, 0u, 0u}; if (pos > 0) R[i] = *(const u32x4*)(proj + (size_t)(r - 16 + i) * BWID + c0); }
#pragma unroll
        for (int i = 0; i < 16; ++i) R[16 + i] = *(const u32x4*)(proj + (size_t)(r + i) * BWID + c0);
        float S[8];
#pragma unroll
        for (int j = 0; j < 8; ++j) S[j] = 0.f;
#pragma unroll
        for (int i = 1; i <= 16; ++i) { float x[8]; unpack8(R[16 - i], x); const float mk = (i <= win) ? 1.0f : 0.0f;
#pragma unroll
            for (int j = 0; j < 8; ++j) S[j] += mk * x[j]; }
#pragma unroll
        for (int jj = 0; jj < 16; ++jj) {
            const int ps = pos + jj; float xv[8], xo[8], o[8];
            unpack8(R[16 + jj], xv);
            const u32x4 ro = sel4(g4 < 2, sel4(g4 == 0, R[16 + jj - 2], R[16 + jj - 4]), sel4(g4 == 2, R[16 + jj - 8], R[jj]));
            unpack8(ro, xo);
            const int cnt = (ps + 1 < win) ? ps + 1 : win; const float inv = 1.0f / (float)cnt;
#pragma unroll
            for (int j = 0; j < 8; ++j) { S[j] += xv[j] - xo[j]; o[j] = S[j] * inv - xv[j]; }
            *(LAS u32x4*)(P + (16 * w + jj) * VP + lane * 16) = pack8(o);
        }
    }
    __syncthreads();
    {
        const int g = w >> 1, fr = lane & 15, fq = lane >> 4;
        const bf16_t* pwT = (const bf16_t*)(p.ws + p.o_pw) + (size_t)(l * 4 + g) * 128 * 128;
        u32x2 gtv[8][4];
#pragma unroll
        for (int tt = 0; tt < 8; ++tt)
#pragma unroll
            for (int dt = 0; dt < 4; ++dt) gtv[tt][dt] = *(const u32x2*)(proj + (size_t)(r0 + 16 * tt + fr) * BWID + PO(1) + 64 * w + 16 * dt + 4 * fq);
        bf16x8 A[4][4];
#pragma unroll
        for (int dt = 0; dt < 4; ++dt)
#pragma unroll
            for (int kk = 0; kk < 4; ++kk) A[dt][kk] = *(const bf16x8*)(pwT + (size_t)(64 * (w & 1) + 16 * dt + fr) * 128 + 32 * kk + 8 * fq);
        const float* psc = p.in[4] + (size_t)l * BWID;
        f32x4 sc[4];
#pragma unroll
        for (int dt = 0; dt < 4; ++dt) sc[dt] = *(const f32x4*)(psc + 64 * w + 16 * dt + 4 * fq);
#pragma unroll
        for (int tt = 0; tt < 8; ++tt) {
            bf16x8 Bf[4];
#pragma unroll
            for (int kk = 0; kk < 4; ++kk) Bf[kk] = *(const LAS bf16x8*)(P + (16 * tt + fr) * VP + (128 * g + 32 * kk + 8 * fq) * 2);
            f32x4 acc[4];
#pragma unroll
            for (int dt = 0; dt < 4; ++dt) { acc[dt] = (f32x4){0.f, 0.f, 0.f, 0.f};
#pragma unroll
                for (int kk = 0; kk < 4; ++kk) acc[dt] = __builtin_amdgcn_mfma_f32_16x16x32_bf16(A[dt][kk], Bf[kk], acc[dt], 0, 0, 0); }
            const int row = r0 + 16 * tt + fr;
#pragma unroll
            for (int dt = 0; dt < 4; ++dt) { const int d = 64 * w + 16 * dt + 4 * fq;
                float gt[4]; unpack4(gtv[tt][dt], gt);
                u32x2 o; o.x = cvt_pk_bf16(acc[dt][0] * sc[dt][0] * silu(gt[0]), acc[dt][1] * sc[dt][1] * silu(gt[1])); o.y = cvt_pk_bf16(acc[dt][2] * sc[dt][2] * silu(gt[2]), acc[dt][3] * sc[dt][3] * silu(gt[3]));
                *(u32x2*)(z0 + (size_t)row * BWID + d) = o; }
        }
    }
}

__device__ void mix_sgu(const Params& p, int l, const bf16_t* proj, bf16_t* z2, int r0, LAS unsigned char* lds) {
    const int tid = otid(), lane = tid & 63, w = tid >> 6, c0 = lane * 8;
    LAS unsigned char* V = lds;
    {
        float lng[8], lnb[8]; load8f(p.in[9] + (size_t)l * BWID + c0, lng); load8f(p.in[10] + (size_t)l * BWID + c0, lnb);
        u32x4 R[16];
#pragma unroll
        for (int jj = 0; jj < 16; ++jj) R[jj] = *(const u32x4*)(proj + (size_t)(r0 + 16 * w + jj) * BWID + PO(5) + c0);
#pragma unroll
        for (int jj = 0; jj < 16; ++jj) {
            float x[8], o[8]; unpack8(R[jj], x);
            float s = 0.f, ss = 0.f;
#pragma unroll
            for (int c = 0; c < 8; ++c) { s += x[c]; ss += x[c] * x[c]; }
            s = wave_sum(s); ss = wave_sum(ss);
            const float mean = s * (1.0f / 512.0f); const float var = fmaxf(ss * (1.0f / 512.0f) - mean * mean, 0.f); const float rstd = rsqrtf(var + 1e-5f);
#pragma unroll
            for (int c = 0; c < 8; ++c) o[c] = (x[c] - mean) * rstd * lng[c] + lnb[c];
            *(LAS u32x4*)(V + (16 * w + jj) * VP + lane * 16) = pack8(o);
        }
    }
    __syncthreads();
    {
        const int g = w >> 1, fr = lane & 15, fq = lane >> 4;
        const unsigned vbase = (unsigned)(size_t)V;
        bf16x8 A[4][4];
#pragma unroll
        for (int ct = 0; ct < 4; ++ct)
#pragma unroll
            for (int kk = 0; kk < 4; ++kk) {
                const unsigned a = vbase + (unsigned)((32 * kk + 8 * fq + (fr >> 2)) * VP + (64 * w + 16 * ct + 4 * (fr & 3)) * 2);
                const u32x2 lo = tr_read(a), hi = tr_read(a + 4 * VP);
                u32x4 t; t.x = lo.x; t.y = lo.y; t.z = hi.x; t.w = hi.y;
                A[ct][kk] = __builtin_bit_cast(bf16x8, t);
            }
        const bf16_t* swm = (const bf16_t*)(p.ws + p.o_sw) + (size_t)(l * 4 + g) * 128 * 128;
        const float* sb = p.in[12] + (size_t)(l * 4 + g) * 128;
#pragma unroll
        for (int hb = 0; hb < 2; ++hb) {
            u32x2 uu[4][4]; bf16x8 Wf[4][4]; float bias[4];
#pragma unroll
            for (int t4 = 0; t4 < 4; ++t4) { const int tt = hb * 4 + t4; const bf16_t* pr = proj + (size_t)(r0 + 16 * tt + fr) * BWID + 64 * w + 4 * fq;
#pragma unroll
                for (int ct = 0; ct < 4; ++ct) uu[t4][ct] = *(const u32x2*)(pr + PO(4) + 16 * ct);
#pragma unroll
                for (int kk = 0; kk < 4; ++kk) if (kk < (tt >> 1) + 1) Wf[t4][kk] = *(const bf16x8*)(swm + (size_t)(16 * tt + fr) * 128 + 32 * kk + 8 * fq);
                bias[t4] = sb[16 * tt + fr]; }
#pragma unroll
            for (int t4 = 0; t4 < 4; ++t4) { const int tt = hb * 4 + t4;
                f32x4 acc[4];
#pragma unroll
                for (int ct = 0; ct < 4; ++ct) acc[ct] = (f32x4){0.f, 0.f, 0.f, 0.f};
#pragma unroll
                for (int kk = 0; kk < 4; ++kk) if (kk < (tt >> 1) + 1) {
#pragma unroll
                    for (int ct = 0; ct < 4; ++ct) acc[ct] = __builtin_amdgcn_mfma_f32_16x16x32_bf16(A[ct][kk], Wf[t4][kk], acc[ct], 0, 0, 0); }
                const int row = r0 + 16 * tt + fr;
#pragma unroll
                for (int ct = 0; ct < 4; ++ct) { const int c = 64 * w + 16 * ct + 4 * fq;
                    float u[4]; unpack4(uu[t4][ct], u);
                    u32x2 o; o.x = cvt_pk_bf16(u[0] * (acc[ct][0] + bias[t4]), u[1] * (acc[ct][1] + bias[t4])); o.y = cvt_pk_bf16(u[2] * (acc[ct][2] + bias[t4]), u[3] * (acc[ct][3] + bias[t4]));
                    *(u32x2*)(z2 + (size_t)row * BWID + c) = o; }
            }
        }
    }
}

__device__ void phase_mix(const Params& p, int l, const bf16_t* proj, bf16_t* z, LAS unsigned char* lds) {
    constexpr int nchunk = TS / 128;
    for (int i = blockIdx.x; i < 4 * nchunk; i += gridDim.x) {
        const int br = i / nchunk, j = i % nchunk, r0 = j * 128, pos0 = (j & 15) * 128;
        if (br == 0) for (int rr = 0; rr < REP_M0; ++rr) { mix_pool(p, l, proj, z + PO(1), r0, pos0, lds); __syncthreads(); }
        else if (br == 1) for (int rr = 0; rr < REP_M1; ++rr) { mix_conv(p, l, proj, z + PO(3), r0, pos0, lds); __syncthreads(); }
        else if (br == 2) for (int rr = 0; rr < REP_M2; ++rr) { mix_sgu(p, l, proj, z + PO(4), r0, lds); __syncthreads(); }
        else for (int rr = 0; rr < REP_M3; ++rr) { mix_sc(p, l, proj, z + PO(6), r0, pos0); __syncthreads(); }
    }
}

#define XB_TMO      128
#define XB_XCNT(j)  (256  + 64 * (j))
#define XB_XSUB(j)  (1280 + 64 * (j))
#define XB_XGEN(j)  (2304 + 64 * (j))
#define XB_TOP      3328
#define XB_TOPGEN   3392
#define XCD_BAR_WORDS 3456
#define XB_SPIN_CAP (1u << 20)
__device__ __forceinline__ unsigned xb_ld(unsigned* p)              { return __hip_atomic_load(p, __ATOMIC_RELAXED, __HIP_MEMORY_SCOPE_AGENT); }
__device__ __forceinline__ unsigned xb_add(unsigned* p, unsigned v) { return __hip_atomic_fetch_add(p, v, __ATOMIC_RELAXED, __HIP_MEMORY_SCOPE_AGENT); }
__device__ __forceinline__ unsigned xb_xcc_id() { return (unsigned)__builtin_amdgcn_s_getreg((3 << 11) | 20) & 0xFu; }
#define XB_SPIN(cond, bar) do { unsigned _sp = 0; while (cond) { __builtin_amdgcn_s_sleep(1); \
    if ((++_sp & 255u) == 0u) { if (xb_ld(&(bar)[XB_TMO])) break; if (_sp > XB_SPIN_CAP) { atomicAdd(&(bar)[XB_TMO], 1u); break; } } } } while (0)
struct XcdBarrier { unsigned* bar; unsigned x; volatile LAS unsigned* st; };
__device__ __forceinline__ XcdBarrier xcd_barrier_post(unsigned* bar, volatile LAS unsigned* st) {
    XcdBarrier b; b.bar = bar; b.x = xb_xcc_id(); b.st = st;
    if (threadIdx.x == 0) (void)xb_add(&bar[XB_XCNT(b.x)], 1u);
    return b;
}
__device__ __forceinline__ void xcd_barrier_complete(unsigned* bar, unsigned x, unsigned& nloc, unsigned& nx) {
    const unsigned G = gridDim.x * gridDim.y * gridDim.z;
    unsigned sum, cnt, mine, sp = 0u;
    for (;;) {
        sum = 0u; cnt = 0u; mine = 0u;
#pragma unroll
        for (unsigned j = 0; j < 16; ++j) { const unsigned c = xb_ld(&bar[XB_XCNT(j)]); sum += c; cnt += (c > 0u) ? 1u : 0u; mine = (j == x) ? c : mine; }
        if (sum == G) break;
        __builtin_amdgcn_s_sleep(1);
        if ((++sp & 255u) == 0u) { if (xb_ld(&bar[XB_TMO])) break; if (sp > XB_SPIN_CAP) { atomicAdd(&bar[XB_TMO], 1u); break; } }
    }
    nloc = mine > 0u ? mine : 1u; nx = cnt > 0u ? cnt : 1u;
}
__device__ __forceinline__ void xcd_barrier(const XcdBarrier& b) {
    asm volatile("s_waitcnt vmcnt(0)" ::: "memory");
    __syncthreads();
    if (threadIdx.x == 0) {
        unsigned* bar = b.bar;
        __builtin_amdgcn_s_waitcnt(0);
        unsigned nloc = b.st[0], nx = b.st[1];
        if (nloc == 0u) { xcd_barrier_complete(bar, b.x, nloc, nx); b.st[0] = nloc; b.st[1] = nx; }
        const unsigned old = xb_add(&bar[XB_XSUB(b.x)], 1u);
        const unsigned gen = old / nloc;
        if (old + 1u == (gen + 1u) * nloc) {
            __builtin_amdgcn_fence(__ATOMIC_RELEASE, "agent");
            asm volatile("s_waitcnt vmcnt(0)" ::: "memory");
            const unsigned og = xb_add(&bar[XB_TOP], 1u);
            const unsigned tg = og / nx;
            if (og + 1u == (tg + 1u) * nx) xb_add(&bar[XB_TOPGEN], 1u);
            else XB_SPIN(xb_ld(&bar[XB_TOPGEN]) == tg, bar);
            __builtin_amdgcn_fence(__ATOMIC_ACQUIRE, "agent");
            xb_add(&bar[XB_XGEN(b.x)], 1u);
            asm volatile("s_waitcnt vmcnt(0)" ::: "memory");
        } else {
            XB_SPIN(xb_ld(&bar[XB_XGEN(b.x)]) == gen, bar);
            __builtin_amdgcn_fence(__ATOMIC_ACQUIRE, "agent");
            asm volatile("s_waitcnt vmcnt(0)" ::: "memory");
        }
    }
    __syncthreads();
}

__global__ void __launch_bounds__(512) mk_forward(Params p) {
    extern __shared__ __attribute__((aligned(16))) unsigned char lds_raw[];
    LAS unsigned char* lds = (LAS unsigned char*)lds_raw;
    cg::grid_group grid = cg::this_grid();
    volatile LAS unsigned* stw = (volatile LAS unsigned*)(lds + LDS_BYTES - 16);
    if (threadIdx.x == 0) { stw[0] = 0u; stw[1] = 0u; }
    __syncthreads();
    const XcdBarrier xbar = xcd_barrier_post((unsigned*)(p.ws + p.o_bar), stw);
    int ph = 0;
#define PHASE_ON (ph >= p.ph_lo && ph < p.ph_hi)
#ifndef XSYNC
#define XSYNC 0
#endif
#define PHASE_END do { if (PHASE_ON && ph + 1 < p.ph_hi) { if (ph == 0) grid.sync(); else xcd_barrier(xbar); for (int xs = 0; xs < XSYNC; ++xs) xcd_barrier(xbar); } ++ph; } while (0)
    constexpr int ts = TS;
    bf16_t* win = (bf16_t*)(p.ws + p.o_win); bf16_t* wb = (bf16_t*)(p.ws + p.o_wb); bf16_t* wo = (bf16_t*)(p.ws + p.o_wo);
    bf16_t* h0 = (bf16_t*)(p.ws + p.o_h); bf16_t* proj = (bf16_t*)(p.ws + p.o_proj);

    if (PHASE_ON) phase_prep(p, lds);
    PHASE_END;
#pragma unroll 1
    for (int l = 0; l < DEPTH; ++l) {
        const float* xin = (l == 0) ? p.in[0] : p.out;
#pragma unroll 1
        for (int s = 0; s < NS; ++s) {
            const size_t tok0 = (size_t)s * ts;
            bf16_t* h = h0 + tok0 * DM; bf16_t* merged = h;
            if (l > 0) { if (PHASE_ON) phase_norm_bf16(xin + tok0 * DM, p.in[1] + (size_t)l * DM, h, ts);
                PHASE_END; }
            if (PHASE_ON) for (int rep = 0; rep < REP_A; ++rep) { pg8::Gemm g{h, win + (size_t)l * DM * INC}; pg8::OrderA S; S.G = (int)gridDim.x; S.c = (int)blockIdx.x; pg8::EpiProj E{proj, proj + (size_t)8 * TS * BWID}; pg8::gemm_phase<DM, 0>(lds, g, S, E); }
            PHASE_END;
            if (PHASE_ON) phase_mix(p, l, proj, proj, lds);
            PHASE_END;
            if (PHASE_ON) for (int rep = 0; rep < REP_C; ++rep) { pg8::Gemm g{proj, wb + (size_t)l * 4 * BWID * DM}; pg8::OrderC S; S.G = (int)gridDim.x; S.c = (int)blockIdx.x;
                pg8::EpiGate E{proj + (size_t)8 * TS * BWID, merged}; pg8::gemm_phase<BWID, (size_t)BWID * DM * 2>(lds, g, S, E); }
            PHASE_END;
            if (PHASE_ON) { pg8::Gemm g{merged, wo + (size_t)l * DM * DM}; pg8::Order<TS / 256, DM / 256, 1> S{(int)gridDim.x, (int)blockIdx.x};
                pg8::EpiRes E{xin + tok0 * DM, p.out + tok0 * DM, DM}; pg8::gemm_phase<DM, 0>(lds, g, S, E); }
            PHASE_END;
        }
    }
    if (PHASE_ON) phase_norm_final(p.out, p.in[16], NTOK);
    PHASE_END;
}

extern "C" void kernel_launch(void* const* d_in, const int* in_sizes, int n_in, void* d_out, int out_size, void* d_ws, size_t ws_size, hipStream_t stream) {
    static int grid = 0;
    if (grid == 0) {
        int dev = 0, cus = 0, per_cu = 0;
        hipGetDevice(&dev); hipDeviceGetAttribute(&cus, hipDeviceAttributeMultiprocessorCount, dev);
        if (hipFuncSetAttribute((const void*)mk_forward, hipFuncAttributeMaxDynamicSharedMemorySize, LDS_BYTES) != hipSuccess) { fprintf(stderr, "hipFuncSetAttribute failed\n"); grid = -1; return; }
        if (hipOccupancyMaxActiveBlocksPerMultiprocessor(&per_cu, (const void*)mk_forward, 512, LDS_BYTES) != hipSuccess || per_cu < 1) { fprintf(stderr, "occupancy query: %d\n", per_cu); per_cu = 1; }
        (void)hipGetLastError();
        grid = cus * per_cu;
    }
    if (grid < 0) return;
    Params p{};
    for (int i = 0; i < 17; ++i) p.in[i] = (const float*)d_in[i];
    p.out = (float*)d_out; p.ws = (unsigned char*)d_ws;
    p.ns = NS; p.ts = TS;
    size_t o = 0;
    p.o_win = o; o += (size_t)DEPTH * DM * INC * 2;
    p.o_wb = o; o += (size_t)DEPTH * 4 * BWID * DM * 2;
    p.o_wo = o; o += (size_t)DEPTH * DM * DM * 2;
    p.o_pw = o; o += (size_t)DEPTH * 4 * 128 * 128 * 2;
    p.o_sw = o; o += (size_t)DEPTH * 4 * 128 * 128 * 2;
    p.o_bar = o; o += 16384;
    p.o_h = o; o += (size_t)NTOK * DM * 2;
    p.o_z = 0;
    p.o_proj = o; o += (size_t)p.ts * (8 * BWID * 2 + 4096);
    if (o > ws_size) { fprintf(stderr, "kernel_launch: workspace too small: need %zu, have %zu\n", o, ws_size); return; }
    const int nph = 1 + NS * 4 + (DEPTH - 1) * NS * 5 + 1;
    if (hipMemsetAsync((char*)d_ws + p.o_bar, 0, 16384, stream) != hipSuccess) { fprintf(stderr, "kernel_launch: memset failed\n"); return; }
#if MULTI_LAUNCH
    for (int ph = 0; ph < nph; ++ph) { p.ph_lo = ph; p.ph_hi = ph + 1; hipLaunchKernelGGL(mk_forward, dim3(grid), dim3(512), LDS_BYTES, stream, p); }
#else
    p.ph_lo = 0; p.ph_hi = nph;
    void* args[] = {&p};
    hipError_t e = hipLaunchCooperativeKernel((const void*)mk_forward, dim3(grid), dim3(512), args, LDS_BYTES, stream);
    if (e != hipSuccess) fprintf(stderr, "cooperative launch failed: %s (grid %d)\n", hipGetErrorString(e), grid);
#endif
}
```

```cpp
#include <hip/hip_runtime.h>
#include <hip/hip_cooperative_groups.h>
#include <cstdio>
namespace cg = cooperative_groups;

#ifndef MULTI_LAUNCH
#define MULTI_LAUNCH 0
#endif

#ifndef REP_N
#define REP_N 1
#endif
#ifndef REP_A
#define REP_A 1
#endif
#ifndef REP_B
#define REP_B 1
#endif
#ifndef REP_C
#define REP_C 1
#endif
#define REP_M0 1
#define REP_M1 1
#define REP_M2 1
#define REP_M3 1
#define LAS __attribute__((address_space(3)))
typedef unsigned short bf16_t;
typedef short bf16x8 __attribute__((ext_vector_type(8)));
typedef float f32x4 __attribute__((ext_vector_type(4)));
typedef float f32x2 __attribute__((ext_vector_type(2)));
typedef unsigned u32x4 __attribute__((ext_vector_type(4)));
typedef unsigned u32x2 __attribute__((ext_vector_type(2)));

constexpr int DM = 1024, SEQ = 2048, NTOK = 32 * 2048, DEPTH = 2, BWID = 512, INC = 10240, GATE0 = 6144;
constexpr int PP = 6144;
constexpr int NS = 1, TS = NTOK / NS;
constexpr int LDS_BYTES = 139264;
constexpr int VP = 1040;

struct Params {
    const float* in[17];
    float* out;
    unsigned char* ws;
    int ts, ns, ph_lo, ph_hi;
    unsigned long long o_win, o_wb, o_wo, o_pw, o_sw, o_h, o_z, o_bar, o_proj;
};

__device__ __forceinline__ int otid() { int t = threadIdx.x; asm volatile("" : "+v"(t)); return t; }
__device__ __forceinline__ unsigned cvt_pk_bf16(float lo, float hi) { unsigned r; asm volatile("v_cvt_pk_bf16_f32 %0, %1, %2" : "=v"(r) : "v"(lo), "v"(hi)); return r; }
__device__ __forceinline__ bf16_t f2bf(float f) { unsigned u = __float_as_uint(f); u += 0x7FFFu + ((u >> 16) & 1u); return (bf16_t)(u >> 16); }
__device__ __forceinline__ void unpack8(const u32x4 v, float (&f)[8]) {
    f[0] = __uint_as_float(v.x << 16); f[1] = __uint_as_float(v.x & 0xffff0000u); f[2] = __uint_as_float(v.y << 16); f[3] = __uint_as_float(v.y & 0xffff0000u);
    f[4] = __uint_as_float(v.z << 16); f[5] = __uint_as_float(v.z & 0xffff0000u); f[6] = __uint_as_float(v.w << 16); f[7] = __uint_as_float(v.w & 0xffff0000u);
}
__device__ __forceinline__ u32x4 pack8(const float (&f)[8]) { u32x4 r; r.x = cvt_pk_bf16(f[0], f[1]); r.y = cvt_pk_bf16(f[2], f[3]); r.z = cvt_pk_bf16(f[4], f[5]); r.w = cvt_pk_bf16(f[6], f[7]); return r; }
__device__ __forceinline__ void unpack4(const u32x2 v, float (&f)[4]) { f[0] = __uint_as_float(v.x << 16); f[1] = __uint_as_float(v.x & 0xffff0000u); f[2] = __uint_as_float(v.y << 16); f[3] = __uint_as_float(v.y & 0xffff0000u); }
__device__ __forceinline__ float sigm(float x) { return __builtin_amdgcn_rcpf(1.0f + __expf(-x)); }
__device__ __forceinline__ float silu(float x) { return x * sigm(x); }
__device__ __forceinline__ void load8f(const float* p, float (&f)[8]) { const f32x4 a = *(const f32x4*)p, b = *(const f32x4*)(p + 4); f[0] = a[0]; f[1] = a[1]; f[2] = a[2]; f[3] = a[3]; f[4] = b[0]; f[5] = b[1]; f[6] = b[2]; f[7] = b[3]; }
__device__ __forceinline__ float wave_sum(float v) {
#pragma unroll
    for (int o = 32; o >= 1; o >>= 1) v += __shfl_xor(v, o);
    return v;
}
__device__ __forceinline__ u32x2 tr_read(unsigned lds_addr) { u32x2 r; asm volatile("ds_read_b64_tr_b16 %0, %1\n\ts_waitcnt lgkmcnt(0)" : "=&v"(r) : "v"(lds_addr) : "memory"); return r; }

namespace pg8 {
constexpr int BM = 256, BK = 64, HALF = 128, HTB = HALF * BK * 2, STAGE_BYTES = 8 * HTB, NXCD = 8, WGM = 8;
__device__ __forceinline__ int lds_byte(int r, int c) { const int st = (r >> 4) * 2 + (c >> 5), rr = r & 15, cc = c & 31, ob = rr * 64 + cc * 2; return st * 1024 + (ob ^ (((ob >> 9) & 1) << 5)); }
__device__ __forceinline__ void stage_rc(int b, int& R, int& C) { const int st = b / 1024, sb = b % 1024, swz = sb ^ (((sb >> 9) & 1) << 5); R = (st >> 1) * 16 + swz / 64; C = (st & 1) * 32 + (swz % 64) / 2; }
__device__ __forceinline__ int perm32(int rho) { const int n = rho >> 4, i = rho & 15; return 8 * (i >> 2) + 4 * n + (i & 3); }

struct Unit { int pm, pn, br; };
struct Gemm { const bf16_t* A; const bf16_t* Bt; };

template <int NM, int NN, int NBR>
struct Order {
    int G, c;
    __device__ __forceinline__ bool next(int i, Unit& u) const {
        constexpr int nwg = NM * NN;
        const int ti = i / NBR;
        const long L = (long)ti * G + c; if (L >= nwg) return false;
        int wgid = (int)L; { constexpr int q = nwg / NXCD, r = nwg % NXCD; const int xcd = wgid % NXCD, off = wgid / NXCD; wgid = (xcd < r ? xcd * (q + 1) : r * (q + 1) + (xcd - r) * q) + off; }
        constexpr int nig = WGM * NN; const int gid = wgid / nig, fm = gid * WGM, gsz = (NM - fm) < WGM ? (NM - fm) : WGM;
        u.pm = fm + ((wgid % nig) % gsz); u.pn = (wgid % nig) / gsz; u.br = i % NBR; return true;
    }
    __device__ __forceinline__ void brow(const Unit& u, int& r0, int& r1) const { r0 = u.pn * BM; r1 = r0 + HALF; }
    __device__ __forceinline__ size_t aoff(const Unit&) const { return 0; }
};
struct OrderC : Order<TS / 256, DM / 256, 4> {
    __device__ __forceinline__ size_t aoff(const Unit& u) const { const int slot = (u.br == 0) ? 1 : (u.br == 1) ? 3 : (u.br == 2) ? 4 : 6; return (size_t)slot * TS * BWID * 2; }
};
struct OrderA : Order<TS / 256, INC / 256, 1> {
    __device__ __forceinline__ void brow(const Unit& u, int& r0, int& r1) const {
        const int pn = u.pn;
        if (pn < 8) { const int pc = pn >> 1; const int piece = (pc == 0) ? 0 : (pc == 1) ? 1 : (pc == 2) ? 4 : 6; r0 = piece * 512 + (pn & 1) * 256; r1 = r0 + HALF; }
        else if (pn < 24) { const int q = (pn - 8) >> 2, sub = (pn - 8) & 3; const int pa = (q == 0) ? 2 : (q == 1) ? 9 : (q == 2) ? 8 : 5, pb = (q == 0) ? 3 : (q == 1) ? 10 : (q == 2) ? 11 : 7;
            r0 = pa * 512 + HALF * sub; r1 = pb * 512 + HALF * sub; }
        else { r0 = pn * BM; r1 = r0 + HALF; }
    }
};

struct EpiProj {
    static constexpr bool PERM = true;
    static __device__ __forceinline__ bool zero_after(const Unit&) { return true; }
    bf16_t* O; bf16_t* G;
    __device__ __forceinline__ void operator()(f32x4 (&acc)[2][2][4][2], const Unit& u, int wr, int wc, int fr_, int fq) const {
        int fr = fr_; asm volatile("" : "+v"(fr));
        if (u.pn < 8) {
            const int pc = u.pn >> 1; const int slot = (pc == 0) ? 0 : (pc == 1) ? 1 : (pc == 2) ? 3 : 5;
            const int row0 = u.pm * BM + wr * 64 + fr, col0 = (u.pn & 1) * BM + wc * 32 + 8 * fq;
            bf16_t* Op = O + (size_t)slot * TS * BWID;
#pragma unroll
            for (int ai = 0; ai < 2; ++ai)
#pragma unroll
                for (int m = 0; m < 4; ++m) { bf16_t* rowp = Op + (size_t)(row0 + ai * HALF + m * 16) * BWID + col0;
#pragma unroll
                    for (int bj = 0; bj < 2; ++bj) { const f32x4 v0 = acc[ai][bj][m][0], v1 = acc[ai][bj][m][1];
                        u32x4 w; w.x = cvt_pk_bf16(v0[0], v0[1]); w.y = cvt_pk_bf16(v0[2], v0[3]); w.z = cvt_pk_bf16(v1[0], v1[1]); w.w = cvt_pk_bf16(v1[2], v1[3]);
                        __builtin_nontemporal_store(w, (u32x4*)(rowp + bj * HALF)); } }
        } else if (u.pn < GATE0 / BM) {
            const int q = (u.pn - 8) >> 2, sub = (u.pn - 8) & 3; const int slot = (q == 0) ? 2 : (q == 1) ? 7 : (q == 2) ? 6 : 4;
            const int row0 = u.pm * BM + wr * 64 + fr, col0 = sub * HALF + wc * 32 + 8 * fq;
            bf16_t* Op = O + (size_t)slot * TS * BWID;
#pragma unroll
            for (int ai = 0; ai < 2; ++ai)
#pragma unroll
                for (int m = 0; m < 4; ++m) {
                    float f[8];
#pragma unroll
                    for (int n = 0; n < 2; ++n)
#pragma unroll
                        for (int j = 0; j < 4; ++j) { const float av = acc[ai][0][m][n][j], bv = acc[ai][1][m][n][j];
                            const float sg = __builtin_amdgcn_rcpf(1.0f + __builtin_amdgcn_exp2f(bv));
                            f[n * 4 + j] = av * ((q == 1) ? bv : (q == 0) ? sg : bv * sg); }
                    __builtin_nontemporal_store(pack8(f), (u32x4*)(Op + (size_t)(row0 + ai * HALF + m * 16) * BWID + col0)); }
        } else {
            unsigned char* gb = (unsigned char*)G + ((size_t)u.pm * 16 + (u.pn - GATE0 / BM)) * 65536 + (((wr * 4 + wc) * 4 + fq) * 16 + fr) * 16;
#pragma unroll
            for (int ai = 0; ai < 2; ++ai)
#pragma unroll
                for (int m = 0; m < 4; ++m) {
                    u32x4 w;
#pragma unroll
                    for (int bj = 0; bj < 2; ++bj)
#pragma unroll
                        for (int n = 0; n < 2; ++n) { unsigned q = 0u;
#pragma unroll
                            for (int j = 0; j < 4; ++j) q = __builtin_amdgcn_cvt_pk_u8_f32(fmaxf(__builtin_amdgcn_rcpf(__builtin_fmaf(__builtin_amdgcn_exp2f(acc[ai][bj][m][n][j]), 1.0f / 255.0f, 1.0f / 255.0f)), 1.0f), j, q);
                            w[bj * 2 + n] = q; }
                    __builtin_nontemporal_store(w, (u32x4*)(gb + (ai * 4 + m) * 8192)); }
        }
    }
};
struct EpiGate {
    static constexpr bool PERM = true;
    static __device__ __forceinline__ bool zero_after(const Unit& u) { return u.br == 3; }
    const bf16_t* G; bf16_t* merged;
    __device__ __forceinline__ void operator()(f32x4 (&acc)[2][2][4][2], const Unit& u, int wr, int wc, int fr_, int fq) const {
        int fr = fr_; asm volatile("" : "+v"(fr));
        const int lrow0 = wr * 64 + fr, lcol0 = wc * 32 + 8 * fq;
        const int br = u.br;
        const bool lastb = (br == 3);
        const unsigned char* gp0 = (const unsigned char*)G + ((size_t)u.pm * 16 + br * 4 + u.pn) * 65536 + (((wr * 4 + wc) * 4 + fq) * 16 + fr) * 16;
        const unsigned char* gnp = lastb ? gp0 : gp0 + 4 * 65536;
        u32x4 gc[2][4], gn[2][4];
#pragma unroll
        for (int ai = 0; ai < 2; ++ai)
#pragma unroll
            for (int m = 0; m < 4; ++m) { gc[ai][m] = *(const u32x4*)(gp0 + (ai * 4 + m) * 8192); gn[ai][m] = *(const u32x4*)(gnp + (ai * 4 + m) * 8192); }
#pragma unroll
        for (int ai = 0; ai < 2; ++ai)
#pragma unroll
            for (int m = 0; m < 4; ++m)
#pragma unroll
                for (int bj = 0; bj < 2; ++bj) {
#pragma unroll
                    for (int n = 0; n < 2; ++n) {
                        const unsigned c = gc[ai][m][bj * 2 + n], d = gn[ai][m][bj * 2 + n];
                        float fc[4], fd[4];
                        fc[0] = (float)(c & 0xffu); fc[1] = (float)((c >> 8) & 0xffu); fc[2] = (float)((c >> 16) & 0xffu); fc[3] = (float)(c >> 24);
                        fd[0] = (float)(d & 0xffu); fd[1] = (float)((d >> 8) & 0xffu); fd[2] = (float)((d >> 16) & 0xffu); fd[3] = (float)(d >> 24);
#pragma unroll
                        for (int j = 0; j < 4; ++j) acc[ai][bj][m][n][j] *= fc[j] * (lastb ? (1.0f / 255.0f) : __builtin_amdgcn_rcpf(fd[j]));
                    }
                    if (lastb) { const f32x4 v0 = acc[ai][bj][m][0], v1 = acc[ai][bj][m][1];
                        u32x4 w; w.x = cvt_pk_bf16(v0[0], v0[1]); w.y = cvt_pk_bf16(v0[2], v0[3]); w.z = cvt_pk_bf16(v1[0], v1[1]); w.w = cvt_pk_bf16(v1[2], v1[3]);
                        *(u32x4*)(merged + ((size_t)u.pm * BM + lrow0 + ai * HALF + m * 16) * DM + u.pn * BM + lcol0 + bj * HALF) = w; }
                }
    }
};
struct EpiRes {
    static constexpr bool PERM = false;
    static __device__ __forceinline__ bool zero_after(const Unit&) { return true; }
    const float* res; float* C; int ldc;
    __device__ __forceinline__ void operator()(const f32x4 (&acc)[2][2][4][2], const Unit& u, int wr, int wc, int fr_, int fq) const {
        int fr = fr_; asm volatile("" : "+v"(fr));
        const int row0 = u.pm * BM + wr * 64 + fr, col0 = u.pn * BM + wc * 32 + 4 * fq;
#pragma unroll
        for (int ai = 0; ai < 2; ++ai)
#pragma unroll
            for (int m = 0; m < 4; ++m) { const size_t off = (size_t)(row0 + ai * HALF + m * 16) * ldc + col0;
                f32x4 rv[2][2];
#pragma unroll
                for (int bj = 0; bj < 2; ++bj)
#pragma unroll
                    for (int n = 0; n < 2; ++n) rv[bj][n] = *(const f32x4*)(res + off + bj * HALF + n * 16);
#pragma unroll
                for (int bj = 0; bj < 2; ++bj)
#pragma unroll
                    for (int n = 0; n < 2; ++n) *(f32x4*)(C + off + bj * HALF + n * 16) = acc[ai][bj][m][n] + rv[bj][n]; }
    }
};

template <int K, size_t B_BR, class Epi, class Sched>
__device__ __forceinline__ void gemm_phase(LAS unsigned char* lds, const Gemm g, const Sched& S, const Epi& E) {
    const int tid = otid(), wid = __builtin_amdgcn_readfirstlane(tid >> 6), lane = tid & 63, wr = wid >> 2, wc = wid & 3, fr = lane & 15, fq = lane >> 4;
    constexpr int nt = K / BK;
    unsigned voffA[2], voffB[2];
#pragma unroll
    for (int i = 0; i < 2; ++i) { int R, C; stage_rc(tid * 16 + i * 8192, R, C); const int Rb = Epi::PERM ? ((R & ~31) + perm32(R & 31)) : R;
        voffA[i] = (unsigned)(R * K + C) * 2u; voffB[i] = (unsigned)(Rb * K + C) * 2u; }
    constexpr size_t kstep = (size_t)(BK * 2);
    constexpr size_t hstep = (size_t)HALF * K * 2;
    constexpr size_t tstep = 2 * hstep;
    const unsigned ldsw = (unsigned)wid * 1024u;
    const int aoff = lds_byte(wr * 64 + fr, fq * 8), boff = lds_byte(wc * 32 + fr, fq * 8);
#define PG8_SA(b, h) (((b) * 2 + (h)) * HTB)
#define PG8_SB(b, h) ((4 + (b) * 2 + (h)) * HTB)
#define PG8_STAGE(bufoff, gbase, voff) do { _Pragma("unroll") for (int _i = 0; _i < 2; ++_i) \
        __builtin_amdgcn_global_load_lds((const unsigned*)((const char*)(gbase) + (voff)[_i]), (LAS unsigned*)(lds + (bufoff) + ldsw + _i * 8192), 16, 0, 0); } while (0)
#define PG8_LDA(dst, b, h) do { _Pragma("unroll") for (int m = 0; m < 4; ++m) _Pragma("unroll") for (int k = 0; k < 2; ++k) dst[m][k] = *(const LAS bf16x8*)(lds + PG8_SA(b, h) + aoff + m * 2048 + k * 1024); } while (0)
#define PG8_LDB(dst, b, h) do { _Pragma("unroll") for (int n = 0; n < 2; ++n) _Pragma("unroll") for (int k = 0; k < 2; ++k) dst[n][k] = *(const LAS bf16x8*)(lds + PG8_SB(b, h) + boff + n * 2048 + k * 1024); } while (0)
#define PG8_MMA(ai, bj, At, Bt) do { __builtin_amdgcn_s_setprio(1); _Pragma("unroll") for (int m = 0; m < 4; ++m) _Pragma("unroll") for (int n = 0; n < 2; ++n) _Pragma("unroll") for (int k = 0; k < 2; ++k) \
        acc[ai][bj][m][n] = __builtin_amdgcn_mfma_f32_16x16x32_bf16(Bt[n][k], At[m][k], acc[ai][bj][m][n], 0, 0, 0); __builtin_amdgcn_s_setprio(0); } while (0)
#define PG8_WAIT_V(n) asm volatile("s_waitcnt vmcnt(" #n ")" ::: "memory")
#define PG8_WAIT_L(n) asm volatile("s_waitcnt lgkmcnt(" #n ")" ::: "memory")
#define PG8_BAR __builtin_amdgcn_s_barrier()
#define PG8_SCHED __builtin_amdgcn_sched_barrier(0)
    Unit cur, nxt; int ui = 0;
    if (!S.next(0, cur)) return;
    f32x4 acc[2][2][4][2];
#pragma unroll
    for (int a = 0; a < 2; ++a)
#pragma unroll
        for (int b = 0; b < 2; ++b)
#pragma unroll
            for (int m = 0; m < 4; ++m)
#pragma unroll
                for (int n = 0; n < 2; ++n) acc[a][b][m][n] = (f32x4){0.f, 0.f, 0.f, 0.f};
    bf16x8 At[4][2], B0[2][2], B1[2][2];
    const char* cA = (const char*)g.A + (size_t)cur.pm * tstep + S.aoff(cur); int rb0, rb1; S.brow(cur, rb0, rb1);
    const char* cB = (const char*)g.Bt + (size_t)rb0 * (K * 2) + (size_t)cur.br * B_BR; const char* cBh = (const char*)g.Bt + (size_t)rb1 * (K * 2) + (size_t)cur.br * B_BR;
    PG8_STAGE(PG8_SB(0, 0), cB, voffB); PG8_STAGE(PG8_SA(0, 0), cA, voffA); PG8_STAGE(PG8_SB(0, 1), cBh, voffB); PG8_STAGE(PG8_SA(0, 1), cA + hstep, voffA);
    if (wr == 1) PG8_BAR;
    PG8_WAIT_V(4); PG8_BAR;
    PG8_STAGE(PG8_SB(1, 0), cB + kstep, voffB); PG8_STAGE(PG8_SA(1, 0), cA + kstep, voffA); PG8_STAGE(PG8_SB(1, 1), cBh + kstep, voffB);
    PG8_WAIT_V(6); PG8_BAR;
    for (;;) {
        const bool has_next = S.next(ui + 1, nxt);
        const char* nA = has_next ? (const char*)g.A + (size_t)nxt.pm * tstep + S.aoff(nxt) : cA; int rn0 = 0, rn1 = 0; if (has_next) S.brow(nxt, rn0, rn1);
        const char* nB = has_next ? (const char*)g.Bt + (size_t)rn0 * (K * 2) + (size_t)nxt.br * B_BR : cB; const char* nBh = has_next ? (const char*)g.Bt + (size_t)rn1 * (K * 2) + (size_t)nxt.br * B_BR : cBh;
        for (int t = 0; t < nt; t += 2) {
            const bool last = (t == nt - 2);
            const char* a1 = cA + (size_t)(t + 1) * kstep;
            const char* a2 = last ? nA : cA + (size_t)(t + 2) * kstep; const char* b2 = last ? nB : cB + (size_t)(t + 2) * kstep; const char* b2h = last ? nBh : cBh + (size_t)(t + 2) * kstep;
            const char* a3 = a2 + kstep; const char* b3 = b2 + kstep; const char* b3h = b2h + kstep;
            PG8_LDB(B0, 0, 0); PG8_SCHED; PG8_LDA(At, 0, 0); PG8_STAGE(PG8_SA(1, 1), a1 + hstep, voffA);
            PG8_WAIT_L(8); PG8_BAR; PG8_WAIT_L(0); PG8_MMA(0, 0, At, B0); PG8_BAR; PG8_SCHED;
            PG8_LDB(B1, 0, 1); PG8_STAGE(PG8_SB(0, 0), b2, voffB);
            PG8_BAR; PG8_WAIT_L(0); PG8_MMA(0, 1, At, B1); PG8_BAR;
            PG8_LDA(At, 0, 1); PG8_STAGE(PG8_SA(0, 0), a2, voffA);
            PG8_BAR; PG8_WAIT_L(0); PG8_MMA(1, 0, At, B0); PG8_BAR; PG8_SCHED;
            PG8_STAGE(PG8_SB(0, 1), b2h, voffB);
            PG8_WAIT_V(6); PG8_BAR; PG8_MMA(1, 1, At, B1); PG8_BAR;
            PG8_LDB(B0, 1, 0); PG8_SCHED; PG8_LDA(At, 1, 0); PG8_STAGE(PG8_SA(0, 1), a2 + hstep, voffA);
            PG8_WAIT_L(8); PG8_BAR; PG8_WAIT_L(0); PG8_MMA(0, 0, At, B0); PG8_BAR; PG8_SCHED;
            PG8_LDB(B1, 1, 1); PG8_STAGE(PG8_SB(1, 0), b3, voffB);
            PG8_BAR; PG8_WAIT_L(0); PG8_MMA(0, 1, At, B1); PG8_BAR;
            PG8_LDA(At, 1, 1); PG8_STAGE(PG8_SA(1, 0), a3, voffA);
            PG8_BAR; PG8_WAIT_L(0); PG8_MMA(1, 0, At, B0); PG8_BAR; PG8_SCHED;
            PG8_STAGE(PG8_SB(1, 1), b3h, voffB);
            PG8_WAIT_V(6); PG8_BAR; PG8_MMA(1, 1, At, B1); PG8_BAR;
        }
        E(acc, cur, wr, wc, fr, fq);
        if (!has_next) break;
        if (Epi::zero_after(cur))
#pragma unroll
        for (int a = 0; a < 2; ++a)
#pragma unroll
            for (int b = 0; b < 2; ++b)
#pragma unroll
                for (int m = 0; m < 4; ++m)
#pragma unroll
                    for (int n = 0; n < 2; ++n) acc[a][b][m][n] = (f32x4){0.f, 0.f, 0.f, 0.f};
        cur = nxt; cA = nA; cB = nB; cBh = nBh; ++ui;
    }
    PG8_WAIT_V(0);
    if (wr == 0) PG8_BAR;
    PG8_BAR;
#undef PG8_SA
#undef PG8_SB
#undef PG8_STAGE
#undef PG8_LDA
#undef PG8_LDB
#undef PG8_MMA
#undef PG8_WAIT_V
#undef PG8_WAIT_L
#undef PG8_BAR
#undef PG8_SCHED
}
}

__device__ void phase_norm_bf16(const float* __restrict__ xin, const float* __restrict__ g, bf16_t* __restrict__ h, int rows);
struct TJob { const float* src; bf16_t* dst; int R, C, tr, tc; float scale; };
__device__ __forceinline__ TJob prep_job(const Params& p, int i) {
    bf16_t* win = (bf16_t*)(p.ws + p.o_win); bf16_t* wb = (bf16_t*)(p.ws + p.o_wb); bf16_t* wo = (bf16_t*)(p.ws + p.o_wo); bf16_t* pw = (bf16_t*)(p.ws + p.o_pw);
    constexpr int T_WIN = 16 * 160, T_WB = 8 * 16, T_WO = 16 * 16, T_PW = 4;
    constexpr int N0 = DEPTH * T_WIN, N1 = N0 + 8 * T_WB, N2 = N1 + DEPTH * T_WO;
    TJob j; j.scale = 1.0f;
    if (i < N0) { const int l = i / T_WIN, t = i % T_WIN; j.src = p.in[2] + (size_t)l * DM * INC; j.dst = win + (size_t)l * DM * INC; j.R = DM; j.C = INC; j.tr = t / 160; j.tc = t % 160;
        const int piece = j.tc >> 3; j.scale = (piece >= 12 || piece == 3 || piece == 7 || piece == 11) ? -1.4426950408889634f : (piece == 5 || piece == 8) ? -0.6931471805599453f : 1.0f; }
    else if (i < N1) { const int k = i - N0, m = k / T_WB, t = k % T_WB; j.src = p.in[14] + (size_t)m * BWID * DM; j.dst = wb + (size_t)m * BWID * DM; j.R = BWID; j.C = DM; j.tr = t / 16; j.tc = t % 16; }
    else if (i < N2) { const int k = i - N1, l = k / T_WO, t = k % T_WO; j.src = p.in[15] + (size_t)l * DM * DM; j.dst = wo + (size_t)l * DM * DM; j.R = DM; j.C = DM; j.tr = t / 16; j.tc = t % 16; }
    else { const int k = i - N2, m = k / T_PW, t = k % T_PW; j.src = p.in[3] + (size_t)m * 128 * 128; j.dst = pw + (size_t)m * 128 * 128; j.R = 128; j.C = 128; j.tr = t / 2; j.tc = t % 2; }
    return j;
}
__device__ void phase_prep(const Params& p, LAS unsigned char* lds) {
    LAS float* sm = (LAS float*)lds;
    const int tid = otid();
    constexpr int NT = DEPTH * 16 * 160 + 8 * 8 * 16 + DEPTH * 16 * 16 + 8 * 4;
    const int lr = tid >> 4, lc = (tid & 15) * 4;
    f32x4 v0, v1;
    int i = blockIdx.x;
    if (i < NT) { const TJob j = prep_job(p, i); const float* sp = j.src + (size_t)(j.tr * 64 + lr) * j.C + j.tc * 64 + lc; v0 = *(const f32x4*)sp; v1 = *(const f32x4*)(sp + (size_t)32 * j.C); }
    for (; i < NT; i += gridDim.x) {
        const TJob j = prep_job(p, i);
#pragma unroll
        for (int e = 0; e < 4; ++e) { sm[lr * 65 + lc + e] = v0[e]; sm[(lr + 32) * 65 + lc + e] = v1[e]; }
        __syncthreads();
        const int in = i + gridDim.x;
        if (in < NT) { const TJob jn = prep_job(p, in); const float* sp = jn.src + (size_t)(jn.tr * 64 + lr) * jn.C + jn.tc * 64 + lc; v0 = *(const f32x4*)sp; v1 = *(const f32x4*)(sp + (size_t)32 * jn.C); }
        { const int c = tid >> 3, r8 = (tid & 7) * 8; float o[8];
#pragma unroll
          for (int e = 0; e < 8; ++e) o[e] = sm[(r8 + e) * 65 + c] * j.scale;
          *(u32x4*)(j.dst + (size_t)(j.tc * 64 + c) * j.R + j.tr * 64 + r8) = pack8(o); }
        __syncthreads();
    }
    const float* sgw = p.in[11]; bf16_t* sw = (bf16_t*)(p.ws + p.o_sw);
    for (int k = blockIdx.x * 512 + tid; k < DEPTH * 4 * 128 * 128; k += gridDim.x * 512) { const int s_ = k & 127, t = (k >> 7) & 127; sw[k] = (s_ <= t) ? f2bf(sgw[k]) : (bf16_t)0; }
    phase_norm_bf16(p.in[0], p.in[1], (bf16_t*)(p.ws + p.o_h), NTOK);
}

__device__ void phase_norm_bf16(const float* __restrict__ xin, const float* __restrict__ g, bf16_t* __restrict__ h, int rows) {
    const int tid = otid(), lane = tid & 63, w = tid >> 6;
    float gv[2][8];
    load8f(g + 8 * lane, gv[0]); load8f(g + 512 + 8 * lane, gv[1]);
    for (int row = blockIdx.x * 8 + w; row < rows; row += gridDim.x * 8) {
        const float* xr = xin + (size_t)row * DM + 8 * lane;
        float v[2][8]; load8f(xr, v[0]); load8f(xr + 512, v[1]);
        float ss = 0.f;
#pragma unroll
        for (int i = 0; i < 2; ++i)
#pragma unroll
            for (int j = 0; j < 8; ++j) ss += v[i][j] * v[i][j];
        ss = wave_sum(ss);
        const float r = rsqrtf(ss * (1.0f / 1024.0f) + 1e-6f);
#pragma unroll
        for (int i = 0; i < 2; ++i) { float o[8];
#pragma unroll
            for (int j = 0; j < 8; ++j) o[j] = v[i][j] * r * gv[i][j];
            *(u32x4*)(h + (size_t)row * DM + 512 * i + 8 * lane) = pack8(o); }
    }
}
__device__ void phase_norm_final(float* __restrict__ x, const float* __restrict__ g, int rows) {
    const int tid = otid(), lane = tid & 63, w = tid >> 6;
    float gv[2][8];
    load8f(g + 8 * lane, gv[0]); load8f(g + 512 + 8 * lane, gv[1]);
    for (int row = blockIdx.x * 8 + w; row < rows; row += gridDim.x * 8) {
        float* xr = x + (size_t)row * DM + 8 * lane;
        float v[2][8]; load8f(xr, v[0]); load8f(xr + 512, v[1]);
        float ss = 0.f;
#pragma unroll
        for (int i = 0; i < 2; ++i)
#pragma unroll
            for (int j = 0; j < 8; ++j) ss += v[i][j] * v[i][j];
        ss = wave_sum(ss);
        const float r = rsqrtf(ss * (1.0f / 1024.0f) + 1e-6f);
#pragma unroll
        for (int i = 0; i < 2; ++i) {
            f32x4 a, b;
#pragma unroll
            for (int j = 0; j < 4; ++j) { a[j] = v[i][j] * r * gv[i][j]; b[j] = v[i][4 + j] * r * gv[i][4 + j]; }
            *(f32x4*)(xr + 512 * i) = a; *(f32x4*)(xr + 512 * i + 4) = b; }
    }
}

#define PO(k) ((size_t)(k) * TS * BWID)
__device__ void mix_sc(const Params& p, int l, const bf16_t* proj, bf16_t* z3, int r0, int pos0) {
    const int tid = otid(), lane = tid & 63, w = tid >> 6, c0 = lane * 8;
    const float* scw = p.in[13] + (size_t)l * 3 * BWID + c0;
    float w0[8], w1[8], w2[8]; load8f(scw, w0); load8f(scw + BWID, w1); load8f(scw + 2 * BWID, w2);
    const int r = r0 + 16 * w, pos = pos0 + 16 * w;
    const bf16_t* bgp = proj + PO(6) + c0; const bf16_t* cxp = proj + PO(7) + c0;
    u32x4 vb[16], vc[18];
    vc[0] = (u32x4){0u, 0u, 0u, 0u}; vc[1] = vc[0];
    if (pos > 0) { vc[0] = *(const u32x4*)(cxp + (size_t)(r - 2) * BWID); vc[1] = *(const u32x4*)(cxp + (size_t)(r - 1) * BWID); }
#pragma unroll
    for (int jj = 0; jj < 16; ++jj) { vb[jj] = *(const u32x4*)(bgp + (size_t)(r + jj) * BWID); vc[2 + jj] = *(const u32x4*)(cxp + (size_t)(r + jj) * BWID); }
    float p2[8], p1[8];
    unpack8(vc[0], p2); unpack8(vc[1], p1);
#pragma unroll
    for (int jj = 0; jj < 16; ++jj) {
        float b[8], cur[8], o[8]; unpack8(vb[jj], b); unpack8(vc[2 + jj], cur);
#pragma unroll
        for (int j = 0; j < 8; ++j) { o[j] = b[j] * (w0[j] * p2[j] + w1[j] * p1[j] + w2[j] * cur[j]); p2[j] = p1[j]; p1[j] = cur[j]; }
        *(u32x4*)(z3 + (size_t)(r + jj) * BWID + c0) = pack8(o);
    }
}

__device__ void mix_conv(const Params& p, int l, const bf16_t* proj, bf16_t* z1, int r0, int pos0, LAS unsigned char* lds) {
    const int tid = otid(), lane = tid & 63, w = tid >> 6, c0 = lane * 8;
    LAS unsigned char* Y = lds; LAS unsigned char* W = lds + 94 * VP;
    const float* cw = p.in[5] + (size_t)l * 31 * BWID;
    for (int i = tid; i < 31 * 64; i += 512) { const int k = i >> 6, cgp = i & 63; float f[8]; load8f(cw + k * BWID + cgp * 8, f); *(LAS u32x4*)(W + k * 1024 + cgp * 16) = pack8(f); }
    float bias[8], lng[8], lnb[8];
    load8f(p.in[6] + (size_t)l * BWID + c0, bias); load8f(p.in[7] + (size_t)l * BWID + c0, lng); load8f(p.in[8] + (size_t)l * BWID + c0, lnb);
    for (int q = 0; q < 2; ++q) {
        const int tr = r0 + 64 * q, tp = pos0 + 64 * q;
        __syncthreads();
        {
            u32x4 la[12];
#pragma unroll
            for (int i = 0; i < 12; ++i) { const int row = 12 * w + i; const bool valid = (row < 94) && (tp - 30 + row >= 0);
                la[i] = (u32x4){0u, 0u, 0u, 0u};
                if (valid) la[i] = *(const u32x4*)(proj + (size_t)(tr - 30 + row) * BWID + PO(2) + c0); }
#pragma unroll
            for (int i = 0; i < 12; ++i) { const int row = 12 * w + i; if (row < 94) *(LAS u32x4*)(Y + row * VP + lane * 16) = la[i]; }
        }
        __syncthreads();
        u32x4 gtv[8];
#pragma unroll
        for (int j = 0; j < 8; ++j) gtv[j] = *(const u32x4*)(proj + (size_t)(tr + 8 * w + j) * BWID + PO(3) + c0);
        float acc[8][8];
#pragma unroll
        for (int j = 0; j < 8; ++j)
#pragma unroll
            for (int c = 0; c < 8; ++c) acc[j][c] = bias[c];
#pragma unroll 1
        for (int k = 0; k < 31; ++k) {
            float wv[8]; unpack8(*(const LAS u32x4*)(W + k * 1024 + lane * 16), wv);
#pragma unroll
            for (int j = 0; j < 8; ++j) { float yv[8]; unpack8(*(const LAS u32x4*)(Y + (8 * w + j + k) * VP + lane * 16), yv);
#pragma unroll
                for (int c = 0; c < 8; ++c) acc[j][c] += wv[c] * yv[c]; }
        }
#pragma unroll
        for (int j = 0; j < 8; ++j) {
            float s = 0.f, ss = 0.f;
#pragma unroll
            for (int c = 0; c < 8; ++c) { s += acc[j][c]; ss += acc[j][c] * acc[j][c]; }
            s = wave_sum(s); ss = wave_sum(ss);
            const float mean = s * (1.0f / 512.0f); const float var = fmaxf(ss * (1.0f / 512.0f) - mean * mean, 0.f); const float rstd = rsqrtf(var + 1e-5f);
            const int row = tr + 8 * w + j;
            float gt[8], o[8]; unpack8(gtv[j], gt);
#pragma unroll
            for (int c = 0; c < 8; ++c) { const float v = (acc[j][c] - mean) * rstd * lng[c] + lnb[c]; o[c] = silu(v) * silu(gt[c]); }
            *(u32x4*)(z1 + (size_t)row * BWID + c0) = pack8(o);
        }
    }
}

__device__ __forceinline__ u32x4 sel4(bool c, const u32x4 a, const u32x4 b) { u32x4 r; r.x = c ? a.x : b.x; r.y = c ? a.y : b.y; r.z = c ? a.z : b.z; r.w = c ? a.w : b.w; return r; }

__device__ void mix_pool(const Params& p, int l, const bf16_t* proj, bf16_t* z0, int r0, int pos0, LAS unsigned char* lds) {
    const int tid = otid(), lane = tid & 63, w = tid >> 6, c0 = lane * 8;
    LAS unsigned char* P = lds;
    {
        const int g4 = lane >> 4, win = 2 << g4;
        const int r = r0 + 16 * w, pos = pos0 + 16 * w;
        u32x4 R[32];
#pragma unroll
        for (int i = 0; i < 16; ++i) { R[i] = (u32x4){0u, 0u, 0u, 0u}; if (pos > 0) R[i] = *(const u32x4*)(proj + (size_t)(r - 16 + i) * BWID + c0); }
#pragma unroll
        for (int i = 0; i < 16; ++i) R[16 + i] = *(const u32x4*)(proj + (size_t)(r + i) * BWID + c0);
        float S[8];
#pragma unroll
        for (int j = 0; j < 8; ++j) S[j] = 0.f;
#pragma unroll
        for (int i = 1; i <= 16; ++i) { float x[8]; unpack8(R[16 - i], x); const float mk = (i <= win) ? 1.0f : 0.0f;
#pragma unroll
            for (int j = 0; j < 8; ++j) S[j] += mk * x[j]; }
#pragma unroll
        for (int jj = 0; jj < 16; ++jj) {
            const int ps = pos + jj; float xv[8], xo[8], o[8];
            unpack8(R[16 + jj], xv);
            const u32x4 ro = sel4(g4 < 2, sel4(g4 == 0, R[16 + jj - 2], R[16 + jj - 4]), sel4(g4 == 2, R[16 + jj - 8], R[jj]));
            unpack8(ro, xo);
            const int cnt = (ps + 1 < win) ? ps + 1 : win; const float inv = 1.0f / (float)cnt;
#pragma unroll
            for (int j = 0; j < 8; ++j) { S[j] += xv[j] - xo[j]; o[j] = S[j] * inv - xv[j]; }
            *(LAS u32x4*)(P + (16 * w + jj) * VP + lane * 16) = pack8(o);
        }
    }
    __syncthreads();
    {
        const int g = w >> 1, fr = lane & 15, fq = lane >> 4;
        const bf16_t* pwT = (const bf16_t*)(p.ws + p.o_pw) + (size_t)(l * 4 + g) * 128 * 128;
        u32x2 gtv[8][4];
#pragma unroll
        for (int tt = 0; tt < 8; ++tt)
#pragma unroll
            for (int dt = 0; dt < 4; ++dt) gtv[tt][dt] = *(const u32x2*)(proj + (size_t)(r0 + 16 * tt + fr) * BWID + PO(1) + 64 * w + 16 * dt + 4 * fq);
        bf16x8 A[4][4];
#pragma unroll
        for (int dt = 0; dt < 4; ++dt)
#pragma unroll
            for (int kk = 0; kk < 4; ++kk) A[dt][kk] = *(const bf16x8*)(pwT + (size_t)(64 * (w & 1) + 16 * dt + fr) * 128 + 32 * kk + 8 * fq);
        const float* psc = p.in[4] + (size_t)l * BWID;
        f32x4 sc[4];
#pragma unroll
        for (int dt = 0; dt < 4; ++dt) sc[dt] = *(const f32x4*)(psc + 64 * w + 16 * dt + 4 * fq);
#pragma unroll
        for (int tt = 0; tt < 8; ++tt) {
            bf16x8 Bf[4];
#pragma unroll
            for (int kk = 0; kk < 4; ++kk) Bf[kk] = *(const LAS bf16x8*)(P + (16 * tt + fr) * VP + (128 * g + 32 * kk + 8 * fq) * 2);
            f32x4 acc[4];
#pragma unroll
            for (int dt = 0; dt < 4; ++dt) { acc[dt] = (f32x4){0.f, 0.f, 0.f, 0.f};
#pragma unroll
                for (int kk = 0; kk < 4; ++kk) acc[dt] = __builtin_amdgcn_mfma_f32_16x16x32_bf16(A[dt][kk], Bf[kk], acc[dt], 0, 0, 0); }
            const int row = r0 + 16 * tt + fr;
#pragma unroll
            for (int dt = 0; dt < 4; ++dt) { const int d = 64 * w + 16 * dt + 4 * fq;
                float gt[4]; unpack4(gtv[tt][dt], gt);
                u32x2 o; o.x = cvt_pk_bf16(acc[dt][0] * sc[dt][0] * silu(gt[0]), acc[dt][1] * sc[dt][1] * silu(gt[1])); o.y = cvt_pk_bf16(acc[dt][2] * sc[dt][2] * silu(gt[2]), acc[dt][3] * sc[dt][3] * silu(gt[3]));
                *(u32x2*)(z0 + (size_t)row * BWID + d) = o; }
        }
    }
}

__device__ void mix_sgu(const Params& p, int l, const bf16_t* proj, bf16_t* z2, int r0, LAS unsigned char* lds) {
    const int tid = otid(), lane = tid & 63, w = tid >> 6, c0 = lane * 8;
    LAS unsigned char* V = lds;
    {
        float lng[8], lnb[8]; load8f(p.in[9] + (size_t)l * BWID + c0, lng); load8f(p.in[10] + (size_t)l * BWID + c0, lnb);
        u32x4 R[16];
#pragma unroll
        for (int jj = 0; jj < 16; ++jj) R[jj] = *(const u32x4*)(proj + (size_t)(r0 + 16 * w + jj) * BWID + PO(5) + c0);
#pragma unroll
        for (int jj = 0; jj < 16; ++jj) {
            float x[8], o[8]; unpack8(R[jj], x);
            float s = 0.f, ss = 0.f;
#pragma unroll
            for (int c = 0; c < 8; ++c) { s += x[c]; ss += x[c] * x[c]; }
            s = wave_sum(s); ss = wave_sum(ss);
            const float mean = s * (1.0f / 512.0f); const float var = fmaxf(ss * (1.0f / 512.0f) - mean * mean, 0.f); const float rstd = rsqrtf(var + 1e-5f);
#pragma unroll
            for (int c = 0; c < 8; ++c) o[c] = (x[c] - mean) * rstd * lng[c] + lnb[c];
            *(LAS u32x4*)(V + (16 * w + jj) * VP + lane * 16) = pack8(o);
        }
    }
    __syncthreads();
    {
        const int g = w >> 1, fr = lane & 15, fq = lane >> 4;
        const unsigned vbase = (unsigned)(size_t)V;
        bf16x8 A[4][4];
#pragma unroll
        for (int ct = 0; ct < 4; ++ct)
#pragma unroll
            for (int kk = 0; kk < 4; ++kk) {
                const unsigned a = vbase + (unsigned)((32 * kk + 8 * fq + (fr >> 2)) * VP + (64 * w + 16 * ct + 4 * (fr & 3)) * 2);
                const u32x2 lo = tr_read(a), hi = tr_read(a + 4 * VP);
                u32x4 t; t.x = lo.x; t.y = lo.y; t.z = hi.x; t.w = hi.y;
                A[ct][kk] = __builtin_bit_cast(bf16x8, t);
            }
        const bf16_t* swm = (const bf16_t*)(p.ws + p.o_sw) + (size_t)(l * 4 + g) * 128 * 128;
        const float* sb = p.in[12] + (size_t)(l * 4 + g) * 128;
#pragma unroll
        for (int hb = 0; hb < 2; ++hb) {
            u32x2 uu[4][4]; bf16x8 Wf[4][4]; float bias[4];
#pragma unroll
            for (int t4 = 0; t4 < 4; ++t4) { const int tt = hb * 4 + t4; const bf16_t* pr = proj + (size_t)(r0 + 16 * tt + fr) * BWID + 64 * w + 4 * fq;
#pragma unroll
                for (int ct = 0; ct < 4; ++ct) uu[t4][ct] = *(const u32x2*)(pr + PO(4) + 16 * ct);
#pragma unroll
                for (int kk = 0; kk < 4; ++kk) if (kk < (tt >> 1) + 1) Wf[t4][kk] = *(const bf16x8*)(swm + (size_t)(16 * tt + fr) * 128 + 32 * kk + 8 * fq);
                bias[t4] = sb[16 * tt + fr]; }
#pragma unroll
            for (int t4 = 0; t4 < 4; ++t4) { const int tt = hb * 4 + t4;
                f32x4 acc[4];
#pragma unroll
                for (int ct = 0; ct < 4; ++ct) acc[ct] = (f32x4){0.f, 0.f, 0.f, 0.f};
#pragma unroll
                for (int kk = 0; kk < 4; ++kk) if (kk < (tt >> 1) + 1) {
#pragma unroll
                    for (int ct = 0; ct < 4; ++ct) acc[ct] = __builtin_amdgcn_mfma_f32_16x16x32_bf16(A[ct][kk], Wf[t4][kk], acc[ct], 0, 0, 0); }
                const int row = r0 + 16 * tt + fr;
#pragma unroll
                for (int ct = 0; ct < 4; ++ct) { const int c = 64 * w + 16 * ct + 4 * fq;
                    float u[4]; unpack4(uu[t4][ct], u);
                    u32x2 o; o.x = cvt_pk_bf16(u[0] * (acc[ct][0] + bias[t4]), u[1] * (acc[ct][1] + bias[t4])); o.y = cvt_pk_bf16(u[2] * (acc[ct][2] + bias[t4]), u[3] * (acc[ct][3] + bias[t4]));
                    *(u32x2*)(z2 + (size_t)row * BWID + c) = o; }
            }
        }
    }
}

__device__ void phase_mix(const Params& p, int l, const bf16_t* proj, bf16_t* z, LAS unsigned char* lds) {
    constexpr int nchunk = TS / 128;
    for (int i = blockIdx.x; i < 4 * nchunk; i += gridDim.x) {
        const int br = i / nchunk, j = i % nchunk, r0 = j * 128, pos0 = (j & 15) * 128;
        if (br == 0) for (int rr = 0; rr < REP_M0; ++rr) { mix_pool(p, l, proj, z + PO(1), r0, pos0, lds); __syncthreads(); }
        else if (br == 1) for (int rr = 0; rr < REP_M1; ++rr) { mix_conv(p, l, proj, z + PO(3), r0, pos0, lds); __syncthreads(); }
        else if (br == 2) for (int rr = 0; rr < REP_M2; ++rr) { mix_sgu(p, l, proj, z + PO(4), r0, lds); __syncthreads(); }
        else for (int rr = 0; rr < REP_M3; ++rr) { mix_sc(p, l, proj, z + PO(6), r0, pos0); __syncthreads(); }
    }
}

#define XB_TMO      128
#define XB_XCNT(j)  (256  + 64 * (j))
#define XB_XSUB(j)  (1280 + 64 * (j))
#define XB_XGEN(j)  (2304 + 64 * (j))
#define XB_TOP      3328
#define XB_TOPGEN   3392
#define XCD_BAR_WORDS 3456
#define XB_SPIN_CAP (1u << 20)
__device__ __forceinline__ unsigned xb_ld(unsigned* p)              { return __hip_atomic_load(p, __ATOMIC_RELAXED, __HIP_MEMORY_SCOPE_AGENT); }
__device__ __forceinline__ unsigned xb_add(unsigned* p, unsigned v) { return __hip_atomic_fetch_add(p, v, __ATOMIC_RELAXED, __HIP_MEMORY_SCOPE_AGENT); }
__device__ __forceinline__ unsigned xb_xcc_id() { return (unsigned)__builtin_amdgcn_s_getreg((3 << 11) | 20) & 0xFu; }
#define XB_SPIN(cond, bar) do { unsigned _sp = 0; while (cond) { __builtin_amdgcn_s_sleep(1); \
    if ((++_sp & 255u) == 0u) { if (xb_ld(&(bar)[XB_TMO])) break; if (_sp > XB_SPIN_CAP) { atomicAdd(&(bar)[XB_TMO], 1u); break; } } } } while (0)
struct XcdBarrier { unsigned* bar; unsigned x; volatile LAS unsigned* st; };
__device__ __forceinline__ XcdBarrier xcd_barrier_post(unsigned* bar, volatile LAS unsigned* st) {
    XcdBarrier b; b.bar = bar; b.x = xb_xcc_id(); b.st = st;
    if (threadIdx.x == 0) (void)xb_add(&bar[XB_XCNT(b.x)], 1u);
    return b;
}
__device__ __forceinline__ void xcd_barrier_complete(unsigned* bar, unsigned x, unsigned& nloc, unsigned& nx) {
    const unsigned G = gridDim.x * gridDim.y * gridDim.z;
    unsigned sum, cnt, mine, sp = 0u;
    for (;;) {
        sum = 0u; cnt = 0u; mine = 0u;
#pragma unroll
        for (unsigned j = 0; j < 16; ++j) { const unsigned c = xb_ld(&bar[XB_XCNT(j)]); sum += c; cnt += (c > 0u) ? 1u : 0u; mine = (j == x) ? c : mine; }
        if (sum == G) break;
        __builtin_amdgcn_s_sleep(1);
        if ((++sp & 255u) == 0u) { if (xb_ld(&bar[XB_TMO])) break; if (sp > XB_SPIN_CAP) { atomicAdd(&bar[XB_TMO], 1u); break; } }
    }
    nloc = mine > 0u ? mine : 1u; nx = cnt > 0u ? cnt : 1u;
}
__device__ __forceinline__ void xcd_barrier(const XcdBarrier& b) {
    asm volatile("s_waitcnt vmcnt(0)" ::: "memory");
    __syncthreads();
    if (threadIdx.x == 0) {
        unsigned* bar = b.bar;
        __builtin_amdgcn_s_waitcnt(0);
        unsigned nloc = b.st[0], nx = b.st[1];
        if (nloc == 0u) { xcd_barrier_complete(bar, b.x, nloc, nx); b.st[0] = nloc; b.st[1] = nx; }
        const unsigned old = xb_add(&bar[XB_XSUB(b.x)], 1u);
        const unsigned gen = old / nloc;
        if (old + 1u == (gen + 1u) * nloc) {
            __builtin_amdgcn_fence(__ATOMIC_RELEASE, "agent");
            asm volatile("s_waitcnt vmcnt(0)" ::: "memory");
            const unsigned og = xb_add(&bar[XB_TOP], 1u);
            const unsigned tg = og / nx;
            if (og + 1u == (tg + 1u) * nx) xb_add(&bar[XB_TOPGEN], 1u);
            else XB_SPIN(xb_ld(&bar[XB_TOPGEN]) == tg, bar);
            __builtin_amdgcn_fence(__ATOMIC_ACQUIRE, "agent");
            xb_add(&bar[XB_XGEN(b.x)], 1u);
            asm volatile("s_waitcnt vmcnt(0)" ::: "memory");
        } else {
            XB_SPIN(xb_ld(&bar[XB_XGEN(b.x)]) == gen, bar);
            __builtin_amdgcn_fence(__ATOMIC_ACQUIRE, "agent");
            asm volatile("s_waitcnt vmcnt(0)" ::: "memory");
        }
    }
    __syncthreads();
}

__global__ void __launch_bounds__(512) mk_forward(Params p) {
    extern __shared__ __attribute__((aligned(16))) unsigned char lds_raw[];
    LAS unsigned char* lds = (LAS unsigned char*)lds_raw;
    cg::grid_group grid = cg::this_grid();
    volatile LAS unsigned* stw = (volatile LAS unsigned*)(lds + LDS_BYTES - 16);
    if (threadIdx.x == 0) { stw[0] = 0u; stw[1] = 0u; }
    __syncthreads();
    const XcdBarrier xbar = xcd_barrier_post((unsigned*)(p.ws + p.o_bar), stw);
    int ph = 0;
#define PHASE_ON (ph >= p.ph_lo && ph < p.ph_hi)
#ifndef XSYNC
#define XSYNC 0
#endif
#define PHASE_END do { if (PHASE_ON && ph + 1 < p.ph_hi) { if (p.ph_hi > 100000) grid.sync();   xcd_barrier(xbar); for (int xs = 0; xs < XSYNC; ++xs) xcd_barrier(xbar); } ++ph; } while (0)
    constexpr int ts = TS;
    bf16_t* win = (bf16_t*)(p.ws + p.o_win); bf16_t* wb = (bf16_t*)(p.ws + p.o_wb); bf16_t* wo = (bf16_t*)(p.ws + p.o_wo);
    bf16_t* h0 = (bf16_t*)(p.ws + p.o_h); bf16_t* proj = (bf16_t*)(p.ws + p.o_proj);

    if (PHASE_ON) phase_prep(p, lds);
    PHASE_END;
#pragma unroll 1
    for (int l = 0; l < DEPTH; ++l) {
        const float* xin = (l == 0) ? p.in[0] : p.out;
#pragma unroll 1
        for (int s = 0; s < NS; ++s) {
            const size_t tok0 = (size_t)s * ts;
            bf16_t* h = h0 + tok0 * DM; bf16_t* merged = h;
            if (l > 0) { if (PHASE_ON) phase_norm_bf16(xin + tok0 * DM, p.in[1] + (size_t)l * DM, h, ts);
                PHASE_END; }
            if (PHASE_ON) for (int rep = 0; rep < REP_A; ++rep) { pg8::Gemm g{h, win + (size_t)l * DM * INC}; pg8::OrderA S; S.G = (int)gridDim.x; S.c = (int)blockIdx.x; pg8::EpiProj E{proj, proj + (size_t)8 * TS * BWID}; pg8::gemm_phase<DM, 0>(lds, g, S, E); }
            PHASE_END;
            if (PHASE_ON) phase_mix(p, l, proj, proj, lds);
            PHASE_END;
            if (PHASE_ON) for (int rep = 0; rep < REP_C; ++rep) { pg8::Gemm g{proj, wb + (size_t)l * 4 * BWID * DM}; pg8::OrderC S; S.G = (int)gridDim.x; S.c = (int)blockIdx.x;
                pg8::EpiGate E{proj + (size_t)8 * TS * BWID, merged}; pg8::gemm_phase<BWID, (size_t)BWID * DM * 2>(lds, g, S, E); }
            PHASE_END;
            if (PHASE_ON) { pg8::Gemm g{merged, wo + (size_t)l * DM * DM}; pg8::Order<TS / 256, DM / 256, 1> S{(int)gridDim.x, (int)blockIdx.x};
                pg8::EpiRes E{xin + tok0 * DM, p.out + tok0 * DM, DM}; pg8::gemm_phase<DM, 0>(lds, g, S, E); }
            PHASE_END;
        }
    }
    if (PHASE_ON) phase_norm_final(p.out, p.in[16], NTOK);
    PHASE_END;
}

extern "C" void kernel_launch(void* const* d_in, const int* in_sizes, int n_in, void* d_out, int out_size, void* d_ws, size_t ws_size, hipStream_t stream) {
    static int grid = 0;
    if (grid == 0) {
        int dev = 0, cus = 0, per_cu = 0;
        hipGetDevice(&dev); hipDeviceGetAttribute(&cus, hipDeviceAttributeMultiprocessorCount, dev);
        if (hipFuncSetAttribute((const void*)mk_forward, hipFuncAttributeMaxDynamicSharedMemorySize, LDS_BYTES) != hipSuccess) { fprintf(stderr, "hipFuncSetAttribute failed\n"); grid = -1; return; }
        if (hipOccupancyMaxActiveBlocksPerMultiprocessor(&per_cu, (const void*)mk_forward, 512, LDS_BYTES) != hipSuccess || per_cu < 1) { fprintf(stderr, "occupancy query: %d\n", per_cu); per_cu = 1; }
        (void)hipGetLastError();
        grid = cus * per_cu;
    }
    if (grid < 0) return;
    Params p{};
    for (int i = 0; i < 17; ++i) p.in[i] = (const float*)d_in[i];
    p.out = (float*)d_out; p.ws = (unsigned char*)d_ws;
    p.ns = NS; p.ts = TS;
    size_t o = 0;
    p.o_win = o; o += (size_t)DEPTH * DM * INC * 2;
    p.o_wb = o; o += (size_t)DEPTH * 4 * BWID * DM * 2;
    p.o_wo = o; o += (size_t)DEPTH * DM * DM * 2;
    p.o_pw = o; o += (size_t)DEPTH * 4 * 128 * 128 * 2;
    p.o_sw = o; o += (size_t)DEPTH * 4 * 128 * 128 * 2;
    p.o_bar = o; o += 16384;
    p.o_h = o; o += (size_t)NTOK * DM * 2;
    p.o_z = 0;
    p.o_proj = o; o += (size_t)p.ts * (8 * BWID * 2 + 4096);
    if (o > ws_size) { fprintf(stderr, "kernel_launch: workspace too small: need %zu, have %zu\n", o, ws_size); return; }
    const int nph = 1 + NS * 4 + (DEPTH - 1) * NS * 5 + 1;
    if (hipMemsetAsync((char*)d_ws + p.o_bar, 0, 16384, stream) != hipSuccess) { fprintf(stderr, "kernel_launch: memset failed\n"); return; }
#if MULTI_LAUNCH
    for (int ph = 0; ph < nph; ++ph) { p.ph_lo = ph; p.ph_hi = ph + 1; hipLaunchKernelGGL(mk_forward, dim3(grid), dim3(512), LDS_BYTES, stream, p); }
#else
    p.ph_lo = 0; p.ph_hi = nph;
    void* args[] = {&p};
    hipError_t e = hipLaunchCooperativeKernel((const void*)mk_forward, dim3(grid), dim3(512), args, LDS_BYTES, stream);
    if (e != hipSuccess) fprintf(stderr, "cooperative launch failed: %s (grid %d)\n", hipGetErrorString(e), grid);
#endif
}
```

```cpp
#include <hip/hip_runtime.h>
#include <hip/hip_cooperative_groups.h>
#include <cstdio>
namespace cg = cooperative_groups;

#ifndef MULTI_LAUNCH
#define MULTI_LAUNCH 0
#endif

#ifndef REP_N
#define REP_N 1
#endif
#ifndef REP_A
#define REP_A 1
#endif
#ifndef REP_B
#define REP_B 1
#endif
#ifndef REP_C
#define REP_C 1
#endif
#define REP_M0 1
#define REP_M1 1
#define REP_M2 1
#define REP_M3 1
#define LAS __attribute__((address_space(3)))
typedef unsigned short bf16_t;
typedef short bf16x8 __attribute__((ext_vector_type(8)));
typedef float f32x4 __attribute__((ext_vector_type(4)));
typedef float f32x2 __attribute__((ext_vector_type(2)));
typedef unsigned u32x4 __attribute__((ext_vector_type(4)));
typedef unsigned u32x2 __attribute__((ext_vector_type(2)));

constexpr int DM = 1024, SEQ = 2048, NTOK = 32 * 2048, DEPTH = 2, BWID = 512, INC = 10240, GATE0 = 6144;
constexpr int PP = 6144;
constexpr int NS = 1, TS = NTOK / NS;
constexpr int LDS_BYTES = 139264;
constexpr int VP = 1040;

struct Params {
    const float* in[17];
    float* out;
    unsigned char* ws;
    int ts, ns, ph_lo, ph_hi;
    unsigned long long o_win, o_wb, o_wo, o_pw, o_sw, o_h, o_z, o_bar, o_proj;
};

__device__ __forceinline__ int otid() { int t = threadIdx.x; asm volatile("" : "+v"(t)); return t; }
__device__ __forceinline__ unsigned cvt_pk_bf16(float lo, float hi) { unsigned r; asm volatile("v_cvt_pk_bf16_f32 %0, %1, %2" : "=v"(r) : "v"(lo), "v"(hi)); return r; }
__device__ __forceinline__ bf16_t f2bf(float f) { unsigned u = __float_as_uint(f); u += 0x7FFFu + ((u >> 16) & 1u); return (bf16_t)(u >> 16); }
__device__ __forceinline__ void unpack8(const u32x4 v, float (&f)[8]) {
    f[0] = __uint_as_float(v.x << 16); f[1] = __uint_as_float(v.x & 0xffff0000u); f[2] = __uint_as_float(v.y << 16); f[3] = __uint_as_float(v.y & 0xffff0000u);
    f[4] = __uint_as_float(v.z << 16); f[5] = __uint_as_float(v.z & 0xffff0000u); f[6] = __uint_as_float(v.w << 16); f[7] = __uint_as_float(v.w & 0xffff0000u);
}
__device__ __forceinline__ u32x4 pack8(const float (&f)[8]) { u32x4 r; r.x = cvt_pk_bf16(f[0], f[1]); r.y = cvt_pk_bf16(f[2], f[3]); r.z = cvt_pk_bf16(f[4], f[5]); r.w = cvt_pk_bf16(f[6], f[7]); return r; }
__device__ __forceinline__ void unpack4(const u32x2 v, float (&f)[4]) { f[0] = __uint_as_float(v.x << 16); f[1] = __uint_as_float(v.x & 0xffff0000u); f[2] = __uint_as_float(v.y << 16); f[3] = __uint_as_float(v.y & 0xffff0000u); }
__device__ __forceinline__ float sigm(float x) { return __builtin_amdgcn_rcpf(1.0f + __expf(-x)); }
__device__ __forceinline__ float silu(float x) { return x * sigm(x); }
__device__ __forceinline__ void load8f(const float* p, float (&f)[8]) { const f32x4 a = *(const f32x4*)p, b = *(const f32x4*)(p + 4); f[0] = a[0]; f[1] = a[1]; f[2] = a[2]; f[3] = a[3]; f[4] = b[0]; f[5] = b[1]; f[6] = b[2]; f[7] = b[3]; }
__device__ __forceinline__ float wave_sum(float v) {
#pragma unroll
    for (int o = 32; o >= 1; o >>= 1) v += __shfl_xor(v, o);
    return v;
}
__device__ __forceinline__ u32x2 tr_read(unsigned lds_addr) { u32x2 r; asm volatile("ds_read_b64_tr_b16 %0, %1\n\ts_waitcnt lgkmcnt(0)" : "=&v"(r) : "v"(lds_addr) : "memory"); return r; }

namespace pg8 {
constexpr int BM = 256, BK = 64, HALF = 128, HTB = HALF * BK * 2, STAGE_BYTES = 8 * HTB, NXCD = 8, WGM = 8;
__device__ __forceinline__ int lds_byte(int r, int c) { const int st = (r >> 4) * 2 + (c >> 5), rr = r & 15, cc = c & 31, ob = rr * 64 + cc * 2; return st * 1024 + (ob ^ (((ob >> 9) & 1) << 5)); }
__device__ __forceinline__ void stage_rc(int b, int& R, int& C) { const int st = b / 1024, sb = b % 1024, swz = sb ^ (((sb >> 9) & 1) << 5); R = (st >> 1) * 16 + swz / 64; C = (st & 1) * 32 + (swz % 64) / 2; }
__device__ __forceinline__ int perm32(int rho) { const int n = rho >> 4, i = rho & 15; return 8 * (i >> 2) + 4 * n + (i & 3); }

struct Unit { int pm, pn, br; };
struct Gemm { const bf16_t* A; const bf16_t* Bt; };

template <int NM, int NN, int NBR>
struct Order {
    int G, c;
    __device__ __forceinline__ bool next(int i, Unit& u) const {
        constexpr int nwg = NM * NN;
        const int ti = i / NBR;
        const long L = (long)ti * G + c; if (L >= nwg) return false;
        int wgid = (int)L; { constexpr int q = nwg / NXCD, r = nwg % NXCD; const int xcd = wgid % NXCD, off = wgid / NXCD; wgid = (xcd < r ? xcd * (q + 1) : r * (q + 1) + (xcd - r) * q) + off; }
        constexpr int nig = WGM * NN; const int gid = wgid / nig, fm = gid * WGM, gsz = (NM - fm) < WGM ? (NM - fm) : WGM;
        u.pm = fm + ((wgid % nig) % gsz); u.pn = (wgid % nig) / gsz; u.br = i % NBR; return true;
    }
    __device__ __forceinline__ void brow(const Unit& u, int& r0, int& r1) const { r0 = u.pn * BM; r1 = r0 + HALF; }
    __device__ __forceinline__ size_t aoff(const Unit&) const { return 0; }
};
struct OrderC : Order<TS / 256, DM / 256, 4> {
    __device__ __forceinline__ size_t aoff(const Unit& u) const { const int slot = (u.br == 0) ? 1 : (u.br == 1) ? 3 : (u.br == 2) ? 4 : 6; return (size_t)slot * TS * BWID * 2; }
};
struct OrderA : Order<TS / 256, INC / 256, 1> {
    __device__ __forceinline__ void brow(const Unit& u, int& r0, int& r1) const {
        const int pn = u.pn;
        if (pn < 8) { const int pc = pn >> 1; const int piece = (pc == 0) ? 0 : (pc == 1) ? 1 : (pc == 2) ? 4 : 6; r0 = piece * 512 + (pn & 1) * 256; r1 = r0 + HALF; }
        else if (pn < 24) { const int q = (pn - 8) >> 2, sub = (pn - 8) & 3; const int pa = (q == 0) ? 2 : (q == 1) ? 9 : (q == 2) ? 8 : 5, pb = (q == 0) ? 3 : (q == 1) ? 10 : (q == 2) ? 11 : 7;
            r0 = pa * 512 + HALF * sub; r1 = pb * 512 + HALF * sub; }
        else { r0 = pn * BM; r1 = r0 + HALF; }
    }
};

struct EpiProj {
    static constexpr bool PERM = true;
    static __device__ __forceinline__ bool zero_after(const Unit&) { return true; }
    bf16_t* O; bf16_t* G;
    __device__ __forceinline__ void operator()(f32x4 (&acc)[2][2][4][2], const Unit& u, int wr, int wc, int fr_, int fq) const {
        int fr = fr_; asm volatile("" : "+v"(fr));
        if (u.pn < 8) {
            const int pc = u.pn >> 1; const int slot = (pc == 0) ? 0 : (pc == 1) ? 1 : (pc == 2) ? 3 : 5;
            const int row0 = u.pm * BM + wr * 64 + fr, col0 = (u.pn & 1) * BM + wc * 32 + 8 * fq;
            bf16_t* Op = O + (size_t)slot * TS * BWID;
#pragma unroll
            for (int ai = 0; ai < 2; ++ai)
#pragma unroll
                for (int m = 0; m < 4; ++m) { bf16_t* rowp = Op + (size_t)(row0 + ai * HALF + m * 16) * BWID + col0;
#pragma unroll
                    for (int bj = 0; bj < 2; ++bj) { const f32x4 v0 = acc[ai][bj][m][0], v1 = acc[ai][bj][m][1];
                        u32x4 w; w.x = cvt_pk_bf16(v0[0], v0[1]); w.y = cvt_pk_bf16(v0[2], v0[3]); w.z = cvt_pk_bf16(v1[0], v1[1]); w.w = cvt_pk_bf16(v1[2], v1[3]);
                        __builtin_nontemporal_store(w, (u32x4*)(rowp + bj * HALF)); } }
        } else if (u.pn < GATE0 / BM) {
            const int q = (u.pn - 8) >> 2, sub = (u.pn - 8) & 3; const int slot = (q == 0) ? 2 : (q == 1) ? 7 : (q == 2) ? 6 : 4;
            const int row0 = u.pm * BM + wr * 64 + fr, col0 = sub * HALF + wc * 32 + 8 * fq;
            bf16_t* Op = O + (size_t)slot * TS * BWID;
#pragma unroll
            for (int ai = 0; ai < 2; ++ai)
#pragma unroll
                for (int m = 0; m < 4; ++m) {
                    float f[8];
#pragma unroll
                    for (int n = 0; n < 2; ++n)
#pragma unroll
                        for (int j = 0; j < 4; ++j) { const float av = acc[ai][0][m][n][j], bv = acc[ai][1][m][n][j];
                            const float sg = __builtin_amdgcn_rcpf(1.0f + __builtin_amdgcn_exp2f(bv));
                            f[n * 4 + j] = av * ((q == 1) ? bv : (q == 0) ? sg : bv * sg); }
                    __builtin_nontemporal_store(pack8(f), (u32x4*)(Op + (size_t)(row0 + ai * HALF + m * 16) * BWID + col0)); }
        } else {
            unsigned char* gb = (unsigned char*)G + ((size_t)u.pm * 16 + (u.pn - GATE0 / BM)) * 65536 + (((wr * 4 + wc) * 4 + fq) * 16 + fr) * 16;
#pragma unroll
            for (int ai = 0; ai < 2; ++ai)
#pragma unroll
                for (int m = 0; m < 4; ++m) {
                    u32x4 w;
#pragma unroll
                    for (int bj = 0; bj < 2; ++bj)
#pragma unroll
                        for (int n = 0; n < 2; ++n) { unsigned q = 0u;
#pragma unroll
                            for (int j = 0; j < 4; ++j) q = __builtin_amdgcn_cvt_pk_u8_f32(fmaxf(__builtin_amdgcn_rcpf(__builtin_fmaf(__builtin_amdgcn_exp2f(acc[ai][bj][m][n][j]), 1.0f / 255.0f, 1.0f / 255.0f)), 1.0f), j, q);
                            w[bj * 2 + n] = q; }
                    __builtin_nontemporal_store(w, (u32x4*)(gb + (ai * 4 + m) * 8192)); }
        }
    }
};
struct EpiGate {
    static constexpr bool PERM = true;
    static __device__ __forceinline__ bool zero_after(const Unit& u) { return u.br == 3; }
    const bf16_t* G; bf16_t* merged;
    __device__ __forceinline__ void operator()(f32x4 (&acc)[2][2][4][2], const Unit& u, int wr, int wc, int fr_, int fq) const {
        int fr = fr_; asm volatile("" : "+v"(fr));
        const int lrow0 = wr * 64 + fr, lcol0 = wc * 32 + 8 * fq;
        const int br = u.br;
        const bool lastb = (br == 3);
        const unsigned char* gp0 = (const unsigned char*)G + ((size_t)u.pm * 16 + br * 4 + u.pn) * 65536 + (((wr * 4 + wc) * 4 + fq) * 16 + fr) * 16;
        const unsigned char* gnp = lastb ? gp0 : gp0 + 4 * 65536;
        u32x4 gc[2][4], gn[2][4];
#pragma unroll
        for (int ai = 0; ai < 2; ++ai)
#pragma unroll
            for (int m = 0; m < 4; ++m) { gc[ai][m] = *(const u32x4*)(gp0 + (ai * 4 + m) * 8192); gn[ai][m] = (u32x4){0u, 0u, 0u, 0u}; if (!lastb) gn[ai][m] = *(const u32x4*)(gnp + (ai * 4 + m) * 8192); }
#pragma unroll
        for (int ai = 0; ai < 2; ++ai)
#pragma unroll
            for (int m = 0; m < 4; ++m)
#pragma unroll
                for (int bj = 0; bj < 2; ++bj) {
#pragma unroll
                    for (int n = 0; n < 2; ++n) {
                        const unsigned c = gc[ai][m][bj * 2 + n], d = gn[ai][m][bj * 2 + n];
                        float fc[4], fd[4];
                        fc[0] = (float)(c & 0xffu); fc[1] = (float)((c >> 8) & 0xffu); fc[2] = (float)((c >> 16) & 0xffu); fc[3] = (float)(c >> 24);
                        fd[0] = (float)(d & 0xffu); fd[1] = (float)((d >> 8) & 0xffu); fd[2] = (float)((d >> 16) & 0xffu); fd[3] = (float)(d >> 24);
#pragma unroll
                        for (int j = 0; j < 4; ++j) acc[ai][bj][m][n][j] *= fc[j] * (lastb ? (1.0f / 255.0f) : __builtin_amdgcn_rcpf(fd[j]));
                    }
                    if (lastb) { const f32x4 v0 = acc[ai][bj][m][0], v1 = acc[ai][bj][m][1];
                        u32x4 w; w.x = cvt_pk_bf16(v0[0], v0[1]); w.y = cvt_pk_bf16(v0[2], v0[3]); w.z = cvt_pk_bf16(v1[0], v1[1]); w.w = cvt_pk_bf16(v1[2], v1[3]);
                        *(u32x4*)(merged + ((size_t)u.pm * BM + lrow0 + ai * HALF + m * 16) * DM + u.pn * BM + lcol0 + bj * HALF) = w; }
                }
    }
};
struct EpiRes {
    static constexpr bool PERM = false;
    static __device__ __forceinline__ bool zero_after(const Unit&) { return true; }
    const float* res; float* C; int ldc;
    __device__ __forceinline__ void operator()(const f32x4 (&acc)[2][2][4][2], const Unit& u, int wr, int wc, int fr_, int fq) const {
        int fr = fr_; asm volatile("" : "+v"(fr));
        const int row0 = u.pm * BM + wr * 64 + fr, col0 = u.pn * BM + wc * 32 + 4 * fq;
#pragma unroll
        for (int ai = 0; ai < 2; ++ai)
#pragma unroll
            for (int m = 0; m < 4; ++m) { const size_t off = (size_t)(row0 + ai * HALF + m * 16) * ldc + col0;
                f32x4 rv[2][2];
#pragma unroll
                for (int bj = 0; bj < 2; ++bj)
#pragma unroll
                    for (int n = 0; n < 2; ++n) rv[bj][n] = *(const f32x4*)(res + off + bj * HALF + n * 16);
#pragma unroll
                for (int bj = 0; bj < 2; ++bj)
#pragma unroll
                    for (int n = 0; n < 2; ++n) *(f32x4*)(C + off + bj * HALF + n * 16) = acc[ai][bj][m][n] + rv[bj][n]; }
    }
};

template <int K, size_t B_BR, class Epi, class Sched>
__device__ __forceinline__ void gemm_phase(LAS unsigned char* lds, const Gemm g, const Sched& S, const Epi& E) {
    const int tid = otid(), wid = __builtin_amdgcn_readfirstlane(tid >> 6), lane = tid & 63, wr = wid >> 2, wc = wid & 3, fr = lane & 15, fq = lane >> 4;
    constexpr int nt = K / BK;
    unsigned voffA[2], voffB[2];
#pragma unroll
    for (int i = 0; i < 2; ++i) { int R, C; stage_rc(tid * 16 + i * 8192, R, C); const int Rb = Epi::PERM ? ((R & ~31) + perm32(R & 31)) : R;
        voffA[i] = (unsigned)(R * K + C) * 2u; voffB[i] = (unsigned)(Rb * K + C) * 2u; }
    constexpr size_t kstep = (size_t)(BK * 2);
    constexpr size_t hstep = (size_t)HALF * K * 2;
    constexpr size_t tstep = 2 * hstep;
    const unsigned ldsw = (unsigned)wid * 1024u;
    const int aoff = lds_byte(wr * 64 + fr, fq * 8), boff = lds_byte(wc * 32 + fr, fq * 8);
#define PG8_SA(b, h) (((b) * 2 + (h)) * HTB)
#define PG8_SB(b, h) ((4 + (b) * 2 + (h)) * HTB)
#define PG8_STAGE(bufoff, gbase, voff) do { _Pragma("unroll") for (int _i = 0; _i < 2; ++_i) \
        __builtin_amdgcn_global_load_lds((const unsigned*)((const char*)(gbase) + (voff)[_i]), (LAS unsigned*)(lds + (bufoff) + ldsw + _i * 8192), 16, 0, 0); } while (0)
#define PG8_LDA(dst, b, h) do { _Pragma("unroll") for (int m = 0; m < 4; ++m) _Pragma("unroll") for (int k = 0; k < 2; ++k) dst[m][k] = *(const LAS bf16x8*)(lds + PG8_SA(b, h) + aoff + m * 2048 + k * 1024); } while (0)
#define PG8_LDB(dst, b, h) do { _Pragma("unroll") for (int n = 0; n < 2; ++n) _Pragma("unroll") for (int k = 0; k < 2; ++k) dst[n][k] = *(const LAS bf16x8*)(lds + PG8_SB(b, h) + boff + n * 2048 + k * 1024); } while (0)
#define PG8_MMA(ai, bj, At, Bt) do { __builtin_amdgcn_s_setprio(1); _Pragma("unroll") for (int m = 0; m < 4; ++m) _Pragma("unroll") for (int n = 0; n < 2; ++n) _Pragma("unroll") for (int k = 0; k < 2; ++k) \
        acc[ai][bj][m][n] = __builtin_amdgcn_mfma_f32_16x16x32_bf16(Bt[n][k], At[m][k], acc[ai][bj][m][n], 0, 0, 0); __builtin_amdgcn_s_setprio(0); } while (0)
#define PG8_WAIT_V(n) asm volatile("s_waitcnt vmcnt(" #n ")" ::: "memory")
#define PG8_WAIT_L(n) asm volatile("s_waitcnt lgkmcnt(" #n ")" ::: "memory")
#define PG8_BAR __builtin_amdgcn_s_barrier()
#define PG8_SCHED __builtin_amdgcn_sched_barrier(0)
    Unit cur, nxt; int ui = 0;
    if (!S.next(0, cur)) return;
    f32x4 acc[2][2][4][2];
#pragma unroll
    for (int a = 0; a < 2; ++a)
#pragma unroll
        for (int b = 0; b < 2; ++b)
#pragma unroll
            for (int m = 0; m < 4; ++m)
#pragma unroll
                for (int n = 0; n < 2; ++n) acc[a][b][m][n] = (f32x4){0.f, 0.f, 0.f, 0.f};
    bf16x8 At[4][2], B0[2][2], B1[2][2];
    const char* cA = (const char*)g.A + (size_t)cur.pm * tstep + S.aoff(cur); int rb0, rb1; S.brow(cur, rb0, rb1);
    const char* cB = (const char*)g.Bt + (size_t)rb0 * (K * 2) + (size_t)cur.br * B_BR; const char* cBh = (const char*)g.Bt + (size_t)rb1 * (K * 2) + (size_t)cur.br * B_BR;
    PG8_STAGE(PG8_SB(0, 0), cB, voffB); PG8_STAGE(PG8_SA(0, 0), cA, voffA); PG8_STAGE(PG8_SB(0, 1), cBh, voffB); PG8_STAGE(PG8_SA(0, 1), cA + hstep, voffA);
    if (wr == 1) PG8_BAR;
    PG8_WAIT_V(4); PG8_BAR;
    PG8_STAGE(PG8_SB(1, 0), cB + kstep, voffB); PG8_STAGE(PG8_SA(1, 0), cA + kstep, voffA); PG8_STAGE(PG8_SB(1, 1), cBh + kstep, voffB);
    PG8_WAIT_V(6); PG8_BAR;
    for (;;) {
        const bool has_next = S.next(ui + 1, nxt);
        const char* nA = has_next ? (const char*)g.A + (size_t)nxt.pm * tstep + S.aoff(nxt) : cA; int rn0 = 0, rn1 = 0; if (has_next) S.brow(nxt, rn0, rn1);
        const char* nB = has_next ? (const char*)g.Bt + (size_t)rn0 * (K * 2) + (size_t)nxt.br * B_BR : cB; const char* nBh = has_next ? (const char*)g.Bt + (size_t)rn1 * (K * 2) + (size_t)nxt.br * B_BR : cBh;
        for (int t = 0; t < nt; t += 2) {
            const bool last = (t == nt - 2);
            const char* a1 = cA + (size_t)(t + 1) * kstep;
            const char* a2 = last ? nA : cA + (size_t)(t + 2) * kstep; const char* b2 = last ? nB : cB + (size_t)(t + 2) * kstep; const char* b2h = last ? nBh : cBh + (size_t)(t + 2) * kstep;
            const char* a3 = a2 + kstep; const char* b3 = b2 + kstep; const char* b3h = b2h + kstep;
            PG8_LDB(B0, 0, 0); PG8_SCHED; PG8_LDA(At, 0, 0); PG8_STAGE(PG8_SA(1, 1), a1 + hstep, voffA);
            PG8_WAIT_L(8); PG8_BAR; PG8_WAIT_L(0); PG8_MMA(0, 0, At, B0); PG8_BAR; PG8_SCHED;
            PG8_LDB(B1, 0, 1); PG8_STAGE(PG8_SB(0, 0), b2, voffB);
            PG8_BAR; PG8_WAIT_L(0); PG8_MMA(0, 1, At, B1); PG8_BAR;
            PG8_LDA(At, 0, 1); PG8_STAGE(PG8_SA(0, 0), a2, voffA);
            PG8_BAR; PG8_WAIT_L(0); PG8_MMA(1, 0, At, B0); PG8_BAR; PG8_SCHED;
            PG8_STAGE(PG8_SB(0, 1), b2h, voffB);
            PG8_WAIT_V(6); PG8_BAR; PG8_MMA(1, 1, At, B1); PG8_BAR;
            PG8_LDB(B0, 1, 0); PG8_SCHED; PG8_LDA(At, 1, 0); PG8_STAGE(PG8_SA(0, 1), a2 + hstep, voffA);
            PG8_WAIT_L(8); PG8_BAR; PG8_WAIT_L(0); PG8_MMA(0, 0, At, B0); PG8_BAR; PG8_SCHED;
            PG8_LDB(B1, 1, 1); PG8_STAGE(PG8_SB(1, 0), b3, voffB);
            PG8_BAR; PG8_WAIT_L(0); PG8_MMA(0, 1, At, B1); PG8_BAR;
            PG8_LDA(At, 1, 1); PG8_STAGE(PG8_SA(1, 0), a3, voffA);
            PG8_BAR; PG8_WAIT_L(0); PG8_MMA(1, 0, At, B0); PG8_BAR; PG8_SCHED;
            PG8_STAGE(PG8_SB(1, 1), b3h, voffB);
            PG8_WAIT_V(6); PG8_BAR; PG8_MMA(1, 1, At, B1); PG8_BAR;
        }
        E(acc, cur, wr, wc, fr, fq);
        if (!has_next) break;
        if (Epi::zero_after(cur))
#pragma unroll
        for (int a = 0; a < 2; ++a)
#pragma unroll
            for (int b = 0; b < 2; ++b)
#pragma unroll
                for (int m = 0; m < 4; ++m)
#pragma unroll
                    for (int n = 0; n < 2; ++n) acc[a][b][m][n] = (f32x4){0.f, 0.f, 0.f, 0.f};
        cur = nxt; cA = nA; cB = nB; cBh = nBh; ++ui;
    }
    PG8_WAIT_V(0);
    if (wr == 0) PG8_BAR;
    PG8_BAR;
#undef PG8_SA
#undef PG8_SB
#undef PG8_STAGE
#undef PG8_LDA
#undef PG8_LDB
#undef PG8_MMA
#undef PG8_WAIT_V
#undef PG8_WAIT_L
#undef PG8_BAR
#undef PG8_SCHED
}
}

__device__ void phase_norm_bf16(const float* __restrict__ xin, const float* __restrict__ g, bf16_t* __restrict__ h, int rows);
struct TJob { const float* src; bf16_t* dst; int R, C, tr, tc; float scale; };
__device__ __forceinline__ TJob prep_job(const Params& p, int i) {
    bf16_t* win = (bf16_t*)(p.ws + p.o_win); bf16_t* wb = (bf16_t*)(p.ws + p.o_wb); bf16_t* wo = (bf16_t*)(p.ws + p.o_wo); bf16_t* pw = (bf16_t*)(p.ws + p.o_pw);
    constexpr int T_WIN = 16 * 160, T_WB = 8 * 16, T_WO = 16 * 16, T_PW = 4;
    constexpr int N0 = DEPTH * T_WIN, N1 = N0 + 8 * T_WB, N2 = N1 + DEPTH * T_WO;
    TJob j; j.scale = 1.0f;
    if (i < N0) { const int l = i / T_WIN, t = i % T_WIN; j.src = p.in[2] + (size_t)l * DM * INC; j.dst = win + (size_t)l * DM * INC; j.R = DM; j.C = INC; j.tr = t / 160; j.tc = t % 160;
        const int piece = j.tc >> 3; j.scale = (piece >= 12 || piece == 3 || piece == 7 || piece == 11) ? -1.4426950408889634f : (piece == 5 || piece == 8) ? -0.6931471805599453f : 1.0f; }
    else if (i < N1) { const int k = i - N0, m = k / T_WB, t = k % T_WB; j.src = p.in[14] + (size_t)m * BWID * DM; j.dst = wb + (size_t)m * BWID * DM; j.R = BWID; j.C = DM; j.tr = t / 16; j.tc = t % 16; }
    else if (i < N2) { const int k = i - N1, l = k / T_WO, t = k % T_WO; j.src = p.in[15] + (size_t)l * DM * DM; j.dst = wo + (size_t)l * DM * DM; j.R = DM; j.C = DM; j.tr = t / 16; j.tc = t % 16; }
    else { const int k = i - N2, m = k / T_PW, t = k % T_PW; j.src = p.in[3] + (size_t)m * 128 * 128; j.dst = pw + (size_t)m * 128 * 128; j.R = 128; j.C = 128; j.tr = t / 2; j.tc = t % 2; }
    return j;
}
__device__ void phase_prep(const Params& p, LAS unsigned char* lds) {
    LAS float* sm = (LAS float*)lds;
    const int tid = otid();
    constexpr int NT = DEPTH * 16 * 160 + 8 * 8 * 16 + DEPTH * 16 * 16 + 8 * 4;
    const int lr = tid >> 4, lc = (tid & 15) * 4;
    f32x4 v0, v1;
    int i = blockIdx.x;
    if (i < NT) { const TJob j = prep_job(p, i); const float* sp = j.src + (size_t)(j.tr * 64 + lr) * j.C + j.tc * 64 + lc; v0 = *(const f32x4*)sp; v1 = *(const f32x4*)(sp + (size_t)32 * j.C); }
    for (; i < NT; i += gridDim.x) {
        const TJob j = prep_job(p, i);
#pragma unroll
        for (int e = 0; e < 4; ++e) { sm[lr * 65 + lc + e] = v0[e]; sm[(lr + 32) * 65 + lc + e] = v1[e]; }
        __syncthreads();
        const int in = i + gridDim.x;
        if (in < NT) { const TJob jn = prep_job(p, in); const float* sp = jn.src + (size_t)(jn.tr * 64 + lr) * jn.C + jn.tc * 64 + lc; v0 = *(const f32x4*)sp; v1 = *(const f32x4*)(sp + (size_t)32 * jn.C); }
        { const int c = tid >> 3, r8 = (tid & 7) * 8; float o[8];
#pragma unroll
          for (int e = 0; e < 8; ++e) o[e] = sm[(r8 + e) * 65 + c] * j.scale;
          *(u32x4*)(j.dst + (size_t)(j.tc * 64 + c) * j.R + j.tr * 64 + r8) = pack8(o); }
        __syncthreads();
    }
    const float* sgw = p.in[11]; bf16_t* sw = (bf16_t*)(p.ws + p.o_sw);
    for (int k = blockIdx.x * 512 + tid; k < DEPTH * 4 * 128 * 128; k += gridDim.x * 512) { const int s_ = k & 127, t = (k >> 7) & 127; sw[k] = (s_ <= t) ? f2bf(sgw[k]) : (bf16_t)0; }
    phase_norm_bf16(p.in[0], p.in[1], (bf16_t*)(p.ws + p.o_h), NTOK);
}

__device__ void phase_norm_bf16(const float* __restrict__ xin, const float* __restrict__ g, bf16_t* __restrict__ h, int rows) {
    const int tid = otid(), lane = tid & 63, w = tid >> 6;
    float gv[2][8];
    load8f(g + 8 * lane, gv[0]); load8f(g + 512 + 8 * lane, gv[1]);
    for (int row = blockIdx.x * 8 + w; row < rows; row += gridDim.x * 8) {
        const float* xr = xin + (size_t)row * DM + 8 * lane;
        float v[2][8]; load8f(xr, v[0]); load8f(xr + 512, v[1]);
        float ss = 0.f;
#pragma unroll
        for (int i = 0; i < 2; ++i)
#pragma unroll
            for (int j = 0; j < 8; ++j) ss += v[i][j] * v[i][j];
        ss = wave_sum(ss);
        const float r = rsqrtf(ss * (1.0f / 1024.0f) + 1e-6f);
#pragma unroll
        for (int i = 0; i < 2; ++i) { float o[8];
#pragma unroll
            for (int j = 0; j < 8; ++j) o[j] = v[i][j] * r * gv[i][j];
            *(u32x4*)(h + (size_t)row * DM + 512 * i + 8 * lane) = pack8(o); }
    }
}
__device__ void phase_norm_final(float* __restrict__ x, const float* __restrict__ g, int rows) {
    const int tid = otid(), lane = tid & 63, w = tid >> 6;
    float gv[2][8];
    load8f(g + 8 * lane, gv[0]); load8f(g + 512 + 8 * lane, gv[1]);
    for (int row = blockIdx.x * 8 + w; row < rows; row += gridDim.x * 8) {
        float* xr = x + (size_t)row * DM + 8 * lane;
        float v[2][8]; load8f(xr, v[0]); load8f(xr + 512, v[1]);
        float ss = 0.f;
#pragma unroll
        for (int i = 0; i < 2; ++i)
#pragma unroll
            for (int j = 0; j < 8; ++j) ss += v[i][j] * v[i][j];
        ss = wave_sum(ss);
        const float r = rsqrtf(ss * (1.0f / 1024.0f) + 1e-6f);
#pragma unroll
        for (int i = 0; i < 2; ++i) {
            f32x4 a, b;
#pragma unroll
            for (int j = 0; j < 4; ++j) { a[j] = v[i][j] * r * gv[i][j]; b[j] = v[i][4 + j] * r * gv[i][4 + j]; }
            *(f32x4*)(xr + 512 * i) = a; *(f32x4*)(xr + 512 * i + 4) = b; }
    }
}

#define PO(k) ((size_t)(k) * TS * BWID)
__device__ void mix_sc(const Params& p, int l, const bf16_t* proj, bf16_t* z3, int r0, int pos0) {
    const int tid = otid(), lane = tid & 63, w = tid >> 6, c0 = lane * 8;
    const float* scw = p.in[13] + (size_t)l * 3 * BWID + c0;
    float w0[8], w1[8], w2[8]; load8f(scw, w0); load8f(scw + BWID, w1); load8f(scw + 2 * BWID, w2);
    const int r = r0 + 16 * w, pos = pos0 + 16 * w;
    const bf16_t* bgp = proj + PO(6) + c0; const bf16_t* cxp = proj + PO(7) + c0;
    u32x4 vb[16], vc[18];
    vc[0] = (u32x4){0u, 0u, 0u, 0u}; vc[1] = vc[0];
    if (pos > 0) { vc[0] = *(const u32x4*)(cxp + (size_t)(r - 2) * BWID); vc[1] = *(const u32x4*)(cxp + (size_t)(r - 1) * BWID); }
#pragma unroll
    for (int jj = 0; jj < 16; ++jj) { vb[jj] = *(const u32x4*)(bgp + (size_t)(r + jj) * BWID); vc[2 + jj] = *(const u32x4*)(cxp + (size_t)(r + jj) * BWID); }
    float p2[8], p1[8];
    unpack8(vc[0], p2); unpack8(vc[1], p1);
#pragma unroll
    for (int jj = 0; jj < 16; ++jj) {
        float b[8], cur[8], o[8]; unpack8(vb[jj], b); unpack8(vc[2 + jj], cur);
#pragma unroll
        for (int j = 0; j < 8; ++j) { o[j] = b[j] * (w0[j] * p2[j] + w1[j] * p1[j] + w2[j] * cur[j]); p2[j] = p1[j]; p1[j] = cur[j]; }
        *(u32x4*)(z3 + (size_t)(r + jj) * BWID + c0) = pack8(o);
    }
}

__device__ void mix_conv(const Params& p, int l, const bf16_t* proj, bf16_t* z1, int r0, int pos0, LAS unsigned char* lds) {
    const int tid = otid(), lane = tid & 63, w = tid >> 6, c0 = lane * 8;
    LAS unsigned char* Y = lds; LAS unsigned char* W = lds + 94 * VP;
    const float* cw = p.in[5] + (size_t)l * 31 * BWID;
    for (int i = tid; i < 31 * 64; i += 512) { const int k = i >> 6, cgp = i & 63; float f[8]; load8f(cw + k * BWID + cgp * 8, f); *(LAS u32x4*)(W + k * 1024 + cgp * 16) = pack8(f); }
    float bias[8], lng[8], lnb[8];
    load8f(p.in[6] + (size_t)l * BWID + c0, bias); load8f(p.in[7] + (size_t)l * BWID + c0, lng); load8f(p.in[8] + (size_t)l * BWID + c0, lnb);
    for (int q = 0; q < 2; ++q) {
        const int tr = r0 + 64 * q, tp = pos0 + 64 * q;
        __syncthreads();
        {
            u32x4 la[12];
#pragma unroll
            for (int i = 0; i < 12; ++i) { const int row = 12 * w + i; const bool valid = (row < 94) && (tp - 30 + row >= 0);
                la[i] = (u32x4){0u, 0u, 0u, 0u};
                if (valid) la[i] = *(const u32x4*)(proj + (size_t)(tr - 30 + row) * BWID + PO(2) + c0); }
#pragma unroll
            for (int i = 0; i < 12; ++i) { const int row = 12 * w + i; if (row < 94) *(LAS u32x4*)(Y + row * VP + lane * 16) = la[i]; }
        }
        __syncthreads();
        u32x4 gtv[8];
#pragma unroll
        for (int j = 0; j < 8; ++j) gtv[j] = *(const u32x4*)(proj + (size_t)(tr + 8 * w + j) * BWID + PO(3) + c0);
        float acc[8][8];
#pragma unroll
        for (int j = 0; j < 8; ++j)
#pragma unroll
            for (int c = 0; c < 8; ++c) acc[j][c] = bias[c];
#pragma unroll 1
        for (int k = 0; k < 31; ++k) {
            float wv[8]; unpack8(*(const LAS u32x4*)(W + k * 1024 + lane * 16), wv);
#pragma unroll
            for (int j = 0; j < 8; ++j) { float yv[8]; unpack8(*(const LAS u32x4*)(Y + (8 * w + j + k) * VP + lane * 16), yv);
#pragma unroll
                for (int c = 0; c < 8; ++c) acc[j][c] += wv[c] * yv[c]; }
        }
#pragma unroll
        for (int j = 0; j < 8; ++j) {
            float s = 0.f, ss = 0.f;
#pragma unroll
            for (int c = 0; c < 8; ++c) { s += acc[j][c]; ss += acc[j][c] * acc[j][c]; }
            s = wave_sum(s); ss = wave_sum(ss);
            const float mean = s * (1.0f / 512.0f); const float var = fmaxf(ss * (1.0f / 512.0f) - mean * mean, 0.f); const float rstd = rsqrtf(var + 1e-5f);
            const int row = tr + 8 * w + j;
            float gt[8], o[8]; unpack8(gtv[j], gt);
#pragma unroll
            for (int c = 0; c < 8; ++c) { const float v = (acc[j][c] - mean) * rstd * lng[c] + lnb[c]; o[c] = silu(v) * silu(gt[c]); }
            *(u32x4*)(z1 + (size_t)row * BWID + c0) = pack8(o);
        }
    }
}

__device__ __forceinline__ u32x4 sel4(bool c, const u32x4 a, const u32x4 b) { u32x4 r; r.x = c ? a.x : b.x; r.y = c ? a.y : b.y; r.z = c ? a.z : b.z; r.w = c ? a.w : b.w; return r; }

__device__ void mix_pool(const Params& p, int l, const bf16_t* proj, bf16_t* z0, int r0, int pos0, LAS unsigned char* lds) {
    const int tid = otid(), lane = tid & 63, w = tid >> 6, c0 = lane * 8;
    LAS unsigned char* P = lds;
    {
        const int g4 = lane >> 4, win = 2 << g4;
        const int r = r0 + 16 * w, pos = pos0 + 16 * w;
        u32x4 R[32];
#pragma unroll
        for (int i = 0; i < 16; ++i) { R[i] = (u32x4){0u, 0u, 0u, 0u}; if (pos > 0) R[i] = *(const u32x4*)(proj + (size_t)(r - 16 + i) * BWID + c0); }
#pragma unroll
        for (int i = 0; i < 16; ++i) R[16 + i] = *(const u32x4*)(proj + (size_t)(r + i) * BWID + c0);
        float S[8];
#pragma unroll
        for (int j = 0; j < 8; ++j) S[j] = 0.f;
#pragma unroll
        for (int i = 1; i <= 16; ++i) { float x[8]; unpack8(R[16 - i], x); const float mk = (i <= win) ? 1.0f : 0.0f;
#pragma unroll
            for (int j = 0; j < 8; ++j) S[j] += mk * x[j]; }
#pragma unroll
        for (int jj = 0; jj < 16; ++jj) {
            const int ps = pos + jj; float xv[8], xo[8], o[8];
            unpack8(R[16 + jj], xv);
            const u32x4 ro = sel4(g4 < 2, sel4(g4 == 0, R[16 + jj - 2], R[16 + jj - 4]), sel4(g4 == 2, R[16 + jj - 8], R[jj]));
            unpack8(ro, xo);
            const int cnt = (ps + 1 < win) ? ps + 1 : win; const float inv = 1.0f / (float)cnt;
#pragma unroll
            for (int j = 0; j < 8; ++j) { S[j] += xv[j] - xo[j]; o[j] = S[j] * inv - xv[j]; }
            *(LAS u32x4*)(P + (16 * w + jj) * VP + lane * 16) = pack8(o);
        }
    }
    __syncthreads();
    {
        const int g = w >> 1, fr = lane & 15, fq = lane >> 4;
        const bf16_t* pwT = (const bf16_t*)(p.ws + p.o_pw) + (size_t)(l * 4 + g) * 128 * 128;
        u32x2 gtv[8][4];
#pragma unroll
        for (int tt = 0; tt < 8; ++tt)
#pragma unroll
            for (int dt = 0; dt < 4; ++dt) gtv[tt][dt] = *(const u32x2*)(proj + (size_t)(r0 + 16 * tt + fr) * BWID + PO(1) + 64 * w + 16 * dt + 4 * fq);
        bf16x8 A[4][4];
#pragma unroll
        for (int dt = 0; dt < 4; ++dt)
#pragma unroll
            for (int kk = 0; kk < 4; ++kk) A[dt][kk] = *(const bf16x8*)(pwT + (size_t)(64 * (w & 1) + 16 * dt + fr) * 128 + 32 * kk + 8 * fq);
        const float* psc = p.in[4] + (size_t)l * BWID;
        f32x4 sc[4];
#pragma unroll
        for (int dt = 0; dt < 4; ++dt) sc[dt] = *(const f32x4*)(psc + 64 * w + 16 * dt + 4 * fq);
#pragma unroll
        for (int tt = 0; tt < 8; ++tt) {
            bf16x8 Bf[4];
#pragma unroll
            for (int kk = 0; kk < 4; ++kk) Bf[kk] = *(const LAS bf16x8*)(P + (16 * tt + fr) * VP + (128 * g + 32 * kk + 8 * fq) * 2);
            f32x4 acc[4];
#pragma unroll
            for (int dt = 0; dt < 4; ++dt) { acc[dt] = (f32x4){0.f, 0.f, 0.f, 0.f};
#pragma unroll
                for (int kk = 0; kk < 4; ++kk) acc[dt] = __builtin_amdgcn_mfma_f32_16x16x32_bf16(A[dt][kk], Bf[kk], acc[dt], 0, 0, 0); }
            const int row = r0 + 16 * tt + fr;
#pragma unroll
            for (int dt = 0; dt < 4; ++dt) { const int d = 64 * w + 16 * dt + 4 * fq;
                float gt[4]; unpack4(gtv[tt][dt], gt);
                u32x2 o; o.x = cvt_pk_bf16(acc[dt][0] * sc[dt][0] * silu(gt[0]), acc[dt][1] * sc[dt][1] * silu(gt[1])); o.y = cvt_pk_bf16(acc[dt][2] * sc[dt][2] * silu(gt[2]), acc[dt][3] * sc[dt][3] * silu(gt[3]));
                *(u32x2*)(z0 + (size_t)row * BWID + d) = o; }
        }
    }
}

__device__ void mix_sgu(const Params& p, int l, const bf16_t* proj, bf16_t* z2, int r0, LAS unsigned char* lds) {
    const int tid = otid(), lane = tid & 63, w = tid >> 6, c0 = lane * 8;
    LAS unsigned char* V = lds;
    {
        float lng[8], lnb[8]; load8f(p.in[9] + (size_t)l * BWID + c0, lng); load8f(p.in[10] + (size_t)l * BWID + c0, lnb);
        u32x4 R[16];
#pragma unroll
        for (int jj = 0; jj < 16; ++jj) R[jj] = *(const u32x4*)(proj + (size_t)(r0 + 16 * w + jj) * BWID + PO(5) + c0);
#pragma unroll
        for (int jj = 0; jj < 16; ++jj) {
            float x[8], o[8]; unpack8(R[jj], x);
            float s = 0.f, ss = 0.f;
#pragma unroll
            for (int c = 0; c < 8; ++c) { s += x[c]; ss += x[c] * x[c]; }
            s = wave_sum(s); ss = wave_sum(ss);
            const float mean = s * (1.0f / 512.0f); const float var = fmaxf(ss * (1.0f / 512.0f) - mean * mean, 0.f); const float rstd = rsqrtf(var + 1e-5f);
#pragma unroll
            for (int c = 0; c < 8; ++c) o[c] = (x[c] - mean) * rstd * lng[c] + lnb[c];
            *(LAS u32x4*)(V + (16 * w + jj) * VP + lane * 16) = pack8(o);
        }
    }
    __syncthreads();
    {
        const int g = w >> 1, fr = lane & 15, fq = lane >> 4;
        const unsigned vbase = (unsigned)(size_t)V;
        bf16x8 A[4][4];
#pragma unroll
        for (int ct = 0; ct < 4; ++ct)
#pragma unroll
            for (int kk = 0; kk < 4; ++kk) {
                const unsigned a = vbase + (unsigned)((32 * kk + 8 * fq + (fr >> 2)) * VP + (64 * w + 16 * ct + 4 * (fr & 3)) * 2);
                const u32x2 lo = tr_read(a), hi = tr_read(a + 4 * VP);
                u32x4 t; t.x = lo.x; t.y = lo.y; t.z = hi.x; t.w = hi.y;
                A[ct][kk] = __builtin_bit_cast(bf16x8, t);
            }
        const bf16_t* swm = (const bf16_t*)(p.ws + p.o_sw) + (size_t)(l * 4 + g) * 128 * 128;
        const float* sb = p.in[12] + (size_t)(l * 4 + g) * 128;
#pragma unroll
        for (int hb = 0; hb < 2; ++hb) {
            u32x2 uu[4][4]; bf16x8 Wf[4][4]; float bias[4];
#pragma unroll
            for (int t4 = 0; t4 < 4; ++t4) { const int tt = hb * 4 + t4; const bf16_t* pr = proj + (size_t)(r0 + 16 * tt + fr) * BWID + 64 * w + 4 * fq;
#pragma unroll
                for (int ct = 0; ct < 4; ++ct) uu[t4][ct] = *(const u32x2*)(pr + PO(4) + 16 * ct);
#pragma unroll
                for (int kk = 0; kk < 4; ++kk) if (kk < (tt >> 1) + 1) Wf[t4][kk] = *(const bf16x8*)(swm + (size_t)(16 * tt + fr) * 128 + 32 * kk + 8 * fq);
                bias[t4] = sb[16 * tt + fr]; }
#pragma unroll
            for (int t4 = 0; t4 < 4; ++t4) { const int tt = hb * 4 + t4;
                f32x4 acc[4];
#pragma unroll
                for (int ct = 0; ct < 4; ++ct) acc[ct] = (f32x4){0.f, 0.f, 0.f, 0.f};
#pragma unroll
                for (int kk = 0; kk < 4; ++kk) if (kk < (tt >> 1) + 1) {
#pragma unroll
                    for (int ct = 0; ct < 4; ++ct) acc[ct] = __builtin_amdgcn_mfma_f32_16x16x32_bf16(A[ct][kk], Wf[t4][kk], acc[ct], 0, 0, 0); }
                const int row = r0 + 16 * tt + fr;
#pragma unroll
                for (int ct = 0; ct < 4; ++ct) { const int c = 64 * w + 16 * ct + 4 * fq;
                    float u[4]; unpack4(uu[t4][ct], u);
                    u32x2 o; o.x = cvt_pk_bf16(u[0] * (acc[ct][0] + bias[t4]), u[1] * (acc[ct][1] + bias[t4])); o.y = cvt_pk_bf16(u[2] * (acc[ct][2] + bias[t4]), u[3] * (acc[ct][3] + bias[t4]));
                    *(u32x2*)(z2 + (size_t)row * BWID + c) = o; }
            }
        }
    }
}

__device__ void phase_mix(const Params& p, int l, const bf16_t* proj, bf16_t* z, LAS unsigned char* lds) {
    constexpr int nchunk = TS / 128;
    for (int i = blockIdx.x; i < 4 * nchunk; i += gridDim.x) {
        const int j = i % nchunk, br = ((i / nchunk) + j) & 3, r0 = j * 128, pos0 = (j & 15) * 128;
        if (br == 0) for (int rr = 0; rr < REP_M0; ++rr) { mix_pool(p, l, proj, z + PO(1), r0, pos0, lds); __syncthreads(); }
        else if (br == 1) for (int rr = 0; rr < REP_M1; ++rr) { mix_conv(p, l, proj, z + PO(3), r0, pos0, lds); __syncthreads(); }
        else if (br == 2) for (int rr = 0; rr < REP_M2; ++rr) { mix_sgu(p, l, proj, z + PO(4), r0, lds); __syncthreads(); }
        else for (int rr = 0; rr < REP_M3; ++rr) { mix_sc(p, l, proj, z + PO(6), r0, pos0); __syncthreads(); }
    }
}

#define XB_TMO      128
#define XB_XCNT(j)  (256  + 64 * (j))
#define XB_XSUB(j)  (1280 + 64 * (j))
#define XB_XGEN(j)  (2304 + 64 * (j))
#define XB_TOP      3328
#define XB_TOPGEN   3392
#define XCD_BAR_WORDS 3456
#define XB_SPIN_CAP (1u << 20)
__device__ __forceinline__ unsigned xb_ld(unsigned* p)              { return __hip_atomic_load(p, __ATOMIC_RELAXED, __HIP_MEMORY_SCOPE_AGENT); }
__device__ __forceinline__ unsigned xb_add(unsigned* p, unsigned v) { return __hip_atomic_fetch_add(p, v, __ATOMIC_RELAXED, __HIP_MEMORY_SCOPE_AGENT); }
__device__ __forceinline__ unsigned xb_xcc_id() { return (unsigned)__builtin_amdgcn_s_getreg((3 << 11) | 20) & 0xFu; }
#define XB_SPIN(cond, bar) do { unsigned _sp = 0; while (cond) { __builtin_amdgcn_s_sleep(1); \
    if ((++_sp & 255u) == 0u) { if (xb_ld(&(bar)[XB_TMO])) break; if (_sp > XB_SPIN_CAP) { atomicAdd(&(bar)[XB_TMO], 1u); break; } } } } while (0)
struct XcdBarrier { unsigned* bar; unsigned x; volatile LAS unsigned* st; };
__device__ __forceinline__ XcdBarrier xcd_barrier_post(unsigned* bar, volatile LAS unsigned* st) {
    XcdBarrier b; b.bar = bar; b.x = xb_xcc_id(); b.st = st;
    if (threadIdx.x == 0) (void)xb_add(&bar[XB_XCNT(b.x)], 1u);
    return b;
}
__device__ __forceinline__ void xcd_barrier_complete(unsigned* bar, unsigned x, unsigned& nloc, unsigned& nx) {
    const unsigned G = gridDim.x * gridDim.y * gridDim.z;
    unsigned sum, cnt, mine, sp = 0u;
    for (;;) {
        sum = 0u; cnt = 0u; mine = 0u;
#pragma unroll
        for (unsigned j = 0; j < 16; ++j) { const unsigned c = xb_ld(&bar[XB_XCNT(j)]); sum += c; cnt += (c > 0u) ? 1u : 0u; mine = (j == x) ? c : mine; }
        if (sum == G) break;
        __builtin_amdgcn_s_sleep(1);
        if ((++sp & 255u) == 0u) { if (xb_ld(&bar[XB_TMO])) break; if (sp > XB_SPIN_CAP) { atomicAdd(&bar[XB_TMO], 1u); break; } }
    }
    nloc = mine > 0u ? mine : 1u; nx = cnt > 0u ? cnt : 1u;
}
__device__ __forceinline__ void xcd_barrier(const XcdBarrier& b) {
    asm volatile("s_waitcnt vmcnt(0)" ::: "memory");
    __syncthreads();
    if (threadIdx.x == 0) {
        unsigned* bar = b.bar;
        __builtin_amdgcn_s_waitcnt(0);
        unsigned nloc = b.st[0], nx = b.st[1];
        if (nloc == 0u) { xcd_barrier_complete(bar, b.x, nloc, nx); b.st[0] = nloc; b.st[1] = nx; }
        const unsigned old = xb_add(&bar[XB_XSUB(b.x)], 1u);
        const unsigned gen = old / nloc;
        if (old + 1u == (gen + 1u) * nloc) {
            __builtin_amdgcn_fence(__ATOMIC_RELEASE, "agent");
            asm volatile("s_waitcnt vmcnt(0)" ::: "memory");
            const unsigned og = xb_add(&bar[XB_TOP], 1u);
            const unsigned tg = og / nx;
            if (og + 1u == (tg + 1u) * nx) xb_add(&bar[XB_TOPGEN], 1u);
            else XB_SPIN(xb_ld(&bar[XB_TOPGEN]) == tg, bar);
            __builtin_amdgcn_fence(__ATOMIC_ACQUIRE, "agent");
            xb_add(&bar[XB_XGEN(b.x)], 1u);
            asm volatile("s_waitcnt vmcnt(0)" ::: "memory");
        } else {
            XB_SPIN(xb_ld(&bar[XB_XGEN(b.x)]) == gen, bar);
            __builtin_amdgcn_fence(__ATOMIC_ACQUIRE, "agent");
            asm volatile("s_waitcnt vmcnt(0)" ::: "memory");
        }
    }
    __syncthreads();
}

__global__ void __launch_bounds__(512) mk_forward(Params p) {
    extern __shared__ __attribute__((aligned(16))) unsigned char lds_raw[];
    LAS unsigned char* lds = (LAS unsigned char*)lds_raw;
    cg::grid_group grid = cg::this_grid();
    volatile LAS unsigned* stw = (volatile LAS unsigned*)(lds + LDS_BYTES - 16);
    if (threadIdx.x == 0) { stw[0] = 0u; stw[1] = 0u; }
    __syncthreads();
    const XcdBarrier xbar = xcd_barrier_post((unsigned*)(p.ws + p.o_bar), stw);
    int ph = 0;
#define PHASE_ON (ph >= p.ph_lo && ph < p.ph_hi)
#ifndef XSYNC
#define XSYNC 0
#endif
#define PHASE_END do { if (PHASE_ON && ph + 1 < p.ph_hi) { if (p.ph_hi > 100000) grid.sync();   xcd_barrier(xbar); for (int xs = 0; xs < XSYNC; ++xs) xcd_barrier(xbar); } ++ph; } while (0)
    constexpr int ts = TS;
    bf16_t* win = (bf16_t*)(p.ws + p.o_win); bf16_t* wb = (bf16_t*)(p.ws + p.o_wb); bf16_t* wo = (bf16_t*)(p.ws + p.o_wo);
    bf16_t* h0 = (bf16_t*)(p.ws + p.o_h); bf16_t* proj = (bf16_t*)(p.ws + p.o_proj);

    if (PHASE_ON) phase_prep(p, lds);
    PHASE_END;
#pragma unroll 1
    for (int l = 0; l < DEPTH; ++l) {
        const float* xin = (l == 0) ? p.in[0] : p.out;
#pragma unroll 1
        for (int s = 0; s < NS; ++s) {
            const size_t tok0 = (size_t)s * ts;
            bf16_t* h = h0 + tok0 * DM; bf16_t* merged = h;
            if (l > 0) { if (PHASE_ON) phase_norm_bf16(xin + tok0 * DM, p.in[1] + (size_t)l * DM, h, ts);
                PHASE_END; }
            if (PHASE_ON) for (int rep = 0; rep < REP_A; ++rep) { pg8::Gemm g{h, win + (size_t)l * DM * INC}; pg8::OrderA S; S.G = (int)gridDim.x; S.c = (int)blockIdx.x; pg8::EpiProj E{proj, proj + (size_t)8 * TS * BWID}; pg8::gemm_phase<DM, 0>(lds, g, S, E); }
            PHASE_END;
            if (PHASE_ON) phase_mix(p, l, proj, proj, lds);
            PHASE_END;
            if (PHASE_ON) for (int rep = 0; rep < REP_C; ++rep) { pg8::Gemm g{proj, wb + (size_t)l * 4 * BWID * DM}; pg8::OrderC S; S.G = (int)gridDim.x; S.c = (int)blockIdx.x;
                pg8::EpiGate E{proj + (size_t)8 * TS * BWID, merged}; pg8::gemm_phase<BWID, (size_t)BWID * DM * 2>(lds, g, S, E); }
            PHASE_END;
            if (PHASE_ON) { pg8::Gemm g{merged, wo + (size_t)l * DM * DM}; pg8::Order<TS / 256, DM / 256, 1> S{(int)gridDim.x, (int)blockIdx.x};
                pg8::EpiRes E{xin + tok0 * DM, p.out + tok0 * DM, DM}; pg8::gemm_phase<DM, 0>(lds, g, S, E); }
            PHASE_END;
        }
    }
    if (PHASE_ON) phase_norm_final(p.out, p.in[16], NTOK);
    PHASE_END;
}

extern "C" void kernel_launch(void* const* d_in, const int* in_sizes, int n_in, void* d_out, int out_size, void* d_ws, size_t ws_size, hipStream_t stream) {
    static int grid = 0;
    if (grid == 0) {
        int dev = 0, cus = 0, per_cu = 0;
        hipGetDevice(&dev); hipDeviceGetAttribute(&cus, hipDeviceAttributeMultiprocessorCount, dev);
        if (hipFuncSetAttribute((const void*)mk_forward, hipFuncAttributeMaxDynamicSharedMemorySize, LDS_BYTES) != hipSuccess) { fprintf(stderr, "hipFuncSetAttribute failed\n"); grid = -1; return; }
        if (hipOccupancyMaxActiveBlocksPerMultiprocessor(&per_cu, (const void*)mk_forward, 512, LDS_BYTES) != hipSuccess || per_cu < 1) { fprintf(stderr, "occupancy query: %d\n", per_cu); per_cu = 1; }
        (void)hipGetLastError();
        grid = cus * per_cu;
    }
    if (grid < 0) return;
    Params p{};
    for (int i = 0; i < 17; ++i) p.in[i] = (const float*)d_in[i];
    p.out = (float*)d_out; p.ws = (unsigned char*)d_ws;
    p.ns = NS; p.ts = TS;
    size_t o = 0;
    p.o_win = o; o += (size_t)DEPTH * DM * INC * 2;
    p.o_wb = o; o += (size_t)DEPTH * 4 * BWID * DM * 2;
    p.o_wo = o; o += (size_t)DEPTH * DM * DM * 2;
    p.o_pw = o; o += (size_t)DEPTH * 4 * 128 * 128 * 2;
    p.o_sw = o; o += (size_t)DEPTH * 4 * 128 * 128 * 2;
    p.o_bar = o; o += 16384;
    p.o_h = o; o += (size_t)NTOK * DM * 2;
    p.o_z = 0;
    p.o_proj = o; o += (size_t)p.ts * (8 * BWID * 2 + 4096);
    if (o > ws_size) { fprintf(stderr, "kernel_launch: workspace too small: need %zu, have %zu\n", o, ws_size); return; }
    const int nph = 1 + NS * 4 + (DEPTH - 1) * NS * 5 + 1;
    if (hipMemsetAsync((char*)d_ws + p.o_bar, 0, 16384, stream) != hipSuccess) { fprintf(stderr, "kernel_launch: memset failed\n"); return; }
#if MULTI_LAUNCH
    for (int ph = 0; ph < nph; ++ph) { p.ph_lo = ph; p.ph_hi = ph + 1; hipLaunchKernelGGL(mk_forward, dim3(grid), dim3(512), LDS_BYTES, stream, p); }
#else
    p.ph_lo = 0; p.ph_hi = nph;
    void* args[] = {&p};
    hipError_t e = hipLaunchCooperativeKernel((const void*)mk_forward, dim3(grid), dim3(512), args, LDS_BYTES, stream);
    if (e != hipSuccess) fprintf(stderr, "cooperative launch failed: %s (grid %d)\n", hipGetErrorString(e), grid);
#endif
}
```

```cpp
#include <hip/hip_runtime.h>
#include <hip/hip_cooperative_groups.h>
#include <cstdio>
namespace cg = cooperative_groups;

#ifndef MULTI_LAUNCH
#define MULTI_LAUNCH 0
#endif

#ifndef REP_N
#define REP_N 1
#endif
#ifndef REP_A
#define REP_A 1
#endif
#ifndef REP_B
#define REP_B 1
#endif
#ifndef REP_C
#define REP_C 1
#endif
#define REP_M0 1
#define REP_M1 1
#define REP_M2 1
#define REP_M3 1
#define LAS __attribute__((address_space(3)))
typedef unsigned short bf16_t;
typedef short bf16x8 __attribute__((ext_vector_type(8)));
typedef float f32x4 __attribute__((ext_vector_type(4)));
typedef float f32x2 __attribute__((ext_vector_type(2)));
typedef unsigned u32x4 __attribute__((ext_vector_type(4)));
typedef unsigned u32x2 __attribute__((ext_vector_type(2)));

constexpr int DM = 1024, SEQ = 2048, NTOK = 32 * 2048, DEPTH = 2, BWID = 512, INC = 10240, GATE0 = 6144;
constexpr int PP = 6144;
constexpr int NS = 1, TS = NTOK / NS;
constexpr int LDS_BYTES = 139264;
constexpr int VP = 1040;

struct Params {
    const float* in[17];
    float* out;
    unsigned char* ws;
    int ts, ns, ph_lo, ph_hi;
    unsigned long long o_win, o_wb, o_wo, o_pw, o_sw, o_h, o_z, o_bar, o_proj;
};

__device__ __forceinline__ int otid() { int t = threadIdx.x; asm volatile("" : "+v"(t)); return t; }
__device__ __forceinline__ unsigned cvt_pk_bf16(float lo, float hi) { unsigned r; asm volatile("v_cvt_pk_bf16_f32 %0, %1, %2" : "=v"(r) : "v"(lo), "v"(hi)); return r; }
__device__ __forceinline__ bf16_t f2bf(float f) { unsigned u = __float_as_uint(f); u += 0x7FFFu + ((u >> 16) & 1u); return (bf16_t)(u >> 16); }
__device__ __forceinline__ void unpack8(const u32x4 v, float (&f)[8]) {
    f[0] = __uint_as_float(v.x << 16); f[1] = __uint_as_float(v.x & 0xffff0000u); f[2] = __uint_as_float(v.y << 16); f[3] = __uint_as_float(v.y & 0xffff0000u);
    f[4] = __uint_as_float(v.z << 16); f[5] = __uint_as_float(v.z & 0xffff0000u); f[6] = __uint_as_float(v.w << 16); f[7] = __uint_as_float(v.w & 0xffff0000u);
}
__device__ __forceinline__ u32x4 pack8(const float (&f)[8]) { u32x4 r; r.x = cvt_pk_bf16(f[0], f[1]); r.y = cvt_pk_bf16(f[2], f[3]); r.z = cvt_pk_bf16(f[4], f[5]); r.w = cvt_pk_bf16(f[6], f[7]); return r; }
__device__ __forceinline__ void unpack4(const u32x2 v, float (&f)[4]) { f[0] = __uint_as_float(v.x << 16); f[1] = __uint_as_float(v.x & 0xffff0000u); f[2] = __uint_as_float(v.y << 16); f[3] = __uint_as_float(v.y & 0xffff0000u); }
__device__ __forceinline__ float sigm(float x) { return __builtin_amdgcn_rcpf(1.0f + __expf(-x)); }
__device__ __forceinline__ float silu(float x) { return x * sigm(x); }
__device__ __forceinline__ void load8f(const float* p, float (&f)[8]) { const f32x4 a = *(const f32x4*)p, b = *(const f32x4*)(p + 4); f[0] = a[0]; f[1] = a[1]; f[2] = a[2]; f[3] = a[3]; f[4] = b[0]; f[5] = b[1]; f[6] = b[2]; f[7] = b[3]; }
__device__ __forceinline__ float wave_sum(float v) {
#pragma unroll
    for (int o = 32; o >= 1; o >>= 1) v += __shfl_xor(v, o);
    return v;
}
__device__ __forceinline__ u32x2 tr_read(unsigned lds_addr) { u32x2 r; asm volatile("ds_read_b64_tr_b16 %0, %1\n\ts_waitcnt lgkmcnt(0)" : "=&v"(r) : "v"(lds_addr) : "memory"); return r; }

namespace pg8 {
constexpr int BM = 256, BK = 64, HALF = 128, HTB = HALF * BK * 2, STAGE_BYTES = 8 * HTB, NXCD = 8, WGM = 8;
__device__ __forceinline__ int lds_byte(int r, int c) { const int st = (r >> 4) * 2 + (c >> 5), rr = r & 15, cc = c & 31, ob = rr * 64 + cc * 2; return st * 1024 + (ob ^ (((ob >> 9) & 1) << 5)); }
__device__ __forceinline__ void stage_rc(int b, int& R, int& C) { const int st = b / 1024, sb = b % 1024, swz = sb ^ (((sb >> 9) & 1) << 5); R = (st >> 1) * 16 + swz / 64; C = (st & 1) * 32 + (swz % 64) / 2; }
__device__ __forceinline__ int perm32(int rho) { const int n = rho >> 4, i = rho & 15; return 8 * (i >> 2) + 4 * n + (i & 3); }

struct Unit { int pm, pn, br; };
struct Gemm { const bf16_t* A; const bf16_t* Bt; };

template <int NM, int NN, int NBR>
struct Order {
    int G, c;
    __device__ __forceinline__ bool next(int i, Unit& u) const {
        constexpr int nwg = NM * NN;
        const int ti = i / NBR;
        const long L = (long)ti * G + c; if (L >= nwg) return false;
        int wgid = (int)L; { constexpr int q = nwg / NXCD, r = nwg % NXCD; const int xcd = wgid % NXCD, off = wgid / NXCD; wgid = (xcd < r ? xcd * (q + 1) : r * (q + 1) + (xcd - r) * q) + off; }
        constexpr int nig = WGM * NN; const int gid = wgid / nig, fm = gid * WGM, gsz = (NM - fm) < WGM ? (NM - fm) : WGM;
        u.pm = fm + ((wgid % nig) % gsz); u.pn = (wgid % nig) / gsz; u.br = i % NBR; return true;
    }
    __device__ __forceinline__ void brow(const Unit& u, int& r0, int& r1) const { r0 = u.pn * BM; r1 = r0 + HALF; }
    __device__ __forceinline__ size_t aoff(const Unit&) const { return 0; }
};
struct OrderC : Order<TS / 256, DM / 256, 4> {
    __device__ __forceinline__ size_t aoff(const Unit& u) const { const int slot = (u.br == 0) ? 1 : (u.br == 1) ? 3 : (u.br == 2) ? 4 : 6; return (size_t)slot * TS * BWID * 2; }
};
struct OrderA : Order<TS / 256, INC / 256, 1> {
    __device__ __forceinline__ void brow(const Unit& u, int& r0, int& r1) const {
        const int pn = u.pn;
        if (pn < 8) { const int pc = pn >> 1; const int piece = (pc == 0) ? 0 : (pc == 1) ? 1 : (pc == 2) ? 4 : 6; r0 = piece * 512 + (pn & 1) * 256; r1 = r0 + HALF; }
        else if (pn < 24) { const int q = (pn - 8) >> 2, sub = (pn - 8) & 3; const int pa = (q == 0) ? 2 : (q == 1) ? 9 : (q == 2) ? 8 : 5, pb = (q == 0) ? 3 : (q == 1) ? 10 : (q == 2) ? 11 : 7;
            r0 = pa * 512 + HALF * sub; r1 = pb * 512 + HALF * sub; }
        else { r0 = pn * BM; r1 = r0 + HALF; }
    }
};

struct EpiProj {
    static constexpr bool PERM = true;
    static __device__ __forceinline__ bool zero_after(const Unit&) { return true; }
    bf16_t* O; bf16_t* G;
    __device__ __forceinline__ void operator()(f32x4 (&acc)[2][2][4][2], const Unit& u, int wr, int wc, int fr_, int fq) const {
        int fr = fr_; asm volatile("" : "+v"(fr));
        if (u.pn < 8) {
            const int pc = u.pn >> 1; const int slot = (pc == 0) ? 0 : (pc == 1) ? 1 : (pc == 2) ? 3 : 5;
            const int row0 = u.pm * BM + wr * 64 + fr, col0 = (u.pn & 1) * BM + wc * 32 + 8 * fq;
            bf16_t* Op = O + (size_t)slot * TS * BWID;
#pragma unroll
            for (int ai = 0; ai < 2; ++ai)
#pragma unroll
                for (int m = 0; m < 4; ++m) { bf16_t* rowp = Op + (size_t)(row0 + ai * HALF + m * 16) * BWID + col0;
#pragma unroll
                    for (int bj = 0; bj < 2; ++bj) { const f32x4 v0 = acc[ai][bj][m][0], v1 = acc[ai][bj][m][1];
                        u32x4 w; w.x = cvt_pk_bf16(v0[0], v0[1]); w.y = cvt_pk_bf16(v0[2], v0[3]); w.z = cvt_pk_bf16(v1[0], v1[1]); w.w = cvt_pk_bf16(v1[2], v1[3]);
                        __builtin_nontemporal_store(w, (u32x4*)(rowp + bj * HALF)); } }
        } else if (u.pn < GATE0 / BM) {
            const int q = (u.pn - 8) >> 2, sub = (u.pn - 8) & 3; const int slot = (q == 0) ? 2 : (q == 1) ? 7 : (q == 2) ? 6 : 4;
            const int row0 = u.pm * BM + wr * 64 + fr, col0 = sub * HALF + wc * 32 + 8 * fq;
            bf16_t* Op = O + (size_t)slot * TS * BWID;
#pragma unroll
            for (int ai = 0; ai < 2; ++ai)
#pragma unroll
                for (int m = 0; m < 4; ++m) {
                    float f[8];
#pragma unroll
                    for (int n = 0; n < 2; ++n)
#pragma unroll
                        for (int j = 0; j < 4; ++j) { const float av = acc[ai][0][m][n][j], bv = acc[ai][1][m][n][j];
                            const float sg = __builtin_amdgcn_rcpf(1.0f + __builtin_amdgcn_exp2f(bv));
                            f[n * 4 + j] = av * ((q == 1) ? bv : (q == 0) ? sg : bv * sg); }
                    __builtin_nontemporal_store(pack8(f), (u32x4*)(Op + (size_t)(row0 + ai * HALF + m * 16) * BWID + col0)); }
        } else {
            unsigned char* gb = (unsigned char*)G + ((size_t)u.pm * 16 + (u.pn - GATE0 / BM)) * 65536 + (((wr * 4 + wc) * 4 + fq) * 16 + fr) * 16;
#pragma unroll
            for (int ai = 0; ai < 2; ++ai)
#pragma unroll
                for (int m = 0; m < 4; ++m) {
                    u32x4 w;
#pragma unroll
                    for (int bj = 0; bj < 2; ++bj)
#pragma unroll
                        for (int n = 0; n < 2; ++n) { unsigned q = 0u;
#pragma unroll
                            for (int j = 0; j < 4; ++j) q = __builtin_amdgcn_cvt_pk_u8_f32(fmaxf(__builtin_amdgcn_rcpf(__builtin_fmaf(__builtin_amdgcn_exp2f(acc[ai][bj][m][n][j]), 1.0f / 255.0f, 1.0f / 255.0f)), 1.0f), j, q);
                            w[bj * 2 + n] = q; }
                    __builtin_nontemporal_store(w, (u32x4*)(gb + (ai * 4 + m) * 8192)); }
        }
    }
};
struct EpiGate {
    static constexpr bool PERM = true;
    static __device__ __forceinline__ bool zero_after(const Unit& u) { return u.br == 3; }
    const bf16_t* G; bf16_t* merged;
    __device__ __forceinline__ void operator()(f32x4 (&acc)[2][2][4][2], const Unit& u, int wr, int wc, int fr_, int fq) const {
        int fr = fr_; asm volatile("" : "+v"(fr));
        const int lrow0 = wr * 64 + fr, lcol0 = wc * 32 + 8 * fq;
        const int br = u.br;
        const bool lastb = (br == 3);
        const unsigned char* gp0 = (const unsigned char*)G + ((size_t)u.pm * 16 + br * 4 + u.pn) * 65536 + (((wr * 4 + wc) * 4 + fq) * 16 + fr) * 16;
        const unsigned char* gnp = lastb ? gp0 : gp0 + 4 * 65536;
        u32x4 gc[2][4], gn[2][4];
#pragma unroll
        for (int ai = 0; ai < 2; ++ai)
#pragma unroll
            for (int m = 0; m < 4; ++m) { gc[ai][m] = *(const u32x4*)(gp0 + (ai * 4 + m) * 8192); gn[ai][m] = (u32x4){0u, 0u, 0u, 0u}; if (!lastb) gn[ai][m] = *(const u32x4*)(gnp + (ai * 4 + m) * 8192); }
#pragma unroll
        for (int ai = 0; ai < 2; ++ai)
#pragma unroll
            for (int m = 0; m < 4; ++m)
#pragma unroll
                for (int bj = 0; bj < 2; ++bj) {
#pragma unroll
                    for (int n = 0; n < 2; ++n) {
                        const unsigned c = gc[ai][m][bj * 2 + n], d = gn[ai][m][bj * 2 + n];
                        float fc[4], fd[4];
                        fc[0] = (float)(c & 0xffu); fc[1] = (float)((c >> 8) & 0xffu); fc[2] = (float)((c >> 16) & 0xffu); fc[3] = (float)(c >> 24);
                        fd[0] = (float)(d & 0xffu); fd[1] = (float)((d >> 8) & 0xffu); fd[2] = (float)((d >> 16) & 0xffu); fd[3] = (float)(d >> 24);
#pragma unroll
                        for (int j = 0; j < 4; ++j) acc[ai][bj][m][n][j] *= fc[j] * (lastb ? (1.0f / 255.0f) : __builtin_amdgcn_rcpf(fd[j]));
                    }
                    if (lastb) { const f32x4 v0 = acc[ai][bj][m][0], v1 = acc[ai][bj][m][1];
                        u32x4 w; w.x = cvt_pk_bf16(v0[0], v0[1]); w.y = cvt_pk_bf16(v0[2], v0[3]); w.z = cvt_pk_bf16(v1[0], v1[1]); w.w = cvt_pk_bf16(v1[2], v1[3]);
                        *(u32x4*)(merged + ((size_t)u.pm * BM + lrow0 + ai * HALF + m * 16) * DM + u.pn * BM + lcol0 + bj * HALF) = w; }
                }
    }
};
struct EpiRes {
    static constexpr bool PERM = false;
    static __device__ __forceinline__ bool zero_after(const Unit&) { return true; }
    const float* res; float* C; int ldc;
    __device__ __forceinline__ void operator()(const f32x4 (&acc)[2][2][4][2], const Unit& u, int wr, int wc, int fr_, int fq) const {
        int fr = fr_; asm volatile("" : "+v"(fr));
        const int row0 = u.pm * BM + wr * 64 + fr, col0 = u.pn * BM + wc * 32 + 4 * fq;
#pragma unroll
        for (int ai = 0; ai < 2; ++ai)
#pragma unroll
            for (int m = 0; m < 4; ++m) { const size_t off = (size_t)(row0 + ai * HALF + m * 16) * ldc + col0;
                f32x4 rv[2][2];
#pragma unroll
                for (int bj = 0; bj < 2; ++bj)
#pragma unroll
                    for (int n = 0; n < 2; ++n) rv[bj][n] = *(const f32x4*)(res + off + bj * HALF + n * 16);
#pragma unroll
                for (int bj = 0; bj < 2; ++bj)
#pragma unroll
                    for (int n = 0; n < 2; ++n) *(f32x4*)(C + off + bj * HALF + n * 16) = acc[ai][bj][m][n] + rv[bj][n]; }
    }
};

template <int K, size_t B_BR, class Epi, class Sched>
__device__ __forceinline__ void gemm_phase(LAS unsigned char* lds, const Gemm g, const Sched& S, const Epi& E) {
    const int tid = otid(), wid = __builtin_amdgcn_readfirstlane(tid >> 6), lane = tid & 63, wr = wid >> 2, wc = wid & 3, fr = lane & 15, fq = lane >> 4;
    constexpr int nt = K / BK;
    unsigned voffA[2], voffB[2];
#pragma unroll
    for (int i = 0; i < 2; ++i) { int R, C; stage_rc(tid * 16 + i * 8192, R, C); const int Rb = Epi::PERM ? ((R & ~31) + perm32(R & 31)) : R;
        voffA[i] = (unsigned)(R * K + C) * 2u; voffB[i] = (unsigned)(Rb * K + C) * 2u; }
    constexpr size_t kstep = (size_t)(BK * 2);
    constexpr size_t hstep = (size_t)HALF * K * 2;
    constexpr size_t tstep = 2 * hstep;
    const unsigned ldsw = (unsigned)wid * 1024u;
    const int aoff = lds_byte(wr * 64 + fr, fq * 8), boff = lds_byte(wc * 32 + fr, fq * 8);
#define PG8_SA(b, h) (((b) * 2 + (h)) * HTB)
#define PG8_SB(b, h) ((4 + (b) * 2 + (h)) * HTB)
#define PG8_STAGE(bufoff, gbase, voff) do { _Pragma("unroll") for (int _i = 0; _i < 2; ++_i) \
        __builtin_amdgcn_global_load_lds((const unsigned*)((const char*)(gbase) + (voff)[_i]), (LAS unsigned*)(lds + (bufoff) + ldsw + _i * 8192), 16, 0, 0); } while (0)
#define PG8_LDA(dst, b, h) do { _Pragma("unroll") for (int m = 0; m < 4; ++m) _Pragma("unroll") for (int k = 0; k < 2; ++k) dst[m][k] = *(const LAS bf16x8*)(lds + PG8_SA(b, h) + aoff + m * 2048 + k * 1024); } while (0)
#define PG8_LDB(dst, b, h) do { _Pragma("unroll") for (int n = 0; n < 2; ++n) _Pragma("unroll") for (int k = 0; k < 2; ++k) dst[n][k] = *(const LAS bf16x8*)(lds + PG8_SB(b, h) + boff + n * 2048 + k * 1024); } while (0)
#define PG8_MMA(ai, bj, At, Bt) do { __builtin_amdgcn_s_setprio(1); _Pragma("unroll") for (int m = 0; m < 4; ++m) _Pragma("unroll") for (int n = 0; n < 2; ++n) _Pragma("unroll") for (int k = 0; k < 2; ++k) \
        acc[ai][bj][m][n] = __builtin_amdgcn_mfma_f32_16x16x32_bf16(Bt[n][k], At[m][k], acc[ai][bj][m][n], 0, 0, 0); __builtin_amdgcn_s_setprio(0); } while (0)
#define PG8_WAIT_V(n) asm volatile("s_waitcnt vmcnt(" #n ")" ::: "memory")
#define PG8_WAIT_L(n) asm volatile("s_waitcnt lgkmcnt(" #n ")" ::: "memory")
#define PG8_BAR __builtin_amdgcn_s_barrier()
#define PG8_SCHED __builtin_amdgcn_sched_barrier(0)
    Unit cur, nxt; int ui = 0;
    if (!S.next(0, cur)) return;
    f32x4 acc[2][2][4][2];
#pragma unroll
    for (int a = 0; a < 2; ++a)
#pragma unroll
        for (int b = 0; b < 2; ++b)
#pragma unroll
            for (int m = 0; m < 4; ++m)
#pragma unroll
                for (int n = 0; n < 2; ++n) acc[a][b][m][n] = (f32x4){0.f, 0.f, 0.f, 0.f};
    bf16x8 At[4][2], B0[2][2], B1[2][2];
    const char* cA = (const char*)g.A + (size_t)cur.pm * tstep + S.aoff(cur); int rb0, rb1; S.brow(cur, rb0, rb1);
    const char* cB = (const char*)g.Bt + (size_t)rb0 * (K * 2) + (size_t)cur.br * B_BR; const char* cBh = (const char*)g.Bt + (size_t)rb1 * (K * 2) + (size_t)cur.br * B_BR;
    PG8_STAGE(PG8_SB(0, 0), cB, voffB); PG8_STAGE(PG8_SA(0, 0), cA, voffA); PG8_STAGE(PG8_SB(0, 1), cBh, voffB); PG8_STAGE(PG8_SA(0, 1), cA + hstep, voffA);
    if (wr == 1) PG8_BAR;
    PG8_WAIT_V(4); PG8_BAR;
    PG8_STAGE(PG8_SB(1, 0), cB + kstep, voffB); PG8_STAGE(PG8_SA(1, 0), cA + kstep, voffA); PG8_STAGE(PG8_SB(1, 1), cBh + kstep, voffB);
    PG8_WAIT_V(6); PG8_BAR;
    for (;;) {
        const bool has_next = S.next(ui + 1, nxt);
        const char* nA = has_next ? (const char*)g.A + (size_t)nxt.pm * tstep + S.aoff(nxt) : cA; int rn0 = 0, rn1 = 0; if (has_next) S.brow(nxt, rn0, rn1);
        const char* nB = has_next ? (const char*)g.Bt + (size_t)rn0 * (K * 2) + (size_t)nxt.br * B_BR : cB; const char* nBh = has_next ? (const char*)g.Bt + (size_t)rn1 * (K * 2) + (size_t)nxt.br * B_BR : cBh;
        for (int t = 0; t < nt; t += 2) {
            const bool last = (t == nt - 2);
            const char* a1 = cA + (size_t)(t + 1) * kstep;
            const char* a2 = last ? nA : cA + (size_t)(t + 2) * kstep; const char* b2 = last ? nB : cB + (size_t)(t + 2) * kstep; const char* b2h = last ? nBh : cBh + (size_t)(t + 2) * kstep;
            const char* a3 = a2 + kstep; const char* b3 = b2 + kstep; const char* b3h = b2h + kstep;
            PG8_LDB(B0, 0, 0); PG8_SCHED; PG8_LDA(At, 0, 0); PG8_STAGE(PG8_SA(1, 1), a1 + hstep, voffA);
            PG8_WAIT_L(8); PG8_BAR; PG8_WAIT_L(0); PG8_MMA(0, 0, At, B0); PG8_BAR; PG8_SCHED;
            PG8_LDB(B1, 0, 1); PG8_STAGE(PG8_SB(0, 0), b2, voffB);
            PG8_BAR; PG8_WAIT_L(0); PG8_MMA(0, 1, At, B1); PG8_BAR;
            PG8_LDA(At, 0, 1); PG8_STAGE(PG8_SA(0, 0), a2, voffA);
            PG8_BAR; PG8_WAIT_L(0); PG8_MMA(1, 0, At, B0); PG8_BAR; PG8_SCHED;
            PG8_STAGE(PG8_SB(0, 1), b2h, voffB);
            PG8_WAIT_V(6); PG8_BAR; PG8_MMA(1, 1, At, B1); PG8_BAR;
            PG8_LDB(B0, 1, 0); PG8_SCHED; PG8_LDA(At, 1, 0); PG8_STAGE(PG8_SA(0, 1), a2 + hstep, voffA);
            PG8_WAIT_L(8); PG8_BAR; PG8_WAIT_L(0); PG8_MMA(0, 0, At, B0); PG8_BAR; PG8_SCHED;
            PG8_LDB(B1, 1, 1); PG8_STAGE(PG8_SB(1, 0), b3, voffB);
            PG8_BAR; PG8_WAIT_L(0); PG8_MMA(0, 1, At, B1); PG8_BAR;
            PG8_LDA(At, 1, 1); PG8_STAGE(PG8_SA(1, 0), a3, voffA);
            PG8_BAR; PG8_WAIT_L(0); PG8_MMA(1, 0, At, B0); PG8_BAR; PG8_SCHED;
            PG8_STAGE(PG8_SB(1, 1), b3h, voffB);
            PG8_WAIT_V(6); PG8_BAR; PG8_MMA(1, 1, At, B1); PG8_BAR;
        }
        E(acc, cur, wr, wc, fr, fq);
        if (!has_next) break;
        if (Epi::zero_after(cur))
#pragma unroll
        for (int a = 0; a < 2; ++a)
#pragma unroll
            for (int b = 0; b < 2; ++b)
#pragma unroll
                for (int m = 0; m < 4; ++m)
#pragma unroll
                    for (int n = 0; n < 2; ++n) acc[a][b][m][n] = (f32x4){0.f, 0.f, 0.f, 0.f};
        cur = nxt; cA = nA; cB = nB; cBh = nBh; ++ui;
    }
    PG8_WAIT_V(0);
    if (wr == 0) PG8_BAR;
    PG8_BAR;
#undef PG8_SA
#undef PG8_SB
#undef PG8_STAGE
#undef PG8_LDA
#undef PG8_LDB
#undef PG8_MMA
#undef PG8_WAIT_V
#undef PG8_WAIT_L
#undef PG8_BAR
#undef PG8_SCHED
}
}

__device__ void phase_norm_bf16(const float* __restrict__ xin, const float* __restrict__ g, bf16_t* __restrict__ h, int rows);
struct TJob { const float* src; bf16_t* dst; int R, C, tr, tc; float scale; };
__device__ __forceinline__ TJob prep_job(const Params& p, int i) {
    bf16_t* win = (bf16_t*)(p.ws + p.o_win); bf16_t* wb = (bf16_t*)(p.ws + p.o_wb); bf16_t* wo = (bf16_t*)(p.ws + p.o_wo); bf16_t* pw = (bf16_t*)(p.ws + p.o_pw);
    constexpr int T_WIN = 16 * 160, T_WB = 8 * 16, T_WO = 16 * 16, T_PW = 4;
    constexpr int N0 = DEPTH * T_WIN, N1 = N0 + 8 * T_WB, N2 = N1 + DEPTH * T_WO;
    TJob j; j.scale = 1.0f;
    if (i < N0) { const int l = i / T_WIN, t = i % T_WIN; j.src = p.in[2] + (size_t)l * DM * INC; j.dst = win + (size_t)l * DM * INC; j.R = DM; j.C = INC; j.tr = t / 160; j.tc = t % 160;
        const int piece = j.tc >> 3; j.scale = (piece >= 12 || piece == 3 || piece == 7 || piece == 11) ? -1.4426950408889634f : (piece == 5 || piece == 8) ? -0.6931471805599453f : 1.0f; }
    else if (i < N1) { const int k = i - N0, m = k / T_WB, t = k % T_WB; j.src = p.in[14] + (size_t)m * BWID * DM; j.dst = wb + (size_t)m * BWID * DM; j.R = BWID; j.C = DM; j.tr = t / 16; j.tc = t % 16; }
    else if (i < N2) { const int k = i - N1, l = k / T_WO, t = k % T_WO; j.src = p.in[15] + (size_t)l * DM * DM; j.dst = wo + (size_t)l * DM * DM; j.R = DM; j.C = DM; j.tr = t / 16; j.tc = t % 16; }
    else { const int k = i - N2, m = k / T_PW, t = k % T_PW; j.src = p.in[3] + (size_t)m * 128 * 128; j.dst = pw + (size_t)m * 128 * 128; j.R = 128; j.C = 128; j.tr = t / 2; j.tc = t % 2; }
    return j;
}
__device__ void phase_prep(const Params& p, LAS unsigned char* lds) {
    LAS float* sm = (LAS float*)lds;
    const int tid = otid();
    constexpr int NT = DEPTH * 16 * 160 + 8 * 8 * 16 + DEPTH * 16 * 16 + 8 * 4;
    const int lr = tid >> 4, lc = (tid & 15) * 4;
    f32x4 v0, v1;
    int i = blockIdx.x;
    if (i < NT) { const TJob j = prep_job(p, i); const float* sp = j.src + (size_t)(j.tr * 64 + lr) * j.C + j.tc * 64 + lc; v0 = *(const f32x4*)sp; v1 = *(const f32x4*)(sp + (size_t)32 * j.C); }
    for (; i < NT; i += gridDim.x) {
        const TJob j = prep_job(p, i);
#pragma unroll
        for (int e = 0; e < 4; ++e) { sm[lr * 65 + lc + e] = v0[e]; sm[(lr + 32) * 65 + lc + e] = v1[e]; }
        __syncthreads();
        const int in = i + gridDim.x;
        if (in < NT) { const TJob jn = prep_job(p, in); const float* sp = jn.src + (size_t)(jn.tr * 64 + lr) * jn.C + jn.tc * 64 + lc; v0 = *(const f32x4*)sp; v1 = *(const f32x4*)(sp + (size_t)32 * jn.C); }
        { const int c = tid >> 3, r8 = (tid & 7) * 8; float o[8];
#pragma unroll
          for (int e = 0; e < 8; ++e) o[e] = sm[(r8 + e) * 65 + c] * j.scale;
          *(u32x4*)(j.dst + (size_t)(j.tc * 64 + c) * j.R + j.tr * 64 + r8) = pack8(o); }
        __syncthreads();
    }
    const float* sgw = p.in[11]; bf16_t* sw = (bf16_t*)(p.ws + p.o_sw);
    for (int k = blockIdx.x * 512 + tid; k < DEPTH * 4 * 128 * 128; k += gridDim.x * 512) { const int s_ = k & 127, t = (k >> 7) & 127; sw[k] = (s_ <= t) ? f2bf(sgw[k]) : (bf16_t)0; }
    phase_norm_bf16(p.in[0], p.in[1], (bf16_t*)(p.ws + p.o_h), NTOK);
}

__device__ void phase_norm_bf16(const float* __restrict__ xin, const float* __restrict__ g, bf16_t* __restrict__ h, int rows) {
    const int tid = otid(), lane = tid & 63, w = tid >> 6;
    float gv[2][8];
    load8f(g + 8 * lane, gv[0]); load8f(g + 512 + 8 * lane, gv[1]);
    for (int row = blockIdx.x * 8 + w; row < rows; row += gridDim.x * 8) {
        const float* xr = xin + (size_t)row * DM + 8 * lane;
        float v[2][8]; load8f(xr, v[0]); load8f(xr + 512, v[1]);
        float ss = 0.f;
#pragma unroll
        for (int i = 0; i < 2; ++i)
#pragma unroll
            for (int j = 0; j < 8; ++j) ss += v[i][j] * v[i][j];
        ss = wave_sum(ss);
        const float r = rsqrtf(ss * (1.0f / 1024.0f) + 1e-6f);
#pragma unroll
        for (int i = 0; i < 2; ++i) { float o[8];
#pragma unroll
            for (int j = 0; j < 8; ++j) o[j] = v[i][j] * r * gv[i][j];
            *(u32x4*)(h + (size_t)row * DM + 512 * i + 8 * lane) = pack8(o); }
    }
}
__device__ void phase_norm_final(float* __restrict__ x, const float* __restrict__ g, int rows) {
    const int tid = otid(), lane = tid & 63, w = tid >> 6;
    float gv[2][8];
    load8f(g + 8 * lane, gv[0]); load8f(g + 512 + 8 * lane, gv[1]);
    for (int row = blockIdx.x * 8 + w; row < rows; row += gridDim.x * 8) {
        float* xr = x + (size_t)row * DM + 8 * lane;
        float v[2][8]; load8f(xr, v[0]); load8f(xr + 512, v[1]);
        float ss = 0.f;
#pragma unroll
        for (int i = 0; i < 2; ++i)
#pragma unroll
            for (int j = 0; j < 8; ++j) ss += v[i][j] * v[i][j];
        ss = wave_sum(ss);
        const float r = rsqrtf(ss * (1.0f / 1024.0f) + 1e-6f);
#pragma unroll
        for (int i = 0; i < 2; ++i) {
            f32x4 a, b;
#pragma unroll
            for (int j = 0; j < 4; ++j) { a[j] = v[i][j] * r * gv[i][j]; b[j] = v[i][4 + j] * r * gv[i][4 + j]; }
            *(f32x4*)(xr + 512 * i) = a; *(f32x4*)(xr + 512 * i + 4) = b; }
    }
}

#define PO(k) ((size_t)(k) * TS * BWID)
__device__ void mix_sc(const Params& p, int l, const bf16_t* proj, bf16_t* z3, int r0, int pos0) {
    const int tid = otid(), lane = tid & 63, w = tid >> 6, c0 = lane * 8;
    const float* scw = p.in[13] + (size_t)l * 3 * BWID + c0;
    float w0[8], w1[8], w2[8]; load8f(scw, w0); load8f(scw + BWID, w1); load8f(scw + 2 * BWID, w2);
    const int r = r0 + 16 * w, pos = pos0 + 16 * w;
    const bf16_t* bgp = proj + PO(6) + c0; const bf16_t* cxp = proj + PO(7) + c0;
    u32x4 vb[16], vc[18];
    vc[0] = (u32x4){0u, 0u, 0u, 0u}; vc[1] = vc[0];
    if (pos > 0) { vc[0] = *(const u32x4*)(cxp + (size_t)(r - 2) * BWID); vc[1] = *(const u32x4*)(cxp + (size_t)(r - 1) * BWID); }
#pragma unroll
    for (int jj = 0; jj < 16; ++jj) { vb[jj] = *(const u32x4*)(bgp + (size_t)(r + jj) * BWID); vc[2 + jj] = *(const u32x4*)(cxp + (size_t)(r + jj) * BWID); }
    float p2[8], p1[8];
    unpack8(vc[0], p2); unpack8(vc[1], p1);
#pragma unroll
    for (int jj = 0; jj < 16; ++jj) {
        float b[8], cur[8], o[8]; unpack8(vb[jj], b); unpack8(vc[2 + jj], cur);
#pragma unroll
        for (int j = 0; j < 8; ++j) { o[j] = b[j] * (w0[j] * p2[j] + w1[j] * p1[j] + w2[j] * cur[j]); p2[j] = p1[j]; p1[j] = cur[j]; }
        *(u32x4*)(z3 + (size_t)(r + jj) * BWID + c0) = pack8(o);
    }
}

__device__ void mix_conv(const Params& p, int l, const bf16_t* proj, bf16_t* z1, int r0, int pos0, LAS unsigned char* lds) {
    const int tid = otid(), lane = tid & 63, w = tid >> 6, c0 = lane * 8;
    LAS unsigned char* Y = lds; LAS unsigned char* W = lds + 94 * VP;
    const float* cw = p.in[5] + (size_t)l * 31 * BWID;
    float bias[8], lng[8], lnb[8];
    load8f(p.in[6] + (size_t)l * BWID + c0, bias); load8f(p.in[7] + (size_t)l * BWID + c0, lng); load8f(p.in[8] + (size_t)l * BWID + c0, lnb);
    u32x4 la[12];
#define CONV_LOAD(q) do { _Pragma("unroll") for (int i = 0; i < 12; ++i) { const int row = 12 * w + i; const bool valid = (row < 94) && (pos0 + 64 * (q) - 30 + row >= 0); \
        la[i] = (u32x4){0u, 0u, 0u, 0u}; if (valid) la[i] = *(const u32x4*)(proj + (size_t)(r0 + 64 * (q) - 30 + row) * BWID + PO(2) + c0); } } while (0)
    CONV_LOAD(0);
    for (int i = tid; i < 31 * 64; i += 512) { const int k = i >> 6, cgp = i & 63; float f[8]; load8f(cw + k * BWID + cgp * 8, f); *(LAS u32x4*)(W + k * 1024 + cgp * 16) = pack8(f); }
#pragma unroll
    for (int q = 0; q < 2; ++q) {
        const int tr = r0 + 64 * q;
        __syncthreads();
#pragma unroll
        for (int i = 0; i < 12; ++i) { const int row = 12 * w + i; if (row < 94) *(LAS u32x4*)(Y + row * VP + lane * 16) = la[i]; }
        __syncthreads();
        if (q == 0) CONV_LOAD(1);
        u32x4 gtv[8];
#pragma unroll
        for (int j = 0; j < 8; ++j) gtv[j] = *(const u32x4*)(proj + (size_t)(tr + 8 * w + j) * BWID + PO(3) + c0);
        float acc[8][8];
#pragma unroll
        for (int j = 0; j < 8; ++j)
#pragma unroll
            for (int c = 0; c < 8; ++c) acc[j][c] = bias[c];
#pragma unroll 1
        for (int k = 0; k < 31; ++k) {
            float wv[8]; unpack8(*(const LAS u32x4*)(W + k * 1024 + lane * 16), wv);
#pragma unroll
            for (int j = 0; j < 8; ++j) { float yv[8]; unpack8(*(const LAS u32x4*)(Y + (8 * w + j + k) * VP + lane * 16), yv);
#pragma unroll
                for (int c = 0; c < 8; ++c) acc[j][c] += wv[c] * yv[c]; }
        }
#pragma unroll
        for (int j = 0; j < 8; ++j) {
            float s = 0.f, ss = 0.f;
#pragma unroll
            for (int c = 0; c < 8; ++c) { s += acc[j][c]; ss += acc[j][c] * acc[j][c]; }
            s = wave_sum(s); ss = wave_sum(ss);
            const float mean = s * (1.0f / 512.0f); const float var = fmaxf(ss * (1.0f / 512.0f) - mean * mean, 0.f); const float rstd = rsqrtf(var + 1e-5f);
            const int row = tr + 8 * w + j;
            float gt[8], o[8]; unpack8(gtv[j], gt);
#pragma unroll
            for (int c = 0; c < 8; ++c) { const float v = (acc[j][c] - mean) * rstd * lng[c] + lnb[c]; o[c] = silu(v) * silu(gt[c]); }
            *(u32x4*)(z1 + (size_t)row * BWID + c0) = pack8(o);
        }
    }
}

#undef CONV_LOAD
__device__ __forceinline__ u32x4 sel4(bool c, const u32x4 a, const u32x4 b) { u32x4 r; r.x = c ? a.x : b.x; r.y = c ? a.y : b.y; r.z = c ? a.z : b.z; r.w = c ? a.w : b.w; return r; }

__device__ void mix_pool(const Params& p, int l, const bf16_t* proj, bf16_t* z0, int r0, int pos0, LAS unsigned char* lds) {
    const int tid = otid(), lane = tid & 63, w = tid >> 6, c0 = lane * 8;
    LAS unsigned char* P = lds;
    {
        const int g4 = lane >> 4, win = 2 << g4;
        const int r = r0 + 16 * w, pos = pos0 + 16 * w;
        u32x4 R[32];
#pragma unroll
        for (int i = 0; i < 16; ++i) { R[i] = (u32x4){0u, 0u, 0u, 0u}; if (pos > 0) R[i] = *(const u32x4*)(proj + (size_t)(r - 16 + i) * BWID + c0); }
#pragma unroll
        for (int i = 0; i < 16; ++i) R[16 + i] = *(const u32x4*)(proj + (size_t)(r + i) * BWID + c0);
        float S[8];
#pragma unroll
        for (int j = 0; j < 8; ++j) S[j] = 0.f;
#pragma unroll
        for (int i = 1; i <= 16; ++i) { float x[8]; unpack8(R[16 - i], x); const float mk = (i <= win) ? 1.0f : 0.0f;
#pragma unroll
            for (int j = 0; j < 8; ++j) S[j] += mk * x[j]; }
#pragma unroll
        for (int jj = 0; jj < 16; ++jj) {
            const int ps = pos + jj; float xv[8], xo[8], o[8];
            unpack8(R[16 + jj], xv);
            const u32x4 ro = sel4(g4 < 2, sel4(g4 == 0, R[16 + jj - 2], R[16 + jj - 4]), sel4(g4 == 2, R[16 + jj - 8], R[jj]));
            unpack8(ro, xo);
            const int cnt = (ps + 1 < win) ? ps + 1 : win; const float inv = 1.0f / (float)cnt;
#pragma unroll
            for (int j = 0; j < 8; ++j) { S[j] += xv[j] - xo[j]; o[j] = S[j] * inv - xv[j]; }
            *(LAS u32x4*)(P + (16 * w + jj) * VP + lane * 16) = pack8(o);
        }
    }
    __syncthreads();
    {
        const int g = w >> 1, fr = lane & 15, fq = lane >> 4;
        const bf16_t* pwT = (const bf16_t*)(p.ws + p.o_pw) + (size_t)(l * 4 + g) * 128 * 128;
        u32x2 gtv[8][4];
#pragma unroll
        for (int tt = 0; tt < 8; ++tt)
#pragma unroll
            for (int dt = 0; dt < 4; ++dt) gtv[tt][dt] = *(const u32x2*)(proj + (size_t)(r0 + 16 * tt + fr) * BWID + PO(1) + 64 * w + 16 * dt + 4 * fq);
        bf16x8 A[4][4];
#pragma unroll
        for (int dt = 0; dt < 4; ++dt)
#pragma unroll
            for (int kk = 0; kk < 4; ++kk) A[dt][kk] = *(const bf16x8*)(pwT + (size_t)(64 * (w & 1) + 16 * dt + fr) * 128 + 32 * kk + 8 * fq);
        const float* psc = p.in[4] + (size_t)l * BWID;
        f32x4 sc[4];
#pragma unroll
        for (int dt = 0; dt < 4; ++dt) sc[dt] = *(const f32x4*)(psc + 64 * w + 16 * dt + 4 * fq);
#pragma unroll
        for (int tt = 0; tt < 8; ++tt) {
            bf16x8 Bf[4];
#pragma unroll
            for (int kk = 0; kk < 4; ++kk) Bf[kk] = *(const LAS bf16x8*)(P + (16 * tt + fr) * VP + (128 * g + 32 * kk + 8 * fq) * 2);
            f32x4 acc[4];
#pragma unroll
            for (int dt = 0; dt < 4; ++dt) { acc[dt] = (f32x4){0.f, 0.f, 0.f, 0.f};
#pragma unroll
                for (int kk = 0; kk < 4; ++kk) acc[dt] = __builtin_amdgcn_mfma_f32_16x16x32_bf16(A[dt][kk], Bf[kk], acc[dt], 0, 0, 0); }
            const int row = r0 + 16 * tt + fr;
#pragma unroll
            for (int dt = 0; dt < 4; ++dt) { const int d = 64 * w + 16 * dt + 4 * fq;
                float gt[4]; unpack4(gtv[tt][dt], gt);
                u32x2 o; o.x = cvt_pk_bf16(acc[dt][0] * sc[dt][0] * silu(gt[0]), acc[dt][1] * sc[dt][1] * silu(gt[1])); o.y = cvt_pk_bf16(acc[dt][2] * sc[dt][2] * silu(gt[2]), acc[dt][3] * sc[dt][3] * silu(gt[3]));
                *(u32x2*)(z0 + (size_t)row * BWID + d) = o; }
        }
    }
}

__device__ void mix_sgu(const Params& p, int l, const bf16_t* proj, bf16_t* z2, int r0, LAS unsigned char* lds) {
    const int tid = otid(), lane = tid & 63, w = tid >> 6, c0 = lane * 8;
    LAS unsigned char* V = lds;
    {
        float lng[8], lnb[8]; load8f(p.in[9] + (size_t)l * BWID + c0, lng); load8f(p.in[10] + (size_t)l * BWID + c0, lnb);
        u32x4 R[16];
#pragma unroll
        for (int jj = 0; jj < 16; ++jj) R[jj] = *(const u32x4*)(proj + (size_t)(r0 + 16 * w + jj) * BWID + PO(5) + c0);
#pragma unroll
        for (int jj = 0; jj < 16; ++jj) {
            float x[8], o[8]; unpack8(R[jj], x);
            float s = 0.f, ss = 0.f;
#pragma unroll
            for (int c = 0; c < 8; ++c) { s += x[c]; ss += x[c] * x[c]; }
            s = wave_sum(s); ss = wave_sum(ss);
            const float mean = s * (1.0f / 512.0f); const float var = fmaxf(ss * (1.0f / 512.0f) - mean * mean, 0.f); const float rstd = rsqrtf(var + 1e-5f);
#pragma unroll
            for (int c = 0; c < 8; ++c) o[c] = (x[c] - mean) * rstd * lng[c] + lnb[c];
            *(LAS u32x4*)(V + (16 * w + jj) * VP + lane * 16) = pack8(o);
        }
    }
    __syncthreads();
    {
        const int g = w >> 1, fr = lane & 15, fq = lane >> 4;
        const unsigned vbase = (unsigned)(size_t)V;
        bf16x8 A[4][4];
#pragma unroll
        for (int ct = 0; ct < 4; ++ct)
#pragma unroll
            for (int kk = 0; kk < 4; ++kk) {
                const unsigned a = vbase + (unsigned)((32 * kk + 8 * fq + (fr >> 2)) * VP + (64 * w + 16 * ct + 4 * (fr & 3)) * 2);
                const u32x2 lo = tr_read(a), hi = tr_read(a + 4 * VP);
                u32x4 t; t.x = lo.x; t.y = lo.y; t.z = hi.x; t.w = hi.y;
                A[ct][kk] = __builtin_bit_cast(bf16x8, t);
            }
        const bf16_t* swm = (const bf16_t*)(p.ws + p.o_sw) + (size_t)(l * 4 + g) * 128 * 128;
        const float* sb = p.in[12] + (size_t)(l * 4 + g) * 128;
#pragma unroll
        for (int hb = 0; hb < 2; ++hb) {
            u32x2 uu[4][4]; bf16x8 Wf[4][4]; float bias[4];
#pragma unroll
            for (int t4 = 0; t4 < 4; ++t4) { const int tt = hb * 4 + t4; const bf16_t* pr = proj + (size_t)(r0 + 16 * tt + fr) * BWID + 64 * w + 4 * fq;
#pragma unroll
                for (int ct = 0; ct < 4; ++ct) uu[t4][ct] = *(const u32x2*)(pr + PO(4) + 16 * ct);
#pragma unroll
                for (int kk = 0; kk < 4; ++kk) if (kk < (tt >> 1) + 1) Wf[t4][kk] = *(const bf16x8*)(swm + (size_t)(16 * tt + fr) * 128 + 32 * kk + 8 * fq);
                bias[t4] = sb[16 * tt + fr]; }
#pragma unroll
            for (int t4 = 0; t4 < 4; ++t4) { const int tt = hb * 4 + t4;
                f32x4 acc[4];
#pragma unroll
                for (int ct = 0; ct < 4; ++ct) acc[ct] = (f32x4){0.f, 0.f, 0.f, 0.f};
#pragma unroll
                for (int kk = 0; kk < 4; ++kk) if (kk < (tt >> 1) + 1) {
#pragma unroll
                    for (int ct = 0; ct < 4; ++ct) acc[ct] = __builtin_amdgcn_mfma_f32_16x16x32_bf16(A[ct][kk], Wf[t4][kk], acc[ct], 0, 0, 0); }
                const int row = r0 + 16 * tt + fr;
#pragma unroll
                for (int ct = 0; ct < 4; ++ct) { const int c = 64 * w + 16 * ct + 4 * fq;
                    float u[4]; unpack4(uu[t4][ct], u);
                    u32x2 o; o.x = cvt_pk_bf16(u[0] * (acc[ct][0] + bias[t4]), u[1] * (acc[ct][1] + bias[t4])); o.y = cvt_pk_bf16(u[2] * (acc[ct][2] + bias[t4]), u[3] * (acc[ct][3] + bias[t4]));
                    *(u32x2*)(z2 + (size_t)row * BWID + c) = o; }
            }
        }
    }
}

__device__ void phase_mix(const Params& p, int l, const bf16_t* proj, bf16_t* z, LAS unsigned char* lds) {
    constexpr int nchunk = TS / 128;
    for (int i = blockIdx.x; i < 4 * nchunk; i += gridDim.x) {
        const int j = i % nchunk, br = ((i / nchunk) + j) & 3, r0 = j * 128, pos0 = (j & 15) * 128;
        if (br == 0) for (int rr = 0; rr < REP_M0; ++rr) { mix_pool(p, l, proj, z + PO(1), r0, pos0, lds); __syncthreads(); }
        else if (br == 1) for (int rr = 0; rr < REP_M1; ++rr) { mix_conv(p, l, proj, z + PO(3), r0, pos0, lds); __syncthreads(); }
        else if (br == 2) for (int rr = 0; rr < REP_M2; ++rr) { mix_sgu(p, l, proj, z + PO(4), r0, lds); __syncthreads(); }
        else for (int rr = 0; rr < REP_M3; ++rr) { mix_sc(p, l, proj, z + PO(6), r0, pos0); __syncthreads(); }
    }
}

#define XB_TMO      128
#define XB_XCNT(j)  (256  + 64 * (j))
#define XB_XSUB(j)  (1280 + 64 * (j))
#define XB_XGEN(j)  (2304 + 64 * (j))
#define XB_TOP      3328
#define XB_TOPGEN   3392
#define XCD_BAR_WORDS 3456
#define XB_SPIN_CAP (1u << 20)
__device__ __forceinline__ unsigned xb_ld(unsigned* p)              { return __hip_atomic_load(p, __ATOMIC_RELAXED, __HIP_MEMORY_SCOPE_AGENT); }
__device__ __forceinline__ unsigned xb_add(unsigned* p, unsigned v) { return __hip_atomic_fetch_add(p, v, __ATOMIC_RELAXED, __HIP_MEMORY_SCOPE_AGENT); }
__device__ __forceinline__ unsigned xb_xcc_id() { return (unsigned)__builtin_amdgcn_s_getreg((3 << 11) | 20) & 0xFu; }
#define XB_SPIN(cond, bar) do { unsigned _sp = 0; while (cond) { __builtin_amdgcn_s_sleep(1); \
    if ((++_sp & 255u) == 0u) { if (xb_ld(&(bar)[XB_TMO])) break; if (_sp > XB_SPIN_CAP) { atomicAdd(&(bar)[XB_TMO], 1u); break; } } } } while (0)
struct XcdBarrier { unsigned* bar; unsigned x; volatile LAS unsigned* st; };
__device__ __forceinline__ XcdBarrier xcd_barrier_post(unsigned* bar, volatile LAS unsigned* st) {
    XcdBarrier b; b.bar = bar; b.x = xb_xcc_id(); b.st = st;
    if (threadIdx.x == 0) (void)xb_add(&bar[XB_XCNT(b.x)], 1u);
    return b;
}
__device__ __forceinline__ void xcd_barrier_complete(unsigned* bar, unsigned x, unsigned& nloc, unsigned& nx) {
    const unsigned G = gridDim.x * gridDim.y * gridDim.z;
    unsigned sum, cnt, mine, sp = 0u;
    for (;;) {
        sum = 0u; cnt = 0u; mine = 0u;
#pragma unroll
        for (unsigned j = 0; j < 16; ++j) { const unsigned c = xb_ld(&bar[XB_XCNT(j)]); sum += c; cnt += (c > 0u) ? 1u : 0u; mine = (j == x) ? c : mine; }
        if (sum == G) break;
        __builtin_amdgcn_s_sleep(1);
        if ((++sp & 255u) == 0u) { if (xb_ld(&bar[XB_TMO])) break; if (sp > XB_SPIN_CAP) { atomicAdd(&bar[XB_TMO], 1u); break; } }
    }
    nloc = mine > 0u ? mine : 1u; nx = cnt > 0u ? cnt : 1u;
}
__device__ __forceinline__ void xcd_barrier(const XcdBarrier& b) {
    asm volatile("s_waitcnt vmcnt(0)" ::: "memory");
    __syncthreads();
    if (threadIdx.x == 0) {
        unsigned* bar = b.bar;
        __builtin_amdgcn_s_waitcnt(0);
        unsigned nloc = b.st[0], nx = b.st[1];
        if (nloc == 0u) { xcd_barrier_complete(bar, b.x, nloc, nx); b.st[0] = nloc; b.st[1] = nx; }
        const unsigned old = xb_add(&bar[XB_XSUB(b.x)], 1u);
        const unsigned gen = old / nloc;
        if (old + 1u == (gen + 1u) * nloc) {
            __builtin_amdgcn_fence(__ATOMIC_RELEASE, "agent");
            asm volatile("s_waitcnt vmcnt(0)" ::: "memory");
            const unsigned og = xb_add(&bar[XB_TOP], 1u);
            const unsigned tg = og / nx;
            if (og + 1u == (tg + 1u) * nx) xb_add(&bar[XB_TOPGEN], 1u);
            else XB_SPIN(xb_ld(&bar[XB_TOPGEN]) == tg, bar);
            __builtin_amdgcn_fence(__ATOMIC_ACQUIRE, "agent");
            xb_add(&bar[XB_XGEN(b.x)], 1u);
            asm volatile("s_waitcnt vmcnt(0)" ::: "memory");
        } else {
            XB_SPIN(xb_ld(&bar[XB_XGEN(b.x)]) == gen, bar);
            __builtin_amdgcn_fence(__ATOMIC_ACQUIRE, "agent");
            asm volatile("s_waitcnt vmcnt(0)" ::: "memory");
        }
    }
    __syncthreads();
}

__global__ void __launch_bounds__(512) mk_forward(Params p) {
    extern __shared__ __attribute__((aligned(16))) unsigned char lds_raw[];
    LAS unsigned char* lds = (LAS unsigned char*)lds_raw;
    cg::grid_group grid = cg::this_grid();
    volatile LAS unsigned* stw = (volatile LAS unsigned*)(lds + LDS_BYTES - 16);
    if (threadIdx.x == 0) { stw[0] = 0u; stw[1] = 0u; }
    __syncthreads();
    const XcdBarrier xbar = xcd_barrier_post((unsigned*)(p.ws + p.o_bar), stw);
    int ph = 0;
#define PHASE_ON (ph >= p.ph_lo && ph < p.ph_hi)
#ifndef XSYNC
#define XSYNC 0
#endif
#define PHASE_END do { if (PHASE_ON && ph + 1 < p.ph_hi) { if (p.ph_hi > 100000) grid.sync();   xcd_barrier(xbar); for (int xs = 0; xs < XSYNC; ++xs) xcd_barrier(xbar); } ++ph; } while (0)
    constexpr int ts = TS;
    bf16_t* win = (bf16_t*)(p.ws + p.o_win); bf16_t* wb = (bf16_t*)(p.ws + p.o_wb); bf16_t* wo = (bf16_t*)(p.ws + p.o_wo);
    bf16_t* h0 = (bf16_t*)(p.ws + p.o_h); bf16_t* proj = (bf16_t*)(p.ws + p.o_proj);

    if (PHASE_ON) phase_prep(p, lds);
    PHASE_END;
#pragma unroll 1
    for (int l = 0; l < DEPTH; ++l) {
        const float* xin = (l == 0) ? p.in[0] : p.out;
#pragma unroll 1
        for (int s = 0; s < NS; ++s) {
            const size_t tok0 = (size_t)s * ts;
            bf16_t* h = h0 + tok0 * DM; bf16_t* merged = h;
            if (l > 0) { if (PHASE_ON) phase_norm_bf16(xin + tok0 * DM, p.in[1] + (size_t)l * DM, h, ts);
                PHASE_END; }
            if (PHASE_ON) for (int rep = 0; rep < REP_A; ++rep) { pg8::Gemm g{h, win + (size_t)l * DM * INC}; pg8::OrderA S; S.G = (int)gridDim.x; S.c = (int)blockIdx.x; pg8::EpiProj E{proj, proj + (size_t)8 * TS * BWID}; pg8::gemm_phase<DM, 0>(lds, g, S, E); }
            PHASE_END;
            if (PHASE_ON) phase_mix(p, l, proj, proj, lds);
            PHASE_END;
            if (PHASE_ON) for (int rep = 0; rep < REP_C; ++rep) { pg8::Gemm g{proj, wb + (size_t)l * 4 * BWID * DM}; pg8::OrderC S; S.G = (int)gridDim.x; S.c = (int)blockIdx.x;
                pg8::EpiGate E{proj + (size_t)8 * TS * BWID, merged}; pg8::gemm_phase<BWID, (size_t)BWID * DM * 2>(lds, g, S, E); }
            PHASE_END;
            if (PHASE_ON) { pg8::Gemm g{merged, wo + (size_t)l * DM * DM}; pg8::Order<TS / 256, DM / 256, 1> S{(int)gridDim.x, (int)blockIdx.x};
                pg8::EpiRes E{xin + tok0 * DM, p.out + tok0 * DM, DM}; pg8::gemm_phase<DM, 0>(lds, g, S, E); }
            PHASE_END;
        }
    }
    if (PHASE_ON) phase_norm_final(p.out, p.in[16], NTOK);
    PHASE_END;
}

extern "C" void kernel_launch(void* const* d_in, const int* in_sizes, int n_in, void* d_out, int out_size, void* d_ws, size_t ws_size, hipStream_t stream) {
    static int grid = 0;
    if (grid == 0) {
        int dev = 0, cus = 0, per_cu = 0;
        hipGetDevice(&dev); hipDeviceGetAttribute(&cus, hipDeviceAttributeMultiprocessorCount, dev);
        if (hipFuncSetAttribute((const void*)mk_forward, hipFuncAttributeMaxDynamicSharedMemorySize, LDS_BYTES) != hipSuccess) { fprintf(stderr, "hipFuncSetAttribute failed\n"); grid = -1; return; }
        if (hipOccupancyMaxActiveBlocksPerMultiprocessor(&per_cu, (const void*)mk_forward, 512, LDS_BYTES) != hipSuccess || per_cu < 1) { fprintf(stderr, "occupancy query: %d\n", per_cu); per_cu = 1; }
        (void)hipGetLastError();
        grid = cus * per_cu;
    }
    if (grid < 0) return;
    Params p{};
    for (int i = 0; i < 17; ++i) p.in[i] = (const float*)d_in[i];
    p.out = (float*)d_out; p.ws = (unsigned char*)d_ws;
    p.ns = NS; p.ts = TS;
    size_t o = 0;
    p.o_win = o; o += (size_t)DEPTH * DM * INC * 2;
    p.o_wb = o; o += (size_t)DEPTH * 4 * BWID * DM * 2;
    p.o_wo = o; o += (size_t)DEPTH * DM * DM * 2;
    p.o_pw = o; o += (size_t)DEPTH * 4 * 128 * 128 * 2;
    p.o_sw = o; o += (size_t)DEPTH * 4 * 128 * 128 * 2;
    p.o_bar = o; o += 16384;
    p.o_h = o; o += (size_t)NTOK * DM * 2;
    p.o_z = 0;
    p.o_proj = o; o += (size_t)p.ts * (8 * BWID * 2 + 4096);
    if (o > ws_size) { fprintf(stderr, "kernel_launch: workspace too small: need %zu, have %zu\n", o, ws_size); return; }
    const int nph = 1 + NS * 4 + (DEPTH - 1) * NS * 5 + 1;
    if (hipMemsetAsync((char*)d_ws + p.o_bar, 0, 16384, stream) != hipSuccess) { fprintf(stderr, "kernel_launch: memset failed\n"); return; }
#if MULTI_LAUNCH
    for (int ph = 0; ph < nph; ++ph) { p.ph_lo = ph; p.ph_hi = ph + 1; hipLaunchKernelGGL(mk_forward, dim3(grid), dim3(512), LDS_BYTES, stream, p); }
#else
    p.ph_lo = 0; p.ph_hi = nph;
    void* args[] = {&p};
    hipError_t e = hipLaunchCooperativeKernel((const void*)mk_forward, dim3(grid), dim3(512), args, LDS_BYTES, stream);
    if (e != hipSuccess) fprintf(stderr, "cooperative launch failed: %s (grid %d)\n", hipGetErrorString(e), grid);
#endif
}
```

```cpp
#include <hip/hip_runtime.h>
#include <hip/hip_cooperative_groups.h>
#include <cstdio>
namespace cg = cooperative_groups;

#ifndef MULTI_LAUNCH
#define MULTI_LAUNCH 0
#endif

#ifndef REP_N
#define REP_N 1
#endif
#ifndef REP_A
#define REP_A 1
#endif
#ifndef REP_B
#define REP_B 1
#endif
#ifndef REP_C
#define REP_C 1
#endif
#define REP_M0 1
#define REP_M1 1
#define REP_M2 1
#define REP_M3 1
#define LAS __attribute__((address_space(3)))
typedef unsigned short bf16_t;
typedef short bf16x8 __attribute__((ext_vector_type(8)));
typedef float f32x4 __attribute__((ext_vector_type(4)));
typedef float f32x2 __attribute__((ext_vector_type(2)));
typedef unsigned u32x4 __attribute__((ext_vector_type(4)));
typedef unsigned u32x2 __attribute__((ext_vector_type(2)));
typedef int i32x8 __attribute__((ext_vector_type(8)));
typedef int i32x4 __attribute__((ext_vector_type(4)));
constexpr int WINR = 6144;

constexpr int DM = 1024, SEQ = 2048, NTOK = 32 * 2048, DEPTH = 2, BWID = 512, INC = 10240, GATE0 = 6144;
constexpr int PP = 6144;
constexpr int NS = 1, TS = NTOK / NS;
constexpr int LDS_BYTES = 139264;
constexpr int VP = 1040;

constexpr int SM1 = 0, SM4 = 2048, SM5 = 3072, SM6 = 34816, SM7 = 35840, SM8 = 36864, SM9 = 37888, SM10 = 38912, SM12 = 39936, SM13 = 40960, SM16 = 44032, SM_TOTAL = 45056;
#define SMALLP(p, OFF) ((const float*)((p).ws + (p).o_small) + (OFF))
struct Params {
    const float* in[17];
    float* out;
    unsigned char* ws;
    int ph_hi;
    unsigned o_win, o_wb, o_wo, o_pw, o_sw, o_h, o_bar, o_proj, o_h8, o_wg8, o_small;
};

__device__ __forceinline__ int lane_id() { return (int)__builtin_amdgcn_mbcnt_hi(~0u, __builtin_amdgcn_mbcnt_lo(~0u, 0u)); }
__device__ __forceinline__ int otid(int wid0) { int t; asm volatile("v_mbcnt_lo_u32_b32 %0, -1, 0\n\tv_mbcnt_hi_u32_b32 %0, -1, %0" : "=v"(t)); return (wid0 << 6) | t; }
__device__ __forceinline__ unsigned cvt_pk_bf16(float lo, float hi) { unsigned r; asm volatile("v_cvt_pk_bf16_f32 %0, %1, %2" : "=v"(r) : "v"(lo), "v"(hi)); return r; }
__device__ __forceinline__ bf16_t f2bf(float f) { unsigned u = __float_as_uint(f); u += 0x7FFFu + ((u >> 16) & 1u); return (bf16_t)(u >> 16); }
__device__ __forceinline__ void unpack8(const u32x4 v, float (&f)[8]) {
    f[0] = __uint_as_float(v.x << 16); f[1] = __uint_as_float(v.x & 0xffff0000u); f[2] = __uint_as_float(v.y << 16); f[3] = __uint_as_float(v.y & 0xffff0000u);
    f[4] = __uint_as_float(v.z << 16); f[5] = __uint_as_float(v.z & 0xffff0000u); f[6] = __uint_as_float(v.w << 16); f[7] = __uint_as_float(v.w & 0xffff0000u);
}
__device__ __forceinline__ u32x4 pack8(const float (&f)[8]) { u32x4 r; r.x = cvt_pk_bf16(f[0], f[1]); r.y = cvt_pk_bf16(f[2], f[3]); r.z = cvt_pk_bf16(f[4], f[5]); r.w = cvt_pk_bf16(f[6], f[7]); return r; }
__device__ __forceinline__ void unpack4(const u32x2 v, float (&f)[4]) { f[0] = __uint_as_float(v.x << 16); f[1] = __uint_as_float(v.x & 0xffff0000u); f[2] = __uint_as_float(v.y << 16); f[3] = __uint_as_float(v.y & 0xffff0000u); }
__device__ __forceinline__ float sigm(float x) { return __builtin_amdgcn_rcpf(1.0f + __expf(-x)); }
__device__ __forceinline__ float silu(float x) { return x * sigm(x); }
__device__ __forceinline__ void load8f(const float* p, float (&f)[8]) { const f32x4 a = *(const f32x4*)p, b = *(const f32x4*)(p + 4); f[0] = a[0]; f[1] = a[1]; f[2] = a[2]; f[3] = a[3]; f[4] = b[0]; f[5] = b[1]; f[6] = b[2]; f[7] = b[3]; }
__device__ __forceinline__ float wave_sum(int wid0, float v) {
    const int lane = otid(wid0) & 63;
#pragma unroll
    for (int o = 32; o >= 1; o >>= 1) v += __builtin_bit_cast(float, __builtin_amdgcn_ds_bpermute((lane ^ o) << 2, __builtin_bit_cast(int, v)));
    return v;
}
__device__ __forceinline__ u32x2 tr_read(unsigned lds_addr) { u32x2 r; asm volatile("ds_read_b64_tr_b16 %0, %1\n\ts_waitcnt lgkmcnt(0)" : "=&v"(r) : "v"(lds_addr) : "memory"); return r; }

namespace pg8 {
constexpr int BM = 256, BK = 64, HALF = 128, HTB = HALF * BK * 2, STAGE_BYTES = 8 * HTB, NXCD = 8, WGM = 8;
__device__ __forceinline__ int lds_byte(int r, int c) { const int st = (r >> 4) * 2 + (c >> 5), rr = r & 15, cc = c & 31, ob = rr * 64 + cc * 2; return st * 1024 + (ob ^ (((ob >> 9) & 1) << 5)); }
__device__ __forceinline__ void stage_rc(int b, int& R, int& C) { const int st = b / 1024, sb = b % 1024, swz = sb ^ (((sb >> 9) & 1) << 5); R = (st >> 1) * 16 + swz / 64; C = (st & 1) * 32 + (swz % 64) / 2; }
__device__ __forceinline__ int perm32(int rho) { const int n = rho >> 4, i = rho & 15; return 8 * (i >> 2) + 4 * n + (i & 3); }

struct Unit { int pm, pn, br; };
struct Gemm { const bf16_t* A; const bf16_t* Bt; };

template <int NM, int NN, int NBR>
struct Order {
    int G, c;
    __device__ __forceinline__ bool next(int i, Unit& u) const {
        constexpr int nwg = NM * NN;
        const int ti = i / NBR;
        const long L = (long)ti * G + c; if (L >= nwg) return false;
        int wgid = (int)L; { constexpr int q = nwg / NXCD, r = nwg % NXCD; const int xcd = wgid % NXCD, off = wgid / NXCD; wgid = (xcd < r ? xcd * (q + 1) : r * (q + 1) + (xcd - r) * q) + off; }
        constexpr int nig = WGM * NN; const int gid = wgid / nig, fm = gid * WGM, gsz = (NM - fm) < WGM ? (NM - fm) : WGM;
        u.pm = fm + ((wgid % nig) % gsz); u.pn = (wgid % nig) / gsz; u.br = i % NBR; return true;
    }
    __device__ __forceinline__ void brow(const Unit& u, int& r0, int& r1) const { r0 = u.pn * BM; r1 = r0 + HALF; }
    __device__ __forceinline__ size_t aoff(const Unit&) const { return 0; }
};
struct OrderC : Order<TS / 256, DM / 256, 4> {
    __device__ __forceinline__ size_t aoff(const Unit& u) const { const int slot = (u.br == 0) ? 1 : (u.br == 1) ? 3 : (u.br == 2) ? 4 : 6; return (size_t)slot * TS * BWID * 2; }
};
struct OrderA : Order<TS / 256, WINR / 256, 1> {
    __device__ __forceinline__ void brow(const Unit& u, int& r0, int& r1) const {
        const int pn = u.pn;
        if (pn < 8) { const int pc = pn >> 1; const int piece = (pc == 0) ? 0 : (pc == 1) ? 1 : (pc == 2) ? 4 : 6; r0 = piece * 512 + (pn & 1) * 256; r1 = r0 + HALF; }
        else if (pn < 24) { const int q = (pn - 8) >> 2, sub = (pn - 8) & 3; const int pa = (q == 0) ? 2 : (q == 1) ? 9 : (q == 2) ? 8 : 5, pb = (q == 0) ? 3 : (q == 1) ? 10 : (q == 2) ? 11 : 7;
            r0 = pa * 512 + HALF * sub; r1 = pb * 512 + HALF * sub; }
        else { r0 = pn * BM; r1 = r0 + HALF; }
    }
};

struct EpiProj {
    static constexpr bool PERM = true;
    static __device__ __forceinline__ bool zero_after(const Unit&) { return true; }
    bf16_t* O;
    __device__ __forceinline__ void operator()(f32x4 (&acc)[2][2][4][2], const Unit& u, int wr, int wc, int fr_, int fq) const {
        int fr = fr_; asm volatile("" : "+v"(fr));
        if (u.pn < 8) {
            const int pc = u.pn >> 1; const int slot = (pc == 0) ? 0 : (pc == 1) ? 1 : (pc == 2) ? 3 : 5;
            const int row0 = u.pm * BM + wr * 64 + fr, col0 = (u.pn & 1) * BM + wc * 32 + 8 * fq;
            bf16_t* Op = O + (size_t)slot * TS * BWID;
#pragma unroll
            for (int ai = 0; ai < 2; ++ai)
#pragma unroll
                for (int m = 0; m < 4; ++m) { bf16_t* rowp = Op + (size_t)(row0 + ai * HALF + m * 16) * BWID + col0;
#pragma unroll
                    for (int bj = 0; bj < 2; ++bj) { const f32x4 v0 = acc[ai][bj][m][0], v1 = acc[ai][bj][m][1];
                        u32x4 w; w.x = cvt_pk_bf16(v0[0], v0[1]); w.y = cvt_pk_bf16(v0[2], v0[3]); w.z = cvt_pk_bf16(v1[0], v1[1]); w.w = cvt_pk_bf16(v1[2], v1[3]);
                        __builtin_nontemporal_store(w, (u32x4*)(rowp + bj * HALF)); } }
        } else {
            const int q = (u.pn - 8) >> 2, sub = (u.pn - 8) & 3; const int slot = (q == 0) ? 2 : (q == 1) ? 7 : (q == 2) ? 6 : 4;
            const int row0 = u.pm * BM + wr * 64 + fr, col0 = sub * HALF + wc * 32 + 8 * fq;
            bf16_t* Op = O + (size_t)slot * TS * BWID;
#pragma unroll
            for (int ai = 0; ai < 2; ++ai)
#pragma unroll
                for (int m = 0; m < 4; ++m) {
                    float f[8];
#pragma unroll
                    for (int n = 0; n < 2; ++n)
#pragma unroll
                        for (int j = 0; j < 4; ++j) { const float av = acc[ai][0][m][n][j], bv = acc[ai][1][m][n][j];
                            const float sg = __builtin_amdgcn_rcpf(1.0f + __builtin_amdgcn_exp2f(bv));
                            f[n * 4 + j] = av * ((q == 1) ? bv : (q == 0) ? sg : bv * sg); }
                    __builtin_nontemporal_store(pack8(f), (u32x4*)(Op + (size_t)(row0 + ai * HALF + m * 16) * BWID + col0)); }
        }
    }
};
struct EpiGateStore {
    static constexpr bool PERM = true;
    static __device__ __forceinline__ bool zero_after(const Unit&) { return true; }
    unsigned char* G;
    __device__ __forceinline__ void operator()(f32x4 (&acc)[2][2][4][2], const Unit& u, int wr, int wc, int fr_, int fq) const {
        int fr = fr_; asm volatile("" : "+v"(fr));
        unsigned char* gb = G + ((size_t)u.pm * 16 + u.pn) * 65536 + (((wr * 4 + wc) * 4 + fq) * 16 + fr) * 16;
        const float c255 = 1.0f / 255.0f;
#pragma unroll
        for (int ai = 0; ai < 2; ++ai)
#pragma unroll
            for (int m = 0; m < 4; ++m) {
                u32x4 w;
#pragma unroll
                for (int bj = 0; bj < 2; ++bj)
#pragma unroll
                    for (int n = 0; n < 2; ++n) { unsigned q = 0u;
#pragma unroll
                        for (int j = 0; j < 4; ++j) q = __builtin_amdgcn_cvt_pk_u8_f32(fmaxf(__builtin_amdgcn_rcpf(__builtin_fmaf(__builtin_amdgcn_exp2f(acc[ai][bj][m][n][j] * 0.03125f), c255, c255)), 1.0f), j, q);
                        w[bj * 2 + n] = q; }
                __builtin_nontemporal_store(w, (u32x4*)(gb + (ai * 4 + m) * 8192));
                __builtin_amdgcn_sched_barrier(0); }
    }
};
struct EpiGate {
    static constexpr bool PERM = true;
    static __device__ __forceinline__ bool zero_after(const Unit& u) { return u.br == 3; }
    const bf16_t* G; bf16_t* merged;
    __device__ __forceinline__ void operator()(f32x4 (&acc)[2][2][4][2], const Unit& u, int wr, int wc, int fr_, int fq) const {
        int fr = fr_; asm volatile("" : "+v"(fr));
        const int lrow0 = wr * 64 + fr, lcol0 = wc * 32 + 8 * fq;
        const int br = u.br;
        const bool lastb = (br == 3);
        const unsigned char* gp0 = (const unsigned char*)G + ((size_t)u.pm * 16 + br * 4 + u.pn) * 65536 + (((wr * 4 + wc) * 4 + fq) * 16 + fr) * 16;
        const unsigned char* gnp = lastb ? gp0 : gp0 + 4 * 65536;
        u32x4 gc[2][4], gn[2][4];
#pragma unroll
        for (int ai = 0; ai < 2; ++ai)
#pragma unroll
            for (int m = 0; m < 4; ++m) { gc[ai][m] = *(const u32x4*)(gp0 + (ai * 4 + m) * 8192); gn[ai][m] = (u32x4){0u, 0u, 0u, 0u}; if (!lastb) gn[ai][m] = *(const u32x4*)(gnp + (ai * 4 + m) * 8192); }
#pragma unroll
        for (int ai = 0; ai < 2; ++ai)
#pragma unroll
            for (int m = 0; m < 4; ++m)
#pragma unroll
                for (int bj = 0; bj < 2; ++bj) {
#pragma unroll
                    for (int n = 0; n < 2; ++n) {
                        const unsigned c = gc[ai][m][bj * 2 + n], d = gn[ai][m][bj * 2 + n];
                        float fc[4], fd[4];
                        fc[0] = (float)(c & 0xffu); fc[1] = (float)((c >> 8) & 0xffu); fc[2] = (float)((c >> 16) & 0xffu); fc[3] = (float)(c >> 24);
                        fd[0] = (float)(d & 0xffu); fd[1] = (float)((d >> 8) & 0xffu); fd[2] = (float)((d >> 16) & 0xffu); fd[3] = (float)(d >> 24);
#pragma unroll
                        for (int j = 0; j < 4; ++j) acc[ai][bj][m][n][j] *= fc[j] * (lastb ? (1.0f / 255.0f) : __builtin_amdgcn_rcpf(fd[j]));
                    }
                    if (lastb) { const f32x4 v0 = acc[ai][bj][m][0], v1 = acc[ai][bj][m][1];
                        u32x4 w; w.x = cvt_pk_bf16(v0[0], v0[1]); w.y = cvt_pk_bf16(v0[2], v0[3]); w.z = cvt_pk_bf16(v1[0], v1[1]); w.w = cvt_pk_bf16(v1[2], v1[3]);
                        *(u32x4*)(merged + ((size_t)u.pm * BM + lrow0 + ai * HALF + m * 16) * DM + u.pn * BM + lcol0 + bj * HALF) = w; }
                }
    }
};
struct EpiRes {
    static constexpr bool PERM = false;
    static __device__ __forceinline__ bool zero_after(const Unit&) { return true; }
    const float* res; float* C; int ldc;
    __device__ __forceinline__ void operator()(const f32x4 (&acc)[2][2][4][2], const Unit& u, int wr, int wc, int fr_, int fq) const {
        int fr = fr_; asm volatile("" : "+v"(fr));
        const int row0 = u.pm * BM + wr * 64 + fr, col0 = u.pn * BM + wc * 32 + 4 * fq;
#pragma unroll
        for (int ai = 0; ai < 2; ++ai)
#pragma unroll
            for (int m = 0; m < 4; ++m) { const size_t off = (size_t)(row0 + ai * HALF + m * 16) * ldc + col0;
                f32x4 rv[2][2];
#pragma unroll
                for (int bj = 0; bj < 2; ++bj)
#pragma unroll
                    for (int n = 0; n < 2; ++n) rv[bj][n] = *(const f32x4*)(res + off + bj * HALF + n * 16);
#pragma unroll
                for (int bj = 0; bj < 2; ++bj)
#pragma unroll
                    for (int n = 0; n < 2; ++n) *(f32x4*)(C + off + bj * HALF + n * 16) = acc[ai][bj][m][n] + rv[bj][n]; }
    }
};

template <int K, size_t B_BR, class Epi, class Sched>
__device__ __forceinline__ void gemm_phase(int wid0, LAS unsigned char* lds, const Gemm g, const Sched& S, const Epi& E) {
    const int tid = otid(wid0), wid = __builtin_amdgcn_readfirstlane(tid >> 6), lane = tid & 63, wr = wid >> 2, wc = wid & 3, fr = lane & 15, fq = lane >> 4;
    constexpr int nt = K / BK;
    unsigned voffA[2], voffB[2];
#pragma unroll
    for (int i = 0; i < 2; ++i) { int R, C; stage_rc(tid * 16 + i * 8192, R, C); const int Rb = Epi::PERM ? ((R & ~31) + perm32(R & 31)) : R;
        voffA[i] = (unsigned)(R * K + C) * 2u; voffB[i] = (unsigned)(Rb * K + C) * 2u; }
    constexpr size_t kstep = (size_t)(BK * 2);
    constexpr size_t hstep = (size_t)HALF * K * 2;
    constexpr size_t tstep = 2 * hstep;
    const unsigned ldsw = (unsigned)wid * 1024u;
    const int aoff = lds_byte(wr * 64 + fr, fq * 8), boff = lds_byte(wc * 32 + fr, fq * 8);
#define PG8_SA(b, h) (((b) * 2 + (h)) * HTB)
#define PG8_SB(b, h) ((4 + (b) * 2 + (h)) * HTB)
#define PG8_STAGE(bufoff, gbase, voff) do { _Pragma("unroll") for (int _i = 0; _i < 2; ++_i) \
        __builtin_amdgcn_global_load_lds((const unsigned*)((const char*)(gbase) + (voff)[_i]), (LAS unsigned*)(lds + (bufoff) + ldsw + _i * 8192), 16, 0, 0); } while (0)
#define PG8_LDA(dst, b, h) do { _Pragma("unroll") for (int m = 0; m < 4; ++m) _Pragma("unroll") for (int k = 0; k < 2; ++k) dst[m][k] = *(const LAS bf16x8*)(lds + PG8_SA(b, h) + aoff + m * 2048 + k * 1024); } while (0)
#define PG8_LDB(dst, b, h) do { _Pragma("unroll") for (int n = 0; n < 2; ++n) _Pragma("unroll") for (int k = 0; k < 2; ++k) dst[n][k] = *(const LAS bf16x8*)(lds + PG8_SB(b, h) + boff + n * 2048 + k * 1024); } while (0)
#define PG8_MMA(ai, bj, At, Bt) do { __builtin_amdgcn_s_setprio(1); _Pragma("unroll") for (int m = 0; m < 4; ++m) _Pragma("unroll") for (int n = 0; n < 2; ++n) _Pragma("unroll") for (int k = 0; k < 2; ++k) \
        acc[ai][bj][m][n] = __builtin_amdgcn_mfma_f32_16x16x32_bf16(Bt[n][k], At[m][k], acc[ai][bj][m][n], 0, 0, 0); __builtin_amdgcn_s_setprio(0); } while (0)
#define PG8_WAIT_V(n) asm volatile("s_waitcnt vmcnt(" #n ")" ::: "memory")
#define PG8_WAIT_L(n) asm volatile("s_waitcnt lgkmcnt(" #n ")" ::: "memory")
#define PG8_BAR __builtin_amdgcn_s_barrier()
#define PG8_SCHED __builtin_amdgcn_sched_barrier(0)
    Unit cur, nxt; int ui = 0;
    if (!S.next(0, cur)) return;
    f32x4 acc[2][2][4][2];
#pragma unroll
    for (int a = 0; a < 2; ++a)
#pragma unroll
        for (int b = 0; b < 2; ++b)
#pragma unroll
            for (int m = 0; m < 4; ++m)
#pragma unroll
                for (int n = 0; n < 2; ++n) acc[a][b][m][n] = (f32x4){0.f, 0.f, 0.f, 0.f};
    bf16x8 At[4][2], B0[2][2], B1[2][2];
    const char* cA = (const char*)g.A + (size_t)cur.pm * tstep + S.aoff(cur); int rb0, rb1; S.brow(cur, rb0, rb1);
    const char* cB = (const char*)g.Bt + (size_t)rb0 * (K * 2) + (size_t)cur.br * B_BR; const char* cBh = (const char*)g.Bt + (size_t)rb1 * (K * 2) + (size_t)cur.br * B_BR;
    PG8_STAGE(PG8_SB(0, 0), cB, voffB); PG8_STAGE(PG8_SA(0, 0), cA, voffA); PG8_STAGE(PG8_SB(0, 1), cBh, voffB); PG8_STAGE(PG8_SA(0, 1), cA + hstep, voffA);
    if (wr == 1) PG8_BAR;
    PG8_WAIT_V(4); PG8_BAR;
    PG8_STAGE(PG8_SB(1, 0), cB + kstep, voffB); PG8_STAGE(PG8_SA(1, 0), cA + kstep, voffA); PG8_STAGE(PG8_SB(1, 1), cBh + kstep, voffB);
    PG8_WAIT_V(6); PG8_BAR;
    for (;;) {
        const bool has_next = S.next(ui + 1, nxt);
        const char* nA = has_next ? (const char*)g.A + (size_t)nxt.pm * tstep + S.aoff(nxt) : cA; int rn0 = 0, rn1 = 0; if (has_next) S.brow(nxt, rn0, rn1);
        const char* nB = has_next ? (const char*)g.Bt + (size_t)rn0 * (K * 2) + (size_t)nxt.br * B_BR : cB; const char* nBh = has_next ? (const char*)g.Bt + (size_t)rn1 * (K * 2) + (size_t)nxt.br * B_BR : cBh;
        for (int t = 0; t < nt; t += 2) {
            const bool last = (t == nt - 2);
            const char* a1 = cA + (size_t)(t + 1) * kstep;
            const char* a2 = last ? nA : cA + (size_t)(t + 2) * kstep; const char* b2 = last ? nB : cB + (size_t)(t + 2) * kstep; const char* b2h = last ? nBh : cBh + (size_t)(t + 2) * kstep;
            const char* a3 = a2 + kstep; const char* b3 = b2 + kstep; const char* b3h = b2h + kstep;
            PG8_LDB(B0, 0, 0); PG8_SCHED; PG8_LDA(At, 0, 0); PG8_STAGE(PG8_SA(1, 1), a1 + hstep, voffA);
            PG8_WAIT_L(8); PG8_BAR; PG8_WAIT_L(0); PG8_MMA(0, 0, At, B0); PG8_BAR; PG8_SCHED;
            PG8_LDB(B1, 0, 1); PG8_STAGE(PG8_SB(0, 0), b2, voffB);
            PG8_BAR; PG8_WAIT_L(0); PG8_MMA(0, 1, At, B1); PG8_BAR;
            PG8_LDA(At, 0, 1); PG8_STAGE(PG8_SA(0, 0), a2, voffA);
            PG8_BAR; PG8_WAIT_L(0); PG8_MMA(1, 0, At, B0); PG8_BAR; PG8_SCHED;
            PG8_STAGE(PG8_SB(0, 1), b2h, voffB);
            PG8_WAIT_V(6); PG8_BAR; PG8_MMA(1, 1, At, B1); PG8_BAR;
            PG8_LDB(B0, 1, 0); PG8_SCHED; PG8_LDA(At, 1, 0); PG8_STAGE(PG8_SA(0, 1), a2 + hstep, voffA);
            PG8_WAIT_L(8); PG8_BAR; PG8_WAIT_L(0); PG8_MMA(0, 0, At, B0); PG8_BAR; PG8_SCHED;
            PG8_LDB(B1, 1, 1); PG8_STAGE(PG8_SB(1, 0), b3, voffB);
            PG8_BAR; PG8_WAIT_L(0); PG8_MMA(0, 1, At, B1); PG8_BAR;
            PG8_LDA(At, 1, 1); PG8_STAGE(PG8_SA(1, 0), a3, voffA);
            PG8_BAR; PG8_WAIT_L(0); PG8_MMA(1, 0, At, B0); PG8_BAR; PG8_SCHED;
            PG8_STAGE(PG8_SB(1, 1), b3h, voffB);
            PG8_WAIT_V(6); PG8_BAR; PG8_MMA(1, 1, At, B1); PG8_BAR;
        }
        E(acc, cur, wr, wc, fr, fq);
        if (!has_next) break;
        if (Epi::zero_after(cur))
#pragma unroll
        for (int a = 0; a < 2; ++a)
#pragma unroll
            for (int b = 0; b < 2; ++b)
#pragma unroll
                for (int m = 0; m < 4; ++m)
#pragma unroll
                    for (int n = 0; n < 2; ++n) acc[a][b][m][n] = (f32x4){0.f, 0.f, 0.f, 0.f};
        cur = nxt; cA = nA; cB = nB; cBh = nBh; ++ui;
    }
    PG8_WAIT_V(0);
    if (wr == 0) PG8_BAR;
    PG8_BAR;
#undef PG8_SA
#undef PG8_SB
#undef PG8_STAGE
#undef PG8_LDA
#undef PG8_LDB
#undef PG8_MMA
#undef PG8_WAIT_V
#undef PG8_WAIT_L
#undef PG8_BAR
#undef PG8_SCHED
}
template <int RB, class Epi, class Sched>
__device__ __forceinline__ void gemm_phase_f8(int wid0, LAS unsigned char* lds, const Gemm g, const Sched& S, const Epi& E) {
    const int tid = otid(wid0), wid = __builtin_amdgcn_readfirstlane(tid >> 6), lane = tid & 63, wr = wid >> 2, wc = wid & 3, fr = lane & 15, fq = lane >> 4;
    constexpr int nt = RB / 128;
    constexpr int K = RB / 2;
    constexpr size_t B_BR = 0;
    unsigned voffA[2], voffB[2]; int aoff, boff;
    constexpr size_t kstep = (size_t)(BK * 2);
    constexpr size_t hstep = (size_t)HALF * K * 2;
    constexpr size_t tstep = 2 * hstep;
    const unsigned ldsw = (unsigned)wid * 1024u;
#define PG8_SETUP() do { const int t_ = otid(wid0), l_ = t_ & 63, fr_ = l_ & 15, fq_ = l_ >> 4; \
        _Pragma("unroll") for (int i = 0; i < 2; ++i) { int R, C; stage_rc(t_ * 16 + i * 8192, R, C); const int Rb = Epi::PERM ? ((R & ~31) + perm32(R & 31)) : R; \
            voffA[i] = (unsigned)(R * K + C) * 2u; voffB[i] = (unsigned)(Rb * K + C) * 2u; } \
        aoff = lds_byte(wr * 64 + fr_, fq_ * 16); boff = lds_byte(wc * 32 + fr_, fq_ * 16); } while (0)
    PG8_SETUP();
#define PG8_SA(b, h) (((b) * 2 + (h)) * HTB)
#define PG8_SB(b, h) ((4 + (b) * 2 + (h)) * HTB)
#define PG8_STAGE(bufoff, gbase, voff) do { _Pragma("unroll") for (int _i = 0; _i < 2; ++_i) \
        __builtin_amdgcn_global_load_lds((const unsigned*)((const char*)(gbase) + (voff)[_i]), (LAS unsigned*)(lds + (bufoff) + ldsw + _i * 8192), 16, 0, 0); } while (0)
#define PG8_LDA(dst, b, h) do { _Pragma("unroll") for (int m = 0; m < 4; ++m) dst[m] = *(const LAS i32x8*)(lds + PG8_SA(b, h) + aoff + m * 2048); } while (0)
#define PG8_LDB(dst, b, h) do { _Pragma("unroll") for (int n = 0; n < 2; ++n) dst[n] = *(const LAS i32x8*)(lds + PG8_SB(b, h) + boff + n * 2048); } while (0)
#define PG8_MMA(ai, bj, At, Bt) do { __builtin_amdgcn_s_setprio(1); _Pragma("unroll") for (int m = 0; m < 4; ++m) _Pragma("unroll") for (int n = 0; n < 2; ++n) \
        acc[ai][bj][m][n] = __builtin_amdgcn_mfma_scale_f32_16x16x128_f8f6f4(Bt[n], At[m], acc[ai][bj][m][n], 0, 0, 0, 127, 0, 127); __builtin_amdgcn_s_setprio(0); } while (0)
#define PG8_WAIT_V(n) asm volatile("s_waitcnt vmcnt(" #n ")" ::: "memory")
#define PG8_WAIT_L(n) asm volatile("s_waitcnt lgkmcnt(" #n ")" ::: "memory")
#define PG8_BAR __builtin_amdgcn_s_barrier()
#define PG8_SCHED __builtin_amdgcn_sched_barrier(0)
    Unit cur, nxt; int ui = 0;
    if (!S.next(0, cur)) return;
    f32x4 acc[2][2][4][2];
#pragma unroll
    for (int a = 0; a < 2; ++a)
#pragma unroll
        for (int b = 0; b < 2; ++b)
#pragma unroll
            for (int m = 0; m < 4; ++m)
#pragma unroll
                for (int n = 0; n < 2; ++n) acc[a][b][m][n] = (f32x4){0.f, 0.f, 0.f, 0.f};
    i32x8 At[4], B0[2], B1[2];
    const char* cA = (const char*)g.A + (size_t)cur.pm * tstep + S.aoff(cur); int rb0, rb1; S.brow(cur, rb0, rb1);
    const char* cB = (const char*)g.Bt + (size_t)rb0 * (K * 2) + (size_t)cur.br * B_BR; const char* cBh = (const char*)g.Bt + (size_t)rb1 * (K * 2) + (size_t)cur.br * B_BR;
    PG8_STAGE(PG8_SB(0, 0), cB, voffB); PG8_STAGE(PG8_SA(0, 0), cA, voffA); PG8_STAGE(PG8_SB(0, 1), cBh, voffB); PG8_STAGE(PG8_SA(0, 1), cA + hstep, voffA);
    if (wr == 1) PG8_BAR;
    PG8_WAIT_V(4); PG8_BAR;
    PG8_STAGE(PG8_SB(1, 0), cB + kstep, voffB); PG8_STAGE(PG8_SA(1, 0), cA + kstep, voffA); PG8_STAGE(PG8_SB(1, 1), cBh + kstep, voffB);
    PG8_WAIT_V(6); PG8_BAR;
    for (;;) {
        const bool has_next = S.next(ui + 1, nxt);
        const char* nA = has_next ? (const char*)g.A + (size_t)nxt.pm * tstep + S.aoff(nxt) : cA; int rn0 = 0, rn1 = 0; if (has_next) S.brow(nxt, rn0, rn1);
        const char* nB = has_next ? (const char*)g.Bt + (size_t)rn0 * (K * 2) + (size_t)nxt.br * B_BR : cB; const char* nBh = has_next ? (const char*)g.Bt + (size_t)rn1 * (K * 2) + (size_t)nxt.br * B_BR : cBh;
        for (int t = 0; t < nt; t += 2) {
            const bool last = (t == nt - 2);
            const char* a1 = cA + (size_t)(t + 1) * kstep;
            const char* a2 = last ? nA : cA + (size_t)(t + 2) * kstep; const char* b2 = last ? nB : cB + (size_t)(t + 2) * kstep; const char* b2h = last ? nBh : cBh + (size_t)(t + 2) * kstep;
            const char* a3 = a2 + kstep; const char* b3 = b2 + kstep; const char* b3h = b2h + kstep;
            PG8_LDB(B0, 0, 0); PG8_SCHED; PG8_LDA(At, 0, 0); PG8_STAGE(PG8_SA(1, 1), a1 + hstep, voffA);
            PG8_WAIT_L(8); PG8_BAR; PG8_WAIT_L(0); PG8_MMA(0, 0, At, B0); PG8_BAR; PG8_SCHED;
            PG8_LDB(B1, 0, 1); PG8_STAGE(PG8_SB(0, 0), b2, voffB);
            PG8_BAR; PG8_WAIT_L(0); PG8_MMA(0, 1, At, B1); PG8_BAR;
            PG8_LDA(At, 0, 1); PG8_STAGE(PG8_SA(0, 0), a2, voffA);
            PG8_BAR; PG8_WAIT_L(0); PG8_MMA(1, 0, At, B0); PG8_BAR; PG8_SCHED;
            PG8_STAGE(PG8_SB(0, 1), b2h, voffB);
            PG8_WAIT_V(6); PG8_BAR; PG8_MMA(1, 1, At, B1); PG8_BAR;
            PG8_LDB(B0, 1, 0); PG8_SCHED; PG8_LDA(At, 1, 0); PG8_STAGE(PG8_SA(0, 1), a2 + hstep, voffA);
            PG8_WAIT_L(8); PG8_BAR; PG8_WAIT_L(0); PG8_MMA(0, 0, At, B0); PG8_BAR; PG8_SCHED;
            PG8_LDB(B1, 1, 1); PG8_STAGE(PG8_SB(1, 0), b3, voffB);
            PG8_BAR; PG8_WAIT_L(0); PG8_MMA(0, 1, At, B1); PG8_BAR;
            PG8_LDA(At, 1, 1); PG8_STAGE(PG8_SA(1, 0), a3, voffA);
            PG8_BAR; PG8_WAIT_L(0); PG8_MMA(1, 0, At, B0); PG8_BAR; PG8_SCHED;
            PG8_STAGE(PG8_SB(1, 1), b3h, voffB);
            PG8_WAIT_V(6); PG8_BAR; PG8_MMA(1, 1, At, B1); PG8_BAR;
        }
        { const int t2_ = otid(wid0) & 63; E(acc, cur, wr, wc, t2_ & 15, t2_ >> 4); }
        if (!has_next) break;
        if (Epi::zero_after(cur))
#pragma unroll
        for (int a = 0; a < 2; ++a)
#pragma unroll
            for (int b = 0; b < 2; ++b)
#pragma unroll
                for (int m = 0; m < 4; ++m)
#pragma unroll
                    for (int n = 0; n < 2; ++n) acc[a][b][m][n] = (f32x4){0.f, 0.f, 0.f, 0.f};
        cur = nxt; cA = nA; cB = nB; cBh = nBh; ++ui;
        PG8_SETUP();
    }
    PG8_WAIT_V(0);
    if (wr == 0) PG8_BAR;
    PG8_BAR;
#undef PG8_SETUP
#undef PG8_SA
#undef PG8_SB
#undef PG8_STAGE
#undef PG8_LDA
#undef PG8_LDB
#undef PG8_MMA
#undef PG8_WAIT_V
#undef PG8_WAIT_L
#undef PG8_BAR
#undef PG8_SCHED
}
}

__device__ void phase_norm_bf16(int wid0, const float* __restrict__ xin, const float* __restrict__ g, bf16_t* __restrict__ h, unsigned char* __restrict__ h8, int rows);
struct TJob { const float* src; bf16_t* dst; unsigned char* dst8; int R, C, tr, tc; float scale; };
__device__ __forceinline__ TJob prep_job(const Params& p, int i) {
    bf16_t* win = (bf16_t*)(p.ws + p.o_win); bf16_t* wb = (bf16_t*)(p.ws + p.o_wb); bf16_t* wo = (bf16_t*)(p.ws + p.o_wo); bf16_t* pw = (bf16_t*)(p.ws + p.o_pw);
    constexpr int T_WIN = 16 * 160, T_WB = 8 * 16, T_WO = 16 * 16, T_PW = 4;
    constexpr int N0 = DEPTH * T_WIN, N1 = N0 + 8 * T_WB, N2 = N1 + DEPTH * T_WO;
    TJob j; j.scale = 1.0f; j.dst8 = nullptr;
    if (i < N0) { const int l = i / T_WIN, t = i % T_WIN; j.src = p.in[2] + (size_t)l * DM * INC; j.dst = win + (size_t)l * DM * WINR; j.R = DM; j.C = INC; j.tr = t / 160; j.tc = t % 160;
        const int piece = j.tc >> 3; j.scale = (piece >= 12 || piece == 3 || piece == 7 || piece == 11) ? -1.4426950408889634f : (piece == 5 || piece == 8) ? -0.6931471805599453f : 1.0f;
        if (piece >= 12) { j.dst = nullptr; j.dst8 = p.ws + p.o_wg8 + (size_t)l * 4096 * DM + (size_t)(j.tc - 96) * 64 * DM; j.scale *= 32.0f; } }
    else if (i < N1) { const int k = i - N0, m = k / T_WB, t = k % T_WB; j.src = p.in[14] + (size_t)m * BWID * DM; j.dst = wb + (size_t)m * BWID * DM; j.R = BWID; j.C = DM; j.tr = t / 16; j.tc = t % 16; }
    else if (i < N2) { const int k = i - N1, l = k / T_WO, t = k % T_WO; j.src = p.in[15] + (size_t)l * DM * DM; j.dst = wo + (size_t)l * DM * DM; j.R = DM; j.C = DM; j.tr = t / 16; j.tc = t % 16; }
    else { const int k = i - N2, m = k / T_PW, t = k % T_PW; j.src = p.in[3] + (size_t)m * 128 * 128; j.dst = pw + (size_t)m * 128 * 128; j.R = 128; j.C = 128; j.tr = t / 2; j.tc = t % 2; }
    return j;
}
__device__ void phase_prep(int wid0, const Params& p, LAS unsigned char* lds) {
    LAS float* sm = (LAS float*)lds;
    const int tid = otid(wid0);
    constexpr int NT = DEPTH * 16 * 160 + 8 * 8 * 16 + DEPTH * 16 * 16 + 8 * 4;
    const int lr = tid >> 4, lc = (tid & 15) * 4;
    f32x4 v0, v1;
    int i = blockIdx.x;
    if (i < NT) { const TJob j = prep_job(p, i); const float* sp = j.src + (size_t)(j.tr * 64 + lr) * j.C + j.tc * 64 + lc; v0 = *(const f32x4*)sp; v1 = *(const f32x4*)(sp + (size_t)32 * j.C); }
    for (; i < NT; i += gridDim.x) {
        const TJob j = prep_job(p, i);
#pragma unroll
        for (int e = 0; e < 4; ++e) { sm[lr * 65 + lc + e] = v0[e]; sm[(lr + 32) * 65 + lc + e] = v1[e]; }
        __syncthreads();
        const int in = i + gridDim.x;
        if (in < NT) { const TJob jn = prep_job(p, in); const float* sp = jn.src + (size_t)(jn.tr * 64 + lr) * jn.C + jn.tc * 64 + lc; v0 = *(const f32x4*)sp; v1 = *(const f32x4*)(sp + (size_t)32 * jn.C); }
        { const int c = tid >> 3, r8 = (tid & 7) * 8; float o[8];
#pragma unroll
          for (int e = 0; e < 8; ++e) o[e] = sm[(r8 + e) * 65 + c] * j.scale;
          if (j.dst8) { unsigned w0 = 0u, w1 = 0u; w0 = __builtin_amdgcn_cvt_pk_fp8_f32(o[0], o[1], w0, false); w0 = __builtin_amdgcn_cvt_pk_fp8_f32(o[2], o[3], w0, true); w1 = __builtin_amdgcn_cvt_pk_fp8_f32(o[4], o[5], w1, false); w1 = __builtin_amdgcn_cvt_pk_fp8_f32(o[6], o[7], w1, true);
              *(u32x2*)(j.dst8 + (size_t)c * DM + j.tr * 64 + r8) = (u32x2){w0, w1}; }
          else *(u32x4*)(j.dst + (size_t)(j.tc * 64 + c) * j.R + j.tr * 64 + r8) = pack8(o); }
        __syncthreads();
    }
    const float* sgw = p.in[11]; bf16_t* sw = (bf16_t*)(p.ws + p.o_sw);
    for (int k = blockIdx.x * 512 + tid; k < DEPTH * 4 * 128 * 128; k += gridDim.x * 512) { const int s_ = k & 127, t = (k >> 7) & 127; sw[k] = (s_ <= t) ? f2bf(sgw[k]) : (bf16_t)0; }
    {
        float* sd = (float*)(p.ws + p.o_small); const int gt = blockIdx.x * 512 + tid, gs = gridDim.x * 512;
#define CPY(K, OFF, N) for (int k = gt; k < (N); k += gs) sd[(OFF) + k] = p.in[K][k];
        CPY(1, SM1, 2048) CPY(4, SM4, 1024) CPY(5, SM5, 31744) CPY(6, SM6, 1024) CPY(7, SM7, 1024) CPY(8, SM8, 1024) CPY(9, SM9, 1024) CPY(10, SM10, 1024) CPY(12, SM12, 1024) CPY(13, SM13, 3072) CPY(16, SM16, 1024)
#undef CPY
    }
    phase_norm_bf16(wid0, p.in[0], p.in[1], (bf16_t*)(p.ws + p.o_h), p.ws + p.o_h8, NTOK);
}

__device__ void phase_norm_bf16(int wid0, const float* __restrict__ xin, const float* __restrict__ g, bf16_t* __restrict__ h, unsigned char* __restrict__ h8, int rows) {
    const int tid = otid(wid0), lane = tid & 63, w = tid >> 6;
    float gv[2][8];
    load8f(g + 8 * lane, gv[0]); load8f(g + 512 + 8 * lane, gv[1]);
    for (int row = blockIdx.x * 8 + w; row < rows; row += gridDim.x * 8) {
        const float* xr = xin + (size_t)row * DM + 8 * lane;
        float v[2][8]; load8f(xr, v[0]); load8f(xr + 512, v[1]);
        float ss = 0.f;
#pragma unroll
        for (int i = 0; i < 2; ++i)
#pragma unroll
            for (int j = 0; j < 8; ++j) ss += v[i][j] * v[i][j];
        ss = wave_sum(wid0, ss);
        const float r = rsqrtf(ss * (1.0f / 1024.0f) + 1e-6f);
#pragma unroll
        for (int i = 0; i < 2; ++i) { float o[8];
#pragma unroll
            for (int j = 0; j < 8; ++j) o[j] = v[i][j] * r * gv[i][j];
            *(u32x4*)(h + (size_t)row * DM + 512 * i + 8 * lane) = pack8(o);
            unsigned w0 = 0u, w1 = 0u; w0 = __builtin_amdgcn_cvt_pk_fp8_f32(o[0], o[1], w0, false); w0 = __builtin_amdgcn_cvt_pk_fp8_f32(o[2], o[3], w0, true); w1 = __builtin_amdgcn_cvt_pk_fp8_f32(o[4], o[5], w1, false); w1 = __builtin_amdgcn_cvt_pk_fp8_f32(o[6], o[7], w1, true);
            *(u32x2*)(h8 + (size_t)row * DM + 512 * i + 8 * lane) = (u32x2){w0, w1}; }
    }
}
__device__ void phase_norm_final(int wid0, float* __restrict__ x, const float* __restrict__ g, int rows) {
    const int tid = otid(wid0), lane = tid & 63, w = tid >> 6;
    float gv[2][8];
    load8f(g + 8 * lane, gv[0]); load8f(g + 512 + 8 * lane, gv[1]);
    for (int row = blockIdx.x * 8 + w; row < rows; row += gridDim.x * 8) {
        float* xr = x + (size_t)row * DM + 8 * lane;
        float v[2][8]; load8f(xr, v[0]); load8f(xr + 512, v[1]);
        float ss = 0.f;
#pragma unroll
        for (int i = 0; i < 2; ++i)
#pragma unroll
            for (int j = 0; j < 8; ++j) ss += v[i][j] * v[i][j];
        ss = wave_sum(wid0, ss);
        const float r = rsqrtf(ss * (1.0f / 1024.0f) + 1e-6f);
#pragma unroll
        for (int i = 0; i < 2; ++i) {
            f32x4 a, b;
#pragma unroll
            for (int j = 0; j < 4; ++j) { a[j] = v[i][j] * r * gv[i][j]; b[j] = v[i][4 + j] * r * gv[i][4 + j]; }
            *(f32x4*)(xr + 512 * i) = a; *(f32x4*)(xr + 512 * i + 4) = b; }
    }
}

#define PO(k) ((size_t)(k) * TS * BWID)
__device__ void mix_sc(int wid0, const Params& p, int l, const bf16_t* proj, bf16_t* z3, int r0, int pos0) {
    const int tid = otid(wid0), lane = tid & 63, w = tid >> 6, c0 = lane * 8;
    const float* scw = SMALLP(p, SM13) + (size_t)l * 3 * BWID + c0;
    float w0[8], w1[8], w2[8]; load8f(scw, w0); load8f(scw + BWID, w1); load8f(scw + 2 * BWID, w2);
    const int r = r0 + 16 * w, pos = pos0 + 16 * w;
    const bf16_t* bgp = proj + PO(6) + c0; const bf16_t* cxp = proj + PO(7) + c0;
    u32x4 vb[16], vc[18];
    vc[0] = (u32x4){0u, 0u, 0u, 0u}; vc[1] = vc[0];
    if (pos > 0) { vc[0] = *(const u32x4*)(cxp + (size_t)(r - 2) * BWID); vc[1] = *(const u32x4*)(cxp + (size_t)(r - 1) * BWID); }
#pragma unroll
    for (int jj = 0; jj < 16; ++jj) { vb[jj] = *(const u32x4*)(bgp + (size_t)(r + jj) * BWID); vc[2 + jj] = *(const u32x4*)(cxp + (size_t)(r + jj) * BWID); }
    float p2[8], p1[8];
    unpack8(vc[0], p2); unpack8(vc[1], p1);
#pragma unroll
    for (int jj = 0; jj < 16; ++jj) {
        float b[8], cur[8], o[8]; unpack8(vb[jj], b); unpack8(vc[2 + jj], cur);
#pragma unroll
        for (int j = 0; j < 8; ++j) { o[j] = b[j] * (w0[j] * p2[j] + w1[j] * p1[j] + w2[j] * cur[j]); p2[j] = p1[j]; p1[j] = cur[j]; }
        *(u32x4*)(z3 + (size_t)(r + jj) * BWID + c0) = pack8(o);
    }
}

__device__ void mix_conv(int wid0, const Params& p, int l, const bf16_t* proj, bf16_t* z1, int r0, int pos0, LAS unsigned char* lds) {
    const int tid = otid(wid0), lane = tid & 63, w = tid >> 6, c0 = lane * 8;
    LAS unsigned char* Y = lds; LAS unsigned char* W = lds + 94 * VP;
    const float* cw = SMALLP(p, SM5) + (size_t)l * 31 * BWID;
    float bias[8], lng[8], lnb[8];
    load8f(SMALLP(p, SM6) + (size_t)l * BWID + c0, bias); load8f(SMALLP(p, SM7) + (size_t)l * BWID + c0, lng); load8f(SMALLP(p, SM8) + (size_t)l * BWID + c0, lnb);
    u32x4 la[12];
#define CONV_LOAD(q) do { _Pragma("unroll") for (int i = 0; i < 12; ++i) { const int row = 12 * w + i; const bool valid = (row < 94) && (pos0 + 64 * (q) - 30 + row >= 0); \
        la[i] = (u32x4){0u, 0u, 0u, 0u}; if (valid) la[i] = *(const u32x4*)(proj + (size_t)(r0 + 64 * (q) - 30 + row) * BWID + PO(2) + c0); } } while (0)
    CONV_LOAD(0);
    for (int i = tid; i < 31 * 64; i += 512) { const int k = i >> 6, cgp = i & 63; float f[8]; load8f(cw + k * BWID + cgp * 8, f); *(LAS u32x4*)(W + k * 1024 + cgp * 16) = pack8(f); }
#pragma unroll
    for (int q = 0; q < 2; ++q) {
        const int tr = r0 + 64 * q;
        __syncthreads();
#pragma unroll
        for (int i = 0; i < 12; ++i) { const int row = 12 * w + i; if (row < 94) *(LAS u32x4*)(Y + row * VP + lane * 16) = la[i]; }
        __syncthreads();
        if (q == 0) CONV_LOAD(1);
        u32x4 gtv[8];
#pragma unroll
        for (int j = 0; j < 8; ++j) gtv[j] = *(const u32x4*)(proj + (size_t)(tr + 8 * w + j) * BWID + PO(3) + c0);
        float acc[8][8];
#pragma unroll
        for (int j = 0; j < 8; ++j)
#pragma unroll
            for (int c = 0; c < 8; ++c) acc[j][c] = bias[c];
#pragma unroll 1
        for (int k = 0; k < 31; ++k) {
            float wv[8]; unpack8(*(const LAS u32x4*)(W + k * 1024 + lane * 16), wv);
#pragma unroll
            for (int j = 0; j < 8; ++j) { float yv[8]; unpack8(*(const LAS u32x4*)(Y + (8 * w + j + k) * VP + lane * 16), yv);
#pragma unroll
                for (int c = 0; c < 8; ++c) acc[j][c] += wv[c] * yv[c]; }
        }
#pragma unroll
        for (int j = 0; j < 8; ++j) {
            float s = 0.f, ss = 0.f;
#pragma unroll
            for (int c = 0; c < 8; ++c) { s += acc[j][c]; ss += acc[j][c] * acc[j][c]; }
            s = wave_sum(wid0, s); ss = wave_sum(wid0, ss);
            const float mean = s * (1.0f / 512.0f); const float var = fmaxf(ss * (1.0f / 512.0f) - mean * mean, 0.f); const float rstd = rsqrtf(var + 1e-5f);
            const int row = tr + 8 * w + j;
            float gt[8], o[8]; unpack8(gtv[j], gt);
#pragma unroll
            for (int c = 0; c < 8; ++c) { const float v = (acc[j][c] - mean) * rstd * lng[c] + lnb[c]; o[c] = silu(v) * silu(gt[c]); }
            *(u32x4*)(z1 + (size_t)row * BWID + c0) = pack8(o);
        }
    }
}

#undef CONV_LOAD
__device__ __forceinline__ u32x4 sel4(bool c, const u32x4 a, const u32x4 b) { u32x4 r; r.x = c ? a.x : b.x; r.y = c ? a.y : b.y; r.z = c ? a.z : b.z; r.w = c ? a.w : b.w; return r; }

__device__ void mix_pool(int wid0, const Params& p, int l, const bf16_t* proj, bf16_t* z0, int r0, int pos0, LAS unsigned char* lds) {
    const int tid = otid(wid0), lane = tid & 63, w = tid >> 6, c0 = lane * 8;
    LAS unsigned char* P = lds;
    {
        const int g4 = lane >> 4, win = 2 << g4;
        const int r = r0 + 16 * w, pos = pos0 + 16 * w;
        u32x4 R[32];
#pragma unroll
        for (int i = 0; i < 16; ++i) { R[i] = (u32x4){0u, 0u, 0u, 0u}; if (pos > 0) R[i] = *(const u32x4*)(proj + (size_t)(r - 16 + i) * BWID + c0); }
#pragma unroll
        for (int i = 0; i < 16; ++i) R[16 + i] = *(const u32x4*)(proj + (size_t)(r + i) * BWID + c0);
        float S[8];
#pragma unroll
        for (int j = 0; j < 8; ++j) S[j] = 0.f;
#pragma unroll
        for (int i = 1; i <= 16; ++i) { float x[8]; unpack8(R[16 - i], x); const float mk = (i <= win) ? 1.0f : 0.0f;
#pragma unroll
            for (int j = 0; j < 8; ++j) S[j] += mk * x[j]; }
#pragma unroll
        for (int jj = 0; jj < 16; ++jj) {
            const int ps = pos + jj; float xv[8], xo[8], o[8];
            unpack8(R[16 + jj], xv);
            const u32x4 ro = sel4(g4 < 2, sel4(g4 == 0, R[16 + jj - 2], R[16 + jj - 4]), sel4(g4 == 2, R[16 + jj - 8], R[jj]));
            unpack8(ro, xo);
            const int cnt = (ps + 1 < win) ? ps + 1 : win; const float inv = 1.0f / (float)cnt;
#pragma unroll
            for (int j = 0; j < 8; ++j) { S[j] += xv[j] - xo[j]; o[j] = S[j] * inv - xv[j]; }
            *(LAS u32x4*)(P + (16 * w + jj) * VP + lane * 16) = pack8(o);
        }
    }
    __syncthreads();
    {
        const int g = w >> 1, fr = lane & 15, fq = lane >> 4;
        const bf16_t* pwT = (const bf16_t*)(p.ws + p.o_pw) + (size_t)(l * 4 + g) * 128 * 128;
        u32x2 gtv[8][4];
#pragma unroll
        for (int tt = 0; tt < 8; ++tt)
#pragma unroll
            for (int dt = 0; dt < 4; ++dt) gtv[tt][dt] = *(const u32x2*)(proj + (size_t)(r0 + 16 * tt + fr) * BWID + PO(1) + 64 * w + 16 * dt + 4 * fq);
        bf16x8 A[4][4];
#pragma unroll
        for (int dt = 0; dt < 4; ++dt)
#pragma unroll
            for (int kk = 0; kk < 4; ++kk) A[dt][kk] = *(const bf16x8*)(pwT + (size_t)(64 * (w & 1) + 16 * dt + fr) * 128 + 32 * kk + 8 * fq);
        const float* psc = SMALLP(p, SM4) + (size_t)l * BWID;
        f32x4 sc[4];
#pragma unroll
        for (int dt = 0; dt < 4; ++dt) sc[dt] = *(const f32x4*)(psc + 64 * w + 16 * dt + 4 * fq);
#pragma unroll
        for (int tt = 0; tt < 8; ++tt) {
            bf16x8 Bf[4];
#pragma unroll
            for (int kk = 0; kk < 4; ++kk) Bf[kk] = *(const LAS bf16x8*)(P + (16 * tt + fr) * VP + (128 * g + 32 * kk + 8 * fq) * 2);
            f32x4 acc[4];
#pragma unroll
            for (int dt = 0; dt < 4; ++dt) { acc[dt] = (f32x4){0.f, 0.f, 0.f, 0.f};
#pragma unroll
                for (int kk = 0; kk < 4; ++kk) acc[dt] = __builtin_amdgcn_mfma_f32_16x16x32_bf16(A[dt][kk], Bf[kk], acc[dt], 0, 0, 0); }
            const int row = r0 + 16 * tt + fr;
#pragma unroll
            for (int dt = 0; dt < 4; ++dt) { const int d = 64 * w + 16 * dt + 4 * fq;
                float gt[4]; unpack4(gtv[tt][dt], gt);
                u32x2 o; o.x = cvt_pk_bf16(acc[dt][0] * sc[dt][0] * silu(gt[0]), acc[dt][1] * sc[dt][1] * silu(gt[1])); o.y = cvt_pk_bf16(acc[dt][2] * sc[dt][2] * silu(gt[2]), acc[dt][3] * sc[dt][3] * silu(gt[3]));
                *(u32x2*)(z0 + (size_t)row * BWID + d) = o; }
        }
    }
}

__device__ void mix_sgu(int wid0, const Params& p, int l, const bf16_t* proj, bf16_t* z2, int r0, LAS unsigned char* lds) {
    const int tid = otid(wid0), lane = tid & 63, w = tid >> 6, c0 = lane * 8;
    LAS unsigned char* V = lds;
    {
        float lng[8], lnb[8]; load8f(SMALLP(p, SM9) + (size_t)l * BWID + c0, lng); load8f(SMALLP(p, SM10) + (size_t)l * BWID + c0, lnb);
        u32x4 R[16];
#pragma unroll
        for (int jj = 0; jj < 16; ++jj) R[jj] = *(const u32x4*)(proj + (size_t)(r0 + 16 * w + jj) * BWID + PO(5) + c0);
#pragma unroll
        for (int jj = 0; jj < 16; ++jj) {
            float x[8], o[8]; unpack8(R[jj], x);
            float s = 0.f, ss = 0.f;
#pragma unroll
            for (int c = 0; c < 8; ++c) { s += x[c]; ss += x[c] * x[c]; }
            s = wave_sum(wid0, s); ss = wave_sum(wid0, ss);
            const float mean = s * (1.0f / 512.0f); const float var = fmaxf(ss * (1.0f / 512.0f) - mean * mean, 0.f); const float rstd = rsqrtf(var + 1e-5f);
#pragma unroll
            for (int c = 0; c < 8; ++c) o[c] = (x[c] - mean) * rstd * lng[c] + lnb[c];
            *(LAS u32x4*)(V + (16 * w + jj) * VP + lane * 16) = pack8(o);
        }
    }
    __syncthreads();
    {
        const int g = w >> 1, fr = lane & 15, fq = lane >> 4;
        const unsigned vbase = (unsigned)(size_t)V;
        bf16x8 A[4][4];
#pragma unroll
        for (int ct = 0; ct < 4; ++ct)
#pragma unroll
            for (int kk = 0; kk < 4; ++kk) {
                const unsigned a = vbase + (unsigned)((32 * kk + 8 * fq + (fr >> 2)) * VP + (64 * w + 16 * ct + 4 * (fr & 3)) * 2);
                const u32x2 lo = tr_read(a), hi = tr_read(a + 4 * VP);
                u32x4 t; t.x = lo.x; t.y = lo.y; t.z = hi.x; t.w = hi.y;
                A[ct][kk] = __builtin_bit_cast(bf16x8, t);
            }
        const bf16_t* swm = (const bf16_t*)(p.ws + p.o_sw) + (size_t)(l * 4 + g) * 128 * 128;
        const float* sb = SMALLP(p, SM12) + (size_t)(l * 4 + g) * 128;
#pragma unroll
        for (int hb = 0; hb < 2; ++hb) {
            u32x2 uu[4][4]; bf16x8 Wf[4][4]; float bias[4];
#pragma unroll
            for (int t4 = 0; t4 < 4; ++t4) { const int tt = hb * 4 + t4; const bf16_t* pr = proj + (size_t)(r0 + 16 * tt + fr) * BWID + 64 * w + 4 * fq;
#pragma unroll
                for (int ct = 0; ct < 4; ++ct) uu[t4][ct] = *(const u32x2*)(pr + PO(4) + 16 * ct);
#pragma unroll
                for (int kk = 0; kk < 4; ++kk) if (kk < (tt >> 1) + 1) Wf[t4][kk] = *(const bf16x8*)(swm + (size_t)(16 * tt + fr) * 128 + 32 * kk + 8 * fq);
                bias[t4] = sb[16 * tt + fr]; }
#pragma unroll
            for (int t4 = 0; t4 < 4; ++t4) { const int tt = hb * 4 + t4;
                f32x4 acc[4];
#pragma unroll
                for (int ct = 0; ct < 4; ++ct) acc[ct] = (f32x4){0.f, 0.f, 0.f, 0.f};
#pragma unroll
                for (int kk = 0; kk < 4; ++kk) if (kk < (tt >> 1) + 1) {
#pragma unroll
                    for (int ct = 0; ct < 4; ++ct) acc[ct] = __builtin_amdgcn_mfma_f32_16x16x32_bf16(A[ct][kk], Wf[t4][kk], acc[ct], 0, 0, 0); }
                const int row = r0 + 16 * tt + fr;
#pragma unroll
                for (int ct = 0; ct < 4; ++ct) { const int c = 64 * w + 16 * ct + 4 * fq;
                    float u[4]; unpack4(uu[t4][ct], u);
                    u32x2 o; o.x = cvt_pk_bf16(u[0] * (acc[ct][0] + bias[t4]), u[1] * (acc[ct][1] + bias[t4])); o.y = cvt_pk_bf16(u[2] * (acc[ct][2] + bias[t4]), u[3] * (acc[ct][3] + bias[t4]));
                    *(u32x2*)(z2 + (size_t)row * BWID + c) = o; }
            }
        }
    }
}

__device__ void phase_mix(int wid0, const Params& p, int l, const bf16_t* proj, bf16_t* z, LAS unsigned char* lds) {
    constexpr int nchunk = TS / 128;
    for (int i = blockIdx.x; i < 4 * nchunk; i += gridDim.x) {
        const int j = i % nchunk, br = ((i / nchunk) + j) & 3, r0 = j * 128, pos0 = (j & 15) * 128;
        if (br == 0) for (int rr = 0; rr < REP_M0; ++rr) { mix_pool(wid0, p, l, proj, z + PO(1), r0, pos0, lds); __syncthreads(); }
        else if (br == 1) for (int rr = 0; rr < REP_M1; ++rr) { mix_conv(wid0, p, l, proj, z + PO(3), r0, pos0, lds); __syncthreads(); }
        else if (br == 2) for (int rr = 0; rr < REP_M2; ++rr) { mix_sgu(wid0, p, l, proj, z + PO(4), r0, lds); __syncthreads(); }
        else for (int rr = 0; rr < REP_M3; ++rr) { mix_sc(wid0, p, l, proj, z + PO(6), r0, pos0); __syncthreads(); }
    }
}

#define XB_TMO      128
#define XB_XCNT(j)  (256  + 64 * (j))
#define XB_XSUB(j)  (1280 + 64 * (j))
#define XB_XGEN(j)  (2304 + 64 * (j))
#define XB_TOP      3328
#define XB_TOPGEN   3392
#define XCD_BAR_WORDS 3456
#define XB_SPIN_CAP (1u << 20)
__device__ __forceinline__ unsigned xb_ld(unsigned* p)              { return __hip_atomic_load(p, __ATOMIC_RELAXED, __HIP_MEMORY_SCOPE_AGENT); }
__device__ __forceinline__ unsigned xb_add(unsigned* p, unsigned v) { return __hip_atomic_fetch_add(p, v, __ATOMIC_RELAXED, __HIP_MEMORY_SCOPE_AGENT); }
__device__ __forceinline__ unsigned xb_xcc_id() { return (unsigned)__builtin_amdgcn_s_getreg((3 << 11) | 20) & 0xFu; }
#define XB_SPIN(cond, bar) do { unsigned _sp = 0; while (cond) { __builtin_amdgcn_s_sleep(1); \
    if ((++_sp & 255u) == 0u) { if (xb_ld(&(bar)[XB_TMO])) break; if (_sp > XB_SPIN_CAP) { atomicAdd(&(bar)[XB_TMO], 1u); break; } } } } while (0)
struct XcdBarrier { unsigned* bar; unsigned x; volatile LAS unsigned* st; };
__device__ __forceinline__ XcdBarrier xcd_barrier_post(bool first, unsigned* bar, volatile LAS unsigned* st) {
    XcdBarrier b; b.bar = bar; b.x = xb_xcc_id(); b.st = st;
    if (first) (void)xb_add(&bar[XB_XCNT(b.x)], 1u);
    return b;
}
__device__ __forceinline__ void xcd_barrier_complete(unsigned* bar, unsigned x, unsigned& nloc, unsigned& nx) {
    const unsigned G = gridDim.x * gridDim.y * gridDim.z;
    unsigned sum, cnt, mine, sp = 0u;
    for (;;) {
        sum = 0u; cnt = 0u; mine = 0u;
#pragma unroll
        for (unsigned j = 0; j < 16; ++j) { const unsigned c = xb_ld(&bar[XB_XCNT(j)]); sum += c; cnt += (c > 0u) ? 1u : 0u; mine = (j == x) ? c : mine; }
        if (sum == G) break;
        __builtin_amdgcn_s_sleep(1);
        if ((++sp & 255u) == 0u) { if (xb_ld(&bar[XB_TMO])) break; if (sp > XB_SPIN_CAP) { atomicAdd(&bar[XB_TMO], 1u); break; } }
    }
    nloc = mine > 0u ? mine : 1u; nx = cnt > 0u ? cnt : 1u;
}
__device__ __forceinline__ void xcd_barrier(int wid0, const XcdBarrier& b) {
    asm volatile("s_waitcnt vmcnt(0)" ::: "memory");
    __syncthreads();
    if (otid(wid0) == 0) {
        unsigned* bar = b.bar; asm volatile("" : "+s"(bar)); unsigned bx = b.x; asm volatile("" : "+s"(bx));
        __builtin_amdgcn_s_waitcnt(0);
        unsigned nloc = b.st[0], nx = b.st[1];
        if (nloc == 0u) { xcd_barrier_complete(bar, bx, nloc, nx); b.st[0] = nloc; b.st[1] = nx; }
        const unsigned old = xb_add(&bar[XB_XSUB(bx)], 1u);
        const unsigned gen = old / nloc;
        if (old + 1u == (gen + 1u) * nloc) {
            __builtin_amdgcn_fence(__ATOMIC_RELEASE, "agent");
            asm volatile("s_waitcnt vmcnt(0)" ::: "memory");
            const unsigned og = xb_add(&bar[XB_TOP], 1u);
            const unsigned tg = og / nx;
            if (og + 1u == (tg + 1u) * nx) xb_add(&bar[XB_TOPGEN], 1u);
            else XB_SPIN(xb_ld(&bar[XB_TOPGEN]) == tg, bar);
            __builtin_amdgcn_fence(__ATOMIC_ACQUIRE, "agent");
            xb_add(&bar[XB_XGEN(bx)], 1u);
            asm volatile("s_waitcnt vmcnt(0)" ::: "memory");
        } else {
            XB_SPIN(xb_ld(&bar[XB_XGEN(bx)]) == gen, bar);
            __builtin_amdgcn_fence(__ATOMIC_ACQUIRE, "agent");
            asm volatile("s_waitcnt vmcnt(0)" ::: "memory");
        }
    }
    __syncthreads();
}

__global__ void __launch_bounds__(512) mk_forward(Params p) {
    extern __shared__ __attribute__((aligned(16))) unsigned char lds_raw[];
    LAS unsigned char* lds = (LAS unsigned char*)lds_raw;
    cg::grid_group grid = cg::this_grid();
    volatile LAS unsigned* stw = (volatile LAS unsigned*)(lds + LDS_BYTES - 16);
    const int wid0 = __builtin_amdgcn_readfirstlane((int)(threadIdx.x >> 6));
    const bool first = (wid0 == 0 && lane_id() == 0);
    if (first) { stw[0] = 0u; stw[1] = 0u; }
    __syncthreads();
    const XcdBarrier xbar = xcd_barrier_post(first, (unsigned*)(p.ws + p.o_bar), stw);
#define PHASE_ON true
#ifndef XSYNC
#define XSYNC 0
#endif
#define PHASE_END do { if (p.ph_hi > 100000) grid.sync();   xcd_barrier(wid0, xbar); } while (0)
    constexpr int ts = TS;
    bf16_t* win = (bf16_t*)(p.ws + p.o_win); bf16_t* wb = (bf16_t*)(p.ws + p.o_wb); bf16_t* wo = (bf16_t*)(p.ws + p.o_wo);
    bf16_t* h0 = (bf16_t*)(p.ws + p.o_h); bf16_t* proj = (bf16_t*)(p.ws + p.o_proj);

    if (PHASE_ON) phase_prep(wid0, p, lds);
    PHASE_END;
#pragma unroll 1
    for (int l = 0; l < DEPTH; ++l) {
        const float* xin = (l == 0) ? p.in[0] : p.out;
#pragma unroll 1
        for (int s = 0; s < NS; ++s) {
            const size_t tok0 = (size_t)s * ts;
            bf16_t* h = h0 + tok0 * DM; bf16_t* merged = h;
            if (l > 0) { if (PHASE_ON) phase_norm_bf16(wid0, xin + tok0 * DM, SMALLP(p, SM1) + (size_t)l * DM, h, p.ws + p.o_h8 + tok0 * DM, ts);
                PHASE_END; }
            if (PHASE_ON) {
                { pg8::Gemm g{h, win + (size_t)l * DM * WINR}; pg8::OrderA S; S.G = (int)gridDim.x; S.c = (int)blockIdx.x; pg8::EpiProj E{proj}; pg8::gemm_phase<DM, 0>(wid0, lds, g, S, E); }
                { pg8::Gemm g{(const bf16_t*)(p.ws + p.o_h8 + tok0 * DM), (const bf16_t*)(p.ws + p.o_wg8 + (size_t)l * 4096 * DM)}; pg8::Order<TS / 256, 4096 / 256, 1> S{(int)gridDim.x, (int)blockIdx.x};
                  pg8::EpiGateStore E{(unsigned char*)(proj + (size_t)8 * TS * BWID)}; pg8::gemm_phase_f8<DM>(wid0, lds, g, S, E); }
            }
            PHASE_END;
            if (PHASE_ON) phase_mix(wid0, p, l, proj, proj, lds);
            PHASE_END;
            if (PHASE_ON) for (int rep = 0; rep < REP_C; ++rep) { pg8::Gemm g{proj, wb + (size_t)l * 4 * BWID * DM}; pg8::OrderC S; S.G = (int)gridDim.x; S.c = (int)blockIdx.x;
                pg8::EpiGate E{proj + (size_t)8 * TS * BWID, merged}; pg8::gemm_phase<BWID, (size_t)BWID * DM * 2>(wid0, lds, g, S, E); }
            PHASE_END;
            if (PHASE_ON) { pg8::Gemm g{merged, wo + (size_t)l * DM * DM}; pg8::Order<TS / 256, DM / 256, 1> S{(int)gridDim.x, (int)blockIdx.x};
                pg8::EpiRes E{xin + tok0 * DM, p.out + tok0 * DM, DM}; pg8::gemm_phase<DM, 0>(wid0, lds, g, S, E); }
            PHASE_END;
        }
    }
    phase_norm_final(wid0, p.out, SMALLP(p, SM16), NTOK);
}

extern "C" void kernel_launch(void* const* d_in, const int* in_sizes, int n_in, void* d_out, int out_size, void* d_ws, size_t ws_size, hipStream_t stream) {
    static int grid = 0;
    if (grid == 0) {
        int dev = 0, cus = 0, per_cu = 0;
        hipGetDevice(&dev); hipDeviceGetAttribute(&cus, hipDeviceAttributeMultiprocessorCount, dev);
        if (hipFuncSetAttribute((const void*)mk_forward, hipFuncAttributeMaxDynamicSharedMemorySize, LDS_BYTES) != hipSuccess) { fprintf(stderr, "hipFuncSetAttribute failed\n"); grid = -1; return; }
        if (hipOccupancyMaxActiveBlocksPerMultiprocessor(&per_cu, (const void*)mk_forward, 512, LDS_BYTES) != hipSuccess || per_cu < 1) { fprintf(stderr, "occupancy query: %d\n", per_cu); per_cu = 1; }
        (void)hipGetLastError();
        grid = cus * per_cu;
    }
    if (grid < 0) return;
    Params p{};
    for (int i = 0; i < 17; ++i) p.in[i] = (const float*)d_in[i];
    p.out = (float*)d_out; p.ws = (unsigned char*)d_ws;
    size_t o = 0;
    p.o_win = (unsigned)o; o += (size_t)DEPTH * DM * WINR * 2;
    p.o_wg8 = (unsigned)o; o += (size_t)DEPTH * 4096 * DM;
    p.o_h8 = (unsigned)o; o += (size_t)NTOK * DM;
    p.o_wb = (unsigned)o; o += (size_t)DEPTH * 4 * BWID * DM * 2;
    p.o_wo = (unsigned)o; o += (size_t)DEPTH * DM * DM * 2;
    p.o_pw = (unsigned)o; o += (size_t)DEPTH * 4 * 128 * 128 * 2;
    p.o_sw = (unsigned)o; o += (size_t)DEPTH * 4 * 128 * 128 * 2;
    p.o_bar = (unsigned)o; o += 16384;
    p.o_small = (unsigned)o; o += (size_t)SM_TOTAL * 4;
    p.o_h = (unsigned)o; o += (size_t)NTOK * DM * 2;
    p.o_proj = (unsigned)o; o += (size_t)TS * (8 * BWID * 2 + 4096);
    if (o > ws_size) { fprintf(stderr, "kernel_launch: workspace too small: need %zu, have %zu\n", o, ws_size); return; }
    const int nph = 1 + NS * 4 + (DEPTH - 1) * NS * 5 + 1;
    if (hipMemsetAsync((char*)d_ws + p.o_bar, 0, 16384, stream) != hipSuccess) { fprintf(stderr, "kernel_launch: memset failed\n"); return; }
    p.ph_hi = nph;
    void* args[] = {&p};
    hipError_t e = hipLaunchCooperativeKernel((const void*)mk_forward, dim3(grid), dim3(512), args, LDS_BYTES, stream);
    if (e != hipSuccess) fprintf(stderr, "cooperative launch failed: %s (grid %d)\n", hipGetErrorString(e), grid);
}
```

```cpp
#include <hip/hip_runtime.h>
#include <hip/hip_cooperative_groups.h>
#include <cstdio>
namespace cg = cooperative_groups;

#ifndef MULTI_LAUNCH
#define MULTI_LAUNCH 0
#endif

#ifndef REP_N
#define REP_N 1
#endif
#ifndef REP_A
#define REP_A 1
#endif
#ifndef REP_B
#define REP_B 1
#endif
#ifndef REP_C
#define REP_C 1
#endif
#define REP_M0 1
#define REP_M1 1
#define REP_M2 1
#define REP_M3 1
#define LAS __attribute__((address_space(3)))
typedef unsigned short bf16_t;
typedef short bf16x8 __attribute__((ext_vector_type(8)));
typedef float f32x4 __attribute__((ext_vector_type(4)));
typedef float f32x2 __attribute__((ext_vector_type(2)));
typedef unsigned u32x4 __attribute__((ext_vector_type(4)));
typedef unsigned u32x2 __attribute__((ext_vector_type(2)));
typedef int i32x8 __attribute__((ext_vector_type(8)));
typedef int i32x4 __attribute__((ext_vector_type(4)));
constexpr int WINR = 6144;

constexpr int DM = 1024, SEQ = 2048, NTOK = 32 * 2048, DEPTH = 2, BWID = 512, INC = 10240, GATE0 = 6144;
constexpr int PP = 6144;
constexpr int NS = 1, TS = NTOK / NS;
constexpr int LDS_BYTES = 139264;
constexpr int VP = 1040;

constexpr int SM1 = 0, SM4 = 2048, SM5 = 3072, SM6 = 34816, SM7 = 35840, SM8 = 36864, SM9 = 37888, SM10 = 38912, SM12 = 39936, SM13 = 40960, SM16 = 44032, SM_TOTAL = 45056;
#define SMALLP(p, OFF) ((const float*)((p).ws + (p).o_small) + (OFF))
struct Params {
    const float* in[17];
    float* out;
    unsigned char* ws;
    int ph_hi;
    unsigned o_win, o_wb, o_wo, o_pw, o_sw, o_h, o_bar, o_proj, o_h8, o_wg8, o_small;
};

__device__ __forceinline__ int lane_id() { return (int)__builtin_amdgcn_mbcnt_hi(~0u, __builtin_amdgcn_mbcnt_lo(~0u, 0u)); }
__device__ __forceinline__ int otid(int wid0) { int t; asm volatile("v_mbcnt_lo_u32_b32 %0, -1, 0\n\tv_mbcnt_hi_u32_b32 %0, -1, %0" : "=v"(t)); return (wid0 << 6) | t; }
__device__ __forceinline__ unsigned cvt_pk_bf16(float lo, float hi) { unsigned r; asm volatile("v_cvt_pk_bf16_f32 %0, %1, %2" : "=v"(r) : "v"(lo), "v"(hi)); return r; }
__device__ __forceinline__ bf16_t f2bf(float f) { unsigned u = __float_as_uint(f); u += 0x7FFFu + ((u >> 16) & 1u); return (bf16_t)(u >> 16); }
__device__ __forceinline__ void unpack8(const u32x4 v, float (&f)[8]) {
    f[0] = __uint_as_float(v.x << 16); f[1] = __uint_as_float(v.x & 0xffff0000u); f[2] = __uint_as_float(v.y << 16); f[3] = __uint_as_float(v.y & 0xffff0000u);
    f[4] = __uint_as_float(v.z << 16); f[5] = __uint_as_float(v.z & 0xffff0000u); f[6] = __uint_as_float(v.w << 16); f[7] = __uint_as_float(v.w & 0xffff0000u);
}
__device__ __forceinline__ u32x4 pack8(const float (&f)[8]) { u32x4 r; r.x = cvt_pk_bf16(f[0], f[1]); r.y = cvt_pk_bf16(f[2], f[3]); r.z = cvt_pk_bf16(f[4], f[5]); r.w = cvt_pk_bf16(f[6], f[7]); return r; }
__device__ __forceinline__ void unpack4(const u32x2 v, float (&f)[4]) { f[0] = __uint_as_float(v.x << 16); f[1] = __uint_as_float(v.x & 0xffff0000u); f[2] = __uint_as_float(v.y << 16); f[3] = __uint_as_float(v.y & 0xffff0000u); }
__device__ __forceinline__ float sigm(float x) { return __builtin_amdgcn_rcpf(1.0f + __expf(-x)); }
__device__ __forceinline__ float silu(float x) { return x * sigm(x); }
__device__ __forceinline__ void load8f(const float* p, float (&f)[8]) { const f32x4 a = *(const f32x4*)p, b = *(const f32x4*)(p + 4); f[0] = a[0]; f[1] = a[1]; f[2] = a[2]; f[3] = a[3]; f[4] = b[0]; f[5] = b[1]; f[6] = b[2]; f[7] = b[3]; }
__device__ __forceinline__ float wave_sum(int wid0, float v) {
    const int lane = otid(wid0) & 63;
#pragma unroll
    for (int o = 32; o >= 1; o >>= 1) v += __builtin_bit_cast(float, __builtin_amdgcn_ds_bpermute((lane ^ o) << 2, __builtin_bit_cast(int, v)));
    return v;
}
__device__ __forceinline__ u32x2 tr_read(unsigned lds_addr) { u32x2 r; asm volatile("ds_read_b64_tr_b16 %0, %1\n\ts_waitcnt lgkmcnt(0)" : "=&v"(r) : "v"(lds_addr) : "memory"); return r; }

namespace pg8 {
constexpr int BM = 256, BK = 64, HALF = 128, HTB = HALF * BK * 2, STAGE_BYTES = 8 * HTB, NXCD = 8, WGM = 8;
__device__ __forceinline__ int lds_byte(int r, int c) { const int st = (r >> 4) * 2 + (c >> 5), rr = r & 15, cc = c & 31, ob = rr * 64 + cc * 2; return st * 1024 + (ob ^ (((ob >> 9) & 1) << 5)); }
__device__ __forceinline__ void stage_rc(int b, int& R, int& C) { const int st = b / 1024, sb = b % 1024, swz = sb ^ (((sb >> 9) & 1) << 5); R = (st >> 1) * 16 + swz / 64; C = (st & 1) * 32 + (swz % 64) / 2; }
__device__ __forceinline__ int perm32(int rho) { const int n = rho >> 4, i = rho & 15; return 8 * (i >> 2) + 4 * n + (i & 3); }

struct Unit { int pm, pn, br; };
struct Gemm { const bf16_t* A; const bf16_t* Bt; };

template <int NM, int NN, int NBR>
struct Order {
    int G, c;
    __device__ __forceinline__ bool next(int i, Unit& u) const {
        constexpr int nwg = NM * NN;
        const int ti = i / NBR;
        const long L = (long)ti * G + c; if (L >= nwg) return false;
        int wgid = (int)L; { constexpr int q = nwg / NXCD, r = nwg % NXCD; const int xcd = wgid % NXCD, off = wgid / NXCD; wgid = (xcd < r ? xcd * (q + 1) : r * (q + 1) + (xcd - r) * q) + off; }
        constexpr int nig = WGM * NN; const int gid = wgid / nig, fm = gid * WGM, gsz = (NM - fm) < WGM ? (NM - fm) : WGM;
        u.pm = fm + ((wgid % nig) % gsz); u.pn = (wgid % nig) / gsz; u.br = i % NBR; return true;
    }
    __device__ __forceinline__ void brow(const Unit& u, int& r0, int& r1) const { r0 = u.pn * BM; r1 = r0 + HALF; }
    __device__ __forceinline__ size_t aoff(const Unit&) const { return 0; }
};
struct OrderC : Order<TS / 256, DM / 256, 4> {
    __device__ __forceinline__ size_t aoff(const Unit& u) const { const int slot = (u.br == 0) ? 1 : (u.br == 1) ? 3 : (u.br == 2) ? 4 : 6; return (size_t)slot * TS * BWID * 2; }
};
struct OrderA : Order<TS / 256, WINR / 256, 1> {
    __device__ __forceinline__ void brow(const Unit& u, int& r0, int& r1) const {
        const int pn = u.pn;
        if (pn < 8) { const int pc = pn >> 1; const int piece = (pc == 0) ? 0 : (pc == 1) ? 1 : (pc == 2) ? 4 : 6; r0 = piece * 512 + (pn & 1) * 256; r1 = r0 + HALF; }
        else if (pn < 24) { const int q = (pn - 8) >> 2, sub = (pn - 8) & 3; const int pa = (q == 0) ? 2 : (q == 1) ? 9 : (q == 2) ? 8 : 5, pb = (q == 0) ? 3 : (q == 1) ? 10 : (q == 2) ? 11 : 7;
            r0 = pa * 512 + HALF * sub; r1 = pb * 512 + HALF * sub; }
        else { r0 = pn * BM; r1 = r0 + HALF; }
    }
};

struct EpiProj {
    static constexpr bool PERM = true;
    static __device__ __forceinline__ bool zero_after(const Unit&) { return true; }
    bf16_t* O;
    __device__ __forceinline__ void operator()(f32x4 (&acc)[2][2][4][2], const Unit& u, int wr, int wc, int fr_, int fq) const {
        int fr = fr_; asm volatile("" : "+v"(fr));
        if (u.pn < 8) {
            const int pc = u.pn >> 1; const int slot = (pc == 0) ? 0 : (pc == 1) ? 1 : (pc == 2) ? 3 : 5;
            const int row0 = u.pm * BM + wr * 64 + fr, col0 = (u.pn & 1) * BM + wc * 32 + 8 * fq;
            bf16_t* Op = O + (size_t)slot * TS * BWID;
#pragma unroll
            for (int ai = 0; ai < 2; ++ai)
#pragma unroll
                for (int m = 0; m < 4; ++m) { bf16_t* rowp = Op + (size_t)(row0 + ai * HALF + m * 16) * BWID + col0;
#pragma unroll
                    for (int bj = 0; bj < 2; ++bj) { const f32x4 v0 = acc[ai][bj][m][0], v1 = acc[ai][bj][m][1];
                        u32x4 w; w.x = cvt_pk_bf16(v0[0], v0[1]); w.y = cvt_pk_bf16(v0[2], v0[3]); w.z = cvt_pk_bf16(v1[0], v1[1]); w.w = cvt_pk_bf16(v1[2], v1[3]);
                        __builtin_nontemporal_store(w, (u32x4*)(rowp + bj * HALF)); } }
        } else {
            const int q = (u.pn - 8) >> 2, sub = (u.pn - 8) & 3; const int slot = (q == 0) ? 2 : (q == 1) ? 7 : (q == 2) ? 6 : 4;
            const int row0 = u.pm * BM + wr * 64 + fr, col0 = sub * HALF + wc * 32 + 8 * fq;
            bf16_t* Op = O + (size_t)slot * TS * BWID;
#pragma unroll
            for (int ai = 0; ai < 2; ++ai)
#pragma unroll
                for (int m = 0; m < 4; ++m) {
                    float f[8];
#pragma unroll
                    for (int n = 0; n < 2; ++n)
#pragma unroll
                        for (int j = 0; j < 4; ++j) { const float av = acc[ai][0][m][n][j], bv = acc[ai][1][m][n][j];
                            const float sg = __builtin_amdgcn_rcpf(1.0f + __builtin_amdgcn_exp2f(bv));
                            f[n * 4 + j] = av * ((q == 1) ? bv : (q == 0) ? sg : bv * sg); }
                    __builtin_nontemporal_store(pack8(f), (u32x4*)(Op + (size_t)(row0 + ai * HALF + m * 16) * BWID + col0)); }
        }
    }
};
struct EpiGateStore {
    static constexpr bool PERM = true;
    static __device__ __forceinline__ bool zero_after(const Unit&) { return true; }
    unsigned char* G;
    __device__ __forceinline__ void operator()(f32x4 (&acc)[2][2][4][2], const Unit& u, int wr, int wc, int fr_, int fq) const {
        int fr = fr_; asm volatile("" : "+v"(fr));
        unsigned char* gb = G + ((size_t)u.pm * 16 + u.pn) * 65536 + (((wr * 4 + wc) * 4 + fq) * 16 + fr) * 16;
        const float c255 = 1.0f / 255.0f;
#pragma unroll
        for (int ai = 0; ai < 2; ++ai)
#pragma unroll
            for (int m = 0; m < 4; ++m) {
                u32x4 w;
#pragma unroll
                for (int bj = 0; bj < 2; ++bj)
#pragma unroll
                    for (int n = 0; n < 2; ++n) { unsigned q = 0u;
#pragma unroll
                        for (int j = 0; j < 4; ++j) q = __builtin_amdgcn_cvt_pk_u8_f32(fmaxf(__builtin_amdgcn_rcpf(__builtin_fmaf(__builtin_amdgcn_exp2f(acc[ai][bj][m][n][j] * 0.03125f), c255, c255)), 1.0f), j, q);
                        w[bj * 2 + n] = q; }
                __builtin_nontemporal_store(w, (u32x4*)(gb + (ai * 4 + m) * 8192));
                __builtin_amdgcn_sched_barrier(0); }
    }
};
struct EpiGate {
    static constexpr bool PERM = true;
    static __device__ __forceinline__ bool zero_after(const Unit& u) { return u.br == 3; }
    const bf16_t* G; bf16_t* merged;
    __device__ __forceinline__ void operator()(f32x4 (&acc)[2][2][4][2], const Unit& u, int wr, int wc, int fr_, int fq) const {
        int fr = fr_; asm volatile("" : "+v"(fr));
        const int lrow0 = wr * 64 + fr, lcol0 = wc * 32 + 8 * fq;
        const int br = u.br;
        const bool lastb = (br == 3);
        const unsigned char* gp0 = (const unsigned char*)G + ((size_t)u.pm * 16 + br * 4 + u.pn) * 65536 + (((wr * 4 + wc) * 4 + fq) * 16 + fr) * 16;
        const unsigned char* gnp = lastb ? gp0 : gp0 + 4 * 65536;
        u32x4 gc[2][4], gn[2][4];
#pragma unroll
        for (int ai = 0; ai < 2; ++ai)
#pragma unroll
            for (int m = 0; m < 4; ++m) { gc[ai][m] = *(const u32x4*)(gp0 + (ai * 4 + m) * 8192); gn[ai][m] = (u32x4){0u, 0u, 0u, 0u}; if (!lastb) gn[ai][m] = *(const u32x4*)(gnp + (ai * 4 + m) * 8192); }
#pragma unroll
        for (int ai = 0; ai < 2; ++ai)
#pragma unroll
            for (int m = 0; m < 4; ++m)
#pragma unroll
                for (int bj = 0; bj < 2; ++bj) {
#pragma unroll
                    for (int n = 0; n < 2; ++n) {
                        const unsigned c = gc[ai][m][bj * 2 + n], d = gn[ai][m][bj * 2 + n];
                        float fc[4], fd[4];
                        fc[0] = (float)(c & 0xffu); fc[1] = (float)((c >> 8) & 0xffu); fc[2] = (float)((c >> 16) & 0xffu); fc[3] = (float)(c >> 24);
                        fd[0] = (float)(d & 0xffu); fd[1] = (float)((d >> 8) & 0xffu); fd[2] = (float)((d >> 16) & 0xffu); fd[3] = (float)(d >> 24);
#pragma unroll
                        for (int j = 0; j < 4; ++j) acc[ai][bj][m][n][j] *= fc[j] * (lastb ? (1.0f / 255.0f) : __builtin_amdgcn_rcpf(fd[j]));
                    }
                    if (lastb) { const f32x4 v0 = acc[ai][bj][m][0], v1 = acc[ai][bj][m][1];
                        u32x4 w; w.x = cvt_pk_bf16(v0[0], v0[1]); w.y = cvt_pk_bf16(v0[2], v0[3]); w.z = cvt_pk_bf16(v1[0], v1[1]); w.w = cvt_pk_bf16(v1[2], v1[3]);
                        *(u32x4*)(merged + ((size_t)u.pm * BM + lrow0 + ai * HALF + m * 16) * DM + u.pn * BM + lcol0 + bj * HALF) = w; }
                }
    }
};
struct EpiRes {
    static constexpr bool PERM = true;
    static __device__ __forceinline__ bool zero_after(const Unit&) { return true; }
    const float* res32; const bf16_t* res16; bf16_t* O;
    __device__ __forceinline__ void operator()(f32x4 (&acc)[2][2][4][2], const Unit& u, int wr, int wc, int fr_, int fq) const {
        int fr = fr_; asm volatile("" : "+v"(fr));
        const int row0 = u.pm * BM + wr * 64 + fr, col0 = u.pn * BM + wc * 32 + 8 * fq;
        const bool r16 = (res16 != nullptr);
#pragma unroll
        for (int ai = 0; ai < 2; ++ai)
#pragma unroll
            for (int m = 0; m < 4; ++m) { const size_t off = (size_t)(row0 + ai * HALF + m * 16) * DM + col0;
                float r[2][8];
#pragma unroll
                for (int bj = 0; bj < 2; ++bj) {
                    if (r16) unpack8(*(const u32x4*)(res16 + off + bj * HALF), r[bj]);
                    else load8f(res32 + off + bj * HALF, r[bj]); }
#pragma unroll
                for (int bj = 0; bj < 2; ++bj) { float o[8];
#pragma unroll
                    for (int j = 0; j < 4; ++j) { o[j] = acc[ai][bj][m][0][j] + r[bj][j]; o[4 + j] = acc[ai][bj][m][1][j] + r[bj][4 + j]; }
                    *(u32x4*)(O + off + bj * HALF) = pack8(o); } }
    }
};

template <int K, size_t B_BR, class Epi, class Sched>
__device__ __forceinline__ void gemm_phase(int wid0, LAS unsigned char* lds, const Gemm g, const Sched& S, const Epi& E) {
    const int tid = otid(wid0), wid = __builtin_amdgcn_readfirstlane(tid >> 6), lane = tid & 63, wr = wid >> 2, wc = wid & 3, fr = lane & 15, fq = lane >> 4;
    constexpr int nt = K / BK;
    unsigned voffA[2], voffB[2];
#pragma unroll
    for (int i = 0; i < 2; ++i) { int R, C; stage_rc(tid * 16 + i * 8192, R, C); const int Rb = Epi::PERM ? ((R & ~31) + perm32(R & 31)) : R;
        voffA[i] = (unsigned)(R * K + C) * 2u; voffB[i] = (unsigned)(Rb * K + C) * 2u; }
    constexpr size_t kstep = (size_t)(BK * 2);
    constexpr size_t hstep = (size_t)HALF * K * 2;
    constexpr size_t tstep = 2 * hstep;
    const unsigned ldsw = (unsigned)wid * 1024u;
    const int aoff = lds_byte(wr * 64 + fr, fq * 8), boff = lds_byte(wc * 32 + fr, fq * 8);
#define PG8_SA(b, h) (((b) * 2 + (h)) * HTB)
#define PG8_SB(b, h) ((4 + (b) * 2 + (h)) * HTB)
#define PG8_STAGE(bufoff, gbase, voff) do { _Pragma("unroll") for (int _i = 0; _i < 2; ++_i) \
        __builtin_amdgcn_global_load_lds((const unsigned*)((const char*)(gbase) + (voff)[_i]), (LAS unsigned*)(lds + (bufoff) + ldsw + _i * 8192), 16, 0, 0); } while (0)
#define PG8_LDA(dst, b, h) do { _Pragma("unroll") for (int m = 0; m < 4; ++m) _Pragma("unroll") for (int k = 0; k < 2; ++k) dst[m][k] = *(const LAS bf16x8*)(lds + PG8_SA(b, h) + aoff + m * 2048 + k * 1024); } while (0)
#define PG8_LDB(dst, b, h) do { _Pragma("unroll") for (int n = 0; n < 2; ++n) _Pragma("unroll") for (int k = 0; k < 2; ++k) dst[n][k] = *(const LAS bf16x8*)(lds + PG8_SB(b, h) + boff + n * 2048 + k * 1024); } while (0)
#define PG8_MMA(ai, bj, At, Bt) do { __builtin_amdgcn_s_setprio(1); _Pragma("unroll") for (int m = 0; m < 4; ++m) _Pragma("unroll") for (int n = 0; n < 2; ++n) _Pragma("unroll") for (int k = 0; k < 2; ++k) \
        acc[ai][bj][m][n] = __builtin_amdgcn_mfma_f32_16x16x32_bf16(Bt[n][k], At[m][k], acc[ai][bj][m][n], 0, 0, 0); __builtin_amdgcn_s_setprio(0); } while (0)
#define PG8_WAIT_V(n) asm volatile("s_waitcnt vmcnt(" #n ")" ::: "memory")
#define PG8_WAIT_L(n) asm volatile("s_waitcnt lgkmcnt(" #n ")" ::: "memory")
#define PG8_BAR __builtin_amdgcn_s_barrier()
#define PG8_SCHED __builtin_amdgcn_sched_barrier(0)
    Unit cur, nxt; int ui = 0;
    if (!S.next(0, cur)) return;
    f32x4 acc[2][2][4][2];
#pragma unroll
    for (int a = 0; a < 2; ++a)
#pragma unroll
        for (int b = 0; b < 2; ++b)
#pragma unroll
            for (int m = 0; m < 4; ++m)
#pragma unroll
                for (int n = 0; n < 2; ++n) acc[a][b][m][n] = (f32x4){0.f, 0.f, 0.f, 0.f};
    bf16x8 At[4][2], B0[2][2], B1[2][2];
    const char* cA = (const char*)g.A + (size_t)cur.pm * tstep + S.aoff(cur); int rb0, rb1; S.brow(cur, rb0, rb1);
    const char* cB = (const char*)g.Bt + (size_t)rb0 * (K * 2) + (size_t)cur.br * B_BR; const char* cBh = (const char*)g.Bt + (size_t)rb1 * (K * 2) + (size_t)cur.br * B_BR;
    PG8_STAGE(PG8_SB(0, 0), cB, voffB); PG8_STAGE(PG8_SA(0, 0), cA, voffA); PG8_STAGE(PG8_SB(0, 1), cBh, voffB); PG8_STAGE(PG8_SA(0, 1), cA + hstep, voffA);
    if (wr == 1) PG8_BAR;
    PG8_WAIT_V(4); PG8_BAR;
    PG8_STAGE(PG8_SB(1, 0), cB + kstep, voffB); PG8_STAGE(PG8_SA(1, 0), cA + kstep, voffA); PG8_STAGE(PG8_SB(1, 1), cBh + kstep, voffB);
    PG8_WAIT_V(6); PG8_BAR;
    for (;;) {
        const bool has_next = S.next(ui + 1, nxt);
        const char* nA = has_next ? (const char*)g.A + (size_t)nxt.pm * tstep + S.aoff(nxt) : cA; int rn0 = 0, rn1 = 0; if (has_next) S.brow(nxt, rn0, rn1);
        const char* nB = has_next ? (const char*)g.Bt + (size_t)rn0 * (K * 2) + (size_t)nxt.br * B_BR : cB; const char* nBh = has_next ? (const char*)g.Bt + (size_t)rn1 * (K * 2) + (size_t)nxt.br * B_BR : cBh;
        for (int t = 0; t < nt; t += 2) {
            const bool last = (t == nt - 2);
            const char* a1 = cA + (size_t)(t + 1) * kstep;
            const char* a2 = last ? nA : cA + (size_t)(t + 2) * kstep; const char* b2 = last ? nB : cB + (size_t)(t + 2) * kstep; const char* b2h = last ? nBh : cBh + (size_t)(t + 2) * kstep;
            const char* a3 = a2 + kstep; const char* b3 = b2 + kstep; const char* b3h = b2h + kstep;
            PG8_LDB(B0, 0, 0); PG8_SCHED; PG8_LDA(At, 0, 0); PG8_STAGE(PG8_SA(1, 1), a1 + hstep, voffA);
            PG8_WAIT_L(8); PG8_BAR; PG8_WAIT_L(0); PG8_MMA(0, 0, At, B0); PG8_BAR; PG8_SCHED;
            PG8_LDB(B1, 0, 1); PG8_STAGE(PG8_SB(0, 0), b2, voffB);
            PG8_BAR; PG8_WAIT_L(0); PG8_MMA(0, 1, At, B1); PG8_BAR;
            PG8_LDA(At, 0, 1); PG8_STAGE(PG8_SA(0, 0), a2, voffA);
            PG8_BAR; PG8_WAIT_L(0); PG8_MMA(1, 0, At, B0); PG8_BAR; PG8_SCHED;
            PG8_STAGE(PG8_SB(0, 1), b2h, voffB);
            PG8_WAIT_V(6); PG8_BAR; PG8_MMA(1, 1, At, B1); PG8_BAR;
            PG8_LDB(B0, 1, 0); PG8_SCHED; PG8_LDA(At, 1, 0); PG8_STAGE(PG8_SA(0, 1), a2 + hstep, voffA);
            PG8_WAIT_L(8); PG8_BAR; PG8_WAIT_L(0); PG8_MMA(0, 0, At, B0); PG8_BAR; PG8_SCHED;
            PG8_LDB(B1, 1, 1); PG8_STAGE(PG8_SB(1, 0), b3, voffB);
            PG8_BAR; PG8_WAIT_L(0); PG8_MMA(0, 1, At, B1); PG8_BAR;
            PG8_LDA(At, 1, 1); PG8_STAGE(PG8_SA(1, 0), a3, voffA);
            PG8_BAR; PG8_WAIT_L(0); PG8_MMA(1, 0, At, B0); PG8_BAR; PG8_SCHED;
            PG8_STAGE(PG8_SB(1, 1), b3h, voffB);
            PG8_WAIT_V(6); PG8_BAR; PG8_MMA(1, 1, At, B1); PG8_BAR;
        }
        E(acc, cur, wr, wc, fr, fq);
        if (!has_next) break;
        if (Epi::zero_after(cur))
#pragma unroll
        for (int a = 0; a < 2; ++a)
#pragma unroll
            for (int b = 0; b < 2; ++b)
#pragma unroll
                for (int m = 0; m < 4; ++m)
#pragma unroll
                    for (int n = 0; n < 2; ++n) acc[a][b][m][n] = (f32x4){0.f, 0.f, 0.f, 0.f};
        cur = nxt; cA = nA; cB = nB; cBh = nBh; ++ui;
    }
    PG8_WAIT_V(0);
    if (wr == 0) PG8_BAR;
    PG8_BAR;
#undef PG8_SA
#undef PG8_SB
#undef PG8_STAGE
#undef PG8_LDA
#undef PG8_LDB
#undef PG8_MMA
#undef PG8_WAIT_V
#undef PG8_WAIT_L
#undef PG8_BAR
#undef PG8_SCHED
}
template <int RB, class Epi, class Sched>
__device__ __forceinline__ void gemm_phase_f8(int wid0, LAS unsigned char* lds, const Gemm g, const Sched& S, const Epi& E) {
    const int tid = otid(wid0), wid = __builtin_amdgcn_readfirstlane(tid >> 6), lane = tid & 63, wr = wid >> 2, wc = wid & 3, fr = lane & 15, fq = lane >> 4;
    constexpr int nt = RB / 128;
    constexpr int K = RB / 2;
    constexpr size_t B_BR = 0;
    unsigned voffA[2], voffB[2]; int aoff, boff;
    constexpr size_t kstep = (size_t)(BK * 2);
    constexpr size_t hstep = (size_t)HALF * K * 2;
    constexpr size_t tstep = 2 * hstep;
    const unsigned ldsw = (unsigned)wid * 1024u;
#define PG8_SETUP() do { const int t_ = otid(wid0), l_ = t_ & 63, fr_ = l_ & 15, fq_ = l_ >> 4; \
        _Pragma("unroll") for (int i = 0; i < 2; ++i) { int R, C; stage_rc(t_ * 16 + i * 8192, R, C); const int Rb = Epi::PERM ? ((R & ~31) + perm32(R & 31)) : R; \
            voffA[i] = (unsigned)(R * K + C) * 2u; voffB[i] = (unsigned)(Rb * K + C) * 2u; } \
        aoff = lds_byte(wr * 64 + fr_, fq_ * 16); boff = lds_byte(wc * 32 + fr_, fq_ * 16); } while (0)
    PG8_SETUP();
#define PG8_SA(b, h) (((b) * 2 + (h)) * HTB)
#define PG8_SB(b, h) ((4 + (b) * 2 + (h)) * HTB)
#define PG8_STAGE(bufoff, gbase, voff) do { _Pragma("unroll") for (int _i = 0; _i < 2; ++_i) \
        __builtin_amdgcn_global_load_lds((const unsigned*)((const char*)(gbase) + (voff)[_i]), (LAS unsigned*)(lds + (bufoff) + ldsw + _i * 8192), 16, 0, 0); } while (0)
#define PG8_LDA(dst, b, h) do { _Pragma("unroll") for (int m = 0; m < 4; ++m) dst[m] = *(const LAS i32x8*)(lds + PG8_SA(b, h) + aoff + m * 2048); } while (0)
#define PG8_LDB(dst, b, h) do { _Pragma("unroll") for (int n = 0; n < 2; ++n) dst[n] = *(const LAS i32x8*)(lds + PG8_SB(b, h) + boff + n * 2048); } while (0)
#define PG8_MMA(ai, bj, At, Bt) do { __builtin_amdgcn_s_setprio(1); _Pragma("unroll") for (int m = 0; m < 4; ++m) _Pragma("unroll") for (int n = 0; n < 2; ++n) \
        acc[ai][bj][m][n] = __builtin_amdgcn_mfma_scale_f32_16x16x128_f8f6f4(Bt[n], At[m], acc[ai][bj][m][n], 0, 0, 0, 127, 0, 127); __builtin_amdgcn_s_setprio(0); } while (0)
#define PG8_WAIT_V(n) asm volatile("s_waitcnt vmcnt(" #n ")" ::: "memory")
#define PG8_WAIT_L(n) asm volatile("s_waitcnt lgkmcnt(" #n ")" ::: "memory")
#define PG8_BAR __builtin_amdgcn_s_barrier()
#define PG8_SCHED __builtin_amdgcn_sched_barrier(0)
    Unit cur, nxt; int ui = 0;
    if (!S.next(0, cur)) return;
    f32x4 acc[2][2][4][2];
#pragma unroll
    for (int a = 0; a < 2; ++a)
#pragma unroll
        for (int b = 0; b < 2; ++b)
#pragma unroll
            for (int m = 0; m < 4; ++m)
#pragma unroll
                for (int n = 0; n < 2; ++n) acc[a][b][m][n] = (f32x4){0.f, 0.f, 0.f, 0.f};
    i32x8 At[4], B0[2], B1[2];
    const char* cA = (const char*)g.A + (size_t)cur.pm * tstep + S.aoff(cur); int rb0, rb1; S.brow(cur, rb0, rb1);
    const char* cB = (const char*)g.Bt + (size_t)rb0 * (K * 2) + (size_t)cur.br * B_BR; const char* cBh = (const char*)g.Bt + (size_t)rb1 * (K * 2) + (size_t)cur.br * B_BR;
    PG8_STAGE(PG8_SB(0, 0), cB, voffB); PG8_STAGE(PG8_SA(0, 0), cA, voffA); PG8_STAGE(PG8_SB(0, 1), cBh, voffB); PG8_STAGE(PG8_SA(0, 1), cA + hstep, voffA);
    if (wr == 1) PG8_BAR;
    PG8_WAIT_V(4); PG8_BAR;
    PG8_STAGE(PG8_SB(1, 0), cB + kstep, voffB); PG8_STAGE(PG8_SA(1, 0), cA + kstep, voffA); PG8_STAGE(PG8_SB(1, 1), cBh + kstep, voffB);
    PG8_WAIT_V(6); PG8_BAR;
    for (;;) {
        const bool has_next = S.next(ui + 1, nxt);
        const char* nA = has_next ? (const char*)g.A + (size_t)nxt.pm * tstep + S.aoff(nxt) : cA; int rn0 = 0, rn1 = 0; if (has_next) S.brow(nxt, rn0, rn1);
        const char* nB = has_next ? (const char*)g.Bt + (size_t)rn0 * (K * 2) + (size_t)nxt.br * B_BR : cB; const char* nBh = has_next ? (const char*)g.Bt + (size_t)rn1 * (K * 2) + (size_t)nxt.br * B_BR : cBh;
        for (int t = 0; t < nt; t += 2) {
            const bool last = (t == nt - 2);
            const char* a1 = cA + (size_t)(t + 1) * kstep;
            const char* a2 = last ? nA : cA + (size_t)(t + 2) * kstep; const char* b2 = last ? nB : cB + (size_t)(t + 2) * kstep; const char* b2h = last ? nBh : cBh + (size_t)(t + 2) * kstep;
            const char* a3 = a2 + kstep; const char* b3 = b2 + kstep; const char* b3h = b2h + kstep;
            PG8_LDB(B0, 0, 0); PG8_SCHED; PG8_LDA(At, 0, 0); PG8_STAGE(PG8_SA(1, 1), a1 + hstep, voffA);
            PG8_WAIT_L(8); PG8_BAR; PG8_WAIT_L(0); PG8_MMA(0, 0, At, B0); PG8_BAR; PG8_SCHED;
            PG8_LDB(B1, 0, 1); PG8_STAGE(PG8_SB(0, 0), b2, voffB);
            PG8_BAR; PG8_WAIT_L(0); PG8_MMA(0, 1, At, B1); PG8_BAR;
            PG8_LDA(At, 0, 1); PG8_STAGE(PG8_SA(0, 0), a2, voffA);
            PG8_BAR; PG8_WAIT_L(0); PG8_MMA(1, 0, At, B0); PG8_BAR; PG8_SCHED;
            PG8_STAGE(PG8_SB(0, 1), b2h, voffB);
            PG8_WAIT_V(6); PG8_BAR; PG8_MMA(1, 1, At, B1); PG8_BAR;
            PG8_LDB(B0, 1, 0); PG8_SCHED; PG8_LDA(At, 1, 0); PG8_STAGE(PG8_SA(0, 1), a2 + hstep, voffA);
            PG8_WAIT_L(8); PG8_BAR; PG8_WAIT_L(0); PG8_MMA(0, 0, At, B0); PG8_BAR; PG8_SCHED;
            PG8_LDB(B1, 1, 1); PG8_STAGE(PG8_SB(1, 0), b3, voffB);
            PG8_BAR; PG8_WAIT_L(0); PG8_MMA(0, 1, At, B1); PG8_BAR;
            PG8_LDA(At, 1, 1); PG8_STAGE(PG8_SA(1, 0), a3, voffA);
            PG8_BAR; PG8_WAIT_L(0); PG8_MMA(1, 0, At, B0); PG8_BAR; PG8_SCHED;
            PG8_STAGE(PG8_SB(1, 1), b3h, voffB);
            PG8_WAIT_V(6); PG8_BAR; PG8_MMA(1, 1, At, B1); PG8_BAR;
        }
        { const int t2_ = otid(wid0) & 63; E(acc, cur, wr, wc, t2_ & 15, t2_ >> 4); }
        if (!has_next) break;
        if (Epi::zero_after(cur))
#pragma unroll
        for (int a = 0; a < 2; ++a)
#pragma unroll
            for (int b = 0; b < 2; ++b)
#pragma unroll
                for (int m = 0; m < 4; ++m)
#pragma unroll
                    for (int n = 0; n < 2; ++n) acc[a][b][m][n] = (f32x4){0.f, 0.f, 0.f, 0.f};
        cur = nxt; cA = nA; cB = nB; cBh = nBh; ++ui;
        PG8_SETUP();
    }
    PG8_WAIT_V(0);
    if (wr == 0) PG8_BAR;
    PG8_BAR;
#undef PG8_SETUP
#undef PG8_SA
#undef PG8_SB
#undef PG8_STAGE
#undef PG8_LDA
#undef PG8_LDB
#undef PG8_MMA
#undef PG8_WAIT_V
#undef PG8_WAIT_L
#undef PG8_BAR
#undef PG8_SCHED
}
}

__device__ void phase_norm_bf16(int wid0, const float* __restrict__ xin, const bf16_t* __restrict__ xin16, const float* __restrict__ g, bf16_t* __restrict__ h, unsigned char* __restrict__ h8, int rows);
struct TJob { const float* src; bf16_t* dst; unsigned char* dst8; int R, C, tr, tc; float scale; };
__device__ __forceinline__ TJob prep_job(const Params& p, int i) {
    bf16_t* win = (bf16_t*)(p.ws + p.o_win); bf16_t* wb = (bf16_t*)(p.ws + p.o_wb); bf16_t* wo = (bf16_t*)(p.ws + p.o_wo); bf16_t* pw = (bf16_t*)(p.ws + p.o_pw);
    constexpr int T_WIN = 16 * 160, T_WB = 8 * 16, T_WO = 16 * 16, T_PW = 4;
    constexpr int N0 = DEPTH * T_WIN, N1 = N0 + 8 * T_WB, N2 = N1 + DEPTH * T_WO;
    TJob j; j.scale = 1.0f; j.dst8 = nullptr;
    if (i < N0) { const int l = i / T_WIN, t = i % T_WIN; j.src = p.in[2] + (size_t)l * DM * INC; j.dst = win + (size_t)l * DM * WINR; j.R = DM; j.C = INC; j.tr = t / 160; j.tc = t % 160;
        const int piece = j.tc >> 3; j.scale = (piece >= 12 || piece == 3 || piece == 7 || piece == 11) ? -1.4426950408889634f : (piece == 5 || piece == 8) ? -0.6931471805599453f : 1.0f;
        if (piece >= 12) { j.dst = nullptr; j.dst8 = p.ws + p.o_wg8 + (size_t)l * 4096 * DM + (size_t)(j.tc - 96) * 64 * DM; j.scale *= 32.0f; } }
    else if (i < N1) { const int k = i - N0, m = k / T_WB, t = k % T_WB; j.src = p.in[14] + (size_t)m * BWID * DM; j.dst = wb + (size_t)m * BWID * DM; j.R = BWID; j.C = DM; j.tr = t / 16; j.tc = t % 16; }
    else if (i < N2) { const int k = i - N1, l = k / T_WO, t = k % T_WO; j.src = p.in[15] + (size_t)l * DM * DM; j.dst = wo + (size_t)l * DM * DM; j.R = DM; j.C = DM; j.tr = t / 16; j.tc = t % 16; }
    else { const int k = i - N2, m = k / T_PW, t = k % T_PW; j.src = p.in[3] + (size_t)m * 128 * 128; j.dst = pw + (size_t)m * 128 * 128; j.R = 128; j.C = 128; j.tr = t / 2; j.tc = t % 2; }
    return j;
}
__device__ void phase_prep(int wid0, const Params& p, LAS unsigned char* lds) {
    LAS float* sm = (LAS float*)lds;
    const int tid = otid(wid0);
    constexpr int NT = DEPTH * 16 * 160 + 8 * 8 * 16 + DEPTH * 16 * 16 + 8 * 4;
    const int lr = tid >> 4, lc = (tid & 15) * 4;
    f32x4 v0, v1;
    int i = blockIdx.x;
    if (i < NT) { const TJob j = prep_job(p, i); const float* sp = j.src + (size_t)(j.tr * 64 + lr) * j.C + j.tc * 64 + lc; v0 = *(const f32x4*)sp; v1 = *(const f32x4*)(sp + (size_t)32 * j.C); }
    for (; i < NT; i += gridDim.x) {
        const TJob j = prep_job(p, i);
#pragma unroll
        for (int e = 0; e < 4; ++e) { sm[lr * 65 + lc + e] = v0[e]; sm[(lr + 32) * 65 + lc + e] = v1[e]; }
        __syncthreads();
        const int in = i + gridDim.x;
        if (in < NT) { const TJob jn = prep_job(p, in); const float* sp = jn.src + (size_t)(jn.tr * 64 + lr) * jn.C + jn.tc * 64 + lc; v0 = *(const f32x4*)sp; v1 = *(const f32x4*)(sp + (size_t)32 * jn.C); }
        { const int c = tid >> 3, r8 = (tid & 7) * 8; float o[8];
#pragma unroll
          for (int e = 0; e < 8; ++e) o[e] = sm[(r8 + e) * 65 + c] * j.scale;
          if (j.dst8) { unsigned w0 = 0u, w1 = 0u; w0 = __builtin_amdgcn_cvt_pk_fp8_f32(o[0], o[1], w0, false); w0 = __builtin_amdgcn_cvt_pk_fp8_f32(o[2], o[3], w0, true); w1 = __builtin_amdgcn_cvt_pk_fp8_f32(o[4], o[5], w1, false); w1 = __builtin_amdgcn_cvt_pk_fp8_f32(o[6], o[7], w1, true);
              *(u32x2*)(j.dst8 + (size_t)c * DM + j.tr * 64 + r8) = (u32x2){w0, w1}; }
          else *(u32x4*)(j.dst + (size_t)(j.tc * 64 + c) * j.R + j.tr * 64 + r8) = pack8(o); }
        __syncthreads();
    }
    const float* sgw = p.in[11]; bf16_t* sw = (bf16_t*)(p.ws + p.o_sw);
    for (int k = blockIdx.x * 512 + tid; k < DEPTH * 4 * 128 * 128; k += gridDim.x * 512) { const int s_ = k & 127, t = (k >> 7) & 127; sw[k] = (s_ <= t) ? f2bf(sgw[k]) : (bf16_t)0; }
    {
        float* sd = (float*)(p.ws + p.o_small); const int gt = blockIdx.x * 512 + tid, gs = gridDim.x * 512;
#define CPY(K, OFF, N) for (int k = gt; k < (N); k += gs) sd[(OFF) + k] = p.in[K][k];
        CPY(1, SM1, 2048) CPY(4, SM4, 1024) CPY(5, SM5, 31744) CPY(6, SM6, 1024) CPY(7, SM7, 1024) CPY(8, SM8, 1024) CPY(9, SM9, 1024) CPY(10, SM10, 1024) CPY(12, SM12, 1024) CPY(13, SM13, 3072) CPY(16, SM16, 1024)
#undef CPY
    }
    phase_norm_bf16(wid0, p.in[0], nullptr, p.in[1], (bf16_t*)(p.ws + p.o_h), p.ws + p.o_h8, NTOK);
}

__device__ void phase_norm_bf16(int wid0, const float* __restrict__ xin, const bf16_t* __restrict__ xin16, const float* __restrict__ g, bf16_t* __restrict__ h, unsigned char* __restrict__ h8, int rows) {
    const int tid = otid(wid0), lane = tid & 63, w = tid >> 6;
    float gv[2][8];
    load8f(g + 8 * lane, gv[0]); load8f(g + 512 + 8 * lane, gv[1]);
    for (int row = blockIdx.x * 8 + w; row < rows; row += gridDim.x * 8) {
        float v[2][8];
        if (xin16) { const bf16_t* xr = xin16 + (size_t)row * DM + 8 * lane; unpack8(*(const u32x4*)xr, v[0]); unpack8(*(const u32x4*)(xr + 512), v[1]); }
        else { const float* xr = xin + (size_t)row * DM + 8 * lane; load8f(xr, v[0]); load8f(xr + 512, v[1]); }
        float ss = 0.f;
#pragma unroll
        for (int i = 0; i < 2; ++i)
#pragma unroll
            for (int j = 0; j < 8; ++j) ss += v[i][j] * v[i][j];
        ss = wave_sum(wid0, ss);
        const float r = rsqrtf(ss * (1.0f / 1024.0f) + 1e-6f);
#pragma unroll
        for (int i = 0; i < 2; ++i) { float o[8];
#pragma unroll
            for (int j = 0; j < 8; ++j) o[j] = v[i][j] * r * gv[i][j];
            *(u32x4*)(h + (size_t)row * DM + 512 * i + 8 * lane) = pack8(o);
            unsigned w0 = 0u, w1 = 0u; w0 = __builtin_amdgcn_cvt_pk_fp8_f32(o[0], o[1], w0, false); w0 = __builtin_amdgcn_cvt_pk_fp8_f32(o[2], o[3], w0, true); w1 = __builtin_amdgcn_cvt_pk_fp8_f32(o[4], o[5], w1, false); w1 = __builtin_amdgcn_cvt_pk_fp8_f32(o[6], o[7], w1, true);
            *(u32x2*)(h8 + (size_t)row * DM + 512 * i + 8 * lane) = (u32x2){w0, w1}; }
    }
}
__device__ void phase_norm_final(int wid0, const bf16_t* __restrict__ x, float* __restrict__ out, const float* __restrict__ g, int rows) {
    const int tid = otid(wid0), lane = tid & 63, w = tid >> 6;
    float gv[2][8];
    load8f(g + 8 * lane, gv[0]); load8f(g + 512 + 8 * lane, gv[1]);
    for (int row = blockIdx.x * 8 + w; row < rows; row += gridDim.x * 8) {
        const bf16_t* xr = x + (size_t)row * DM + 8 * lane; float* orow = out + (size_t)row * DM + 8 * lane;
        float v[2][8]; unpack8(*(const u32x4*)xr, v[0]); unpack8(*(const u32x4*)(xr + 512), v[1]);
        float ss = 0.f;
#pragma unroll
        for (int i = 0; i < 2; ++i)
#pragma unroll
            for (int j = 0; j < 8; ++j) ss += v[i][j] * v[i][j];
        ss = wave_sum(wid0, ss);
        const float r = rsqrtf(ss * (1.0f / 1024.0f) + 1e-6f);
#pragma unroll
        for (int i = 0; i < 2; ++i) {
            f32x4 a, b;
#pragma unroll
            for (int j = 0; j < 4; ++j) { a[j] = v[i][j] * r * gv[i][j]; b[j] = v[i][4 + j] * r * gv[i][4 + j]; }
            *(f32x4*)(orow + 512 * i) = a; *(f32x4*)(orow + 512 * i + 4) = b; }
    }
}

#define PO(k) ((size_t)(k) * TS * BWID)
__device__ void mix_sc(int wid0, const Params& p, int l, const bf16_t* proj, bf16_t* z3, int r0, int pos0) {
    const int tid = otid(wid0), lane = tid & 63, w = tid >> 6, c0 = lane * 8;
    const float* scw = SMALLP(p, SM13) + (size_t)l * 3 * BWID + c0;
    float w0[8], w1[8], w2[8]; load8f(scw, w0); load8f(scw + BWID, w1); load8f(scw + 2 * BWID, w2);
    const int r = r0 + 16 * w, pos = pos0 + 16 * w;
    const bf16_t* bgp = proj + PO(6) + c0; const bf16_t* cxp = proj + PO(7) + c0;
    u32x4 vb[16], vc[18];
    vc[0] = (u32x4){0u, 0u, 0u, 0u}; vc[1] = vc[0];
    if (pos > 0) { vc[0] = *(const u32x4*)(cxp + (size_t)(r - 2) * BWID); vc[1] = *(const u32x4*)(cxp + (size_t)(r - 1) * BWID); }
#pragma unroll
    for (int jj = 0; jj < 16; ++jj) { vb[jj] = *(const u32x4*)(bgp + (size_t)(r + jj) * BWID); vc[2 + jj] = *(const u32x4*)(cxp + (size_t)(r + jj) * BWID); }
    float p2[8], p1[8];
    unpack8(vc[0], p2); unpack8(vc[1], p1);
#pragma unroll
    for (int jj = 0; jj < 16; ++jj) {
        float b[8], cur[8], o[8]; unpack8(vb[jj], b); unpack8(vc[2 + jj], cur);
#pragma unroll
        for (int j = 0; j < 8; ++j) { o[j] = b[j] * (w0[j] * p2[j] + w1[j] * p1[j] + w2[j] * cur[j]); p2[j] = p1[j]; p1[j] = cur[j]; }
        *(u32x4*)(z3 + (size_t)(r + jj) * BWID + c0) = pack8(o);
    }
}

__device__ void mix_conv(int wid0, const Params& p, int l, const bf16_t* proj, bf16_t* z1, int r0, int pos0, LAS unsigned char* lds) {
    const int tid = otid(wid0), lane = tid & 63, w = tid >> 6, c0 = lane * 8;
    LAS unsigned char* Y = lds; LAS unsigned char* W = lds + 94 * VP;
    const float* cw = SMALLP(p, SM5) + (size_t)l * 31 * BWID;
    float bias[8], lng[8], lnb[8];
    load8f(SMALLP(p, SM6) + (size_t)l * BWID + c0, bias); load8f(SMALLP(p, SM7) + (size_t)l * BWID + c0, lng); load8f(SMALLP(p, SM8) + (size_t)l * BWID + c0, lnb);
    u32x4 la[12];
#define CONV_LOAD(q) do { _Pragma("unroll") for (int i = 0; i < 12; ++i) { const int row = 12 * w + i; const bool valid = (row < 94) && (pos0 + 64 * (q) - 30 + row >= 0); \
        la[i] = (u32x4){0u, 0u, 0u, 0u}; if (valid) la[i] = *(const u32x4*)(proj + (size_t)(r0 + 64 * (q) - 30 + row) * BWID + PO(2) + c0); } } while (0)
    CONV_LOAD(0);
    for (int i = tid; i < 31 * 64; i += 512) { const int k = i >> 6, cgp = i & 63; float f[8]; load8f(cw + k * BWID + cgp * 8, f); *(LAS u32x4*)(W + k * 1024 + cgp * 16) = pack8(f); }
#pragma unroll
    for (int q = 0; q < 2; ++q) {
        const int tr = r0 + 64 * q;
        __syncthreads();
#pragma unroll
        for (int i = 0; i < 12; ++i) { const int row = 12 * w + i; if (row < 94) *(LAS u32x4*)(Y + row * VP + lane * 16) = la[i]; }
        __syncthreads();
        if (q == 0) CONV_LOAD(1);
        u32x4 gtv[8];
#pragma unroll
        for (int j = 0; j < 8; ++j) gtv[j] = *(const u32x4*)(proj + (size_t)(tr + 8 * w + j) * BWID + PO(3) + c0);
        float acc[8][8];
#pragma unroll
        for (int j = 0; j < 8; ++j)
#pragma unroll
            for (int c = 0; c < 8; ++c) acc[j][c] = bias[c];
#pragma unroll 1
        for (int k = 0; k < 31; ++k) {
            float wv[8]; unpack8(*(const LAS u32x4*)(W + k * 1024 + lane * 16), wv);
#pragma unroll
            for (int j = 0; j < 8; ++j) { float yv[8]; unpack8(*(const LAS u32x4*)(Y + (8 * w + j + k) * VP + lane * 16), yv);
#pragma unroll
                for (int c = 0; c < 8; ++c) acc[j][c] += wv[c] * yv[c]; }
        }
#pragma unroll
        for (int j = 0; j < 8; ++j) {
            float s = 0.f, ss = 0.f;
#pragma unroll
            for (int c = 0; c < 8; ++c) { s += acc[j][c]; ss += acc[j][c] * acc[j][c]; }
            s = wave_sum(wid0, s); ss = wave_sum(wid0, ss);
            const float mean = s * (1.0f / 512.0f); const float var = fmaxf(ss * (1.0f / 512.0f) - mean * mean, 0.f); const float rstd = rsqrtf(var + 1e-5f);
            const int row = tr + 8 * w + j;
            float gt[8], o[8]; unpack8(gtv[j], gt);
#pragma unroll
            for (int c = 0; c < 8; ++c) { const float v = (acc[j][c] - mean) * rstd * lng[c] + lnb[c]; o[c] = silu(v) * silu(gt[c]); }
            *(u32x4*)(z1 + (size_t)row * BWID + c0) = pack8(o);
        }
    }
}

#undef CONV_LOAD
__device__ __forceinline__ u32x4 sel4(bool c, const u32x4 a, const u32x4 b) { u32x4 r; r.x = c ? a.x : b.x; r.y = c ? a.y : b.y; r.z = c ? a.z : b.z; r.w = c ? a.w : b.w; return r; }

__device__ void mix_pool(int wid0, const Params& p, int l, const bf16_t* proj, bf16_t* z0, int r0, int pos0, LAS unsigned char* lds) {
    const int tid = otid(wid0), lane = tid & 63, w = tid >> 6, c0 = lane * 8;
    LAS unsigned char* P = lds;
    {
        const int g4 = lane >> 4, win = 2 << g4;
        const int r = r0 + 16 * w, pos = pos0 + 16 * w;
        u32x4 R[32];
#pragma unroll
        for (int i = 0; i < 16; ++i) { R[i] = (u32x4){0u, 0u, 0u, 0u}; if (pos > 0) R[i] = *(const u32x4*)(proj + (size_t)(r - 16 + i) * BWID + c0); }
#pragma unroll
        for (int i = 0; i < 16; ++i) R[16 + i] = *(const u32x4*)(proj + (size_t)(r + i) * BWID + c0);
        float S[8];
#pragma unroll
        for (int j = 0; j < 8; ++j) S[j] = 0.f;
#pragma unroll
        for (int i = 1; i <= 16; ++i) { float x[8]; unpack8(R[16 - i], x); const float mk = (i <= win) ? 1.0f : 0.0f;
#pragma unroll
            for (int j = 0; j < 8; ++j) S[j] += mk * x[j]; }
#pragma unroll
        for (int jj = 0; jj < 16; ++jj) {
            const int ps = pos + jj; float xv[8], xo[8], o[8];
            unpack8(R[16 + jj], xv);
            const u32x4 ro = sel4(g4 < 2, sel4(g4 == 0, R[16 + jj - 2], R[16 + jj - 4]), sel4(g4 == 2, R[16 + jj - 8], R[jj]));
            unpack8(ro, xo);
            const int cnt = (ps + 1 < win) ? ps + 1 : win; const float inv = 1.0f / (float)cnt;
#pragma unroll
            for (int j = 0; j < 8; ++j) { S[j] += xv[j] - xo[j]; o[j] = S[j] * inv - xv[j]; }
            *(LAS u32x4*)(P + (16 * w + jj) * VP + lane * 16) = pack8(o);
        }
    }
    __syncthreads();
    {
        const int g = w >> 1, fr = lane & 15, fq = lane >> 4;
        const bf16_t* pwT = (const bf16_t*)(p.ws + p.o_pw) + (size_t)(l * 4 + g) * 128 * 128;
        u32x2 gtv[8][4];
#pragma unroll
        for (int tt = 0; tt < 8; ++tt)
#pragma unroll
            for (int dt = 0; dt < 4; ++dt) gtv[tt][dt] = *(const u32x2*)(proj + (size_t)(r0 + 16 * tt + fr) * BWID + PO(1) + 64 * w + 16 * dt + 4 * fq);
        bf16x8 A[4][4];
#pragma unroll
        for (int dt = 0; dt < 4; ++dt)
#pragma unroll
            for (int kk = 0; kk < 4; ++kk) A[dt][kk] = *(const bf16x8*)(pwT + (size_t)(64 * (w & 1) + 16 * dt + fr) * 128 + 32 * kk + 8 * fq);
        const float* psc = SMALLP(p, SM4) + (size_t)l * BWID;
        f32x4 sc[4];
#pragma unroll
        for (int dt = 0; dt < 4; ++dt) sc[dt] = *(const f32x4*)(psc + 64 * w + 16 * dt + 4 * fq);
#pragma unroll
        for (int tt = 0; tt < 8; ++tt) {
            bf16x8 Bf[4];
#pragma unroll
            for (int kk = 0; kk < 4; ++kk) Bf[kk] = *(const LAS bf16x8*)(P + (16 * tt + fr) * VP + (128 * g + 32 * kk + 8 * fq) * 2);
            f32x4 acc[4];
#pragma unroll
            for (int dt = 0; dt < 4; ++dt) { acc[dt] = (f32x4){0.f, 0.f, 0.f, 0.f};
#pragma unroll
                for (int kk = 0; kk < 4; ++kk) acc[dt] = __builtin_amdgcn_mfma_f32_16x16x32_bf16(A[dt][kk], Bf[kk], acc[dt], 0, 0, 0); }
            const int row = r0 + 16 * tt + fr;
#pragma unroll
            for (int dt = 0; dt < 4; ++dt) { const int d = 64 * w + 16 * dt + 4 * fq;
                float gt[4]; unpack4(gtv[tt][dt], gt);
                u32x2 o; o.x = cvt_pk_bf16(acc[dt][0] * sc[dt][0] * silu(gt[0]), acc[dt][1] * sc[dt][1] * silu(gt[1])); o.y = cvt_pk_bf16(acc[dt][2] * sc[dt][2] * silu(gt[2]), acc[dt][3] * sc[dt][3] * silu(gt[3]));
                *(u32x2*)(z0 + (size_t)row * BWID + d) = o; }
        }
    }
}

__device__ void mix_sgu(int wid0, const Params& p, int l, const bf16_t* proj, bf16_t* z2, int r0, LAS unsigned char* lds) {
    const int tid = otid(wid0), lane = tid & 63, w = tid >> 6, c0 = lane * 8;
    LAS unsigned char* V = lds;
    {
        float lng[8], lnb[8]; load8f(SMALLP(p, SM9) + (size_t)l * BWID + c0, lng); load8f(SMALLP(p, SM10) + (size_t)l * BWID + c0, lnb);
        u32x4 R[16];
#pragma unroll
        for (int jj = 0; jj < 16; ++jj) R[jj] = *(const u32x4*)(proj + (size_t)(r0 + 16 * w + jj) * BWID + PO(5) + c0);
#pragma unroll
        for (int jj = 0; jj < 16; ++jj) {
            float x[8], o[8]; unpack8(R[jj], x);
            float s = 0.f, ss = 0.f;
#pragma unroll
            for (int c = 0; c < 8; ++c) { s += x[c]; ss += x[c] * x[c]; }
            s = wave_sum(wid0, s); ss = wave_sum(wid0, ss);
            const float mean = s * (1.0f / 512.0f); const float var = fmaxf(ss * (1.0f / 512.0f) - mean * mean, 0.f); const float rstd = rsqrtf(var + 1e-5f);
#pragma unroll
            for (int c = 0; c < 8; ++c) o[c] = (x[c] - mean) * rstd * lng[c] + lnb[c];
            *(LAS u32x4*)(V + (16 * w + jj) * VP + lane * 16) = pack8(o);
        }
    }
    __syncthreads();
    {
        const int g = w >> 1, fr = lane & 15, fq = lane >> 4;
        const unsigned vbase = (unsigned)(size_t)V;
        bf16x8 A[4][4];
#pragma unroll
        for (int ct = 0; ct < 4; ++ct)
#pragma unroll
            for (int kk = 0; kk < 4; ++kk) {
                const unsigned a = vbase + (unsigned)((32 * kk + 8 * fq + (fr >> 2)) * VP + (64 * w + 16 * ct + 4 * (fr & 3)) * 2);
                const u32x2 lo = tr_read(a), hi = tr_read(a + 4 * VP);
                u32x4 t; t.x = lo.x; t.y = lo.y; t.z = hi.x; t.w = hi.y;
                A[ct][kk] = __builtin_bit_cast(bf16x8, t);
            }
        const bf16_t* swm = (const bf16_t*)(p.ws + p.o_sw) + (size_t)(l * 4 + g) * 128 * 128;
        const float* sb = SMALLP(p, SM12) + (size_t)(l * 4 + g) * 128;
#pragma unroll
        for (int hb = 0; hb < 2; ++hb) {
            u32x2 uu[4][4]; bf16x8 Wf[4][4]; float bias[4];
#pragma unroll
            for (int t4 = 0; t4 < 4; ++t4) { const int tt = hb * 4 + t4; const bf16_t* pr = proj + (size_t)(r0 + 16 * tt + fr) * BWID + 64 * w + 4 * fq;
#pragma unroll
                for (int ct = 0; ct < 4; ++ct) uu[t4][ct] = *(const u32x2*)(pr + PO(4) + 16 * ct);
#pragma unroll
                for (int kk = 0; kk < 4; ++kk) if (kk < (tt >> 1) + 1) Wf[t4][kk] = *(const bf16x8*)(swm + (size_t)(16 * tt + fr) * 128 + 32 * kk + 8 * fq);
                bias[t4] = sb[16 * tt + fr]; }
#pragma unroll
            for (int t4 = 0; t4 < 4; ++t4) { const int tt = hb * 4 + t4;
                f32x4 acc[4];
#pragma unroll
                for (int ct = 0; ct < 4; ++ct) acc[ct] = (f32x4){0.f, 0.f, 0.f, 0.f};
#pragma unroll
                for (int kk = 0; kk < 4; ++kk) if (kk < (tt >> 1) + 1) {
#pragma unroll
                    for (int ct = 0; ct < 4; ++ct) acc[ct] = __builtin_amdgcn_mfma_f32_16x16x32_bf16(A[ct][kk], Wf[t4][kk], acc[ct], 0, 0, 0); }
                const int row = r0 + 16 * tt + fr;
#pragma unroll
                for (int ct = 0; ct < 4; ++ct) { const int c = 64 * w + 16 * ct + 4 * fq;
                    float u[4]; unpack4(uu[t4][ct], u);
                    u32x2 o; o.x = cvt_pk_bf16(u[0] * (acc[ct][0] + bias[t4]), u[1] * (acc[ct][1] + bias[t4])); o.y = cvt_pk_bf16(u[2] * (acc[ct][2] + bias[t4]), u[3] * (acc[ct][3] + bias[t4]));
                    *(u32x2*)(z2 + (size_t)row * BWID + c) = o; }
            }
        }
    }
}

__device__ void phase_mix(int wid0, const Params& p, int l, const bf16_t* proj, bf16_t* z, LAS unsigned char* lds) {
    constexpr int nchunk = TS / 128;
    for (int i = blockIdx.x; i < 4 * nchunk; i += gridDim.x) {
        const int j = i % nchunk, br = ((i / nchunk) + j) & 3, r0 = j * 128, pos0 = (j & 15) * 128;
        if (br == 0) for (int rr = 0; rr < REP_M0; ++rr) { mix_pool(wid0, p, l, proj, z + PO(1), r0, pos0, lds); __syncthreads(); }
        else if (br == 1) for (int rr = 0; rr < REP_M1; ++rr) { mix_conv(wid0, p, l, proj, z + PO(3), r0, pos0, lds); __syncthreads(); }
        else if (br == 2) for (int rr = 0; rr < REP_M2; ++rr) { mix_sgu(wid0, p, l, proj, z + PO(4), r0, lds); __syncthreads(); }
        else for (int rr = 0; rr < REP_M3; ++rr) { mix_sc(wid0, p, l, proj, z + PO(6), r0, pos0); __syncthreads(); }
    }
}

#define XB_TMO      128
#define XB_XCNT(j)  (256  + 64 * (j))
#define XB_XSUB(j)  (1280 + 64 * (j))
#define XB_XGEN(j)  (2304 + 64 * (j))
#define XB_TOP      3328
#define XB_TOPGEN   3392
#define XCD_BAR_WORDS 3456
#define XB_SPIN_CAP (1u << 20)
__device__ __forceinline__ unsigned xb_ld(unsigned* p)              { return __hip_atomic_load(p, __ATOMIC_RELAXED, __HIP_MEMORY_SCOPE_AGENT); }
__device__ __forceinline__ unsigned xb_add(unsigned* p, unsigned v) { return __hip_atomic_fetch_add(p, v, __ATOMIC_RELAXED, __HIP_MEMORY_SCOPE_AGENT); }
__device__ __forceinline__ unsigned xb_xcc_id() { return (unsigned)__builtin_amdgcn_s_getreg((3 << 11) | 20) & 0xFu; }
#define XB_SPIN(cond, bar) do { unsigned _sp = 0; while (cond) { __builtin_amdgcn_s_sleep(1); \
    if ((++_sp & 255u) == 0u) { if (xb_ld(&(bar)[XB_TMO])) break; if (_sp > XB_SPIN_CAP) { atomicAdd(&(bar)[XB_TMO], 1u); break; } } } } while (0)
struct XcdBarrier { unsigned* bar; unsigned x; volatile LAS unsigned* st; };
__device__ __forceinline__ XcdBarrier xcd_barrier_post(bool first, unsigned* bar, volatile LAS unsigned* st) {
    XcdBarrier b; b.bar = bar; b.x = xb_xcc_id(); b.st = st;
    if (first) (void)xb_add(&bar[XB_XCNT(b.x)], 1u);
    return b;
}
__device__ __forceinline__ void xcd_barrier_complete(unsigned* bar, unsigned x, unsigned& nloc, unsigned& nx) {
    const unsigned G = gridDim.x * gridDim.y * gridDim.z;
    unsigned sum, cnt, mine, sp = 0u;
    for (;;) {
        sum = 0u; cnt = 0u; mine = 0u;
#pragma unroll
        for (unsigned j = 0; j < 16; ++j) { const unsigned c = xb_ld(&bar[XB_XCNT(j)]); sum += c; cnt += (c > 0u) ? 1u : 0u; mine = (j == x) ? c : mine; }
        if (sum == G) break;
        __builtin_amdgcn_s_sleep(1);
        if ((++sp & 255u) == 0u) { if (xb_ld(&bar[XB_TMO])) break; if (sp > XB_SPIN_CAP) { atomicAdd(&bar[XB_TMO], 1u); break; } }
    }
    nloc = mine > 0u ? mine : 1u; nx = cnt > 0u ? cnt : 1u;
}
__device__ __forceinline__ void xcd_barrier(int wid0, const XcdBarrier& b) {
    asm volatile("s_waitcnt vmcnt(0)" ::: "memory");
    __syncthreads();
    if (otid(wid0) == 0) {
        unsigned* bar = b.bar; asm volatile("" : "+s"(bar)); unsigned bx = b.x; asm volatile("" : "+s"(bx));
        __builtin_amdgcn_s_waitcnt(0);
        unsigned nloc = b.st[0], nx = b.st[1];
        if (nloc == 0u) { xcd_barrier_complete(bar, bx, nloc, nx); b.st[0] = nloc; b.st[1] = nx; }
        const unsigned old = xb_add(&bar[XB_XSUB(bx)], 1u);
        const unsigned gen = old / nloc;
        if (old + 1u == (gen + 1u) * nloc) {
            __builtin_amdgcn_fence(__ATOMIC_RELEASE, "agent");
            asm volatile("s_waitcnt vmcnt(0)" ::: "memory");
            const unsigned og = xb_add(&bar[XB_TOP], 1u);
            const unsigned tg = og / nx;
            if (og + 1u == (tg + 1u) * nx) xb_add(&bar[XB_TOPGEN], 1u);
            else XB_SPIN(xb_ld(&bar[XB_TOPGEN]) == tg, bar);
            __builtin_amdgcn_fence(__ATOMIC_ACQUIRE, "agent");
            xb_add(&bar[XB_XGEN(bx)], 1u);
            asm volatile("s_waitcnt vmcnt(0)" ::: "memory");
        } else {
            XB_SPIN(xb_ld(&bar[XB_XGEN(bx)]) == gen, bar);
            __builtin_amdgcn_fence(__ATOMIC_ACQUIRE, "agent");
            asm volatile("s_waitcnt vmcnt(0)" ::: "memory");
        }
    }
    __syncthreads();
}

__global__ void __launch_bounds__(512) mk_forward(Params p) {
    extern __shared__ __attribute__((aligned(16))) unsigned char lds_raw[];
    LAS unsigned char* lds = (LAS unsigned char*)lds_raw;
    cg::grid_group grid = cg::this_grid();
    volatile LAS unsigned* stw = (volatile LAS unsigned*)(lds + LDS_BYTES - 16);
    const int wid0 = __builtin_amdgcn_readfirstlane((int)(threadIdx.x >> 6));
    const bool first = (wid0 == 0 && lane_id() == 0);
    if (first) { stw[0] = 0u; stw[1] = 0u; }
    __syncthreads();
    const XcdBarrier xbar = xcd_barrier_post(first, (unsigned*)(p.ws + p.o_bar), stw);
#define PHASE_ON true
#ifndef XSYNC
#define XSYNC 0
#endif
#define PHASE_END do { if (p.ph_hi > 100000) grid.sync();   xcd_barrier(wid0, xbar); } while (0)
    constexpr int ts = TS;
    bf16_t* win = (bf16_t*)(p.ws + p.o_win); bf16_t* wb = (bf16_t*)(p.ws + p.o_wb); bf16_t* wo = (bf16_t*)(p.ws + p.o_wo);
    bf16_t* h0 = (bf16_t*)(p.ws + p.o_h); bf16_t* proj = (bf16_t*)(p.ws + p.o_proj);

    if (PHASE_ON) phase_prep(wid0, p, lds);
    PHASE_END;
#pragma unroll 1
    for (int l = 0; l < DEPTH; ++l) {
        bf16_t* x1b = (bf16_t*)p.out;
#pragma unroll 1
        for (int s = 0; s < NS; ++s) {
            const size_t tok0 = (size_t)s * ts;
            bf16_t* h = h0 + tok0 * DM; bf16_t* merged = h;
            if (l > 0) { if (PHASE_ON) phase_norm_bf16(wid0, nullptr, x1b + tok0 * DM, SMALLP(p, SM1) + (size_t)l * DM, h, p.ws + p.o_h8 + tok0 * DM, ts);
                PHASE_END; }
            if (PHASE_ON) {
                { pg8::Gemm g{h, win + (size_t)l * DM * WINR}; pg8::OrderA S; S.G = (int)gridDim.x; S.c = (int)blockIdx.x; pg8::EpiProj E{proj}; pg8::gemm_phase<DM, 0>(wid0, lds, g, S, E); }
                { pg8::Gemm g{(const bf16_t*)(p.ws + p.o_h8 + tok0 * DM), (const bf16_t*)(p.ws + p.o_wg8 + (size_t)l * 4096 * DM)}; pg8::Order<TS / 256, 4096 / 256, 1> S{(int)gridDim.x, (int)blockIdx.x};
                  pg8::EpiGateStore E{(unsigned char*)(proj + (size_t)8 * TS * BWID)}; pg8::gemm_phase_f8<DM>(wid0, lds, g, S, E); }
            }
            PHASE_END;
            if (PHASE_ON) phase_mix(wid0, p, l, proj, proj, lds);
            PHASE_END;
            if (PHASE_ON) for (int rep = 0; rep < REP_C; ++rep) { pg8::Gemm g{proj, wb + (size_t)l * 4 * BWID * DM}; pg8::OrderC S; S.G = (int)gridDim.x; S.c = (int)blockIdx.x;
                pg8::EpiGate E{proj + (size_t)8 * TS * BWID, merged}; pg8::gemm_phase<BWID, (size_t)BWID * DM * 2>(wid0, lds, g, S, E); }
            PHASE_END;
            if (PHASE_ON) { pg8::Gemm g{merged, wo + (size_t)l * DM * DM}; pg8::Order<TS / 256, DM / 256, 1> S{(int)gridDim.x, (int)blockIdx.x};
                pg8::EpiRes E{(l == 0) ? p.in[0] + tok0 * DM : nullptr, (l == 0) ? nullptr : x1b + tok0 * DM, (l == 0) ? x1b + tok0 * DM : proj + tok0 * DM}; pg8::gemm_phase<DM, 0>(wid0, lds, g, S, E); }
            PHASE_END;
        }
    }
    phase_norm_final(wid0, proj, p.out, SMALLP(p, SM16), NTOK);
}

extern "C" void kernel_launch(void* const* d_in, const int* in_sizes, int n_in, void* d_out, int out_size, void* d_ws, size_t ws_size, hipStream_t stream) {
    static int grid = 0;
    if (grid == 0) {
        int dev = 0, cus = 0, per_cu = 0;
        hipGetDevice(&dev); hipDeviceGetAttribute(&cus, hipDeviceAttributeMultiprocessorCount, dev);
        if (hipFuncSetAttribute((const void*)mk_forward, hipFuncAttributeMaxDynamicSharedMemorySize, LDS_BYTES) != hipSuccess) { fprintf(stderr, "hipFuncSetAttribute failed\n"); grid = -1; return; }
        if (hipOccupancyMaxActiveBlocksPerMultiprocessor(&per_cu, (const void*)mk_forward, 512, LDS_BYTES) != hipSuccess || per_cu < 1) { fprintf(stderr, "occupancy query: %d\n", per_cu); per_cu = 1; }
        (void)hipGetLastError();
        grid = cus * per_cu;
    }
    if (grid < 0) return;
    Params p{};
    for (int i = 0; i < 17; ++i) p.in[i] = (const float*)d_in[i];
    p.out = (float*)d_out; p.ws = (unsigned char*)d_ws;
    size_t o = 0;
    p.o_win = (unsigned)o; o += (size_t)DEPTH * DM * WINR * 2;
    p.o_wg8 = (unsigned)o; o += (size_t)DEPTH * 4096 * DM;
    p.o_h8 = (unsigned)o; o += (size_t)NTOK * DM;
    p.o_wb = (unsigned)o; o += (size_t)DEPTH * 4 * BWID * DM * 2;
    p.o_wo = (unsigned)o; o += (size_t)DEPTH * DM * DM * 2;
    p.o_pw = (unsigned)o; o += (size_t)DEPTH * 4 * 128 * 128 * 2;
    p.o_sw = (unsigned)o; o += (size_t)DEPTH * 4 * 128 * 128 * 2;
    p.o_bar = (unsigned)o; o += 16384;
    p.o_small = (unsigned)o; o += (size_t)SM_TOTAL * 4;
    p.o_h = (unsigned)o; o += (size_t)NTOK * DM * 2;
    p.o_proj = (unsigned)o; o += (size_t)TS * (8 * BWID * 2 + 4096);
    if (o > ws_size) { fprintf(stderr, "kernel_launch: workspace too small: need %zu, have %zu\n", o, ws_size); return; }
    const int nph = 1 + NS * 4 + (DEPTH - 1) * NS * 5 + 1;
    if (hipMemsetAsync((char*)d_ws + p.o_bar, 0, 16384, stream) != hipSuccess) { fprintf(stderr, "kernel_launch: memset failed\n"); return; }
    p.ph_hi = nph;
    void* args[] = {&p};
    hipError_t e = hipLaunchCooperativeKernel((const void*)mk_forward, dim3(grid), dim3(512), args, LDS_BYTES, stream);
    if (e != hipSuccess) fprintf(stderr, "cooperative launch failed: %s (grid %d)\n", hipGetErrorString(e), grid);
}
```

```cpp
#include <hip/hip_runtime.h>
#include <hip/hip_cooperative_groups.h>
#include <cstdio>
namespace cg = cooperative_groups;

#ifndef MULTI_LAUNCH
#define MULTI_LAUNCH 0
#endif

#ifndef REP_N
#define REP_N 1
#endif
#ifndef REP_A
#define REP_A 1
#endif
#ifndef REP_B
#define REP_B 1
#endif
#ifndef REP_C
#define REP_C 1
#endif
#define REP_M0 1
#define REP_M1 1
#define REP_M2 1
#define REP_M3 1
#define LAS __attribute__((address_space(3)))
typedef unsigned short bf16_t;
typedef short bf16x8 __attribute__((ext_vector_type(8)));
typedef float f32x4 __attribute__((ext_vector_type(4)));
typedef float f32x2 __attribute__((ext_vector_type(2)));
typedef unsigned u32x4 __attribute__((ext_vector_type(4)));
typedef unsigned u32x2 __attribute__((ext_vector_type(2)));
typedef int i32x8 __attribute__((ext_vector_type(8)));
typedef int i32x4 __attribute__((ext_vector_type(4)));
constexpr int WINR = 6144;

constexpr int DM = 1024, SEQ = 2048, NTOK = 32 * 2048, DEPTH = 2, BWID = 512, INC = 10240, GATE0 = 6144;
constexpr int PP = 6144;
constexpr int NS = 1, TS = NTOK / NS;
constexpr int LDS_BYTES = 139264;
constexpr int VP = 1040;

constexpr int SM1 = 0, SM4 = 2048, SM5 = 3072, SM6 = 34816, SM7 = 35840, SM8 = 36864, SM9 = 37888, SM10 = 38912, SM12 = 39936, SM13 = 40960, SM16 = 44032, SM_TOTAL = 45056;
#define SMALLP(p, OFF) ((const float*)((p).ws + (p).o_small) + (OFF))
struct Params {
    const float* in[17];
    float* out;
    unsigned char* ws;
    int ph_hi;
    unsigned o_win, o_wb, o_wo, o_pw, o_sw, o_h, o_bar, o_proj, o_h8, o_wg8, o_small;
};

__device__ __forceinline__ int lane_id() { return (int)__builtin_amdgcn_mbcnt_hi(~0u, __builtin_amdgcn_mbcnt_lo(~0u, 0u)); }
__device__ __forceinline__ int otid(int wid0) { int t; asm volatile("v_mbcnt_lo_u32_b32 %0, -1, 0\n\tv_mbcnt_hi_u32_b32 %0, -1, %0" : "=v"(t)); return (wid0 << 6) | t; }
__device__ __forceinline__ unsigned cvt_pk_bf16(float lo, float hi) { unsigned r; asm volatile("v_cvt_pk_bf16_f32 %0, %1, %2" : "=v"(r) : "v"(lo), "v"(hi)); return r; }
__device__ __forceinline__ bf16_t f2bf(float f) { unsigned u = __float_as_uint(f); u += 0x7FFFu + ((u >> 16) & 1u); return (bf16_t)(u >> 16); }
__device__ __forceinline__ void unpack8(const u32x4 v, float (&f)[8]) {
    f[0] = __uint_as_float(v.x << 16); f[1] = __uint_as_float(v.x & 0xffff0000u); f[2] = __uint_as_float(v.y << 16); f[3] = __uint_as_float(v.y & 0xffff0000u);
    f[4] = __uint_as_float(v.z << 16); f[5] = __uint_as_float(v.z & 0xffff0000u); f[6] = __uint_as_float(v.w << 16); f[7] = __uint_as_float(v.w & 0xffff0000u);
}
__device__ __forceinline__ u32x4 pack8(const float (&f)[8]) { u32x4 r; r.x = cvt_pk_bf16(f[0], f[1]); r.y = cvt_pk_bf16(f[2], f[3]); r.z = cvt_pk_bf16(f[4], f[5]); r.w = cvt_pk_bf16(f[6], f[7]); return r; }
__device__ __forceinline__ void unpack4(const u32x2 v, float (&f)[4]) { f[0] = __uint_as_float(v.x << 16); f[1] = __uint_as_float(v.x & 0xffff0000u); f[2] = __uint_as_float(v.y << 16); f[3] = __uint_as_float(v.y & 0xffff0000u); }
__device__ __forceinline__ float sigm(float x) { return __builtin_amdgcn_rcpf(1.0f + __expf(-x)); }
__device__ __forceinline__ float silu(float x) { return x * sigm(x); }
__device__ __forceinline__ void load8f(const float* p, float (&f)[8]) { const f32x4 a = *(const f32x4*)p, b = *(const f32x4*)(p + 4); f[0] = a[0]; f[1] = a[1]; f[2] = a[2]; f[3] = a[3]; f[4] = b[0]; f[5] = b[1]; f[6] = b[2]; f[7] = b[3]; }
__device__ __forceinline__ float wave_sum(int wid0, float v) {
    const int lane = otid(wid0) & 63;
#pragma unroll
    for (int o = 32; o >= 1; o >>= 1) v += __builtin_bit_cast(float, __builtin_amdgcn_ds_bpermute((lane ^ o) << 2, __builtin_bit_cast(int, v)));
    return v;
}
__device__ __forceinline__ u32x2 tr_read(unsigned lds_addr) { u32x2 r; asm volatile("ds_read_b64_tr_b16 %0, %1\n\ts_waitcnt lgkmcnt(0)" : "=&v"(r) : "v"(lds_addr) : "memory"); return r; }

namespace pg8 {
constexpr int BM = 256, BK = 64, HALF = 128, HTB = HALF * BK * 2, STAGE_BYTES = 8 * HTB, NXCD = 8, WGM = 8;
__device__ __forceinline__ int lds_byte(int r, int c) { const int st = (r >> 4) * 2 + (c >> 5), rr = r & 15, cc = c & 31, ob = rr * 64 + cc * 2; return st * 1024 + (ob ^ (((ob >> 9) & 1) << 5)); }
__device__ __forceinline__ void stage_rc(int b, int& R, int& C) { const int st = b / 1024, sb = b % 1024, swz = sb ^ (((sb >> 9) & 1) << 5); R = (st >> 1) * 16 + swz / 64; C = (st & 1) * 32 + (swz % 64) / 2; }
__device__ __forceinline__ int perm32(int rho) { const int n = rho >> 4, i = rho & 15; return 8 * (i >> 2) + 4 * n + (i & 3); }

struct Unit { int pm, pn, br; };
struct Gemm { const bf16_t* A; const bf16_t* Bt; };

template <int NM, int NN, int NBR>
struct Order {
    int G, c;
    __device__ __forceinline__ bool next(int i, Unit& u) const {
        constexpr int nwg = NM * NN;
        const int ti = i / NBR;
        const long L = (long)ti * G + c; if (L >= nwg) return false;
        int wgid = (int)L; { constexpr int q = nwg / NXCD, r = nwg % NXCD; const int xcd = wgid % NXCD, off = wgid / NXCD; wgid = (xcd < r ? xcd * (q + 1) : r * (q + 1) + (xcd - r) * q) + off; }
        constexpr int nig = WGM * NN; const int gid = wgid / nig, fm = gid * WGM, gsz = (NM - fm) < WGM ? (NM - fm) : WGM;
        u.pm = fm + ((wgid % nig) % gsz); u.pn = (wgid % nig) / gsz; u.br = i % NBR; return true;
    }
    __device__ __forceinline__ void brow(const Unit& u, int& r0, int& r1) const { r0 = u.pn * BM; r1 = r0 + HALF; }
    __device__ __forceinline__ size_t aoff(const Unit&) const { return 0; }
};
struct OrderC : Order<TS / 256, DM / 256, 4> {
    __device__ __forceinline__ size_t aoff(const Unit& u) const { const int slot = (u.br == 0) ? 1 : (u.br == 1) ? 3 : (u.br == 2) ? 4 : 6; return (size_t)slot * TS * BWID * 2; }
};
struct OrderA : Order<TS / 256, WINR / 256, 1> {
    __device__ __forceinline__ void brow(const Unit& u, int& r0, int& r1) const {
        const int pn = u.pn;
        if (pn < 8) { const int pc = pn >> 1; const int piece = (pc == 0) ? 0 : (pc == 1) ? 1 : (pc == 2) ? 4 : 6; r0 = piece * 512 + (pn & 1) * 256; r1 = r0 + HALF; }
        else if (pn < 24) { const int q = (pn - 8) >> 2, sub = (pn - 8) & 3; const int pa = (q == 0) ? 2 : (q == 1) ? 9 : (q == 2) ? 8 : 5, pb = (q == 0) ? 3 : (q == 1) ? 10 : (q == 2) ? 11 : 7;
            r0 = pa * 512 + HALF * sub; r1 = pb * 512 + HALF * sub; }
        else { r0 = pn * BM; r1 = r0 + HALF; }
    }
};

struct EpiProj {
    static constexpr bool PERM = true;
    static __device__ __forceinline__ bool zero_after(const Unit&) { return true; }
    bf16_t* O;
    __device__ __forceinline__ void operator()(f32x4 (&acc)[2][2][4][2], const Unit& u, int wr, int wc, int fr_, int fq) const {
        int fr = fr_; asm volatile("" : "+v"(fr));
        if (u.pn < 8) {
            const int pc = u.pn >> 1; const int slot = (pc == 0) ? 0 : (pc == 1) ? 1 : (pc == 2) ? 3 : 5;
            const int row0 = u.pm * BM + wr * 64 + fr, col0 = (u.pn & 1) * BM + wc * 32 + 8 * fq;
            bf16_t* Op = O + (size_t)slot * TS * BWID;
#pragma unroll
            for (int ai = 0; ai < 2; ++ai)
#pragma unroll
                for (int m = 0; m < 4; ++m) { bf16_t* rowp = Op + (size_t)(row0 + ai * HALF + m * 16) * BWID + col0;
#pragma unroll
                    for (int bj = 0; bj < 2; ++bj) { const f32x4 v0 = acc[ai][bj][m][0], v1 = acc[ai][bj][m][1];
                        u32x4 w; w.x = cvt_pk_bf16(v0[0], v0[1]); w.y = cvt_pk_bf16(v0[2], v0[3]); w.z = cvt_pk_bf16(v1[0], v1[1]); w.w = cvt_pk_bf16(v1[2], v1[3]);
                        __builtin_nontemporal_store(w, (u32x4*)(rowp + bj * HALF)); } }
        } else {
            const int q = (u.pn - 8) >> 2, sub = (u.pn - 8) & 3; const int slot = (q == 0) ? 2 : (q == 1) ? 7 : (q == 2) ? 6 : 4;
            const int row0 = u.pm * BM + wr * 64 + fr, col0 = sub * HALF + wc * 32 + 8 * fq;
            bf16_t* Op = O + (size_t)slot * TS * BWID;
#pragma unroll
            for (int ai = 0; ai < 2; ++ai)
#pragma unroll
                for (int m = 0; m < 4; ++m) {
                    float f[8];
#pragma unroll
                    for (int n = 0; n < 2; ++n)
#pragma unroll
                        for (int j = 0; j < 4; ++j) { const float av = acc[ai][0][m][n][j], bv = acc[ai][1][m][n][j];
                            const float sg = __builtin_amdgcn_rcpf(1.0f + __builtin_amdgcn_exp2f(bv));
                            f[n * 4 + j] = av * ((q == 1) ? bv : (q == 0) ? sg : bv * sg); }
                    __builtin_nontemporal_store(pack8(f), (u32x4*)(Op + (size_t)(row0 + ai * HALF + m * 16) * BWID + col0)); }
        }
    }
};
struct EpiGateStore {
    static constexpr bool PERM = true;
    static __device__ __forceinline__ bool zero_after(const Unit&) { return true; }
    unsigned char* G;
    __device__ __forceinline__ void operator()(f32x4 (&acc)[2][2][4][2], const Unit& u, int wr, int wc, int fr_, int fq) const {
        int fr = fr_; asm volatile("" : "+v"(fr));
        unsigned char* gb = G + ((size_t)u.pm * 16 + u.pn) * 65536 + (((wr * 4 + wc) * 4 + fq) * 16 + fr) * 16;
        const float c255 = 1.0f / 255.0f;
#pragma unroll
        for (int ai = 0; ai < 2; ++ai)
#pragma unroll
            for (int m = 0; m < 4; ++m) {
                u32x4 w;
#pragma unroll
                for (int bj = 0; bj < 2; ++bj)
#pragma unroll
                    for (int n = 0; n < 2; ++n) { unsigned q = 0u;
#pragma unroll
                        for (int j = 0; j < 4; ++j) q = __builtin_amdgcn_cvt_pk_u8_f32(fmaxf(__builtin_amdgcn_rcpf(__builtin_fmaf(__builtin_amdgcn_exp2f(acc[ai][bj][m][n][j]), c255, c255)), 1.0f), j, q);
                        w[bj * 2 + n] = q; }
                __builtin_nontemporal_store(w, (u32x4*)(gb + (ai * 4 + m) * 8192));
                __builtin_amdgcn_sched_barrier(0); }
    }
};
struct EpiGate {
    static constexpr bool PERM = true;
    static __device__ __forceinline__ bool zero_after(const Unit& u) { return u.br == 3; }
    const bf16_t* G; bf16_t* merged;
    __device__ __forceinline__ void operator()(f32x4 (&acc)[2][2][4][2], const Unit& u, int wr, int wc, int fr_, int fq) const {
        int fr = fr_; asm volatile("" : "+v"(fr));
        const int lrow0 = wr * 64 + fr, lcol0 = wc * 32 + 8 * fq;
        const int br = u.br;
        const bool lastb = (br == 3);
        const unsigned char* gp0 = (const unsigned char*)G + ((size_t)u.pm * 16 + br * 4 + u.pn) * 65536 + (((wr * 4 + wc) * 4 + fq) * 16 + fr) * 16;
        const unsigned char* gnp = lastb ? gp0 : gp0 + 4 * 65536;
        u32x4 gc[2][4], gn[2][4];
#pragma unroll
        for (int ai = 0; ai < 2; ++ai)
#pragma unroll
            for (int m = 0; m < 4; ++m) { gc[ai][m] = *(const u32x4*)(gp0 + (ai * 4 + m) * 8192); gn[ai][m] = (u32x4){0u, 0u, 0u, 0u}; if (!lastb) gn[ai][m] = *(const u32x4*)(gnp + (ai * 4 + m) * 8192); }
#pragma unroll
        for (int ai = 0; ai < 2; ++ai)
#pragma unroll
            for (int m = 0; m < 4; ++m)
#pragma unroll
                for (int bj = 0; bj < 2; ++bj) {
#pragma unroll
                    for (int n = 0; n < 2; ++n) {
                        const unsigned c = gc[ai][m][bj * 2 + n], d = gn[ai][m][bj * 2 + n];
                        float fc[4], fd[4];
                        fc[0] = (float)(c & 0xffu); fc[1] = (float)((c >> 8) & 0xffu); fc[2] = (float)((c >> 16) & 0xffu); fc[3] = (float)(c >> 24);
                        fd[0] = (float)(d & 0xffu); fd[1] = (float)((d >> 8) & 0xffu); fd[2] = (float)((d >> 16) & 0xffu); fd[3] = (float)(d >> 24);
#pragma unroll
                        for (int j = 0; j < 4; ++j) acc[ai][bj][m][n][j] *= fc[j] * (lastb ? (1.0f / 255.0f) : __builtin_amdgcn_rcpf(fd[j]));
                    }
                    if (lastb) { const f32x4 v0 = acc[ai][bj][m][0], v1 = acc[ai][bj][m][1];
                        u32x4 w; w.x = cvt_pk_bf16(v0[0], v0[1]); w.y = cvt_pk_bf16(v0[2], v0[3]); w.z = cvt_pk_bf16(v1[0], v1[1]); w.w = cvt_pk_bf16(v1[2], v1[3]);
                        *(u32x4*)(merged + ((size_t)u.pm * BM + lrow0 + ai * HALF + m * 16) * DM + u.pn * BM + lcol0 + bj * HALF) = w; }
                }
    }
};
struct EpiRes {
    static constexpr bool PERM = true;
    static __device__ __forceinline__ bool zero_after(const Unit&) { return true; }
    const float* res32; const bf16_t* res16; bf16_t* O;
    __device__ __forceinline__ void operator()(f32x4 (&acc)[2][2][4][2], const Unit& u, int wr, int wc, int fr_, int fq) const {
        int fr = fr_; asm volatile("" : "+v"(fr));
        const int row0 = u.pm * BM + wr * 64 + fr, col0 = u.pn * BM + wc * 32 + 8 * fq;
        const bool r16 = (res16 != nullptr);
#pragma unroll
        for (int ai = 0; ai < 2; ++ai)
#pragma unroll
            for (int m = 0; m < 4; ++m) { const size_t off = (size_t)(row0 + ai * HALF + m * 16) * DM + col0;
                float r[2][8];
#pragma unroll
                for (int bj = 0; bj < 2; ++bj) {
                    if (r16) unpack8(*(const u32x4*)(res16 + off + bj * HALF), r[bj]);
                    else load8f(res32 + off + bj * HALF, r[bj]); }
#pragma unroll
                for (int bj = 0; bj < 2; ++bj) { float o[8];
#pragma unroll
                    for (int j = 0; j < 4; ++j) { o[j] = acc[ai][bj][m][0][j] + r[bj][j]; o[4 + j] = acc[ai][bj][m][1][j] + r[bj][4 + j]; }
                    *(u32x4*)(O + off + bj * HALF) = pack8(o); } }
    }
};

template <int K, size_t B_BR, class Epi, class Sched>
__device__ __forceinline__ void gemm_phase(int wid0, LAS unsigned char* lds, const Gemm g, const Sched& S, const Epi& E) {
    const int tid = otid(wid0), wid = __builtin_amdgcn_readfirstlane(tid >> 6), lane = tid & 63, wr = wid >> 2, wc = wid & 3, fr = lane & 15, fq = lane >> 4;
    constexpr int nt = K / BK;
    unsigned voffA[2], voffB[2];
#pragma unroll
    for (int i = 0; i < 2; ++i) { int R, C; stage_rc(tid * 16 + i * 8192, R, C); const int Rb = Epi::PERM ? ((R & ~31) + perm32(R & 31)) : R;
        voffA[i] = (unsigned)(R * K + C) * 2u; voffB[i] = (unsigned)(Rb * K + C) * 2u; }
    constexpr size_t kstep = (size_t)(BK * 2);
    constexpr size_t hstep = (size_t)HALF * K * 2;
    constexpr size_t tstep = 2 * hstep;
    const unsigned ldsw = (unsigned)wid * 1024u;
    const int aoff = lds_byte(wr * 64 + fr, fq * 8), boff = lds_byte(wc * 32 + fr, fq * 8);
#define PG8_SA(b, h) (((b) * 2 + (h)) * HTB)
#define PG8_SB(b, h) ((4 + (b) * 2 + (h)) * HTB)
#define PG8_STAGE(bufoff, gbase, voff) do { _Pragma("unroll") for (int _i = 0; _i < 2; ++_i) \
        __builtin_amdgcn_global_load_lds((const unsigned*)((const char*)(gbase) + (voff)[_i]), (LAS unsigned*)(lds + (bufoff) + ldsw + _i * 8192), 16, 0, 0); } while (0)
#define PG8_LDA(dst, b, h) do { _Pragma("unroll") for (int m = 0; m < 4; ++m) _Pragma("unroll") for (int k = 0; k < 2; ++k) dst[m][k] = *(const LAS bf16x8*)(lds + PG8_SA(b, h) + aoff + m * 2048 + k * 1024); } while (0)
#define PG8_LDB(dst, b, h) do { _Pragma("unroll") for (int n = 0; n < 2; ++n) _Pragma("unroll") for (int k = 0; k < 2; ++k) dst[n][k] = *(const LAS bf16x8*)(lds + PG8_SB(b, h) + boff + n * 2048 + k * 1024); } while (0)
#define PG8_MMA(ai, bj, At, Bt) do { __builtin_amdgcn_s_setprio(1); _Pragma("unroll") for (int m = 0; m < 4; ++m) _Pragma("unroll") for (int n = 0; n < 2; ++n) _Pragma("unroll") for (int k = 0; k < 2; ++k) \
        acc[ai][bj][m][n] = __builtin_amdgcn_mfma_f32_16x16x32_bf16(Bt[n][k], At[m][k], acc[ai][bj][m][n], 0, 0, 0); __builtin_amdgcn_s_setprio(0); } while (0)
#define PG8_WAIT_V(n) asm volatile("s_waitcnt vmcnt(" #n ")" ::: "memory")
#define PG8_WAIT_L(n) asm volatile("s_waitcnt lgkmcnt(" #n ")" ::: "memory")
#define PG8_BAR __builtin_amdgcn_s_barrier()
#define PG8_SCHED __builtin_amdgcn_sched_barrier(0)
    Unit cur, nxt; int ui = 0;
    if (!S.next(0, cur)) return;
    f32x4 acc[2][2][4][2];
#pragma unroll
    for (int a = 0; a < 2; ++a)
#pragma unroll
        for (int b = 0; b < 2; ++b)
#pragma unroll
            for (int m = 0; m < 4; ++m)
#pragma unroll
                for (int n = 0; n < 2; ++n) acc[a][b][m][n] = (f32x4){0.f, 0.f, 0.f, 0.f};
    bf16x8 At[4][2], B0[2][2], B1[2][2];
    const char* cA = (const char*)g.A + (size_t)cur.pm * tstep + S.aoff(cur); int rb0, rb1; S.brow(cur, rb0, rb1);
    const char* cB = (const char*)g.Bt + (size_t)rb0 * (K * 2) + (size_t)cur.br * B_BR; const char* cBh = (const char*)g.Bt + (size_t)rb1 * (K * 2) + (size_t)cur.br * B_BR;
    PG8_STAGE(PG8_SB(0, 0), cB, voffB); PG8_STAGE(PG8_SA(0, 0), cA, voffA); PG8_STAGE(PG8_SB(0, 1), cBh, voffB); PG8_STAGE(PG8_SA(0, 1), cA + hstep, voffA);
    if (wr == 1) PG8_BAR;
    PG8_WAIT_V(4); PG8_BAR;
    PG8_STAGE(PG8_SB(1, 0), cB + kstep, voffB); PG8_STAGE(PG8_SA(1, 0), cA + kstep, voffA); PG8_STAGE(PG8_SB(1, 1), cBh + kstep, voffB);
    PG8_WAIT_V(6); PG8_BAR;
    for (;;) {
        const bool has_next = S.next(ui + 1, nxt);
        const char* nA = has_next ? (const char*)g.A + (size_t)nxt.pm * tstep + S.aoff(nxt) : cA; int rn0 = 0, rn1 = 0; if (has_next) S.brow(nxt, rn0, rn1);
        const char* nB = has_next ? (const char*)g.Bt + (size_t)rn0 * (K * 2) + (size_t)nxt.br * B_BR : cB; const char* nBh = has_next ? (const char*)g.Bt + (size_t)rn1 * (K * 2) + (size_t)nxt.br * B_BR : cBh;
        for (int t = 0; t < nt; t += 2) {
            const bool last = (t == nt - 2);
            const char* a1 = cA + (size_t)(t + 1) * kstep;
            const char* a2 = last ? nA : cA + (size_t)(t + 2) * kstep; const char* b2 = last ? nB : cB + (size_t)(t + 2) * kstep; const char* b2h = last ? nBh : cBh + (size_t)(t + 2) * kstep;
            const char* a3 = a2 + kstep; const char* b3 = b2 + kstep; const char* b3h = b2h + kstep;
            PG8_LDB(B0, 0, 0); PG8_SCHED; PG8_LDA(At, 0, 0); PG8_STAGE(PG8_SA(1, 1), a1 + hstep, voffA);
            PG8_WAIT_L(8); PG8_BAR; PG8_WAIT_L(0); PG8_MMA(0, 0, At, B0); PG8_BAR; PG8_SCHED;
            PG8_LDB(B1, 0, 1); PG8_STAGE(PG8_SB(0, 0), b2, voffB);
            PG8_BAR; PG8_WAIT_L(0); PG8_MMA(0, 1, At, B1); PG8_BAR;
            PG8_LDA(At, 0, 1); PG8_STAGE(PG8_SA(0, 0), a2, voffA);
            PG8_BAR; PG8_WAIT_L(0); PG8_MMA(1, 0, At, B0); PG8_BAR; PG8_SCHED;
            PG8_STAGE(PG8_SB(0, 1), b2h, voffB);
            PG8_WAIT_V(6); PG8_BAR; PG8_MMA(1, 1, At, B1); PG8_BAR;
            PG8_LDB(B0, 1, 0); PG8_SCHED; PG8_LDA(At, 1, 0); PG8_STAGE(PG8_SA(0, 1), a2 + hstep, voffA);
            PG8_WAIT_L(8); PG8_BAR; PG8_WAIT_L(0); PG8_MMA(0, 0, At, B0); PG8_BAR; PG8_SCHED;
            PG8_LDB(B1, 1, 1); PG8_STAGE(PG8_SB(1, 0), b3, voffB);
            PG8_BAR; PG8_WAIT_L(0); PG8_MMA(0, 1, At, B1); PG8_BAR;
            PG8_LDA(At, 1, 1); PG8_STAGE(PG8_SA(1, 0), a3, voffA);
            PG8_BAR; PG8_WAIT_L(0); PG8_MMA(1, 0, At, B0); PG8_BAR; PG8_SCHED;
            PG8_STAGE(PG8_SB(1, 1), b3h, voffB);
            PG8_WAIT_V(6); PG8_BAR; PG8_MMA(1, 1, At, B1); PG8_BAR;
        }
        E(acc, cur, wr, wc, fr, fq);
        if (!has_next) break;
        if (Epi::zero_after(cur))
#pragma unroll
        for (int a = 0; a < 2; ++a)
#pragma unroll
            for (int b = 0; b < 2; ++b)
#pragma unroll
                for (int m = 0; m < 4; ++m)
#pragma unroll
                    for (int n = 0; n < 2; ++n) acc[a][b][m][n] = (f32x4){0.f, 0.f, 0.f, 0.f};
        cur = nxt; cA = nA; cB = nB; cBh = nBh; ++ui;
    }
    PG8_WAIT_V(0);
    if (wr == 0) PG8_BAR;
    PG8_BAR;
#undef PG8_SA
#undef PG8_SB
#undef PG8_STAGE
#undef PG8_LDA
#undef PG8_LDB
#undef PG8_MMA
#undef PG8_WAIT_V
#undef PG8_WAIT_L
#undef PG8_BAR
#undef PG8_SCHED
}
template <int RB, class Epi, class Sched>
__device__ __forceinline__ void gemm_phase_f8(int wid0, LAS unsigned char* lds, const Gemm g, const Sched& S, const Epi& E) {
    const int tid = otid(wid0), wid = __builtin_amdgcn_readfirstlane(tid >> 6), lane = tid & 63, wr = wid >> 2, wc = wid & 3, fr = lane & 15, fq = lane >> 4;
    constexpr int nt = RB / 128;
    constexpr int K = RB / 2;
    constexpr size_t B_BR = 0;
    unsigned voffA[2], voffB[2]; int aoff, boff;
    constexpr size_t kstep = (size_t)(BK * 2);
    constexpr size_t hstep = (size_t)HALF * K * 2;
    constexpr size_t tstep = 2 * hstep;
    const unsigned ldsw = (unsigned)wid * 1024u;
#define PG8_SETUP() do { const int t_ = otid(wid0), l_ = t_ & 63, fr_ = l_ & 15, fq_ = l_ >> 4; \
        _Pragma("unroll") for (int i = 0; i < 2; ++i) { int R, C; stage_rc(t_ * 16 + i * 8192, R, C); const int Rb = Epi::PERM ? ((R & ~31) + perm32(R & 31)) : R; \
            voffA[i] = (unsigned)(R * K + C) * 2u; voffB[i] = (unsigned)(Rb * K + C) * 2u; } \
        aoff = lds_byte(wr * 64 + fr_, fq_ * 16); boff = lds_byte(wc * 32 + fr_, fq_ * 16); } while (0)
    PG8_SETUP();
#define PG8_SA(b, h) (((b) * 2 + (h)) * HTB)
#define PG8_SB(b, h) ((4 + (b) * 2 + (h)) * HTB)
#define PG8_STAGE(bufoff, gbase, voff) do { _Pragma("unroll") for (int _i = 0; _i < 2; ++_i) \
        __builtin_amdgcn_global_load_lds((const unsigned*)((const char*)(gbase) + (voff)[_i]), (LAS unsigned*)(lds + (bufoff) + ldsw + _i * 8192), 16, 0, 0); } while (0)
#define PG8_LDA(dst, b, h) do { _Pragma("unroll") for (int m = 0; m < 4; ++m) dst[m] = *(const LAS i32x8*)(lds + PG8_SA(b, h) + aoff + m * 2048); } while (0)
#define PG8_LDB(dst, b, h) do { _Pragma("unroll") for (int n = 0; n < 2; ++n) dst[n] = *(const LAS i32x8*)(lds + PG8_SB(b, h) + boff + n * 2048); } while (0)
#define PG8_MMA(ai, bj, At, Bt) do { __builtin_amdgcn_s_setprio(1); _Pragma("unroll") for (int m = 0; m < 4; ++m) _Pragma("unroll") for (int n = 0; n < 2; ++n) \
        acc[ai][bj][m][n] = __builtin_amdgcn_mfma_scale_f32_16x16x128_f8f6f4(Bt[n], At[m], acc[ai][bj][m][n], 0, 0, 0, 122, 0, 127); __builtin_amdgcn_s_setprio(0); } while (0)
#define PG8_WAIT_V(n) asm volatile("s_waitcnt vmcnt(" #n ")" ::: "memory")
#define PG8_WAIT_L(n) asm volatile("s_waitcnt lgkmcnt(" #n ")" ::: "memory")
#define PG8_BAR __builtin_amdgcn_s_barrier()
#define PG8_SCHED __builtin_amdgcn_sched_barrier(0)
    Unit cur, nxt; int ui = 0;
    if (!S.next(0, cur)) return;
    f32x4 acc[2][2][4][2];
#pragma unroll
    for (int a = 0; a < 2; ++a)
#pragma unroll
        for (int b = 0; b < 2; ++b)
#pragma unroll
            for (int m = 0; m < 4; ++m)
#pragma unroll
                for (int n = 0; n < 2; ++n) acc[a][b][m][n] = (f32x4){0.f, 0.f, 0.f, 0.f};
    i32x8 At[4], B0[2], B1[2];
    const char* cA = (const char*)g.A + (size_t)cur.pm * tstep + S.aoff(cur); int rb0, rb1; S.brow(cur, rb0, rb1);
    const char* cB = (const char*)g.Bt + (size_t)rb0 * (K * 2) + (size_t)cur.br * B_BR; const char* cBh = (const char*)g.Bt + (size_t)rb1 * (K * 2) + (size_t)cur.br * B_BR;
    PG8_STAGE(PG8_SB(0, 0), cB, voffB); PG8_STAGE(PG8_SA(0, 0), cA, voffA); PG8_STAGE(PG8_SB(0, 1), cBh, voffB); PG8_STAGE(PG8_SA(0, 1), cA + hstep, voffA);
    if (wr == 1) PG8_BAR;
    PG8_WAIT_V(4); PG8_BAR;
    PG8_STAGE(PG8_SB(1, 0), cB + kstep, voffB); PG8_STAGE(PG8_SA(1, 0), cA + kstep, voffA); PG8_STAGE(PG8_SB(1, 1), cBh + kstep, voffB);
    PG8_WAIT_V(6); PG8_BAR;
    for (;;) {
        const bool has_next = S.next(ui + 1, nxt);
        const char* nA = has_next ? (const char*)g.A + (size_t)nxt.pm * tstep + S.aoff(nxt) : cA; int rn0 = 0, rn1 = 0; if (has_next) S.brow(nxt, rn0, rn1);
        const char* nB = has_next ? (const char*)g.Bt + (size_t)rn0 * (K * 2) + (size_t)nxt.br * B_BR : cB; const char* nBh = has_next ? (const char*)g.Bt + (size_t)rn1 * (K * 2) + (size_t)nxt.br * B_BR : cBh;
        for (int t = 0; t < nt; t += 2) {
            const bool last = (t == nt - 2);
            const char* a1 = cA + (size_t)(t + 1) * kstep;
            const char* a2 = last ? nA : cA + (size_t)(t + 2) * kstep; const char* b2 = last ? nB : cB + (size_t)(t + 2) * kstep; const char* b2h = last ? nBh : cBh + (size_t)(t + 2) * kstep;
            const char* a3 = a2 + kstep; const char* b3 = b2 + kstep; const char* b3h = b2h + kstep;
            PG8_LDB(B0, 0, 0); PG8_SCHED; PG8_LDA(At, 0, 0); PG8_STAGE(PG8_SA(1, 1), a1 + hstep, voffA);
            PG8_WAIT_L(8); PG8_BAR; PG8_WAIT_L(0); PG8_MMA(0, 0, At, B0); PG8_BAR; PG8_SCHED;
            PG8_LDB(B1, 0, 1); PG8_STAGE(PG8_SB(0, 0), b2, voffB);
            PG8_BAR; PG8_WAIT_L(0); PG8_MMA(0, 1, At, B1); PG8_BAR;
            PG8_LDA(At, 0, 1); PG8_STAGE(PG8_SA(0, 0), a2, voffA);
            PG8_BAR; PG8_WAIT_L(0); PG8_MMA(1, 0, At, B0); PG8_BAR; PG8_SCHED;
            PG8_STAGE(PG8_SB(0, 1), b2h, voffB);
            PG8_WAIT_V(6); PG8_BAR; PG8_MMA(1, 1, At, B1); PG8_BAR;
            PG8_LDB(B0, 1, 0); PG8_SCHED; PG8_LDA(At, 1, 0); PG8_STAGE(PG8_SA(0, 1), a2 + hstep, voffA);
            PG8_WAIT_L(8); PG8_BAR; PG8_WAIT_L(0); PG8_MMA(0, 0, At, B0); PG8_BAR; PG8_SCHED;
            PG8_LDB(B1, 1, 1); PG8_STAGE(PG8_SB(1, 0), b3, voffB);
            PG8_BAR; PG8_WAIT_L(0); PG8_MMA(0, 1, At, B1); PG8_BAR;
            PG8_LDA(At, 1, 1); PG8_STAGE(PG8_SA(1, 0), a3, voffA);
            PG8_BAR; PG8_WAIT_L(0); PG8_MMA(1, 0, At, B0); PG8_BAR; PG8_SCHED;
            PG8_STAGE(PG8_SB(1, 1), b3h, voffB);
            PG8_WAIT_V(6); PG8_BAR; PG8_MMA(1, 1, At, B1); PG8_BAR;
        }
        { const int t2_ = otid(wid0) & 63; E(acc, cur, wr, wc, t2_ & 15, t2_ >> 4); }
        if (!has_next) break;
        if (Epi::zero_after(cur))
#pragma unroll
        for (int a = 0; a < 2; ++a)
#pragma unroll
            for (int b = 0; b < 2; ++b)
#pragma unroll
                for (int m = 0; m < 4; ++m)
#pragma unroll
                    for (int n = 0; n < 2; ++n) acc[a][b][m][n] = (f32x4){0.f, 0.f, 0.f, 0.f};
        cur = nxt; cA = nA; cB = nB; cBh = nBh; ++ui;
        PG8_SETUP();
    }
    PG8_WAIT_V(0);
    if (wr == 0) PG8_BAR;
    PG8_BAR;
#undef PG8_SETUP
#undef PG8_SA
#undef PG8_SB
#undef PG8_STAGE
#undef PG8_LDA
#undef PG8_LDB
#undef PG8_MMA
#undef PG8_WAIT_V
#undef PG8_WAIT_L
#undef PG8_BAR
#undef PG8_SCHED
}
}

__device__ void phase_norm_bf16(int wid0, const float* __restrict__ xin, const bf16_t* __restrict__ xin16, const float* __restrict__ g, bf16_t* __restrict__ h, unsigned char* __restrict__ h8, int rows);
struct TJob { const float* src; bf16_t* dst; unsigned char* dst8; int R, C, tr, tc; float scale; };
__device__ __forceinline__ TJob prep_job(const Params& p, int i) {
    bf16_t* win = (bf16_t*)(p.ws + p.o_win); bf16_t* wb = (bf16_t*)(p.ws + p.o_wb); bf16_t* wo = (bf16_t*)(p.ws + p.o_wo); bf16_t* pw = (bf16_t*)(p.ws + p.o_pw);
    constexpr int T_WIN = 16 * 160, T_WB = 8 * 16, T_WO = 16 * 16, T_PW = 4;
    constexpr int N0 = DEPTH * T_WIN, N1 = N0 + 8 * T_WB, N2 = N1 + DEPTH * T_WO;
    TJob j; j.scale = 1.0f; j.dst8 = nullptr;
    if (i < N0) { const int l = i / T_WIN, t = i % T_WIN; j.src = p.in[2] + (size_t)l * DM * INC; j.dst = win + (size_t)l * DM * WINR; j.R = DM; j.C = INC; j.tr = t / 160; j.tc = t % 160;
        const int piece = j.tc >> 3; j.scale = (piece >= 12 || piece == 3 || piece == 7 || piece == 11) ? -1.4426950408889634f : (piece == 5 || piece == 8) ? -0.6931471805599453f : 1.0f;
        if (piece >= 12) { j.dst = nullptr; j.dst8 = p.ws + p.o_wg8 + (size_t)l * 4096 * DM + (size_t)(j.tc - 96) * 64 * DM; j.scale *= 32.0f; } }
    else if (i < N1) { const int k = i - N0, m = k / T_WB, t = k % T_WB; j.src = p.in[14] + (size_t)m * BWID * DM; j.dst = wb + (size_t)m * BWID * DM; j.R = BWID; j.C = DM; j.tr = t / 16; j.tc = t % 16; }
    else if (i < N2) { const int k = i - N1, l = k / T_WO, t = k % T_WO; j.src = p.in[15] + (size_t)l * DM * DM; j.dst = wo + (size_t)l * DM * DM; j.R = DM; j.C = DM; j.tr = t / 16; j.tc = t % 16; }
    else { const int k = i - N2, m = k / T_PW, t = k % T_PW; j.src = p.in[3] + (size_t)m * 128 * 128; j.dst = pw + (size_t)m * 128 * 128; j.R = 128; j.C = 128; j.tr = t / 2; j.tc = t % 2; }
    return j;
}
__device__ void phase_prep(int wid0, const Params& p, LAS unsigned char* lds) {
    LAS float* sm = (LAS float*)lds;
    const int tid = otid(wid0);
    constexpr int NT = DEPTH * 16 * 160 + 8 * 8 * 16 + DEPTH * 16 * 16 + 8 * 4;
    const int lr = tid >> 4, lc = (tid & 15) * 4;
    f32x4 v0, v1;
    int i = blockIdx.x;
    if (i < NT) { const TJob j = prep_job(p, i); const float* sp = j.src + (size_t)(j.tr * 64 + lr) * j.C + j.tc * 64 + lc; v0 = *(const f32x4*)sp; v1 = *(const f32x4*)(sp + (size_t)32 * j.C); }
    for (; i < NT; i += gridDim.x) {
        const TJob j = prep_job(p, i);
#pragma unroll
        for (int e = 0; e < 4; ++e) { sm[lr * 65 + lc + e] = v0[e]; sm[(lr + 32) * 65 + lc + e] = v1[e]; }
        __syncthreads();
        const int in = i + gridDim.x;
        if (in < NT) { const TJob jn = prep_job(p, in); const float* sp = jn.src + (size_t)(jn.tr * 64 + lr) * jn.C + jn.tc * 64 + lc; v0 = *(const f32x4*)sp; v1 = *(const f32x4*)(sp + (size_t)32 * jn.C); }
        { const int c = tid >> 3, r8 = (tid & 7) * 8; float o[8];
#pragma unroll
          for (int e = 0; e < 8; ++e) o[e] = sm[(r8 + e) * 65 + c] * j.scale;
          if (j.dst8) { unsigned w0 = 0u, w1 = 0u; w0 = __builtin_amdgcn_cvt_pk_fp8_f32(o[0], o[1], w0, false); w0 = __builtin_amdgcn_cvt_pk_fp8_f32(o[2], o[3], w0, true); w1 = __builtin_amdgcn_cvt_pk_fp8_f32(o[4], o[5], w1, false); w1 = __builtin_amdgcn_cvt_pk_fp8_f32(o[6], o[7], w1, true);
              *(u32x2*)(j.dst8 + (size_t)c * DM + j.tr * 64 + r8) = (u32x2){w0, w1}; }
          else *(u32x4*)(j.dst + (size_t)(j.tc * 64 + c) * j.R + j.tr * 64 + r8) = pack8(o); }
        __syncthreads();
    }
    const float* sgw = p.in[11]; bf16_t* sw = (bf16_t*)(p.ws + p.o_sw);
    for (int k = blockIdx.x * 512 + tid; k < DEPTH * 4 * 128 * 128; k += gridDim.x * 512) { const int s_ = k & 127, t = (k >> 7) & 127; sw[k] = (s_ <= t) ? f2bf(sgw[k]) : (bf16_t)0; }
    {
        float* sd = (float*)(p.ws + p.o_small); const int gt = blockIdx.x * 512 + tid, gs = gridDim.x * 512;
#define CPY(K, OFF, N) for (int k = gt; k < (N); k += gs) sd[(OFF) + k] = p.in[K][k];
        CPY(1, SM1, 2048) CPY(4, SM4, 1024) CPY(5, SM5, 31744) CPY(6, SM6, 1024) CPY(7, SM7, 1024) CPY(8, SM8, 1024) CPY(9, SM9, 1024) CPY(10, SM10, 1024) CPY(12, SM12, 1024) CPY(13, SM13, 3072) CPY(16, SM16, 1024)
#undef CPY
    }
    phase_norm_bf16(wid0, p.in[0], nullptr, p.in[1], (bf16_t*)(p.ws + p.o_h), p.ws + p.o_h8, NTOK);
}

__device__ void phase_norm_bf16(int wid0, const float* __restrict__ xin, const bf16_t* __restrict__ xin16, const float* __restrict__ g, bf16_t* __restrict__ h, unsigned char* __restrict__ h8, int rows) {
    const int tid = otid(wid0), lane = tid & 63, w = tid >> 6;
    float gv[2][8];
    load8f(g + 8 * lane, gv[0]); load8f(g + 512 + 8 * lane, gv[1]);
    for (int row = blockIdx.x * 8 + w; row < rows; row += gridDim.x * 8) {
        float v[2][8];
        if (xin16) { const bf16_t* xr = xin16 + (size_t)row * DM + 8 * lane; unpack8(*(const u32x4*)xr, v[0]); unpack8(*(const u32x4*)(xr + 512), v[1]); }
        else { const float* xr = xin + (size_t)row * DM + 8 * lane; load8f(xr, v[0]); load8f(xr + 512, v[1]); }
        float ss = 0.f;
#pragma unroll
        for (int i = 0; i < 2; ++i)
#pragma unroll
            for (int j = 0; j < 8; ++j) ss += v[i][j] * v[i][j];
        ss = wave_sum(wid0, ss);
        const float r = rsqrtf(ss * (1.0f / 1024.0f) + 1e-6f);
#pragma unroll
        for (int i = 0; i < 2; ++i) { float o[8];
#pragma unroll
            for (int j = 0; j < 8; ++j) o[j] = v[i][j] * r * gv[i][j];
            *(u32x4*)(h + (size_t)row * DM + 512 * i + 8 * lane) = pack8(o);
            unsigned w0 = 0u, w1 = 0u; w0 = __builtin_amdgcn_cvt_pk_fp8_f32(o[0], o[1], w0, false); w0 = __builtin_amdgcn_cvt_pk_fp8_f32(o[2], o[3], w0, true); w1 = __builtin_amdgcn_cvt_pk_fp8_f32(o[4], o[5], w1, false); w1 = __builtin_amdgcn_cvt_pk_fp8_f32(o[6], o[7], w1, true);
            *(u32x2*)(h8 + (size_t)row * DM + 512 * i + 8 * lane) = (u32x2){w0, w1}; }
    }
}
__device__ void phase_norm_final(int wid0, const bf16_t* __restrict__ x, float* __restrict__ out, const float* __restrict__ g, int rows) {
    const int tid = otid(wid0), lane = tid & 63, w = tid >> 6;
    float gv[2][8];
    load8f(g + 8 * lane, gv[0]); load8f(g + 512 + 8 * lane, gv[1]);
    for (int row = blockIdx.x * 8 + w; row < rows; row += gridDim.x * 8) {
        const bf16_t* xr = x + (size_t)row * DM + 8 * lane; float* orow = out + (size_t)row * DM + 8 * lane;
        float v[2][8]; unpack8(*(const u32x4*)xr, v[0]); unpack8(*(const u32x4*)(xr + 512), v[1]);
        float ss = 0.f;
#pragma unroll
        for (int i = 0; i < 2; ++i)
#pragma unroll
            for (int j = 0; j < 8; ++j) ss += v[i][j] * v[i][j];
        ss = wave_sum(wid0, ss);
        const float r = rsqrtf(ss * (1.0f / 1024.0f) + 1e-6f);
#pragma unroll
        for (int i = 0; i < 2; ++i) {
            f32x4 a, b;
#pragma unroll
            for (int j = 0; j < 4; ++j) { a[j] = v[i][j] * r * gv[i][j]; b[j] = v[i][4 + j] * r * gv[i][4 + j]; }
            *(f32x4*)(orow + 512 * i) = a; *(f32x4*)(orow + 512 * i + 4) = b; }
    }
}

#define PO(k) ((size_t)(k) * TS * BWID)
__device__ void mix_sc(int wid0, const Params& p, int l, const bf16_t* proj, bf16_t* z3, int r0, int pos0) {
    const int tid = otid(wid0), lane = tid & 63, w = tid >> 6, c0 = lane * 8;
    const float* scw = SMALLP(p, SM13) + (size_t)l * 3 * BWID + c0;
    float w0[8], w1[8], w2[8]; load8f(scw, w0); load8f(scw + BWID, w1); load8f(scw + 2 * BWID, w2);
    const int r = r0 + 16 * w, pos = pos0 + 16 * w;
    const bf16_t* bgp = proj + PO(6) + c0; const bf16_t* cxp = proj + PO(7) + c0;
    u32x4 vb[16], vc[18];
    vc[0] = (u32x4){0u, 0u, 0u, 0u}; vc[1] = vc[0];
    if (pos > 0) { vc[0] = *(const u32x4*)(cxp + (size_t)(r - 2) * BWID); vc[1] = *(const u32x4*)(cxp + (size_t)(r - 1) * BWID); }
#pragma unroll
    for (int jj = 0; jj < 16; ++jj) { vb[jj] = *(const u32x4*)(bgp + (size_t)(r + jj) * BWID); vc[2 + jj] = *(const u32x4*)(cxp + (size_t)(r + jj) * BWID); }
    float p2[8], p1[8];
    unpack8(vc[0], p2); unpack8(vc[1], p1);
#pragma unroll
    for (int jj = 0; jj < 16; ++jj) {
        float b[8], cur[8], o[8]; unpack8(vb[jj], b); unpack8(vc[2 + jj], cur);
#pragma unroll
        for (int j = 0; j < 8; ++j) { o[j] = b[j] * (w0[j] * p2[j] + w1[j] * p1[j] + w2[j] * cur[j]); p2[j] = p1[j]; p1[j] = cur[j]; }
        *(u32x4*)(z3 + (size_t)(r + jj) * BWID + c0) = pack8(o);
    }
}

__device__ void mix_conv(int wid0, const Params& p, int l, const bf16_t* proj, bf16_t* z1, int r0, int pos0, LAS unsigned char* lds) {
    const int tid = otid(wid0), lane = tid & 63, w = tid >> 6, c0 = lane * 8;
    LAS unsigned char* Y = lds; LAS unsigned char* W = lds + 94 * VP;
    const float* cw = SMALLP(p, SM5) + (size_t)l * 31 * BWID;
    float bias[8], lng[8], lnb[8];
    load8f(SMALLP(p, SM6) + (size_t)l * BWID + c0, bias); load8f(SMALLP(p, SM7) + (size_t)l * BWID + c0, lng); load8f(SMALLP(p, SM8) + (size_t)l * BWID + c0, lnb);
    u32x4 la[12];
#define CONV_LOAD(q) do { _Pragma("unroll") for (int i = 0; i < 12; ++i) { const int row = 12 * w + i; const bool valid = (row < 94) && (pos0 + 64 * (q) - 30 + row >= 0); \
        la[i] = (u32x4){0u, 0u, 0u, 0u}; if (valid) la[i] = *(const u32x4*)(proj + (size_t)(r0 + 64 * (q) - 30 + row) * BWID + PO(2) + c0); } } while (0)
    CONV_LOAD(0);
    for (int i = tid; i < 31 * 64; i += 512) { const int k = i >> 6, cgp = i & 63; float f[8]; load8f(cw + k * BWID + cgp * 8, f); *(LAS u32x4*)(W + k * 1024 + cgp * 16) = pack8(f); }
#pragma unroll
    for (int q = 0; q < 2; ++q) {
        const int tr = r0 + 64 * q;
        __syncthreads();
#pragma unroll
        for (int i = 0; i < 12; ++i) { const int row = 12 * w + i; if (row < 94) *(LAS u32x4*)(Y + row * VP + lane * 16) = la[i]; }
        __syncthreads();
        if (q == 0) CONV_LOAD(1);
        u32x4 gtv[8];
#pragma unroll
        for (int j = 0; j < 8; ++j) gtv[j] = *(const u32x4*)(proj + (size_t)(tr + 8 * w + j) * BWID + PO(3) + c0);
        float acc[8][8];
#pragma unroll
        for (int j = 0; j < 8; ++j)
#pragma unroll
            for (int c = 0; c < 8; ++c) acc[j][c] = bias[c];
#pragma unroll 1
        for (int k = 0; k < 31; ++k) {
            float wv[8]; unpack8(*(const LAS u32x4*)(W + k * 1024 + lane * 16), wv);
#pragma unroll
            for (int j = 0; j < 8; ++j) { float yv[8]; unpack8(*(const LAS u32x4*)(Y + (8 * w + j + k) * VP + lane * 16), yv);
#pragma unroll
                for (int c = 0; c < 8; ++c) acc[j][c] += wv[c] * yv[c]; }
        }
#pragma unroll
        for (int j = 0; j < 8; ++j) {
            float s = 0.f, ss = 0.f;
#pragma unroll
            for (int c = 0; c < 8; ++c) { s += acc[j][c]; ss += acc[j][c] * acc[j][c]; }
            s = wave_sum(wid0, s); ss = wave_sum(wid0, ss);
            const float mean = s * (1.0f / 512.0f); const float var = fmaxf(ss * (1.0f / 512.0f) - mean * mean, 0.f); const float rstd = rsqrtf(var + 1e-5f);
            const int row = tr + 8 * w + j;
            float gt[8], o[8]; unpack8(gtv[j], gt);
#pragma unroll
            for (int c = 0; c < 8; ++c) { const float v = (acc[j][c] - mean) * rstd * lng[c] + lnb[c]; o[c] = silu(v) * silu(gt[c]); }
            *(u32x4*)(z1 + (size_t)row * BWID + c0) = pack8(o);
        }
    }
}

#undef CONV_LOAD
__device__ __forceinline__ u32x4 sel4(bool c, const u32x4 a, const u32x4 b) { u32x4 r; r.x = c ? a.x : b.x; r.y = c ? a.y : b.y; r.z = c ? a.z : b.z; r.w = c ? a.w : b.w; return r; }

__device__ void mix_pool(int wid0, const Params& p, int l, const bf16_t* proj, bf16_t* z0, int r0, int pos0, LAS unsigned char* lds) {
    const int tid = otid(wid0), lane = tid & 63, w = tid >> 6, c0 = lane * 8;
    LAS unsigned char* P = lds;
    {
        const int g4 = lane >> 4, win = 2 << g4;
        const int r = r0 + 16 * w, pos = pos0 + 16 * w;
        u32x4 R[32];
#pragma unroll
        for (int i = 0; i < 16; ++i) { R[i] = (u32x4){0u, 0u, 0u, 0u}; if (pos > 0) R[i] = *(const u32x4*)(proj + (size_t)(r - 16 + i) * BWID + c0); }
#pragma unroll
        for (int i = 0; i < 16; ++i) R[16 + i] = *(const u32x4*)(proj + (size_t)(r + i) * BWID + c0);
        float S[8];
#pragma unroll
        for (int j = 0; j < 8; ++j) S[j] = 0.f;
#pragma unroll
        for (int i = 1; i <= 16; ++i) { float x[8]; unpack8(R[16 - i], x); const float mk = (i <= win) ? 1.0f : 0.0f;
#pragma unroll
            for (int j = 0; j < 8; ++j) S[j] += mk * x[j]; }
#pragma unroll
        for (int jj = 0; jj < 16; ++jj) {
            const int ps = pos + jj; float xv[8], xo[8], o[8];
            unpack8(R[16 + jj], xv);
            const u32x4 ro = sel4(g4 < 2, sel4(g4 == 0, R[16 + jj - 2], R[16 + jj - 4]), sel4(g4 == 2, R[16 + jj - 8], R[jj]));
            unpack8(ro, xo);
            const int cnt = (ps + 1 < win) ? ps + 1 : win; const float inv = 1.0f / (float)cnt;
#pragma unroll
            for (int j = 0; j < 8; ++j) { S[j] += xv[j] - xo[j]; o[j] = S[j] * inv - xv[j]; }
            *(LAS u32x4*)(P + (16 * w + jj) * VP + lane * 16) = pack8(o);
        }
    }
    __syncthreads();
    {
        const int g = w >> 1, fr = lane & 15, fq = lane >> 4;
        const bf16_t* pwT = (const bf16_t*)(p.ws + p.o_pw) + (size_t)(l * 4 + g) * 128 * 128;
        u32x2 gtv[8][4];
#pragma unroll
        for (int tt = 0; tt < 8; ++tt)
#pragma unroll
            for (int dt = 0; dt < 4; ++dt) gtv[tt][dt] = *(const u32x2*)(proj + (size_t)(r0 + 16 * tt + fr) * BWID + PO(1) + 64 * w + 16 * dt + 4 * fq);
        bf16x8 A[4][4];
#pragma unroll
        for (int dt = 0; dt < 4; ++dt)
#pragma unroll
            for (int kk = 0; kk < 4; ++kk) A[dt][kk] = *(const bf16x8*)(pwT + (size_t)(64 * (w & 1) + 16 * dt + fr) * 128 + 32 * kk + 8 * fq);
        const float* psc = SMALLP(p, SM4) + (size_t)l * BWID;
        f32x4 sc[4];
#pragma unroll
        for (int dt = 0; dt < 4; ++dt) sc[dt] = *(const f32x4*)(psc + 64 * w + 16 * dt + 4 * fq);
#pragma unroll
        for (int tt = 0; tt < 8; ++tt) {
            bf16x8 Bf[4];
#pragma unroll
            for (int kk = 0; kk < 4; ++kk) Bf[kk] = *(const LAS bf16x8*)(P + (16 * tt + fr) * VP + (128 * g + 32 * kk + 8 * fq) * 2);
            f32x4 acc[4];
#pragma unroll
            for (int dt = 0; dt < 4; ++dt) { acc[dt] = (f32x4){0.f, 0.f, 0.f, 0.f};
#pragma unroll
                for (int kk = 0; kk < 4; ++kk) acc[dt] = __builtin_amdgcn_mfma_f32_16x16x32_bf16(A[dt][kk], Bf[kk], acc[dt], 0, 0, 0); }
            const int row = r0 + 16 * tt + fr;
#pragma unroll
            for (int dt = 0; dt < 4; ++dt) { const int d = 64 * w + 16 * dt + 4 * fq;
                float gt[4]; unpack4(gtv[tt][dt], gt);
                u32x2 o; o.x = cvt_pk_bf16(acc[dt][0] * sc[dt][0] * silu(gt[0]), acc[dt][1] * sc[dt][1] * silu(gt[1])); o.y = cvt_pk_bf16(acc[dt][2] * sc[dt][2] * silu(gt[2]), acc[dt][3] * sc[dt][3] * silu(gt[3]));
                *(u32x2*)(z0 + (size_t)row * BWID + d) = o; }
        }
    }
}

__device__ void mix_sgu(int wid0, const Params& p, int l, const bf16_t* proj, bf16_t* z2, int r0, LAS unsigned char* lds) {
    const int tid = otid(wid0), lane = tid & 63, w = tid >> 6, c0 = lane * 8;
    LAS unsigned char* V = lds;
    {
        float lng[8], lnb[8]; load8f(SMALLP(p, SM9) + (size_t)l * BWID + c0, lng); load8f(SMALLP(p, SM10) + (size_t)l * BWID + c0, lnb);
        u32x4 R[16];
#pragma unroll
        for (int jj = 0; jj < 16; ++jj) R[jj] = *(const u32x4*)(proj + (size_t)(r0 + 16 * w + jj) * BWID + PO(5) + c0);
#pragma unroll
        for (int jj = 0; jj < 16; ++jj) {
            float x[8], o[8]; unpack8(R[jj], x);
            float s = 0.f, ss = 0.f;
#pragma unroll
            for (int c = 0; c < 8; ++c) { s += x[c]; ss += x[c] * x[c]; }
            s = wave_sum(wid0, s); ss = wave_sum(wid0, ss);
            const float mean = s * (1.0f / 512.0f); const float var = fmaxf(ss * (1.0f / 512.0f) - mean * mean, 0.f); const float rstd = rsqrtf(var + 1e-5f);
#pragma unroll
            for (int c = 0; c < 8; ++c) o[c] = (x[c] - mean) * rstd * lng[c] + lnb[c];
            *(LAS u32x4*)(V + (16 * w + jj) * VP + lane * 16) = pack8(o);
        }
    }
    __syncthreads();
    {
        const int g = w >> 1, fr = lane & 15, fq = lane >> 4;
        const unsigned vbase = (unsigned)(size_t)V;
        bf16x8 A[4][4];
#pragma unroll
        for (int ct = 0; ct < 4; ++ct)
#pragma unroll
            for (int kk = 0; kk < 4; ++kk) {
                const unsigned a = vbase + (unsigned)((32 * kk + 8 * fq + (fr >> 2)) * VP + (64 * w + 16 * ct + 4 * (fr & 3)) * 2);
                const u32x2 lo = tr_read(a), hi = tr_read(a + 4 * VP);
                u32x4 t; t.x = lo.x; t.y = lo.y; t.z = hi.x; t.w = hi.y;
                A[ct][kk] = __builtin_bit_cast(bf16x8, t);
            }
        const bf16_t* swm = (const bf16_t*)(p.ws + p.o_sw) + (size_t)(l * 4 + g) * 128 * 128;
        const float* sb = SMALLP(p, SM12) + (size_t)(l * 4 + g) * 128;
#pragma unroll
        for (int hb = 0; hb < 2; ++hb) {
            u32x2 uu[4][4]; bf16x8 Wf[4][4]; float bias[4];
#pragma unroll
            for (int t4 = 0; t4 < 4; ++t4) { const int tt = hb * 4 + t4; const bf16_t* pr = proj + (size_t)(r0 + 16 * tt + fr) * BWID + 64 * w + 4 * fq;
#pragma unroll
                for (int ct = 0; ct < 4; ++ct) uu[t4][ct] = *(const u32x2*)(pr + PO(4) + 16 * ct);
#pragma unroll
                for (int kk = 0; kk < 4; ++kk) if (kk < (tt >> 1) + 1) Wf[t4][kk] = *(const bf16x8*)(swm + (size_t)(16 * tt + fr) * 128 + 32 * kk + 8 * fq);
                bias[t4] = sb[16 * tt + fr]; }
#pragma unroll
            for (int t4 = 0; t4 < 4; ++t4) { const int tt = hb * 4 + t4;
                f32x4 acc[4];
#pragma unroll
                for (int ct = 0; ct < 4; ++ct) acc[ct] = (f32x4){0.f, 0.f, 0.f, 0.f};
#pragma unroll
                for (int kk = 0; kk < 4; ++kk) if (kk < (tt >> 1) + 1) {
#pragma unroll
                    for (int ct = 0; ct < 4; ++ct) acc[ct] = __builtin_amdgcn_mfma_f32_16x16x32_bf16(A[ct][kk], Wf[t4][kk], acc[ct], 0, 0, 0); }
                const int row = r0 + 16 * tt + fr;
#pragma unroll
                for (int ct = 0; ct < 4; ++ct) { const int c = 64 * w + 16 * ct + 4 * fq;
                    float u[4]; unpack4(uu[t4][ct], u);
                    u32x2 o; o.x = cvt_pk_bf16(u[0] * (acc[ct][0] + bias[t4]), u[1] * (acc[ct][1] + bias[t4])); o.y = cvt_pk_bf16(u[2] * (acc[ct][2] + bias[t4]), u[3] * (acc[ct][3] + bias[t4]));
                    *(u32x2*)(z2 + (size_t)row * BWID + c) = o; }
            }
        }
    }
}

__device__ void phase_mix(int wid0, const Params& p, int l, const bf16_t* proj, bf16_t* z, LAS unsigned char* lds) {
    constexpr int nchunk = TS / 128;
    for (int i = blockIdx.x; i < 4 * nchunk; i += gridDim.x) {
        const int j = i % nchunk, br = ((i / nchunk) + j) & 3, r0 = j * 128, pos0 = (j & 15) * 128;
        if (br == 0) for (int rr = 0; rr < REP_M0; ++rr) { mix_pool(wid0, p, l, proj, z + PO(1), r0, pos0, lds); __syncthreads(); }
        else if (br == 1) for (int rr = 0; rr < REP_M1; ++rr) { mix_conv(wid0, p, l, proj, z + PO(3), r0, pos0, lds); __syncthreads(); }
        else if (br == 2) for (int rr = 0; rr < REP_M2; ++rr) { mix_sgu(wid0, p, l, proj, z + PO(4), r0, lds); __syncthreads(); }
        else for (int rr = 0; rr < REP_M3; ++rr) { mix_sc(wid0, p, l, proj, z + PO(6), r0, pos0); __syncthreads(); }
    }
}

#define XB_TMO      128
#define XB_XCNT(j)  (256  + 64 * (j))
#define XB_XSUB(j)  (1280 + 64 * (j))
#define XB_XGEN(j)  (2304 + 64 * (j))
#define XB_TOP      3328
#define XB_TOPGEN   3392
#define XCD_BAR_WORDS 3456
#define XB_SPIN_CAP (1u << 20)
__device__ __forceinline__ unsigned xb_ld(unsigned* p)              { return __hip_atomic_load(p, __ATOMIC_RELAXED, __HIP_MEMORY_SCOPE_AGENT); }
__device__ __forceinline__ unsigned xb_add(unsigned* p, unsigned v) { return __hip_atomic_fetch_add(p, v, __ATOMIC_RELAXED, __HIP_MEMORY_SCOPE_AGENT); }
__device__ __forceinline__ unsigned xb_xcc_id() { return (unsigned)__builtin_amdgcn_s_getreg((3 << 11) | 20) & 0xFu; }
#define XB_SPIN(cond, bar) do { unsigned _sp = 0; while (cond) { __builtin_amdgcn_s_sleep(1); \
    if ((++_sp & 255u) == 0u) { if (xb_ld(&(bar)[XB_TMO])) break; if (_sp > XB_SPIN_CAP) { atomicAdd(&(bar)[XB_TMO], 1u); break; } } } } while (0)
struct XcdBarrier { unsigned* bar; unsigned x; volatile LAS unsigned* st; };
__device__ __forceinline__ XcdBarrier xcd_barrier_post(bool first, unsigned* bar, volatile LAS unsigned* st) {
    XcdBarrier b; b.bar = bar; b.x = xb_xcc_id(); b.st = st;
    if (first) (void)xb_add(&bar[XB_XCNT(b.x)], 1u);
    return b;
}
__device__ __forceinline__ void xcd_barrier_complete(unsigned* bar, unsigned x, unsigned& nloc, unsigned& nx) {
    const unsigned G = gridDim.x * gridDim.y * gridDim.z;
    unsigned sum, cnt, mine, sp = 0u;
    for (;;) {
        sum = 0u; cnt = 0u; mine = 0u;
#pragma unroll
        for (unsigned j = 0; j < 16; ++j) { const unsigned c = xb_ld(&bar[XB_XCNT(j)]); sum += c; cnt += (c > 0u) ? 1u : 0u; mine = (j == x) ? c : mine; }
        if (sum == G) break;
        __builtin_amdgcn_s_sleep(1);
        if ((++sp & 255u) == 0u) { if (xb_ld(&bar[XB_TMO])) break; if (sp > XB_SPIN_CAP) { atomicAdd(&bar[XB_TMO], 1u); break; } }
    }
    nloc = mine > 0u ? mine : 1u; nx = cnt > 0u ? cnt : 1u;
}
__device__ __forceinline__ void xcd_barrier(int wid0, const XcdBarrier& b) {
    asm volatile("s_waitcnt vmcnt(0)" ::: "memory");
    __syncthreads();
    if (otid(wid0) == 0) {
        unsigned* bar = b.bar; asm volatile("" : "+s"(bar)); unsigned bx = b.x; asm volatile("" : "+s"(bx));
        __builtin_amdgcn_s_waitcnt(0);
        unsigned nloc = b.st[0], nx = b.st[1];
        if (nloc == 0u) { xcd_barrier_complete(bar, bx, nloc, nx); b.st[0] = nloc; b.st[1] = nx; }
        const unsigned old = xb_add(&bar[XB_XSUB(bx)], 1u);
        const unsigned gen = old / nloc;
        if (old + 1u == (gen + 1u) * nloc) {
            __builtin_amdgcn_fence(__ATOMIC_RELEASE, "agent");
            asm volatile("s_waitcnt vmcnt(0)" ::: "memory");
            const unsigned og = xb_add(&bar[XB_TOP], 1u);
            const unsigned tg = og / nx;
            if (og + 1u == (tg + 1u) * nx) xb_add(&bar[XB_TOPGEN], 1u);
            else XB_SPIN(xb_ld(&bar[XB_TOPGEN]) == tg, bar);
            __builtin_amdgcn_fence(__ATOMIC_ACQUIRE, "agent");
            xb_add(&bar[XB_XGEN(bx)], 1u);
            asm volatile("s_waitcnt vmcnt(0)" ::: "memory");
        } else {
            XB_SPIN(xb_ld(&bar[XB_XGEN(bx)]) == gen, bar);
            __builtin_amdgcn_fence(__ATOMIC_ACQUIRE, "agent");
            asm volatile("s_waitcnt vmcnt(0)" ::: "memory");
        }
    }
    __syncthreads();
}

__global__ void __launch_bounds__(512) mk_forward(Params p) {
    extern __shared__ __attribute__((aligned(16))) unsigned char lds_raw[];
    LAS unsigned char* lds = (LAS unsigned char*)lds_raw;
    cg::grid_group grid = cg::this_grid();
    volatile LAS unsigned* stw = (volatile LAS unsigned*)(lds + LDS_BYTES - 16);
    const int wid0 = __builtin_amdgcn_readfirstlane((int)(threadIdx.x >> 6));
    const bool first = (wid0 == 0 && lane_id() == 0);
    if (first) { stw[0] = 0u; stw[1] = 0u; }
    __syncthreads();
    const XcdBarrier xbar = xcd_barrier_post(first, (unsigned*)(p.ws + p.o_bar), stw);
#define PHASE_ON true
#ifndef XSYNC
#define XSYNC 0
#endif
#define PHASE_END do { if (p.ph_hi > 100000) grid.sync();   xcd_barrier(wid0, xbar); } while (0)
    constexpr int ts = TS;
    bf16_t* win = (bf16_t*)(p.ws + p.o_win); bf16_t* wb = (bf16_t*)(p.ws + p.o_wb); bf16_t* wo = (bf16_t*)(p.ws + p.o_wo);
    bf16_t* h0 = (bf16_t*)(p.ws + p.o_h); bf16_t* proj = (bf16_t*)(p.ws + p.o_proj);

    if (PHASE_ON) phase_prep(wid0, p, lds);
    PHASE_END;
#pragma unroll 1
    for (int l = 0; l < DEPTH; ++l) {
        bf16_t* x1b = (bf16_t*)p.out;
#pragma unroll 1
        for (int s = 0; s < NS; ++s) {
            const size_t tok0 = (size_t)s * ts;
            bf16_t* h = h0 + tok0 * DM; bf16_t* merged = h;
            if (l > 0) { if (PHASE_ON) phase_norm_bf16(wid0, nullptr, x1b + tok0 * DM, SMALLP(p, SM1) + (size_t)l * DM, h, p.ws + p.o_h8 + tok0 * DM, ts);
                PHASE_END; }
            if (PHASE_ON) {
                { pg8::Gemm g{h, win + (size_t)l * DM * WINR}; pg8::OrderA S; S.G = (int)gridDim.x; S.c = (int)blockIdx.x; pg8::EpiProj E{proj}; pg8::gemm_phase<DM, 0>(wid0, lds, g, S, E); }
                { pg8::Gemm g{(const bf16_t*)(p.ws + p.o_h8 + tok0 * DM), (const bf16_t*)(p.ws + p.o_wg8 + (size_t)l * 4096 * DM)}; pg8::Order<TS / 256, 4096 / 256, 1> S{(int)gridDim.x, (int)blockIdx.x};
                  pg8::EpiGateStore E{(unsigned char*)(proj + (size_t)8 * TS * BWID)}; pg8::gemm_phase_f8<DM>(wid0, lds, g, S, E); }
            }
            PHASE_END;
            if (PHASE_ON) phase_mix(wid0, p, l, proj, proj, lds);
            PHASE_END;
            if (PHASE_ON) for (int rep = 0; rep < REP_C; ++rep) { pg8::Gemm g{proj, wb + (size_t)l * 4 * BWID * DM}; pg8::OrderC S; S.G = (int)gridDim.x; S.c = (int)blockIdx.x;
                pg8::EpiGate E{proj + (size_t)8 * TS * BWID, merged}; pg8::gemm_phase<BWID, (size_t)BWID * DM * 2>(wid0, lds, g, S, E); }
            PHASE_END;
            if (PHASE_ON) { pg8::Gemm g{merged, wo + (size_t)l * DM * DM}; pg8::Order<TS / 256, DM / 256, 1> S{(int)gridDim.x, (int)blockIdx.x};
                pg8::EpiRes E{(l == 0) ? p.in[0] + tok0 * DM : nullptr, (l == 0) ? nullptr : x1b + tok0 * DM, (l == 0) ? x1b + tok0 * DM : proj + tok0 * DM}; pg8::gemm_phase<DM, 0>(wid0, lds, g, S, E); }
            PHASE_END;
        }
    }
    phase_norm_final(wid0, proj, p.out, SMALLP(p, SM16), NTOK);
}

extern "C" void kernel_launch(void* const* d_in, const int* in_sizes, int n_in, void* d_out, int out_size, void* d_ws, size_t ws_size, hipStream_t stream) {
    static int grid = 0;
    if (grid == 0) {
        int dev = 0, cus = 0, per_cu = 0;
        hipGetDevice(&dev); hipDeviceGetAttribute(&cus, hipDeviceAttributeMultiprocessorCount, dev);
        if (hipFuncSetAttribute((const void*)mk_forward, hipFuncAttributeMaxDynamicSharedMemorySize, LDS_BYTES) != hipSuccess) { fprintf(stderr, "hipFuncSetAttribute failed\n"); grid = -1; return; }
        if (hipOccupancyMaxActiveBlocksPerMultiprocessor(&per_cu, (const void*)mk_forward, 512, LDS_BYTES) != hipSuccess || per_cu < 1) { fprintf(stderr, "occupancy query: %d\n", per_cu); per_cu = 1; }
        (void)hipGetLastError();
        grid = cus * per_cu;
    }
    if (grid < 0) return;
    Params p{};
    for (int i = 0; i < 17; ++i) p.in[i] = (const float*)d_in[i];
    p.out = (float*)d_out; p.ws = (unsigned char*)d_ws;
    size_t o = 0;
    p.o_win = (unsigned)o; o += (size_t)DEPTH * DM * WINR * 2;
    p.o_wg8 = (unsigned)o; o += (size_t)DEPTH * 4096 * DM;
    p.o_h8 = (unsigned)o; o += (size_t)NTOK * DM;
    p.o_wb = (unsigned)o; o += (size_t)DEPTH * 4 * BWID * DM * 2;
    p.o_wo = (unsigned)o; o += (size_t)DEPTH * DM * DM * 2;
    p.o_pw = (unsigned)o; o += (size_t)DEPTH * 4 * 128 * 128 * 2;
    p.o_sw = (unsigned)o; o += (size_t)DEPTH * 4 * 128 * 128 * 2;
    p.o_bar = (unsigned)o; o += 16384;
    p.o_small = (unsigned)o; o += (size_t)SM_TOTAL * 4;
    p.o_h = (unsigned)o; o += (size_t)NTOK * DM * 2;
    p.o_proj = (unsigned)o; o += (size_t)TS * (8 * BWID * 2 + 4096);
    if (o > ws_size) { fprintf(stderr, "kernel_launch: workspace too small: need %zu, have %zu\n", o, ws_size); return; }
    const int nph = 1 + NS * 4 + (DEPTH - 1) * NS * 5 + 1;
    if (hipMemsetAsync((char*)d_ws + p.o_bar, 0, 16384, stream) != hipSuccess) { fprintf(stderr, "kernel_launch: memset failed\n"); return; }
    p.ph_hi = nph;
    void* args[] = {&p};
    hipError_t e = hipLaunchCooperativeKernel((const void*)mk_forward, dim3(grid), dim3(512), args, LDS_BYTES, stream);
    if (e != hipSuccess) fprintf(stderr, "cooperative launch failed: %s (grid %d)\n", hipGetErrorString(e), grid);
}
```

```cpp
#include <hip/hip_runtime.h>
#include <hip/hip_cooperative_groups.h>
#include <cstdio>
namespace cg = cooperative_groups;

#ifndef MULTI_LAUNCH
#define MULTI_LAUNCH 0
#endif

#ifndef REP_N
#define REP_N 1
#endif
#ifndef REP_A
#define REP_A 1
#endif
#ifndef REP_B
#define REP_B 1
#endif
#ifndef REP_C
#define REP_C 1
#endif
#define REP_M0 1
#define REP_M1 1
#define REP_M2 1
#define REP_M3 1
#define LAS __attribute__((address_space(3)))
typedef unsigned short bf16_t;
typedef short bf16x8 __attribute__((ext_vector_type(8)));
typedef float f32x4 __attribute__((ext_vector_type(4)));
typedef float f32x2 __attribute__((ext_vector_type(2)));
typedef unsigned u32x4 __attribute__((ext_vector_type(4)));
typedef unsigned u32x2 __attribute__((ext_vector_type(2)));
typedef int i32x8 __attribute__((ext_vector_type(8)));
typedef int i32x4 __attribute__((ext_vector_type(4)));
constexpr int WINR = 6144;

constexpr int DM = 1024, SEQ = 2048, NTOK = 32 * 2048, DEPTH = 2, BWID = 512, INC = 10240, GATE0 = 6144;
constexpr int PP = 6144;
constexpr int NS = 1, TS = NTOK / NS;
constexpr int LDS_BYTES = 139264;
constexpr int VP = 1040;

constexpr int SM1 = 0, SM4 = 2048, SM5 = 3072, SM6 = 34816, SM7 = 35840, SM8 = 36864, SM9 = 37888, SM10 = 38912, SM12 = 39936, SM13 = 40960, SM16 = 44032, SM_TOTAL = 45056;
#define SMALLP(p, OFF) ((const float*)((p).ws + (p).o_small) + (OFF))
struct Params {
    const float* in[17];
    float* out;
    unsigned char* ws;
    int ph_hi;
    unsigned o_win, o_wb, o_wo, o_pw, o_sw, o_h, o_bar, o_proj, o_h8, o_wg8, o_small;
};

__device__ __forceinline__ int lane_id() { return (int)__builtin_amdgcn_mbcnt_hi(~0u, __builtin_amdgcn_mbcnt_lo(~0u, 0u)); }
__device__ __forceinline__ int otid(int wid0) { int t; asm volatile("v_mbcnt_lo_u32_b32 %0, -1, 0\n\tv_mbcnt_hi_u32_b32 %0, -1, %0" : "=v"(t)); return (wid0 << 6) | t; }
__device__ __forceinline__ unsigned cvt_pk_bf16(float lo, float hi) { unsigned r; asm volatile("v_cvt_pk_bf16_f32 %0, %1, %2" : "=v"(r) : "v"(lo), "v"(hi)); return r; }
__device__ __forceinline__ bf16_t f2bf(float f) { unsigned u = __float_as_uint(f); u += 0x7FFFu + ((u >> 16) & 1u); return (bf16_t)(u >> 16); }
__device__ __forceinline__ void unpack8(const u32x4 v, float (&f)[8]) {
    f[0] = __uint_as_float(v.x << 16); f[1] = __uint_as_float(v.x & 0xffff0000u); f[2] = __uint_as_float(v.y << 16); f[3] = __uint_as_float(v.y & 0xffff0000u);
    f[4] = __uint_as_float(v.z << 16); f[5] = __uint_as_float(v.z & 0xffff0000u); f[6] = __uint_as_float(v.w << 16); f[7] = __uint_as_float(v.w & 0xffff0000u);
}
__device__ __forceinline__ u32x4 pack8(const float (&f)[8]) { u32x4 r; r.x = cvt_pk_bf16(f[0], f[1]); r.y = cvt_pk_bf16(f[2], f[3]); r.z = cvt_pk_bf16(f[4], f[5]); r.w = cvt_pk_bf16(f[6], f[7]); return r; }
__device__ __forceinline__ void unpack4(const u32x2 v, float (&f)[4]) { f[0] = __uint_as_float(v.x << 16); f[1] = __uint_as_float(v.x & 0xffff0000u); f[2] = __uint_as_float(v.y << 16); f[3] = __uint_as_float(v.y & 0xffff0000u); }
__device__ __forceinline__ float sigm(float x) { return __builtin_amdgcn_rcpf(1.0f + __expf(-x)); }
__device__ __forceinline__ float silu(float x) { return x * sigm(x); }
__device__ __forceinline__ void load8f(const float* p, float (&f)[8]) { const f32x4 a = *(const f32x4*)p, b = *(const f32x4*)(p + 4); f[0] = a[0]; f[1] = a[1]; f[2] = a[2]; f[3] = a[3]; f[4] = b[0]; f[5] = b[1]; f[6] = b[2]; f[7] = b[3]; }
__device__ __forceinline__ float wave_sum(int wid0, float v) {
    const int lane = otid(wid0) & 63;
#pragma unroll
    for (int o = 32; o >= 1; o >>= 1) v += __builtin_bit_cast(float, __builtin_amdgcn_ds_bpermute((lane ^ o) << 2, __builtin_bit_cast(int, v)));
    return v;
}
__device__ __forceinline__ u32x2 tr_read(unsigned lds_addr) { u32x2 r; asm volatile("ds_read_b64_tr_b16 %0, %1\n\ts_waitcnt lgkmcnt(0)" : "=&v"(r) : "v"(lds_addr) : "memory"); return r; }

namespace pg8 {
constexpr int BM = 256, BK = 64, HALF = 128, HTB = HALF * BK * 2, STAGE_BYTES = 8 * HTB, NXCD = 8, WGM = 8;
__device__ __forceinline__ int lds_byte(int r, int c) { const int st = (r >> 4) * 2 + (c >> 5), rr = r & 15, cc = c & 31, ob = rr * 64 + cc * 2; return st * 1024 + (ob ^ (((ob >> 9) & 1) << 5)); }
__device__ __forceinline__ void stage_rc(int b, int& R, int& C) { const int st = b / 1024, sb = b % 1024, swz = sb ^ (((sb >> 9) & 1) << 5); R = (st >> 1) * 16 + swz / 64; C = (st & 1) * 32 + (swz % 64) / 2; }
__device__ __forceinline__ int perm32(int rho) { const int n = rho >> 4, i = rho & 15; return 8 * (i >> 2) + 4 * n + (i & 3); }

struct Unit { int pm, pn, br; };
struct Gemm { const bf16_t* A; const bf16_t* Bt; };

template <int NM, int NN, int NBR>
struct Order {
    int G, c;
    __device__ __forceinline__ bool next(int i, Unit& u) const {
        constexpr int nwg = NM * NN;
        const int ti = i / NBR;
        const long L = (long)ti * G + c; if (L >= nwg) return false;
        int wgid = (int)L; { constexpr int q = nwg / NXCD, r = nwg % NXCD; const int xcd = wgid % NXCD, off = wgid / NXCD; wgid = (xcd < r ? xcd * (q + 1) : r * (q + 1) + (xcd - r) * q) + off; }
        constexpr int nig = WGM * NN; const int gid = wgid / nig, fm = gid * WGM, gsz = (NM - fm) < WGM ? (NM - fm) : WGM;
        u.pm = fm + ((wgid % nig) % gsz); u.pn = (wgid % nig) / gsz; u.br = i % NBR; return true;
    }
    __device__ __forceinline__ void brow(const Unit& u, int& r0, int& r1) const { r0 = u.pn * BM; r1 = r0 + HALF; }
    __device__ __forceinline__ size_t aoff(const Unit&) const { return 0; }
};
struct OrderC : Order<TS / 256, DM / 256, 4> {
    __device__ __forceinline__ size_t aoff(const Unit& u) const { const int slot = (u.br == 0) ? 1 : (u.br == 1) ? 3 : (u.br == 2) ? 4 : 6; return (size_t)slot * TS * BWID * 2; }
};
struct OrderA : Order<TS / 256, WINR / 256, 1> {
    __device__ __forceinline__ void brow(const Unit& u, int& r0, int& r1) const {
        const int pn = u.pn;
        if (pn < 8) { const int pc = pn >> 1; const int piece = (pc == 0) ? 0 : (pc == 1) ? 1 : (pc == 2) ? 4 : 6; r0 = piece * 512 + (pn & 1) * 256; r1 = r0 + HALF; }
        else if (pn < 24) { const int q = (pn - 8) >> 2, sub = (pn - 8) & 3; const int pa = (q == 0) ? 2 : (q == 1) ? 9 : (q == 2) ? 8 : 5, pb = (q == 0) ? 3 : (q == 1) ? 10 : (q == 2) ? 11 : 7;
            r0 = pa * 512 + HALF * sub; r1 = pb * 512 + HALF * sub; }
        else { r0 = pn * BM; r1 = r0 + HALF; }
    }
};

struct EpiProj {
    static constexpr bool PERM = true;
    static __device__ __forceinline__ bool zero_after(const Unit&) { return true; }
    bf16_t* O;
    __device__ __forceinline__ void operator()(f32x4 (&acc)[2][2][4][2], const Unit& u, int wr, int wc, int fr_, int fq) const {
        int fr = fr_; asm volatile("" : "+v"(fr));
        if (u.pn < 8) {
            const int pc = u.pn >> 1; const int slot = (pc == 0) ? 0 : (pc == 1) ? 1 : (pc == 2) ? 3 : 5;
            const int row0 = u.pm * BM + wr * 64 + fr, col0 = (u.pn & 1) * BM + wc * 32 + 8 * fq;
            bf16_t* Op = O + (size_t)slot * TS * BWID;
#pragma unroll
            for (int ai = 0; ai < 2; ++ai)
#pragma unroll
                for (int m = 0; m < 4; ++m) { bf16_t* rowp = Op + (size_t)(row0 + ai * HALF + m * 16) * BWID + col0;
#pragma unroll
                    for (int bj = 0; bj < 2; ++bj) { const f32x4 v0 = acc[ai][bj][m][0], v1 = acc[ai][bj][m][1];
                        u32x4 w; w.x = cvt_pk_bf16(v0[0], v0[1]); w.y = cvt_pk_bf16(v0[2], v0[3]); w.z = cvt_pk_bf16(v1[0], v1[1]); w.w = cvt_pk_bf16(v1[2], v1[3]);
                        __builtin_nontemporal_store(w, (u32x4*)(rowp + bj * HALF)); } }
        } else {
            const int q = (u.pn - 8) >> 2, sub = (u.pn - 8) & 3; const int slot = (q == 0) ? 2 : (q == 1) ? 7 : (q == 2) ? 6 : 4;
            const int row0 = u.pm * BM + wr * 64 + fr, col0 = sub * HALF + wc * 32 + 8 * fq;
            bf16_t* Op = O + (size_t)slot * TS * BWID;
#pragma unroll
            for (int ai = 0; ai < 2; ++ai)
#pragma unroll
                for (int m = 0; m < 4; ++m) {
                    float f[8];
#pragma unroll
                    for (int n = 0; n < 2; ++n)
#pragma unroll
                        for (int j = 0; j < 4; ++j) { const float av = acc[ai][0][m][n][j], bv = acc[ai][1][m][n][j];
                            const float sg = __builtin_amdgcn_rcpf(1.0f + __builtin_amdgcn_exp2f(bv));
                            f[n * 4 + j] = av * ((q == 1) ? bv : (q == 0) ? sg : bv * sg); }
                    __builtin_nontemporal_store(pack8(f), (u32x4*)(Op + (size_t)(row0 + ai * HALF + m * 16) * BWID + col0)); }
        }
    }
};
struct EpiGateStore {
    static constexpr bool PERM = true;
    static __device__ __forceinline__ bool zero_after(const Unit&) { return true; }
    unsigned char* G;
    __device__ __forceinline__ void operator()(f32x4 (&acc)[2][2][4][2], const Unit& u, int wr, int wc, int fr_, int fq) const {
        int fr = fr_; asm volatile("" : "+v"(fr));
        unsigned char* gb = G + ((size_t)u.pm * 16 + u.pn) * 65536 + (((wr * 4 + wc) * 4 + fq) * 16 + fr) * 16;
        const float c255 = 1.0f / 255.0f;
#pragma unroll
        for (int ai = 0; ai < 2; ++ai)
#pragma unroll
            for (int m = 0; m < 4; ++m) {
                u32x4 w;
#pragma unroll
                for (int bj = 0; bj < 2; ++bj)
#pragma unroll
                    for (int n = 0; n < 2; ++n) { unsigned q = 0u;
#pragma unroll
                        for (int j = 0; j < 4; ++j) q = __builtin_amdgcn_cvt_pk_u8_f32(fmaxf(__builtin_amdgcn_rcpf(__builtin_fmaf(__builtin_amdgcn_exp2f(acc[ai][bj][m][n][j]), c255, c255)), 1.0f), j, q);
                        w[bj * 2 + n] = q; }
                __builtin_nontemporal_store(w, (u32x4*)(gb + (ai * 4 + m) * 8192));
                __builtin_amdgcn_sched_barrier(0); }
    }
};
struct EpiGate {
    static constexpr bool PERM = true;
    static __device__ __forceinline__ bool zero_after(const Unit& u) { return u.br == 3; }
    const bf16_t* G; bf16_t* merged;
    __device__ __forceinline__ void operator()(f32x4 (&acc)[2][2][4][2], const Unit& u, int wr, int wc, int fr_, int fq) const {
        int fr = fr_; asm volatile("" : "+v"(fr));
        const int lrow0 = wr * 64 + fr, lcol0 = wc * 32 + 8 * fq;
        const int br = u.br;
        const bool lastb = (br == 3);
        const unsigned char* gp0 = (const unsigned char*)G + ((size_t)u.pm * 16 + br * 4 + u.pn) * 65536 + (((wr * 4 + wc) * 4 + fq) * 16 + fr) * 16;
        const unsigned char* gnp = lastb ? gp0 : gp0 + 4 * 65536;
        u32x4 gc[2][4], gn[2][4];
#pragma unroll
        for (int ai = 0; ai < 2; ++ai)
#pragma unroll
            for (int m = 0; m < 4; ++m) { gc[ai][m] = *(const u32x4*)(gp0 + (ai * 4 + m) * 8192); gn[ai][m] = (u32x4){0u, 0u, 0u, 0u}; if (!lastb) gn[ai][m] = *(const u32x4*)(gnp + (ai * 4 + m) * 8192); }
#pragma unroll
        for (int ai = 0; ai < 2; ++ai)
#pragma unroll
            for (int m = 0; m < 4; ++m)
#pragma unroll
                for (int bj = 0; bj < 2; ++bj) {
#pragma unroll
                    for (int n = 0; n < 2; ++n) {
                        const unsigned c = gc[ai][m][bj * 2 + n], d = gn[ai][m][bj * 2 + n];
                        float fc[4], fd[4];
                        fc[0] = (float)(c & 0xffu); fc[1] = (float)((c >> 8) & 0xffu); fc[2] = (float)((c >> 16) & 0xffu); fc[3] = (float)(c >> 24);
                        fd[0] = (float)(d & 0xffu); fd[1] = (float)((d >> 8) & 0xffu); fd[2] = (float)((d >> 16) & 0xffu); fd[3] = (float)(d >> 24);
#pragma unroll
                        for (int j = 0; j < 4; ++j) acc[ai][bj][m][n][j] *= fc[j] * (lastb ? (1.0f / 255.0f) : __builtin_amdgcn_rcpf(fd[j]));
                    }
                    if (lastb) { const f32x4 v0 = acc[ai][bj][m][0], v1 = acc[ai][bj][m][1];
                        u32x4 w; w.x = cvt_pk_bf16(v0[0], v0[1]); w.y = cvt_pk_bf16(v0[2], v0[3]); w.z = cvt_pk_bf16(v1[0], v1[1]); w.w = cvt_pk_bf16(v1[2], v1[3]);
                        *(u32x4*)(merged + ((size_t)u.pm * BM + lrow0 + ai * HALF + m * 16) * DM + u.pn * BM + lcol0 + bj * HALF) = w; }
                }
    }
};
struct EpiRes {
    static constexpr bool PERM = true;
    static __device__ __forceinline__ bool zero_after(const Unit&) { return true; }
    const float* res32; const bf16_t* res16; bf16_t* O;
    __device__ __forceinline__ void operator()(f32x4 (&acc)[2][2][4][2], const Unit& u, int wr, int wc, int fr_, int fq) const {
        int fr = fr_; asm volatile("" : "+v"(fr));
        const int row0 = u.pm * BM + wr * 64 + fr, col0 = u.pn * BM + wc * 32 + 8 * fq;
        const bool r16 = (res16 != nullptr);
        if (r16) {
            u32x4 rr[2][4][2];
#pragma unroll
            for (int ai = 0; ai < 2; ++ai)
#pragma unroll
                for (int m = 0; m < 4; ++m)
#pragma unroll
                    for (int bj = 0; bj < 2; ++bj) rr[ai][m][bj] = *(const u32x4*)(res16 + (size_t)(row0 + ai * HALF + m * 16) * DM + col0 + bj * HALF);
#pragma unroll
            for (int ai = 0; ai < 2; ++ai)
#pragma unroll
                for (int m = 0; m < 4; ++m)
#pragma unroll
                    for (int bj = 0; bj < 2; ++bj) { float r[8], o[8]; unpack8(rr[ai][m][bj], r);
#pragma unroll
                        for (int j = 0; j < 4; ++j) { o[j] = acc[ai][bj][m][0][j] + r[j]; o[4 + j] = acc[ai][bj][m][1][j] + r[4 + j]; }
                        *(u32x4*)(O + (size_t)(row0 + ai * HALF + m * 16) * DM + col0 + bj * HALF) = pack8(o); }
        } else {
#pragma unroll
            for (int ai = 0; ai < 2; ++ai) {
                f32x4 rr[4][2][2];
#pragma unroll
                for (int m = 0; m < 4; ++m)
#pragma unroll
                    for (int bj = 0; bj < 2; ++bj) { const float* q = res32 + (size_t)(row0 + ai * HALF + m * 16) * DM + col0 + bj * HALF; rr[m][bj][0] = *(const f32x4*)q; rr[m][bj][1] = *(const f32x4*)(q + 4); }
#pragma unroll
                for (int m = 0; m < 4; ++m)
#pragma unroll
                    for (int bj = 0; bj < 2; ++bj) { float o[8];
#pragma unroll
                        for (int j = 0; j < 4; ++j) { o[j] = acc[ai][bj][m][0][j] + rr[m][bj][0][j]; o[4 + j] = acc[ai][bj][m][1][j] + rr[m][bj][1][j]; }
                        *(u32x4*)(O + (size_t)(row0 + ai * HALF + m * 16) * DM + col0 + bj * HALF) = pack8(o); }
                asm volatile("" ::: "memory");
            }
        }
    }
};

template <int K, size_t B_BR, class Epi, class Sched>
__device__ __forceinline__ void gemm_phase(int wid0, LAS unsigned char* lds, const Gemm g, const Sched& S, const Epi& E) {
    const int tid = otid(wid0), wid = __builtin_amdgcn_readfirstlane(tid >> 6), lane = tid & 63, wr = wid >> 2, wc = wid & 3, fr = lane & 15, fq = lane >> 4;
    constexpr int nt = K / BK;
    unsigned voffA[2], voffB[2];
#pragma unroll
    for (int i = 0; i < 2; ++i) { int R, C; stage_rc(tid * 16 + i * 8192, R, C); const int Rb = Epi::PERM ? ((R & ~31) + perm32(R & 31)) : R;
        voffA[i] = (unsigned)(R * K + C) * 2u; voffB[i] = (unsigned)(Rb * K + C) * 2u; }
    constexpr size_t kstep = (size_t)(BK * 2);
    constexpr size_t hstep = (size_t)HALF * K * 2;
    constexpr size_t tstep = 2 * hstep;
    const unsigned ldsw = (unsigned)wid * 1024u;
    const int aoff = lds_byte(wr * 64 + fr, fq * 8), boff = lds_byte(wc * 32 + fr, fq * 8);
#define PG8_SA(b, h) (((b) * 2 + (h)) * HTB)
#define PG8_SB(b, h) ((4 + (b) * 2 + (h)) * HTB)
#define PG8_STAGE(bufoff, gbase, voff) do { _Pragma("unroll") for (int _i = 0; _i < 2; ++_i) \
        __builtin_amdgcn_global_load_lds((const unsigned*)((const char*)(gbase) + (voff)[_i]), (LAS unsigned*)(lds + (bufoff) + ldsw + _i * 8192), 16, 0, 0); } while (0)
#define PG8_LDA(dst, b, h) do { _Pragma("unroll") for (int m = 0; m < 4; ++m) _Pragma("unroll") for (int k = 0; k < 2; ++k) dst[m][k] = *(const LAS bf16x8*)(lds + PG8_SA(b, h) + aoff + m * 2048 + k * 1024); } while (0)
#define PG8_LDB(dst, b, h) do { _Pragma("unroll") for (int n = 0; n < 2; ++n) _Pragma("unroll") for (int k = 0; k < 2; ++k) dst[n][k] = *(const LAS bf16x8*)(lds + PG8_SB(b, h) + boff + n * 2048 + k * 1024); } while (0)
#define PG8_MMA(ai, bj, At, Bt) do { __builtin_amdgcn_s_setprio(1); _Pragma("unroll") for (int m = 0; m < 4; ++m) _Pragma("unroll") for (int n = 0; n < 2; ++n) _Pragma("unroll") for (int k = 0; k < 2; ++k) \
        acc[ai][bj][m][n] = __builtin_amdgcn_mfma_f32_16x16x32_bf16(Bt[n][k], At[m][k], acc[ai][bj][m][n], 0, 0, 0); __builtin_amdgcn_s_setprio(0); } while (0)
#define PG8_WAIT_V(n) asm volatile("s_waitcnt vmcnt(" #n ")" ::: "memory")
#define PG8_WAIT_L(n) asm volatile("s_waitcnt lgkmcnt(" #n ")" ::: "memory")
#define PG8_BAR __builtin_amdgcn_s_barrier()
#define PG8_SCHED __builtin_amdgcn_sched_barrier(0)
    Unit cur, nxt; int ui = 0;
    if (!S.next(0, cur)) return;
    f32x4 acc[2][2][4][2];
#pragma unroll
    for (int a = 0; a < 2; ++a)
#pragma unroll
        for (int b = 0; b < 2; ++b)
#pragma unroll
            for (int m = 0; m < 4; ++m)
#pragma unroll
                for (int n = 0; n < 2; ++n) acc[a][b][m][n] = (f32x4){0.f, 0.f, 0.f, 0.f};
    bf16x8 At[4][2], B0[2][2], B1[2][2];
    const char* cA = (const char*)g.A + (size_t)cur.pm * tstep + S.aoff(cur); int rb0, rb1; S.brow(cur, rb0, rb1);
    const char* cB = (const char*)g.Bt + (size_t)rb0 * (K * 2) + (size_t)cur.br * B_BR; const char* cBh = (const char*)g.Bt + (size_t)rb1 * (K * 2) + (size_t)cur.br * B_BR;
    PG8_STAGE(PG8_SB(0, 0), cB, voffB); PG8_STAGE(PG8_SA(0, 0), cA, voffA); PG8_STAGE(PG8_SB(0, 1), cBh, voffB); PG8_STAGE(PG8_SA(0, 1), cA + hstep, voffA);
    if (wr == 1) PG8_BAR;
    PG8_WAIT_V(4); PG8_BAR;
    PG8_STAGE(PG8_SB(1, 0), cB + kstep, voffB); PG8_STAGE(PG8_SA(1, 0), cA + kstep, voffA); PG8_STAGE(PG8_SB(1, 1), cBh + kstep, voffB);
    PG8_WAIT_V(6); PG8_BAR;
    for (;;) {
        const bool has_next = S.next(ui + 1, nxt);
        const char* nA = has_next ? (const char*)g.A + (size_t)nxt.pm * tstep + S.aoff(nxt) : cA; int rn0 = 0, rn1 = 0; if (has_next) S.brow(nxt, rn0, rn1);
        const char* nB = has_next ? (const char*)g.Bt + (size_t)rn0 * (K * 2) + (size_t)nxt.br * B_BR : cB; const char* nBh = has_next ? (const char*)g.Bt + (size_t)rn1 * (K * 2) + (size_t)nxt.br * B_BR : cBh;
        for (int t = 0; t < nt; t += 2) {
            const bool last = (t == nt - 2);
            const char* a1 = cA + (size_t)(t + 1) * kstep;
            const char* a2 = last ? nA : cA + (size_t)(t + 2) * kstep; const char* b2 = last ? nB : cB + (size_t)(t + 2) * kstep; const char* b2h = last ? nBh : cBh + (size_t)(t + 2) * kstep;
            const char* a3 = a2 + kstep; const char* b3 = b2 + kstep; const char* b3h = b2h + kstep;
            PG8_LDB(B0, 0, 0); PG8_SCHED; PG8_LDA(At, 0, 0); PG8_STAGE(PG8_SA(1, 1), a1 + hstep, voffA);
            PG8_WAIT_L(8); PG8_BAR; PG8_WAIT_L(0); PG8_MMA(0, 0, At, B0); PG8_BAR; PG8_SCHED;
            PG8_LDB(B1, 0, 1); PG8_STAGE(PG8_SB(0, 0), b2, voffB);
            PG8_BAR; PG8_WAIT_L(0); PG8_MMA(0, 1, At, B1); PG8_BAR;
            PG8_LDA(At, 0, 1); PG8_STAGE(PG8_SA(0, 0), a2, voffA);
            PG8_BAR; PG8_WAIT_L(0); PG8_MMA(1, 0, At, B0); PG8_BAR; PG8_SCHED;
            PG8_STAGE(PG8_SB(0, 1), b2h, voffB);
            PG8_WAIT_V(6); PG8_BAR; PG8_MMA(1, 1, At, B1); PG8_BAR;
            PG8_LDB(B0, 1, 0); PG8_SCHED; PG8_LDA(At, 1, 0); PG8_STAGE(PG8_SA(0, 1), a2 + hstep, voffA);
            PG8_WAIT_L(8); PG8_BAR; PG8_WAIT_L(0); PG8_MMA(0, 0, At, B0); PG8_BAR; PG8_SCHED;
            PG8_LDB(B1, 1, 1); PG8_STAGE(PG8_SB(1, 0), b3, voffB);
            PG8_BAR; PG8_WAIT_L(0); PG8_MMA(0, 1, At, B1); PG8_BAR;
            PG8_LDA(At, 1, 1); PG8_STAGE(PG8_SA(1, 0), a3, voffA);
            PG8_BAR; PG8_WAIT_L(0); PG8_MMA(1, 0, At, B0); PG8_BAR; PG8_SCHED;
            PG8_STAGE(PG8_SB(1, 1), b3h, voffB);
            PG8_WAIT_V(6); PG8_BAR; PG8_MMA(1, 1, At, B1); PG8_BAR;
        }
        E(acc, cur, wr, wc, fr, fq);
        if (!has_next) break;
        if (Epi::zero_after(cur))
#pragma unroll
        for (int a = 0; a < 2; ++a)
#pragma unroll
            for (int b = 0; b < 2; ++b)
#pragma unroll
                for (int m = 0; m < 4; ++m)
#pragma unroll
                    for (int n = 0; n < 2; ++n) acc[a][b][m][n] = (f32x4){0.f, 0.f, 0.f, 0.f};
        cur = nxt; cA = nA; cB = nB; cBh = nBh; ++ui;
    }
    PG8_WAIT_V(0);
    if (wr == 0) PG8_BAR;
    PG8_BAR;
#undef PG8_SA
#undef PG8_SB
#undef PG8_STAGE
#undef PG8_LDA
#undef PG8_LDB
#undef PG8_MMA
#undef PG8_WAIT_V
#undef PG8_WAIT_L
#undef PG8_BAR
#undef PG8_SCHED
}
template <int RB, class Epi, class Sched>
__device__ __forceinline__ void gemm_phase_f8(int wid0, LAS unsigned char* lds, const Gemm g, const Sched& S, const Epi& E) {
    const int tid = otid(wid0), wid = __builtin_amdgcn_readfirstlane(tid >> 6), lane = tid & 63, wr = wid >> 2, wc = wid & 3, fr = lane & 15, fq = lane >> 4;
    constexpr int nt = RB / 128;
    constexpr int K = RB / 2;
    constexpr size_t B_BR = 0;
    unsigned voffA[2], voffB[2]; int aoff, boff;
    constexpr size_t kstep = (size_t)(BK * 2);
    constexpr size_t hstep = (size_t)HALF * K * 2;
    constexpr size_t tstep = 2 * hstep;
    const unsigned ldsw = (unsigned)wid * 1024u;
#define PG8_SETUP() do { const int t_ = otid(wid0), l_ = t_ & 63, fr_ = l_ & 15, fq_ = l_ >> 4; \
        _Pragma("unroll") for (int i = 0; i < 2; ++i) { int R, C; stage_rc(t_ * 16 + i * 8192, R, C); const int Rb = Epi::PERM ? ((R & ~31) + perm32(R & 31)) : R; \
            voffA[i] = (unsigned)(R * K + C) * 2u; voffB[i] = (unsigned)(Rb * K + C) * 2u; } \
        aoff = lds_byte(wr * 64 + fr_, fq_ * 16); boff = lds_byte(wc * 32 + fr_, fq_ * 16); } while (0)
    PG8_SETUP();
#define PG8_SA(b, h) (((b) * 2 + (h)) * HTB)
#define PG8_SB(b, h) ((4 + (b) * 2 + (h)) * HTB)
#define PG8_STAGE(bufoff, gbase, voff) do { _Pragma("unroll") for (int _i = 0; _i < 2; ++_i) \
        __builtin_amdgcn_global_load_lds((const unsigned*)((const char*)(gbase) + (voff)[_i]), (LAS unsigned*)(lds + (bufoff) + ldsw + _i * 8192), 16, 0, 0); } while (0)
#define PG8_LDA(dst, b, h) do { _Pragma("unroll") for (int m = 0; m < 4; ++m) dst[m] = *(const LAS i32x8*)(lds + PG8_SA(b, h) + aoff + m * 2048); } while (0)
#define PG8_LDB(dst, b, h) do { _Pragma("unroll") for (int n = 0; n < 2; ++n) dst[n] = *(const LAS i32x8*)(lds + PG8_SB(b, h) + boff + n * 2048); } while (0)
#define PG8_MMA(ai, bj, At, Bt) do { __builtin_amdgcn_s_setprio(1); _Pragma("unroll") for (int m = 0; m < 4; ++m) _Pragma("unroll") for (int n = 0; n < 2; ++n) \
        acc[ai][bj][m][n] = __builtin_amdgcn_mfma_scale_f32_16x16x128_f8f6f4(Bt[n], At[m], acc[ai][bj][m][n], 0, 0, 0, 122, 0, 127); __builtin_amdgcn_s_setprio(0); } while (0)
#define PG8_WAIT_V(n) asm volatile("s_waitcnt vmcnt(" #n ")" ::: "memory")
#define PG8_WAIT_L(n) asm volatile("s_waitcnt lgkmcnt(" #n ")" ::: "memory")
#define PG8_BAR __builtin_amdgcn_s_barrier()
#define PG8_SCHED __builtin_amdgcn_sched_barrier(0)
    Unit cur, nxt; int ui = 0;
    if (!S.next(0, cur)) return;
    f32x4 acc[2][2][4][2];
#pragma unroll
    for (int a = 0; a < 2; ++a)
#pragma unroll
        for (int b = 0; b < 2; ++b)
#pragma unroll
            for (int m = 0; m < 4; ++m)
#pragma unroll
                for (int n = 0; n < 2; ++n) acc[a][b][m][n] = (f32x4){0.f, 0.f, 0.f, 0.f};
    i32x8 At[4], B0[2], B1[2];
    const char* cA = (const char*)g.A + (size_t)cur.pm * tstep + S.aoff(cur); int rb0, rb1; S.brow(cur, rb0, rb1);
    const char* cB = (const char*)g.Bt + (size_t)rb0 * (K * 2) + (size_t)cur.br * B_BR; const char* cBh = (const char*)g.Bt + (size_t)rb1 * (K * 2) + (size_t)cur.br * B_BR;
    PG8_STAGE(PG8_SB(0, 0), cB, voffB); PG8_STAGE(PG8_SA(0, 0), cA, voffA); PG8_STAGE(PG8_SB(0, 1), cBh, voffB); PG8_STAGE(PG8_SA(0, 1), cA + hstep, voffA);
    if (wr == 1) PG8_BAR;
    PG8_WAIT_V(4); PG8_BAR;
    PG8_STAGE(PG8_SB(1, 0), cB + kstep, voffB); PG8_STAGE(PG8_SA(1, 0), cA + kstep, voffA); PG8_STAGE(PG8_SB(1, 1), cBh + kstep, voffB);
    PG8_WAIT_V(6); PG8_BAR;
    for (;;) {
        const bool has_next = S.next(ui + 1, nxt);
        const char* nA = has_next ? (const char*)g.A + (size_t)nxt.pm * tstep + S.aoff(nxt) : cA; int rn0 = 0, rn1 = 0; if (has_next) S.brow(nxt, rn0, rn1);
        const char* nB = has_next ? (const char*)g.Bt + (size_t)rn0 * (K * 2) + (size_t)nxt.br * B_BR : cB; const char* nBh = has_next ? (const char*)g.Bt + (size_t)rn1 * (K * 2) + (size_t)nxt.br * B_BR : cBh;
        for (int t = 0; t < nt; t += 2) {
            const bool last = (t == nt - 2);
            const char* a1 = cA + (size_t)(t + 1) * kstep;
            const char* a2 = last ? nA : cA + (size_t)(t + 2) * kstep; const char* b2 = last ? nB : cB + (size_t)(t + 2) * kstep; const char* b2h = last ? nBh : cBh + (size_t)(t + 2) * kstep;
            const char* a3 = a2 + kstep; const char* b3 = b2 + kstep; const char* b3h = b2h + kstep;
            PG8_LDB(B0, 0, 0); PG8_SCHED; PG8_LDA(At, 0, 0); PG8_STAGE(PG8_SA(1, 1), a1 + hstep, voffA);
            PG8_WAIT_L(8); PG8_BAR; PG8_WAIT_L(0); PG8_MMA(0, 0, At, B0); PG8_BAR; PG8_SCHED;
            PG8_LDB(B1, 0, 1); PG8_STAGE(PG8_SB(0, 0), b2, voffB);
            PG8_BAR; PG8_WAIT_L(0); PG8_MMA(0, 1, At, B1); PG8_BAR;
            PG8_LDA(At, 0, 1); PG8_STAGE(PG8_SA(0, 0), a2, voffA);
            PG8_BAR; PG8_WAIT_L(0); PG8_MMA(1, 0, At, B0); PG8_BAR; PG8_SCHED;
            PG8_STAGE(PG8_SB(0, 1), b2h, voffB);
            PG8_WAIT_V(6); PG8_BAR; PG8_MMA(1, 1, At, B1); PG8_BAR;
            PG8_LDB(B0, 1, 0); PG8_SCHED; PG8_LDA(At, 1, 0); PG8_STAGE(PG8_SA(0, 1), a2 + hstep, voffA);
            PG8_WAIT_L(8); PG8_BAR; PG8_WAIT_L(0); PG8_MMA(0, 0, At, B0); PG8_BAR; PG8_SCHED;
            PG8_LDB(B1, 1, 1); PG8_STAGE(PG8_SB(1, 0), b3, voffB);
            PG8_BAR; PG8_WAIT_L(0); PG8_MMA(0, 1, At, B1); PG8_BAR;
            PG8_LDA(At, 1, 1); PG8_STAGE(PG8_SA(1, 0), a3, voffA);
            PG8_BAR; PG8_WAIT_L(0); PG8_MMA(1, 0, At, B0); PG8_BAR; PG8_SCHED;
            PG8_STAGE(PG8_SB(1, 1), b3h, voffB);
            PG8_WAIT_V(6); PG8_BAR; PG8_MMA(1, 1, At, B1); PG8_BAR;
        }
        { const int t2_ = otid(wid0) & 63; E(acc, cur, wr, wc, t2_ & 15, t2_ >> 4); }
        if (!has_next) break;
        if (Epi::zero_after(cur))
#pragma unroll
        for (int a = 0; a < 2; ++a)
#pragma unroll
            for (int b = 0; b < 2; ++b)
#pragma unroll
                for (int m = 0; m < 4; ++m)
#pragma unroll
                    for (int n = 0; n < 2; ++n) acc[a][b][m][n] = (f32x4){0.f, 0.f, 0.f, 0.f};
        cur = nxt; cA = nA; cB = nB; cBh = nBh; ++ui;
        PG8_SETUP();
    }
    PG8_WAIT_V(0);
    if (wr == 0) PG8_BAR;
    PG8_BAR;
#undef PG8_SETUP
#undef PG8_SA
#undef PG8_SB
#undef PG8_STAGE
#undef PG8_LDA
#undef PG8_LDB
#undef PG8_MMA
#undef PG8_WAIT_V
#undef PG8_WAIT_L
#undef PG8_BAR
#undef PG8_SCHED
}
}

__device__ void phase_norm_bf16(int wid0, const float* __restrict__ xin, const bf16_t* __restrict__ xin16, const float* __restrict__ g, bf16_t* __restrict__ h, unsigned char* __restrict__ h8, int rows);
struct TJob { const float* src; bf16_t* dst; unsigned char* dst8; int R, C, tr, tc; float scale; };
__device__ __forceinline__ TJob prep_job(const Params& p, int i) {
    bf16_t* win = (bf16_t*)(p.ws + p.o_win); bf16_t* wb = (bf16_t*)(p.ws + p.o_wb); bf16_t* wo = (bf16_t*)(p.ws + p.o_wo); bf16_t* pw = (bf16_t*)(p.ws + p.o_pw);
    constexpr int T_WIN = 16 * 160, T_WB = 8 * 16, T_WO = 16 * 16, T_PW = 4;
    constexpr int N0 = DEPTH * T_WIN, N1 = N0 + 8 * T_WB, N2 = N1 + DEPTH * T_WO;
    TJob j; j.scale = 1.0f; j.dst8 = nullptr;
    if (i < N0) { const int l = i / T_WIN, t = i % T_WIN; j.src = p.in[2] + (size_t)l * DM * INC; j.dst = win + (size_t)l * DM * WINR; j.R = DM; j.C = INC; j.tr = t / 160; j.tc = t % 160;
        const int piece = j.tc >> 3; j.scale = (piece >= 12 || piece == 3 || piece == 7 || piece == 11) ? -1.4426950408889634f : (piece == 5 || piece == 8) ? -0.6931471805599453f : 1.0f;
        if (piece >= 12) { j.dst = nullptr; j.dst8 = p.ws + p.o_wg8 + (size_t)l * 4096 * DM + (size_t)(j.tc - 96) * 64 * DM; j.scale *= 32.0f; } }
    else if (i < N1) { const int k = i - N0, m = k / T_WB, t = k % T_WB; j.src = p.in[14] + (size_t)m * BWID * DM; j.dst = wb + (size_t)m * BWID * DM; j.R = BWID; j.C = DM; j.tr = t / 16; j.tc = t % 16; }
    else if (i < N2) { const int k = i - N1, l = k / T_WO, t = k % T_WO; j.src = p.in[15] + (size_t)l * DM * DM; j.dst = wo + (size_t)l * DM * DM; j.R = DM; j.C = DM; j.tr = t / 16; j.tc = t % 16; }
    else { const int k = i - N2, m = k / T_PW, t = k % T_PW; j.src = p.in[3] + (size_t)m * 128 * 128; j.dst = pw + (size_t)m * 128 * 128; j.R = 128; j.C = 128; j.tr = t / 2; j.tc = t % 2; }
    return j;
}
__device__ void phase_prep(int wid0, const Params& p, LAS unsigned char* lds) {
    LAS float* sm = (LAS float*)lds;
    const int tid = otid(wid0);
    constexpr int NT = DEPTH * 16 * 160 + 8 * 8 * 16 + DEPTH * 16 * 16 + 8 * 4;
    const int lr = tid >> 4, lc = (tid & 15) * 4;
    f32x4 v0, v1;
    int i = blockIdx.x;
    if (i < NT) { const TJob j = prep_job(p, i); const float* sp = j.src + (size_t)(j.tr * 64 + lr) * j.C + j.tc * 64 + lc; v0 = *(const f32x4*)sp; v1 = *(const f32x4*)(sp + (size_t)32 * j.C); }
    for (; i < NT; i += gridDim.x) {
        const TJob j = prep_job(p, i);
#pragma unroll
        for (int e = 0; e < 4; ++e) { sm[lr * 65 + lc + e] = v0[e]; sm[(lr + 32) * 65 + lc + e] = v1[e]; }
        __syncthreads();
        const int in = i + gridDim.x;
        if (in < NT) { const TJob jn = prep_job(p, in); const float* sp = jn.src + (size_t)(jn.tr * 64 + lr) * jn.C + jn.tc * 64 + lc; v0 = *(const f32x4*)sp; v1 = *(const f32x4*)(sp + (size_t)32 * jn.C); }
        { const int c = tid >> 3, r8 = (tid & 7) * 8; float o[8];
#pragma unroll
          for (int e = 0; e < 8; ++e) o[e] = sm[(r8 + e) * 65 + c] * j.scale;
          if (j.dst8) { unsigned w0 = 0u, w1 = 0u; w0 = __builtin_amdgcn_cvt_pk_fp8_f32(o[0], o[1], w0, false); w0 = __builtin_amdgcn_cvt_pk_fp8_f32(o[2], o[3], w0, true); w1 = __builtin_amdgcn_cvt_pk_fp8_f32(o[4], o[5], w1, false); w1 = __builtin_amdgcn_cvt_pk_fp8_f32(o[6], o[7], w1, true);
              *(u32x2*)(j.dst8 + (size_t)c * DM + j.tr * 64 + r8) = (u32x2){w0, w1}; }
          else *(u32x4*)(j.dst + (size_t)(j.tc * 64 + c) * j.R + j.tr * 64 + r8) = pack8(o); }
        __syncthreads();
    }
    const float* sgw = p.in[11]; bf16_t* sw = (bf16_t*)(p.ws + p.o_sw);
    for (int k = blockIdx.x * 512 + tid; k < DEPTH * 4 * 128 * 128; k += gridDim.x * 512) { const int s_ = k & 127, t = (k >> 7) & 127; sw[k] = (s_ <= t) ? f2bf(sgw[k]) : (bf16_t)0; }
    {
        float* sd = (float*)(p.ws + p.o_small); const int gt = blockIdx.x * 512 + tid, gs = gridDim.x * 512;
#define CPY(K, OFF, N) for (int k = gt; k < (N); k += gs) sd[(OFF) + k] = p.in[K][k];
        CPY(1, SM1, 2048) CPY(4, SM4, 1024) CPY(5, SM5, 31744) CPY(6, SM6, 1024) CPY(7, SM7, 1024) CPY(8, SM8, 1024) CPY(9, SM9, 1024) CPY(10, SM10, 1024) CPY(12, SM12, 1024) CPY(13, SM13, 3072) CPY(16, SM16, 1024)
#undef CPY
    }
    phase_norm_bf16(wid0, p.in[0], nullptr, p.in[1], (bf16_t*)(p.ws + p.o_h), p.ws + p.o_h8, NTOK);
}

__device__ void phase_norm_bf16(int wid0, const float* __restrict__ xin, const bf16_t* __restrict__ xin16, const float* __restrict__ g, bf16_t* __restrict__ h, unsigned char* __restrict__ h8, int rows) {
    const int tid = otid(wid0), lane = tid & 63, w = tid >> 6;
    float gv[2][8];
    load8f(g + 8 * lane, gv[0]); load8f(g + 512 + 8 * lane, gv[1]);
    for (int row = blockIdx.x * 8 + w; row < rows; row += gridDim.x * 8) {
        float v[2][8];
        if (xin16) { const bf16_t* xr = xin16 + (size_t)row * DM + 8 * lane; unpack8(*(const u32x4*)xr, v[0]); unpack8(*(const u32x4*)(xr + 512), v[1]); }
        else { const float* xr = xin + (size_t)row * DM + 8 * lane; load8f(xr, v[0]); load8f(xr + 512, v[1]); }
        float ss = 0.f;
#pragma unroll
        for (int i = 0; i < 2; ++i)
#pragma unroll
            for (int j = 0; j < 8; ++j) ss += v[i][j] * v[i][j];
        ss = wave_sum(wid0, ss);
        const float r = rsqrtf(ss * (1.0f / 1024.0f) + 1e-6f);
#pragma unroll
        for (int i = 0; i < 2; ++i) { float o[8];
#pragma unroll
            for (int j = 0; j < 8; ++j) o[j] = v[i][j] * r * gv[i][j];
            *(u32x4*)(h + (size_t)row * DM + 512 * i + 8 * lane) = pack8(o);
            unsigned w0 = 0u, w1 = 0u; w0 = __builtin_amdgcn_cvt_pk_fp8_f32(o[0], o[1], w0, false); w0 = __builtin_amdgcn_cvt_pk_fp8_f32(o[2], o[3], w0, true); w1 = __builtin_amdgcn_cvt_pk_fp8_f32(o[4], o[5], w1, false); w1 = __builtin_amdgcn_cvt_pk_fp8_f32(o[6], o[7], w1, true);
            *(u32x2*)(h8 + (size_t)row * DM + 512 * i + 8 * lane) = (u32x2){w0, w1}; }
    }
}
__device__ void phase_norm_final(int wid0, const bf16_t* __restrict__ x, float* __restrict__ out, const float* __restrict__ g, int rows) {
    const int tid = otid(wid0), lane = tid & 63, w = tid >> 6;
    float gv[2][8];
    load8f(g + 8 * lane, gv[0]); load8f(g + 512 + 8 * lane, gv[1]);
    for (int row = blockIdx.x * 8 + w; row < rows; row += gridDim.x * 8) {
        const bf16_t* xr = x + (size_t)row * DM + 8 * lane; float* orow = out + (size_t)row * DM + 8 * lane;
        float v[2][8]; unpack8(*(const u32x4*)xr, v[0]); unpack8(*(const u32x4*)(xr + 512), v[1]);
        float ss = 0.f;
#pragma unroll
        for (int i = 0; i < 2; ++i)
#pragma unroll
            for (int j = 0; j < 8; ++j) ss += v[i][j] * v[i][j];
        ss = wave_sum(wid0, ss);
        const float r = rsqrtf(ss * (1.0f / 1024.0f) + 1e-6f);
#pragma unroll
        for (int i = 0; i < 2; ++i) {
            f32x4 a, b;
#pragma unroll
            for (int j = 0; j < 4; ++j) { a[j] = v[i][j] * r * gv[i][j]; b[j] = v[i][4 + j] * r * gv[i][4 + j]; }
            *(f32x4*)(orow + 512 * i) = a; *(f32x4*)(orow + 512 * i + 4) = b; }
    }
}

#define PO(k) ((size_t)(k) * TS * BWID)
__device__ void mix_sc(int wid0, const Params& p, int l, const bf16_t* proj, bf16_t* z3, int r0, int pos0) {
    const int tid = otid(wid0), lane = tid & 63, w = tid >> 6, c0 = lane * 8;
    const float* scw = SMALLP(p, SM13) + (size_t)l * 3 * BWID + c0;
    float w0[8], w1[8], w2[8]; load8f(scw, w0); load8f(scw + BWID, w1); load8f(scw + 2 * BWID, w2);
    const int r = r0 + 16 * w, pos = pos0 + 16 * w;
    const bf16_t* bgp = proj + PO(6) + c0; const bf16_t* cxp = proj + PO(7) + c0;
    u32x4 vb[16], vc[18];
    vc[0] = (u32x4){0u, 0u, 0u, 0u}; vc[1] = vc[0];
    if (pos > 0) { vc[0] = *(const u32x4*)(cxp + (size_t)(r - 2) * BWID); vc[1] = *(const u32x4*)(cxp + (size_t)(r - 1) * BWID); }
#pragma unroll
    for (int jj = 0; jj < 16; ++jj) { vb[jj] = *(const u32x4*)(bgp + (size_t)(r + jj) * BWID); vc[2 + jj] = *(const u32x4*)(cxp + (size_t)(r + jj) * BWID); }
    float p2[8], p1[8];
    unpack8(vc[0], p2); unpack8(vc[1], p1);
#pragma unroll
    for (int jj = 0; jj < 16; ++jj) {
        float b[8], cur[8], o[8]; unpack8(vb[jj], b); unpack8(vc[2 + jj], cur);
#pragma unroll
        for (int j = 0; j < 8; ++j) { o[j] = b[j] * (w0[j] * p2[j] + w1[j] * p1[j] + w2[j] * cur[j]); p2[j] = p1[j]; p1[j] = cur[j]; }
        *(u32x4*)(z3 + (size_t)(r + jj) * BWID + c0) = pack8(o);
    }
}

__device__ void mix_conv(int wid0, const Params& p, int l, const bf16_t* proj, bf16_t* z1, int r0, int pos0, LAS unsigned char* lds) {
    const int tid = otid(wid0), lane = tid & 63, w = tid >> 6, c0 = lane * 8;
    LAS unsigned char* Y = lds; LAS unsigned char* W = lds + 94 * VP;
    const float* cw = SMALLP(p, SM5) + (size_t)l * 31 * BWID;
    float bias[8], lng[8], lnb[8];
    load8f(SMALLP(p, SM6) + (size_t)l * BWID + c0, bias); load8f(SMALLP(p, SM7) + (size_t)l * BWID + c0, lng); load8f(SMALLP(p, SM8) + (size_t)l * BWID + c0, lnb);
    u32x4 la[12];
#define CONV_LOAD(q) do { _Pragma("unroll") for (int i = 0; i < 12; ++i) { const int row = 12 * w + i; const bool valid = (row < 94) && (pos0 + 64 * (q) - 30 + row >= 0); \
        la[i] = (u32x4){0u, 0u, 0u, 0u}; if (valid) la[i] = *(const u32x4*)(proj + (size_t)(r0 + 64 * (q) - 30 + row) * BWID + PO(2) + c0); } } while (0)
    CONV_LOAD(0);
    for (int i = tid; i < 31 * 64; i += 512) { const int k = i >> 6, cgp = i & 63; float f[8]; load8f(cw + k * BWID + cgp * 8, f); *(LAS u32x4*)(W + k * 1024 + cgp * 16) = pack8(f); }
#pragma unroll
    for (int q = 0; q < 2; ++q) {
        const int tr = r0 + 64 * q;
        __syncthreads();
#pragma unroll
        for (int i = 0; i < 12; ++i) { const int row = 12 * w + i; if (row < 94) *(LAS u32x4*)(Y + row * VP + lane * 16) = la[i]; }
        __syncthreads();
        if (q == 0) CONV_LOAD(1);
        u32x4 gtv[8];
#pragma unroll
        for (int j = 0; j < 8; ++j) gtv[j] = *(const u32x4*)(proj + (size_t)(tr + 8 * w + j) * BWID + PO(3) + c0);
        float acc[8][8];
#pragma unroll
        for (int j = 0; j < 8; ++j)
#pragma unroll
            for (int c = 0; c < 8; ++c) acc[j][c] = bias[c];
#pragma unroll 1
        for (int k = 0; k < 31; ++k) {
            float wv[8]; unpack8(*(const LAS u32x4*)(W + k * 1024 + lane * 16), wv);
#pragma unroll
            for (int j = 0; j < 8; ++j) { float yv[8]; unpack8(*(const LAS u32x4*)(Y + (8 * w + j + k) * VP + lane * 16), yv);
#pragma unroll
                for (int c = 0; c < 8; ++c) acc[j][c] += wv[c] * yv[c]; }
        }
#pragma unroll
        for (int j = 0; j < 8; ++j) {
            float s = 0.f, ss = 0.f;
#pragma unroll
            for (int c = 0; c < 8; ++c) { s += acc[j][c]; ss += acc[j][c] * acc[j][c]; }
            s = wave_sum(wid0, s); ss = wave_sum(wid0, ss);
            const float mean = s * (1.0f / 512.0f); const float var = fmaxf(ss * (1.0f / 512.0f) - mean * mean, 0.f); const float rstd = rsqrtf(var + 1e-5f);
            const int row = tr + 8 * w + j;
            float gt[8], o[8]; unpack8(gtv[j], gt);
#pragma unroll
            for (int c = 0; c < 8; ++c) { const float v = (acc[j][c] - mean) * rstd * lng[c] + lnb[c]; o[c] = silu(v) * silu(gt[c]); }
            *(u32x4*)(z1 + (size_t)row * BWID + c0) = pack8(o);
        }
    }
}

#undef CONV_LOAD
__device__ __forceinline__ u32x4 sel4(bool c, const u32x4 a, const u32x4 b) { u32x4 r; r.x = c ? a.x : b.x; r.y = c ? a.y : b.y; r.z = c ? a.z : b.z; r.w = c ? a.w : b.w; return r; }

__device__ void mix_pool(int wid0, const Params& p, int l, const bf16_t* proj, bf16_t* z0, int r0, int pos0, LAS unsigned char* lds) {
    const int tid = otid(wid0), lane = tid & 63, w = tid >> 6, c0 = lane * 8;
    LAS unsigned char* P = lds;
    {
        const int g4 = lane >> 4, win = 2 << g4;
        const int r = r0 + 16 * w, pos = pos0 + 16 * w;
        u32x4 R[32];
#pragma unroll
        for (int i = 0; i < 16; ++i) { R[i] = (u32x4){0u, 0u, 0u, 0u}; if (pos > 0) R[i] = *(const u32x4*)(proj + (size_t)(r - 16 + i) * BWID + c0); }
#pragma unroll
        for (int i = 0; i < 16; ++i) R[16 + i] = *(const u32x4*)(proj + (size_t)(r + i) * BWID + c0);
        float S[8];
#pragma unroll
        for (int j = 0; j < 8; ++j) S[j] = 0.f;
#pragma unroll
        for (int i = 1; i <= 16; ++i) { float x[8]; unpack8(R[16 - i], x); const float mk = (i <= win) ? 1.0f : 0.0f;
#pragma unroll
            for (int j = 0; j < 8; ++j) S[j] += mk * x[j]; }
#pragma unroll
        for (int jj = 0; jj < 16; ++jj) {
            const int ps = pos + jj; float xv[8], xo[8], o[8];
            unpack8(R[16 + jj], xv);
            const u32x4 ro = sel4(g4 < 2, sel4(g4 == 0, R[16 + jj - 2], R[16 + jj - 4]), sel4(g4 == 2, R[16 + jj - 8], R[jj]));
            unpack8(ro, xo);
            const int cnt = (ps + 1 < win) ? ps + 1 : win; const float inv = 1.0f / (float)cnt;
#pragma unroll
            for (int j = 0; j < 8; ++j) { S[j] += xv[j] - xo[j]; o[j] = S[j] * inv - xv[j]; }
            *(LAS u32x4*)(P + (16 * w + jj) * VP + lane * 16) = pack8(o);
        }
    }
    __syncthreads();
    {
        const int g = w >> 1, fr = lane & 15, fq = lane >> 4;
        const bf16_t* pwT = (const bf16_t*)(p.ws + p.o_pw) + (size_t)(l * 4 + g) * 128 * 128;
        u32x2 gtv[8][4];
#pragma unroll
        for (int tt = 0; tt < 8; ++tt)
#pragma unroll
            for (int dt = 0; dt < 4; ++dt) gtv[tt][dt] = *(const u32x2*)(proj + (size_t)(r0 + 16 * tt + fr) * BWID + PO(1) + 64 * w + 16 * dt + 4 * fq);
        bf16x8 A[4][4];
#pragma unroll
        for (int dt = 0; dt < 4; ++dt)
#pragma unroll
            for (int kk = 0; kk < 4; ++kk) A[dt][kk] = *(const bf16x8*)(pwT + (size_t)(64 * (w & 1) + 16 * dt + fr) * 128 + 32 * kk + 8 * fq);
        const float* psc = SMALLP(p, SM4) + (size_t)l * BWID;
        f32x4 sc[4];
#pragma unroll
        for (int dt = 0; dt < 4; ++dt) sc[dt] = *(const f32x4*)(psc + 64 * w + 16 * dt + 4 * fq);
#pragma unroll
        for (int tt = 0; tt < 8; ++tt) {
            bf16x8 Bf[4];
#pragma unroll
            for (int kk = 0; kk < 4; ++kk) Bf[kk] = *(const LAS bf16x8*)(P + (16 * tt + fr) * VP + (128 * g + 32 * kk + 8 * fq) * 2);
            f32x4 acc[4];
#pragma unroll
            for (int dt = 0; dt < 4; ++dt) { acc[dt] = (f32x4){0.f, 0.f, 0.f, 0.f};
#pragma unroll
                for (int kk = 0; kk < 4; ++kk) acc[dt] = __builtin_amdgcn_mfma_f32_16x16x32_bf16(A[dt][kk], Bf[kk], acc[dt], 0, 0, 0); }
            const int row = r0 + 16 * tt + fr;
#pragma unroll
            for (int dt = 0; dt < 4; ++dt) { const int d = 64 * w + 16 * dt + 4 * fq;
                float gt[4]; unpack4(gtv[tt][dt], gt);
                u32x2 o; o.x = cvt_pk_bf16(acc[dt][0] * sc[dt][0] * silu(gt[0]), acc[dt][1] * sc[dt][1] * silu(gt[1])); o.y = cvt_pk_bf16(acc[dt][2] * sc[dt][2] * silu(gt[2]), acc[dt][3] * sc[dt][3] * silu(gt[3]));
                *(u32x2*)(z0 + (size_t)row * BWID + d) = o; }
        }
    }
}

__device__ void mix_sgu(int wid0, const Params& p, int l, const bf16_t* proj, bf16_t* z2, int r0, LAS unsigned char* lds) {
    const int tid = otid(wid0), lane = tid & 63, w = tid >> 6, c0 = lane * 8;
    LAS unsigned char* V = lds;
    {
        float lng[8], lnb[8]; load8f(SMALLP(p, SM9) + (size_t)l * BWID + c0, lng); load8f(SMALLP(p, SM10) + (size_t)l * BWID + c0, lnb);
        u32x4 R[16];
#pragma unroll
        for (int jj = 0; jj < 16; ++jj) R[jj] = *(const u32x4*)(proj + (size_t)(r0 + 16 * w + jj) * BWID + PO(5) + c0);
#pragma unroll
        for (int jj = 0; jj < 16; ++jj) {
            float x[8], o[8]; unpack8(R[jj], x);
            float s = 0.f, ss = 0.f;
#pragma unroll
            for (int c = 0; c < 8; ++c) { s += x[c]; ss += x[c] * x[c]; }
            s = wave_sum(wid0, s); ss = wave_sum(wid0, ss);
            const float mean = s * (1.0f / 512.0f); const float var = fmaxf(ss * (1.0f / 512.0f) - mean * mean, 0.f); const float rstd = rsqrtf(var + 1e-5f);
#pragma unroll
            for (int c = 0; c < 8; ++c) o[c] = (x[c] - mean) * rstd * lng[c] + lnb[c];
            *(LAS u32x4*)(V + (16 * w + jj) * VP + lane * 16) = pack8(o);
        }
    }
    __syncthreads();
    {
        const int g = w >> 1, fr = lane & 15, fq = lane >> 4;
        const unsigned vbase = (unsigned)(size_t)V;
        bf16x8 A[4][4];
#pragma unroll
        for (int ct = 0; ct < 4; ++ct)
#pragma unroll
            for (int kk = 0; kk < 4; ++kk) {
                const unsigned a = vbase + (unsigned)((32 * kk + 8 * fq + (fr >> 2)) * VP + (64 * w + 16 * ct + 4 * (fr & 3)) * 2);
                const u32x2 lo = tr_read(a), hi = tr_read(a + 4 * VP);
                u32x4 t; t.x = lo.x; t.y = lo.y; t.z = hi.x; t.w = hi.y;
                A[ct][kk] = __builtin_bit_cast(bf16x8, t);
            }
        const bf16_t* swm = (const bf16_t*)(p.ws + p.o_sw) + (size_t)(l * 4 + g) * 128 * 128;
        const float* sb = SMALLP(p, SM12) + (size_t)(l * 4 + g) * 128;
#pragma unroll
        for (int hb = 0; hb < 2; ++hb) {
            u32x2 uu[4][4]; bf16x8 Wf[4][4]; float bias[4];
#pragma unroll
            for (int t4 = 0; t4 < 4; ++t4) { const int tt = hb * 4 + t4; const bf16_t* pr = proj + (size_t)(r0 + 16 * tt + fr) * BWID + 64 * w + 4 * fq;
#pragma unroll
                for (int ct = 0; ct < 4; ++ct) uu[t4][ct] = *(const u32x2*)(pr + PO(4) + 16 * ct);
#pragma unroll
                for (int kk = 0; kk < 4; ++kk) if (kk < (tt >> 1) + 1) Wf[t4][kk] = *(const bf16x8*)(swm + (size_t)(16 * tt + fr) * 128 + 32 * kk + 8 * fq);
                bias[t4] = sb[16 * tt + fr]; }
#pragma unroll
            for (int t4 = 0; t4 < 4; ++t4) { const int tt = hb * 4 + t4;
                f32x4 acc[4];
#pragma unroll
                for (int ct = 0; ct < 4; ++ct) acc[ct] = (f32x4){0.f, 0.f, 0.f, 0.f};
#pragma unroll
                for (int kk = 0; kk < 4; ++kk) if (kk < (tt >> 1) + 1) {
#pragma unroll
                    for (int ct = 0; ct < 4; ++ct) acc[ct] = __builtin_amdgcn_mfma_f32_16x16x32_bf16(A[ct][kk], Wf[t4][kk], acc[ct], 0, 0, 0); }
                const int row = r0 + 16 * tt + fr;
#pragma unroll
                for (int ct = 0; ct < 4; ++ct) { const int c = 64 * w + 16 * ct + 4 * fq;
                    float u[4]; unpack4(uu[t4][ct], u);
                    u32x2 o; o.x = cvt_pk_bf16(u[0] * (acc[ct][0] + bias[t4]), u[1] * (acc[ct][1] + bias[t4])); o.y = cvt_pk_bf16(u[2] * (acc[ct][2] + bias[t4]), u[3] * (acc[ct][3] + bias[t4]));
                    *(u32x2*)(z2 + (size_t)row * BWID + c) = o; }
            }
        }
    }
}

__device__ void phase_mix(int wid0, const Params& p, int l, const bf16_t* proj, bf16_t* z, LAS unsigned char* lds) {
    constexpr int nchunk = TS / 128;
    for (int i = blockIdx.x; i < 4 * nchunk; i += gridDim.x) {
        const int j = i % nchunk, br = ((i / nchunk) + j) & 3, r0 = j * 128, pos0 = (j & 15) * 128;
        if (br == 0) for (int rr = 0; rr < REP_M0; ++rr) { mix_pool(wid0, p, l, proj, z + PO(1), r0, pos0, lds); __syncthreads(); }
        else if (br == 1) for (int rr = 0; rr < REP_M1; ++rr) { mix_conv(wid0, p, l, proj, z + PO(3), r0, pos0, lds); __syncthreads(); }
        else if (br == 2) for (int rr = 0; rr < REP_M2; ++rr) { mix_sgu(wid0, p, l, proj, z + PO(4), r0, lds); __syncthreads(); }
        else for (int rr = 0; rr < REP_M3; ++rr) { mix_sc(wid0, p, l, proj, z + PO(6), r0, pos0); __syncthreads(); }
    }
}

#define XB_TMO      128
#define XB_XCNT(j)  (256  + 64 * (j))
#define XB_XSUB(j)  (1280 + 64 * (j))
#define XB_XGEN(j)  (2304 + 64 * (j))
#define XB_TOP      3328
#define XB_TOPGEN   3392
#define XCD_BAR_WORDS 3456
#define XB_SPIN_CAP (1u << 20)
__device__ __forceinline__ unsigned xb_ld(unsigned* p)              { return __hip_atomic_load(p, __ATOMIC_RELAXED, __HIP_MEMORY_SCOPE_AGENT); }
__device__ __forceinline__ unsigned xb_add(unsigned* p, unsigned v) { return __hip_atomic_fetch_add(p, v, __ATOMIC_RELAXED, __HIP_MEMORY_SCOPE_AGENT); }
__device__ __forceinline__ unsigned xb_xcc_id() { return (unsigned)__builtin_amdgcn_s_getreg((3 << 11) | 20) & 0xFu; }
#define XB_SPIN(cond, bar) do { unsigned _sp = 0; while (cond) { __builtin_amdgcn_s_sleep(1); \
    if ((++_sp & 255u) == 0u) { if (xb_ld(&(bar)[XB_TMO])) break; if (_sp > XB_SPIN_CAP) { atomicAdd(&(bar)[XB_TMO], 1u); break; } } } } while (0)
struct XcdBarrier { unsigned* bar; unsigned x; volatile LAS unsigned* st; };
__device__ __forceinline__ XcdBarrier xcd_barrier_post(bool first, unsigned* bar, volatile LAS unsigned* st) {
    XcdBarrier b; b.bar = bar; b.x = xb_xcc_id(); b.st = st;
    if (first) (void)xb_add(&bar[XB_XCNT(b.x)], 1u);
    return b;
}
__device__ __forceinline__ void xcd_barrier_complete(unsigned* bar, unsigned x, unsigned& nloc, unsigned& nx) {
    const unsigned G = gridDim.x * gridDim.y * gridDim.z;
    unsigned sum, cnt, mine, sp = 0u;
    for (;;) {
        sum = 0u; cnt = 0u; mine = 0u;
#pragma unroll
        for (unsigned j = 0; j < 16; ++j) { const unsigned c = xb_ld(&bar[XB_XCNT(j)]); sum += c; cnt += (c > 0u) ? 1u : 0u; mine = (j == x) ? c : mine; }
        if (sum == G) break;
        __builtin_amdgcn_s_sleep(1);
        if ((++sp & 255u) == 0u) { if (xb_ld(&bar[XB_TMO])) break; if (sp > XB_SPIN_CAP) { atomicAdd(&bar[XB_TMO], 1u); break; } }
    }
    nloc = mine > 0u ? mine : 1u; nx = cnt > 0u ? cnt : 1u;
}
__device__ __forceinline__ void xcd_barrier(int wid0, const XcdBarrier& b) {
    asm volatile("s_waitcnt vmcnt(0)" ::: "memory");
    __syncthreads();
    if (otid(wid0) == 0) {
        unsigned* bar = b.bar; asm volatile("" : "+s"(bar)); unsigned bx = b.x; asm volatile("" : "+s"(bx));
        __builtin_amdgcn_s_waitcnt(0);
        unsigned nloc = b.st[0], nx = b.st[1];
        if (nloc == 0u) { xcd_barrier_complete(bar, bx, nloc, nx); b.st[0] = nloc; b.st[1] = nx; }
        const unsigned old = xb_add(&bar[XB_XSUB(bx)], 1u);
        const unsigned gen = old / nloc;
        if (old + 1u == (gen + 1u) * nloc) {
            __builtin_amdgcn_fence(__ATOMIC_RELEASE, "agent");
            asm volatile("s_waitcnt vmcnt(0)" ::: "memory");
            const unsigned og = xb_add(&bar[XB_TOP], 1u);
            const unsigned tg = og / nx;
            if (og + 1u == (tg + 1u) * nx) xb_add(&bar[XB_TOPGEN], 1u);
            else XB_SPIN(xb_ld(&bar[XB_TOPGEN]) == tg, bar);
            __builtin_amdgcn_fence(__ATOMIC_ACQUIRE, "agent");
            xb_add(&bar[XB_XGEN(bx)], 1u);
            asm volatile("s_waitcnt vmcnt(0)" ::: "memory");
        } else {
            XB_SPIN(xb_ld(&bar[XB_XGEN(bx)]) == gen, bar);
            __builtin_amdgcn_fence(__ATOMIC_ACQUIRE, "agent");
            asm volatile("s_waitcnt vmcnt(0)" ::: "memory");
        }
    }
    __syncthreads();
}

__global__ void __launch_bounds__(512) mk_forward(Params p) {
    extern __shared__ __attribute__((aligned(16))) unsigned char lds_raw[];
    LAS unsigned char* lds = (LAS unsigned char*)lds_raw;
    cg::grid_group grid = cg::this_grid();
    volatile LAS unsigned* stw = (volatile LAS unsigned*)(lds + LDS_BYTES - 16);
    const int wid0 = __builtin_amdgcn_readfirstlane((int)(threadIdx.x >> 6));
    const bool first = (wid0 == 0 && lane_id() == 0);
    if (first) { stw[0] = 0u; stw[1] = 0u; }
    __syncthreads();
    const XcdBarrier xbar = xcd_barrier_post(first, (unsigned*)(p.ws + p.o_bar), stw);
#define PHASE_ON true
#ifndef XSYNC
#define XSYNC 0
#endif
#define PHASE_END do { if (p.ph_hi > 100000) grid.sync();   xcd_barrier(wid0, xbar); } while (0)
    constexpr int ts = TS;
    bf16_t* win = (bf16_t*)(p.ws + p.o_win); bf16_t* wb = (bf16_t*)(p.ws + p.o_wb); bf16_t* wo = (bf16_t*)(p.ws + p.o_wo);
    bf16_t* h0 = (bf16_t*)(p.ws + p.o_h); bf16_t* proj = (bf16_t*)(p.ws + p.o_proj);

    if (PHASE_ON) phase_prep(wid0, p, lds);
    PHASE_END;
#pragma unroll 1
    for (int l = 0; l < DEPTH; ++l) {
        bf16_t* x1b = (bf16_t*)p.out;
#pragma unroll 1
        for (int s = 0; s < NS; ++s) {
            const size_t tok0 = (size_t)s * ts;
            bf16_t* h = h0 + tok0 * DM; bf16_t* merged = h;
            if (l > 0) { if (PHASE_ON) phase_norm_bf16(wid0, nullptr, x1b + tok0 * DM, SMALLP(p, SM1) + (size_t)l * DM, h, p.ws + p.o_h8 + tok0 * DM, ts);
                PHASE_END; }
            if (PHASE_ON) {
                { pg8::Gemm g{h, win + (size_t)l * DM * WINR}; pg8::OrderA S; S.G = (int)gridDim.x; S.c = (int)blockIdx.x; pg8::EpiProj E{proj}; pg8::gemm_phase<DM, 0>(wid0, lds, g, S, E); }
                { pg8::Gemm g{(const bf16_t*)(p.ws + p.o_h8 + tok0 * DM), (const bf16_t*)(p.ws + p.o_wg8 + (size_t)l * 4096 * DM)}; pg8::Order<TS / 256, 4096 / 256, 1> S{(int)gridDim.x, (int)blockIdx.x};
                  pg8::EpiGateStore E{(unsigned char*)(proj + (size_t)8 * TS * BWID)}; pg8::gemm_phase_f8<DM>(wid0, lds, g, S, E); }
            }
            PHASE_END;
            if (PHASE_ON) phase_mix(wid0, p, l, proj, proj, lds);
            PHASE_END;
            if (PHASE_ON) for (int rep = 0; rep < REP_C; ++rep) { pg8::Gemm g{proj, wb + (size_t)l * 4 * BWID * DM}; pg8::OrderC S; S.G = (int)gridDim.x; S.c = (int)blockIdx.x;
                pg8::EpiGate E{proj + (size_t)8 * TS * BWID, merged}; pg8::gemm_phase<BWID, (size_t)BWID * DM * 2>(wid0, lds, g, S, E); }
            PHASE_END;
            if (PHASE_ON) { pg8::Gemm g{merged, wo + (size_t)l * DM * DM}; pg8::Order<TS / 256, DM / 256, 1> S{(int)gridDim.x, (int)blockIdx.x};
                pg8::EpiRes E{(l == 0) ? p.in[0] + tok0 * DM : nullptr, (l == 0) ? nullptr : x1b + tok0 * DM, (l == 0) ? x1b + tok0 * DM : proj + tok0 * DM}; pg8::gemm_phase<DM, 0>(wid0, lds, g, S, E); }
            PHASE_END;
        }
    }
    phase_norm_final(wid0, proj, p.out, SMALLP(p, SM16), NTOK);
}

extern "C" void kernel_launch(void* const* d_in, const int* in_sizes, int n_in, void* d_out, int out_size, void* d_ws, size_t ws_size, hipStream_t stream) {
    static int grid = 0;
    if (grid == 0) {
        int dev = 0, cus = 0, per_cu = 0;
        hipGetDevice(&dev); hipDeviceGetAttribute(&cus, hipDeviceAttributeMultiprocessorCount, dev);
        if (hipFuncSetAttribute((const void*)mk_forward, hipFuncAttributeMaxDynamicSharedMemorySize, LDS_BYTES) != hipSuccess) { fprintf(stderr, "hipFuncSetAttribute failed\n"); grid = -1; return; }
        if (hipOccupancyMaxActiveBlocksPerMultiprocessor(&per_cu, (const void*)mk_forward, 512, LDS_BYTES) != hipSuccess || per_cu < 1) { fprintf(stderr, "occupancy query: %d\n", per_cu); per_cu = 1; }
        (void)hipGetLastError();
        grid = cus * per_cu;
    }
    if (grid < 0) return;
    Params p{};
    for (int i = 0; i < 17; ++i) p.in[i] = (const float*)d_in[i];
    p.out = (float*)d_out; p.ws = (unsigned char*)d_ws;
    size_t o = 0;
    p.o_win = (unsigned)o; o += (size_t)DEPTH * DM * WINR * 2;
    p.o_wg8 = (unsigned)o; o += (size_t)DEPTH * 4096 * DM;
    p.o_h8 = (unsigned)o; o += (size_t)NTOK * DM;
    p.o_wb = (unsigned)o; o += (size_t)DEPTH * 4 * BWID * DM * 2;
    p.o_wo = (unsigned)o; o += (size_t)DEPTH * DM * DM * 2;
    p.o_pw = (unsigned)o; o += (size_t)DEPTH * 4 * 128 * 128 * 2;
    p.o_sw = (unsigned)o; o += (size_t)DEPTH * 4 * 128 * 128 * 2;
    p.o_bar = (unsigned)o; o += 16384;
    p.o_small = (unsigned)o; o += (size_t)SM_TOTAL * 4;
    p.o_h = (unsigned)o; o += (size_t)NTOK * DM * 2;
    p.o_proj = (unsigned)o; o += (size_t)TS * (8 * BWID * 2 + 4096);
    if (o > ws_size) { fprintf(stderr, "kernel_launch: workspace too small: need %zu, have %zu\n", o, ws_size); return; }
    const int nph = 1 + NS * 4 + (DEPTH - 1) * NS * 5 + 1;
    if (hipMemsetAsync((char*)d_ws + p.o_bar, 0, 16384, stream) != hipSuccess) { fprintf(stderr, "kernel_launch: memset failed\n"); return; }
    p.ph_hi = nph;
    void* args[] = {&p};
    hipError_t e = hipLaunchCooperativeKernel((const void*)mk_forward, dim3(grid), dim3(512), args, LDS_BYTES, stream);
    if (e != hipSuccess) fprintf(stderr, "cooperative launch failed: %s (grid %d)\n", hipGetErrorString(e), grid);
}
```

```cpp
#include <hip/hip_runtime.h>
#include <hip/hip_cooperative_groups.h>
#include <cstdio>
namespace cg = cooperative_groups;

#ifndef MULTI_LAUNCH
#define MULTI_LAUNCH 0
#endif

#ifndef REP_N
#define REP_N 1
#endif
#ifndef REP_A
#define REP_A 1
#endif
#ifndef REP_B
#define REP_B 1
#endif
#ifndef REP_C
#define REP_C 1
#endif
#define REP_M0 1
#define REP_M1 1
#define REP_M2 1
#define REP_M3 1
#define LAS __attribute__((address_space(3)))
typedef unsigned short bf16_t;
typedef short bf16x8 __attribute__((ext_vector_type(8)));
typedef float f32x4 __attribute__((ext_vector_type(4)));
typedef float f32x2 __attribute__((ext_vector_type(2)));
typedef unsigned u32x4 __attribute__((ext_vector_type(4)));
typedef unsigned u32x2 __attribute__((ext_vector_type(2)));
typedef int i32x8 __attribute__((ext_vector_type(8)));
typedef int i32x4 __attribute__((ext_vector_type(4)));
constexpr int WINR = 6144;

constexpr int DM = 1024, SEQ = 2048, NTOK = 32 * 2048, DEPTH = 2, BWID = 512, INC = 10240, GATE0 = 6144;
constexpr int PP = 6144;
constexpr int NS = 1, TS = NTOK / NS;
constexpr int LDS_BYTES = 139264;
constexpr int VP = 1040;

constexpr int SM1 = 0, SM4 = 2048, SM5 = 3072, SM6 = 34816, SM7 = 35840, SM8 = 36864, SM9 = 37888, SM10 = 38912, SM12 = 39936, SM13 = 40960, SM16 = 44032, SM_TOTAL = 45056;
#define SMALLP(p, OFF) ((const float*)((p).ws + (p).o_small) + (OFF))
struct Params {
    const float* in[17];
    float* out;
    unsigned char* ws;
    int ph_hi;
    unsigned o_win, o_wb, o_wo, o_pw, o_sw, o_h, o_bar, o_proj, o_h8, o_wg8, o_small;
};

__device__ __forceinline__ int lane_id() { return (int)__builtin_amdgcn_mbcnt_hi(~0u, __builtin_amdgcn_mbcnt_lo(~0u, 0u)); }
__device__ __forceinline__ int otid(int wid0) { int t; asm volatile("v_mbcnt_lo_u32_b32 %0, -1, 0\n\tv_mbcnt_hi_u32_b32 %0, -1, %0" : "=v"(t)); return (wid0 << 6) | t; }
__device__ __forceinline__ unsigned cvt_pk_bf16(float lo, float hi) { unsigned r; asm volatile("v_cvt_pk_bf16_f32 %0, %1, %2" : "=v"(r) : "v"(lo), "v"(hi)); return r; }
__device__ __forceinline__ bf16_t f2bf(float f) { unsigned u = __float_as_uint(f); u += 0x7FFFu + ((u >> 16) & 1u); return (bf16_t)(u >> 16); }
__device__ __forceinline__ void unpack8(const u32x4 v, float (&f)[8]) {
    f[0] = __uint_as_float(v.x << 16); f[1] = __uint_as_float(v.x & 0xffff0000u); f[2] = __uint_as_float(v.y << 16); f[3] = __uint_as_float(v.y & 0xffff0000u);
    f[4] = __uint_as_float(v.z << 16); f[5] = __uint_as_float(v.z & 0xffff0000u); f[6] = __uint_as_float(v.w << 16); f[7] = __uint_as_float(v.w & 0xffff0000u);
}
__device__ __forceinline__ u32x4 pack8(const float (&f)[8]) { u32x4 r; r.x = cvt_pk_bf16(f[0], f[1]); r.y = cvt_pk_bf16(f[2], f[3]); r.z = cvt_pk_bf16(f[4], f[5]); r.w = cvt_pk_bf16(f[6], f[7]); return r; }
__device__ __forceinline__ void unpack4(const u32x2 v, float (&f)[4]) { f[0] = __uint_as_float(v.x << 16); f[1] = __uint_as_float(v.x & 0xffff0000u); f[2] = __uint_as_float(v.y << 16); f[3] = __uint_as_float(v.y & 0xffff0000u); }
__device__ __forceinline__ float sigm(float x) { return __builtin_amdgcn_rcpf(1.0f + __expf(-x)); }
__device__ __forceinline__ float silu(float x) { return x * sigm(x); }
__device__ __forceinline__ void load8f(const float* p, float (&f)[8]) { const f32x4 a = *(const f32x4*)p, b = *(const f32x4*)(p + 4); f[0] = a[0]; f[1] = a[1]; f[2] = a[2]; f[3] = a[3]; f[4] = b[0]; f[5] = b[1]; f[6] = b[2]; f[7] = b[3]; }
__device__ __forceinline__ float wave_sum(int wid0, float v) {
    const int lane = otid(wid0) & 63;
#pragma unroll
    for (int o = 32; o >= 1; o >>= 1) v += __builtin_bit_cast(float, __builtin_amdgcn_ds_bpermute((lane ^ o) << 2, __builtin_bit_cast(int, v)));
    return v;
}
__device__ __forceinline__ u32x2 tr_read(unsigned lds_addr) { u32x2 r; asm volatile("ds_read_b64_tr_b16 %0, %1\n\ts_waitcnt lgkmcnt(0)" : "=&v"(r) : "v"(lds_addr) : "memory"); return r; }

namespace pg8 {
constexpr int BM = 256, BK = 64, HALF = 128, HTB = HALF * BK * 2, STAGE_BYTES = 8 * HTB, NXCD = 8, WGM = 8;
__device__ __forceinline__ int lds_byte(int r, int c) { const int st = (r >> 4) * 2 + (c >> 5), rr = r & 15, cc = c & 31, ob = rr * 64 + cc * 2; return st * 1024 + (ob ^ (((ob >> 9) & 1) << 5)); }
__device__ __forceinline__ void stage_rc(int b, int& R, int& C) { const int st = b / 1024, sb = b % 1024, swz = sb ^ (((sb >> 9) & 1) << 5); R = (st >> 1) * 16 + swz / 64; C = (st & 1) * 32 + (swz % 64) / 2; }
__device__ __forceinline__ int perm32(int rho) { const int n = rho >> 4, i = rho & 15; return 8 * (i >> 2) + 4 * n + (i & 3); }

struct Unit { int pm, pn, br; };
struct Gemm { const bf16_t* A; const bf16_t* Bt; };

template <int NM, int NN, int NBR>
struct Order {
    int G, c;
    __device__ __forceinline__ bool next(int i, Unit& u) const {
        constexpr int nwg = NM * NN;
        const int ti = i / NBR;
        const long L = (long)ti * G + c; if (L >= nwg) return false;
        int wgid = (int)L; { constexpr int q = nwg / NXCD, r = nwg % NXCD; const int xcd = wgid % NXCD, off = wgid / NXCD; wgid = (xcd < r ? xcd * (q + 1) : r * (q + 1) + (xcd - r) * q) + off; }
        constexpr int nig = WGM * NN; const int gid = wgid / nig, fm = gid * WGM, gsz = (NM - fm) < WGM ? (NM - fm) : WGM;
        u.pm = fm + ((wgid % nig) % gsz); u.pn = (wgid % nig) / gsz; u.br = i % NBR; return true;
    }
    __device__ __forceinline__ void brow(const Unit& u, int& r0, int& r1) const { r0 = u.pn * BM; r1 = r0 + HALF; }
    __device__ __forceinline__ size_t aoff(const Unit&) const { return 0; }
};
struct OrderC : Order<TS / 256, DM / 256, 4> {
    __device__ __forceinline__ size_t aoff(const Unit& u) const { const int slot = (u.br == 0) ? 1 : (u.br == 1) ? 3 : (u.br == 2) ? 4 : 6; return (size_t)slot * TS * BWID * 2; }
};
struct OrderA : Order<TS / 256, WINR / 256, 1> {
    __device__ __forceinline__ void brow(const Unit& u, int& r0, int& r1) const {
        const int pn = u.pn;
        if (pn < 8) { const int pc = pn >> 1; const int piece = (pc == 0) ? 0 : (pc == 1) ? 1 : (pc == 2) ? 4 : 6; r0 = piece * 512 + (pn & 1) * 256; r1 = r0 + HALF; }
        else if (pn < 24) { const int q = (pn - 8) >> 2, sub = (pn - 8) & 3; const int pa = (q == 0) ? 2 : (q == 1) ? 9 : (q == 2) ? 8 : 5, pb = (q == 0) ? 3 : (q == 1) ? 10 : (q == 2) ? 11 : 7;
            r0 = pa * 512 + HALF * sub; r1 = pb * 512 + HALF * sub; }
        else { r0 = pn * BM; r1 = r0 + HALF; }
    }
};

struct EpiProj {
    static constexpr bool PERM = true;
    static __device__ __forceinline__ bool zero_after(const Unit&) { return true; }
    bf16_t* O;
    __device__ __forceinline__ void operator()(f32x4 (&acc)[2][2][4][2], const Unit& u, int wr, int wc, int fr_, int fq) const {
        int fr = fr_; asm volatile("" : "+v"(fr));
        if (u.pn < 8) {
            const int pc = u.pn >> 1; const int slot = (pc == 0) ? 0 : (pc == 1) ? 1 : (pc == 2) ? 3 : 5;
            const int row0 = u.pm * BM + wr * 64 + fr, col0 = (u.pn & 1) * BM + wc * 32 + 8 * fq;
            bf16_t* Op = O + (size_t)slot * TS * BWID;
#pragma unroll
            for (int ai = 0; ai < 2; ++ai)
#pragma unroll
                for (int m = 0; m < 4; ++m) { bf16_t* rowp = Op + (size_t)(row0 + ai * HALF + m * 16) * BWID + col0;
#pragma unroll
                    for (int bj = 0; bj < 2; ++bj) { const f32x4 v0 = acc[ai][bj][m][0], v1 = acc[ai][bj][m][1];
                        u32x4 w; w.x = cvt_pk_bf16(v0[0], v0[1]); w.y = cvt_pk_bf16(v0[2], v0[3]); w.z = cvt_pk_bf16(v1[0], v1[1]); w.w = cvt_pk_bf16(v1[2], v1[3]);
                        __builtin_nontemporal_store(w, (u32x4*)(rowp + bj * HALF)); } }
        } else {
            const int q = (u.pn - 8) >> 2, sub = (u.pn - 8) & 3; const int slot = (q == 0) ? 2 : (q == 1) ? 7 : (q == 2) ? 6 : 4;
            const int row0 = u.pm * BM + wr * 64 + fr, col0 = sub * HALF + wc * 32 + 8 * fq;
            bf16_t* Op = O + (size_t)slot * TS * BWID;
#pragma unroll
            for (int ai = 0; ai < 2; ++ai)
#pragma unroll
                for (int m = 0; m < 4; ++m) {
                    float f[8];
#pragma unroll
                    for (int n = 0; n < 2; ++n)
#pragma unroll
                        for (int j = 0; j < 4; ++j) { const float av = acc[ai][0][m][n][j], bv = acc[ai][1][m][n][j];
                            const float sg = __builtin_amdgcn_rcpf(1.0f + __builtin_amdgcn_exp2f(bv));
                            f[n * 4 + j] = av * ((q == 1) ? bv : (q == 0) ? sg : bv * sg); }
                    __builtin_nontemporal_store(pack8(f), (u32x4*)(Op + (size_t)(row0 + ai * HALF + m * 16) * BWID + col0)); }
        }
    }
};
struct EpiGateStore {
    static constexpr bool PERM = true;
    static __device__ __forceinline__ bool zero_after(const Unit&) { return true; }
    unsigned char* G;
    __device__ __forceinline__ void operator()(f32x4 (&acc)[2][2][4][2], const Unit& u, int wr, int wc, int fr_, int fq) const {
        int fr = fr_; asm volatile("" : "+v"(fr));
        unsigned char* gb = G + ((size_t)u.pm * 16 + u.pn) * 65536 + (((wr * 4 + wc) * 4 + fq) * 16 + fr) * 16;
        const float c255 = 1.0f / 255.0f;
#pragma unroll
        for (int ai = 0; ai < 2; ++ai)
#pragma unroll
            for (int m = 0; m < 4; ++m) {
                u32x4 w;
#pragma unroll
                for (int bj = 0; bj < 2; ++bj)
#pragma unroll
                    for (int n = 0; n < 2; ++n) { unsigned q = 0u;
#pragma unroll
                        for (int j = 0; j < 4; ++j) q = __builtin_amdgcn_cvt_pk_u8_f32(fmaxf(__builtin_amdgcn_rcpf(__builtin_fmaf(__builtin_amdgcn_exp2f(acc[ai][bj][m][n][j]), c255, c255)), 1.0f), j, q);
                        w[bj * 2 + n] = q; }
                __builtin_nontemporal_store(w, (u32x4*)(gb + (ai * 4 + m) * 8192));
                __builtin_amdgcn_sched_barrier(0); }
    }
};
struct EpiGate {
    static constexpr bool PERM = true;
    static __device__ __forceinline__ bool zero_after(const Unit& u) { return u.br == 3; }
    const bf16_t* G; bf16_t* merged;
    __device__ __forceinline__ void operator()(f32x4 (&acc)[2][2][4][2], const Unit& u, int wr, int wc, int fr_, int fq) const {
        int fr = fr_; asm volatile("" : "+v"(fr));
        const int lrow0 = wr * 64 + fr, lcol0 = wc * 32 + 8 * fq;
        const int br = u.br;
        const bool lastb = (br == 3);
        const unsigned char* gp0 = (const unsigned char*)G + ((size_t)u.pm * 16 + br * 4 + u.pn) * 65536 + (((wr * 4 + wc) * 4 + fq) * 16 + fr) * 16;
        const unsigned char* gnp = lastb ? gp0 : gp0 + 4 * 65536;
        u32x4 gc[2][4], gn[2][4];
#pragma unroll
        for (int ai = 0; ai < 2; ++ai)
#pragma unroll
            for (int m = 0; m < 4; ++m) { gc[ai][m] = *(const u32x4*)(gp0 + (ai * 4 + m) * 8192); gn[ai][m] = (u32x4){~0u, ~0u, ~0u, ~0u}; if (!lastb) gn[ai][m] = *(const u32x4*)(gnp + (ai * 4 + m) * 8192); }
#pragma unroll
        for (int ai = 0; ai < 2; ++ai)
#pragma unroll
            for (int m = 0; m < 4; ++m)
#pragma unroll
                for (int bj = 0; bj < 2; ++bj) {
#pragma unroll
                    for (int n = 0; n < 2; ++n) {
                        const unsigned c = gc[ai][m][bj * 2 + n], d = gn[ai][m][bj * 2 + n];
                        float fc[4], fd[4];
                        fc[0] = (float)(c & 0xffu); fc[1] = (float)((c >> 8) & 0xffu); fc[2] = (float)((c >> 16) & 0xffu); fc[3] = (float)(c >> 24);
                        fd[0] = (float)(d & 0xffu); fd[1] = (float)((d >> 8) & 0xffu); fd[2] = (float)((d >> 16) & 0xffu); fd[3] = (float)(d >> 24);
#pragma unroll
                        for (int j = 0; j < 4; ++j) acc[ai][bj][m][n][j] *= fc[j] * __builtin_amdgcn_rcpf(fd[j]);
                    }
                    if (lastb) { const f32x4 v0 = acc[ai][bj][m][0], v1 = acc[ai][bj][m][1];
                        u32x4 w; w.x = cvt_pk_bf16(v0[0], v0[1]); w.y = cvt_pk_bf16(v0[2], v0[3]); w.z = cvt_pk_bf16(v1[0], v1[1]); w.w = cvt_pk_bf16(v1[2], v1[3]);
                        *(u32x4*)(merged + ((size_t)u.pm * BM + lrow0 + ai * HALF + m * 16) * DM + u.pn * BM + lcol0 + bj * HALF) = w; }
                }
    }
};
struct EpiRes {
    static constexpr bool PERM = true;
    static __device__ __forceinline__ bool zero_after(const Unit&) { return true; }
    const float* res32; const bf16_t* res16; bf16_t* O;
    __device__ __forceinline__ void operator()(f32x4 (&acc)[2][2][4][2], const Unit& u, int wr, int wc, int fr_, int fq) const {
        int fr = fr_; asm volatile("" : "+v"(fr));
        const int row0 = u.pm * BM + wr * 64 + fr, col0 = u.pn * BM + wc * 32 + 8 * fq;
        const bool r16 = (res16 != nullptr);
        if (r16) {
            u32x4 rr[2][4][2];
#pragma unroll
            for (int ai = 0; ai < 2; ++ai)
#pragma unroll
                for (int m = 0; m < 4; ++m)
#pragma unroll
                    for (int bj = 0; bj < 2; ++bj) rr[ai][m][bj] = *(const u32x4*)(res16 + (size_t)(row0 + ai * HALF + m * 16) * DM + col0 + bj * HALF);
#pragma unroll
            for (int ai = 0; ai < 2; ++ai)
#pragma unroll
                for (int m = 0; m < 4; ++m)
#pragma unroll
                    for (int bj = 0; bj < 2; ++bj) { float r[8], o[8]; unpack8(rr[ai][m][bj], r);
#pragma unroll
                        for (int j = 0; j < 4; ++j) { o[j] = acc[ai][bj][m][0][j] + r[j]; o[4 + j] = acc[ai][bj][m][1][j] + r[4 + j]; }
                        *(u32x4*)(O + (size_t)(row0 + ai * HALF + m * 16) * DM + col0 + bj * HALF) = pack8(o); }
        } else {
#pragma unroll
            for (int ai = 0; ai < 2; ++ai) {
                f32x4 rr[4][2][2];
#pragma unroll
                for (int m = 0; m < 4; ++m)
#pragma unroll
                    for (int bj = 0; bj < 2; ++bj) { const float* q = res32 + (size_t)(row0 + ai * HALF + m * 16) * DM + col0 + bj * HALF; rr[m][bj][0] = *(const f32x4*)q; rr[m][bj][1] = *(const f32x4*)(q + 4); }
#pragma unroll
                for (int m = 0; m < 4; ++m)
#pragma unroll
                    for (int bj = 0; bj < 2; ++bj) { float o[8];
#pragma unroll
                        for (int j = 0; j < 4; ++j) { o[j] = acc[ai][bj][m][0][j] + rr[m][bj][0][j]; o[4 + j] = acc[ai][bj][m][1][j] + rr[m][bj][1][j]; }
                        *(u32x4*)(O + (size_t)(row0 + ai * HALF + m * 16) * DM + col0 + bj * HALF) = pack8(o); }
                asm volatile("" ::: "memory");
            }
        }
    }
};

template <int K, size_t B_BR, class Epi, class Sched>
__device__ __forceinline__ void gemm_phase(int wid0, LAS unsigned char* lds, const Gemm g, const Sched& S, const Epi& E) {
    const int tid = otid(wid0), wid = __builtin_amdgcn_readfirstlane(tid >> 6), lane = tid & 63, wr = wid >> 2, wc = wid & 3, fr = lane & 15, fq = lane >> 4;
    constexpr int nt = K / BK;
    unsigned voffA[2], voffB[2];
#pragma unroll
    for (int i = 0; i < 2; ++i) { int R, C; stage_rc(tid * 16 + i * 8192, R, C); const int Rb = Epi::PERM ? ((R & ~31) + perm32(R & 31)) : R;
        voffA[i] = (unsigned)(R * K + C) * 2u; voffB[i] = (unsigned)(Rb * K + C) * 2u; }
    constexpr size_t kstep = (size_t)(BK * 2);
    constexpr size_t hstep = (size_t)HALF * K * 2;
    constexpr size_t tstep = 2 * hstep;
    const unsigned ldsw = (unsigned)wid * 1024u;
    const int aoff = lds_byte(wr * 64 + fr, fq * 8), boff = lds_byte(wc * 32 + fr, fq * 8);
#define PG8_SA(b, h) (((b) * 2 + (h)) * HTB)
#define PG8_SB(b, h) ((4 + (b) * 2 + (h)) * HTB)
#define PG8_STAGE(bufoff, gbase, voff) do { _Pragma("unroll") for (int _i = 0; _i < 2; ++_i) \
        __builtin_amdgcn_global_load_lds((const unsigned*)((const char*)(gbase) + (voff)[_i]), (LAS unsigned*)(lds + (bufoff) + ldsw + _i * 8192), 16, 0, 0); } while (0)
#define PG8_LDA(dst, b, h) do { _Pragma("unroll") for (int m = 0; m < 4; ++m) _Pragma("unroll") for (int k = 0; k < 2; ++k) dst[m][k] = *(const LAS bf16x8*)(lds + PG8_SA(b, h) + aoff + m * 2048 + k * 1024); } while (0)
#define PG8_LDB(dst, b, h) do { _Pragma("unroll") for (int n = 0; n < 2; ++n) _Pragma("unroll") for (int k = 0; k < 2; ++k) dst[n][k] = *(const LAS bf16x8*)(lds + PG8_SB(b, h) + boff + n * 2048 + k * 1024); } while (0)
#define PG8_MMA(ai, bj, At, Bt) do { __builtin_amdgcn_s_setprio(1); _Pragma("unroll") for (int m = 0; m < 4; ++m) _Pragma("unroll") for (int n = 0; n < 2; ++n) _Pragma("unroll") for (int k = 0; k < 2; ++k) \
        acc[ai][bj][m][n] = __builtin_amdgcn_mfma_f32_16x16x32_bf16(Bt[n][k], At[m][k], acc[ai][bj][m][n], 0, 0, 0); __builtin_amdgcn_s_setprio(0); } while (0)
#define PG8_WAIT_V(n) asm volatile("s_waitcnt vmcnt(" #n ")" ::: "memory")
#define PG8_WAIT_L(n) asm volatile("s_waitcnt lgkmcnt(" #n ")" ::: "memory")
#define PG8_BAR __builtin_amdgcn_s_barrier()
#define PG8_SCHED __builtin_amdgcn_sched_barrier(0)
    Unit cur, nxt; int ui = 0;
    if (!S.next(0, cur)) return;
    f32x4 acc[2][2][4][2];
#pragma unroll
    for (int a = 0; a < 2; ++a)
#pragma unroll
        for (int b = 0; b < 2; ++b)
#pragma unroll
            for (int m = 0; m < 4; ++m)
#pragma unroll
                for (int n = 0; n < 2; ++n) acc[a][b][m][n] = (f32x4){0.f, 0.f, 0.f, 0.f};
    bf16x8 At[4][2], B0[2][2], B1[2][2];
    const char* cA = (const char*)g.A + (size_t)cur.pm * tstep + S.aoff(cur); int rb0, rb1; S.brow(cur, rb0, rb1);
    const char* cB = (const char*)g.Bt + (size_t)rb0 * (K * 2) + (size_t)cur.br * B_BR; const char* cBh = (const char*)g.Bt + (size_t)rb1 * (K * 2) + (size_t)cur.br * B_BR;
    PG8_STAGE(PG8_SB(0, 0), cB, voffB); PG8_STAGE(PG8_SA(0, 0), cA, voffA); PG8_STAGE(PG8_SB(0, 1), cBh, voffB); PG8_STAGE(PG8_SA(0, 1), cA + hstep, voffA);
    if (wr == 1) PG8_BAR;
    PG8_WAIT_V(4); PG8_BAR;
    PG8_STAGE(PG8_SB(1, 0), cB + kstep, voffB); PG8_STAGE(PG8_SA(1, 0), cA + kstep, voffA); PG8_STAGE(PG8_SB(1, 1), cBh + kstep, voffB);
    PG8_WAIT_V(6); PG8_BAR;
    for (;;) {
        const bool has_next = S.next(ui + 1, nxt);
        const char* nA = has_next ? (const char*)g.A + (size_t)nxt.pm * tstep + S.aoff(nxt) : cA; int rn0 = 0, rn1 = 0; if (has_next) S.brow(nxt, rn0, rn1);
        const char* nB = has_next ? (const char*)g.Bt + (size_t)rn0 * (K * 2) + (size_t)nxt.br * B_BR : cB; const char* nBh = has_next ? (const char*)g.Bt + (size_t)rn1 * (K * 2) + (size_t)nxt.br * B_BR : cBh;
        for (int t = 0; t < nt; t += 2) {
            const bool last = (t == nt - 2);
            const char* a1 = cA + (size_t)(t + 1) * kstep;
            const char* a2 = last ? nA : cA + (size_t)(t + 2) * kstep; const char* b2 = last ? nB : cB + (size_t)(t + 2) * kstep; const char* b2h = last ? nBh : cBh + (size_t)(t + 2) * kstep;
            const char* a3 = a2 + kstep; const char* b3 = b2 + kstep; const char* b3h = b2h + kstep;
            PG8_LDB(B0, 0, 0); PG8_SCHED; PG8_LDA(At, 0, 0); PG8_STAGE(PG8_SA(1, 1), a1 + hstep, voffA);
            PG8_WAIT_L(8); PG8_BAR; PG8_WAIT_L(0); PG8_MMA(0, 0, At, B0); PG8_BAR; PG8_SCHED;
            PG8_LDB(B1, 0, 1); PG8_STAGE(PG8_SB(0, 0), b2, voffB);
            PG8_BAR; PG8_WAIT_L(0); PG8_MMA(0, 1, At, B1); PG8_BAR;
            PG8_LDA(At, 0, 1); PG8_STAGE(PG8_SA(0, 0), a2, voffA);
            PG8_BAR; PG8_WAIT_L(0); PG8_MMA(1, 0, At, B0); PG8_BAR; PG8_SCHED;
            PG8_STAGE(PG8_SB(0, 1), b2h, voffB);
            PG8_WAIT_V(6); PG8_BAR; PG8_MMA(1, 1, At, B1); PG8_BAR;
            PG8_LDB(B0, 1, 0); PG8_SCHED; PG8_LDA(At, 1, 0); PG8_STAGE(PG8_SA(0, 1), a2 + hstep, voffA);
            PG8_WAIT_L(8); PG8_BAR; PG8_WAIT_L(0); PG8_MMA(0, 0, At, B0); PG8_BAR; PG8_SCHED;
            PG8_LDB(B1, 1, 1); PG8_STAGE(PG8_SB(1, 0), b3, voffB);
            PG8_BAR; PG8_WAIT_L(0); PG8_MMA(0, 1, At, B1); PG8_BAR;
            PG8_LDA(At, 1, 1); PG8_STAGE(PG8_SA(1, 0), a3, voffA);
            PG8_BAR; PG8_WAIT_L(0); PG8_MMA(1, 0, At, B0); PG8_BAR; PG8_SCHED;
            PG8_STAGE(PG8_SB(1, 1), b3h, voffB);
            PG8_WAIT_V(6); PG8_BAR; PG8_MMA(1, 1, At, B1); PG8_BAR;
        }
        E(acc, cur, wr, wc, fr, fq);
        if (!has_next) break;
        if (Epi::zero_after(cur))
#pragma unroll
        for (int a = 0; a < 2; ++a)
#pragma unroll
            for (int b = 0; b < 2; ++b)
#pragma unroll
                for (int m = 0; m < 4; ++m)
#pragma unroll
                    for (int n = 0; n < 2; ++n) acc[a][b][m][n] = (f32x4){0.f, 0.f, 0.f, 0.f};
        cur = nxt; cA = nA; cB = nB; cBh = nBh; ++ui;
    }
    PG8_WAIT_V(0);
    if (wr == 0) PG8_BAR;
    PG8_BAR;
#undef PG8_SA
#undef PG8_SB
#undef PG8_STAGE
#undef PG8_LDA
#undef PG8_LDB
#undef PG8_MMA
#undef PG8_WAIT_V
#undef PG8_WAIT_L
#undef PG8_BAR
#undef PG8_SCHED
}
template <int RB, class Epi, class Sched>
__device__ __forceinline__ void gemm_phase_f8(int wid0, LAS unsigned char* lds, const Gemm g, const Sched& S, const Epi& E) {
    const int tid = otid(wid0), wid = __builtin_amdgcn_readfirstlane(tid >> 6), lane = tid & 63, wr = wid >> 2, wc = wid & 3, fr = lane & 15, fq = lane >> 4;
    constexpr int nt = RB / 128;
    constexpr int K = RB / 2;
    constexpr size_t B_BR = 0;
    unsigned voffA[2], voffB[2]; int aoff, boff;
    constexpr size_t kstep = (size_t)(BK * 2);
    constexpr size_t hstep = (size_t)HALF * K * 2;
    constexpr size_t tstep = 2 * hstep;
    const unsigned ldsw = (unsigned)wid * 1024u;
#define PG8_SETUP() do { const int t_ = otid(wid0), l_ = t_ & 63, fr_ = l_ & 15, fq_ = l_ >> 4; \
        _Pragma("unroll") for (int i = 0; i < 2; ++i) { int R, C; stage_rc(t_ * 16 + i * 8192, R, C); const int Rb = Epi::PERM ? ((R & ~31) + perm32(R & 31)) : R; \
            voffA[i] = (unsigned)(R * K + C) * 2u; voffB[i] = (unsigned)(Rb * K + C) * 2u; } \
        aoff = lds_byte(wr * 64 + fr_, fq_ * 16); boff = lds_byte(wc * 32 + fr_, fq_ * 16); } while (0)
    PG8_SETUP();
#define PG8_SA(b, h) (((b) * 2 + (h)) * HTB)
#define PG8_SB(b, h) ((4 + (b) * 2 + (h)) * HTB)
#define PG8_STAGE(bufoff, gbase, voff) do { _Pragma("unroll") for (int _i = 0; _i < 2; ++_i) \
        __builtin_amdgcn_global_load_lds((const unsigned*)((const char*)(gbase) + (voff)[_i]), (LAS unsigned*)(lds + (bufoff) + ldsw + _i * 8192), 16, 0, 0); } while (0)
#define PG8_LDA(dst, b, h) do { _Pragma("unroll") for (int m = 0; m < 4; ++m) dst[m] = *(const LAS i32x8*)(lds + PG8_SA(b, h) + aoff + m * 2048); } while (0)
#define PG8_LDB(dst, b, h) do { _Pragma("unroll") for (int n = 0; n < 2; ++n) dst[n] = *(const LAS i32x8*)(lds + PG8_SB(b, h) + boff + n * 2048); } while (0)
#define PG8_MMA(ai, bj, At, Bt) do { __builtin_amdgcn_s_setprio(1); _Pragma("unroll") for (int m = 0; m < 4; ++m) _Pragma("unroll") for (int n = 0; n < 2; ++n) \
        acc[ai][bj][m][n] = __builtin_amdgcn_mfma_scale_f32_16x16x128_f8f6f4(Bt[n], At[m], acc[ai][bj][m][n], 0, 0, 0, 122, 0, 127); __builtin_amdgcn_s_setprio(0); } while (0)
#define PG8_WAIT_V(n) asm volatile("s_waitcnt vmcnt(" #n ")" ::: "memory")
#define PG8_WAIT_L(n) asm volatile("s_waitcnt lgkmcnt(" #n ")" ::: "memory")
#define PG8_BAR __builtin_amdgcn_s_barrier()
#define PG8_SCHED __builtin_amdgcn_sched_barrier(0)
    Unit cur, nxt; int ui = 0;
    if (!S.next(0, cur)) return;
    f32x4 acc[2][2][4][2];
#pragma unroll
    for (int a = 0; a < 2; ++a)
#pragma unroll
        for (int b = 0; b < 2; ++b)
#pragma unroll
            for (int m = 0; m < 4; ++m)
#pragma unroll
                for (int n = 0; n < 2; ++n) acc[a][b][m][n] = (f32x4){0.f, 0.f, 0.f, 0.f};
    i32x8 At[4], B0[2], B1[2];
    const char* cA = (const char*)g.A + (size_t)cur.pm * tstep + S.aoff(cur); int rb0, rb1; S.brow(cur, rb0, rb1);
    const char* cB = (const char*)g.Bt + (size_t)rb0 * (K * 2) + (size_t)cur.br * B_BR; const char* cBh = (const char*)g.Bt + (size_t)rb1 * (K * 2) + (size_t)cur.br * B_BR;
    PG8_STAGE(PG8_SB(0, 0), cB, voffB); PG8_STAGE(PG8_SA(0, 0), cA, voffA); PG8_STAGE(PG8_SB(0, 1), cBh, voffB); PG8_STAGE(PG8_SA(0, 1), cA + hstep, voffA);
    if (wr == 1) PG8_BAR;
    PG8_WAIT_V(4); PG8_BAR;
    PG8_STAGE(PG8_SB(1, 0), cB + kstep, voffB); PG8_STAGE(PG8_SA(1, 0), cA + kstep, voffA); PG8_STAGE(PG8_SB(1, 1), cBh + kstep, voffB);
    PG8_WAIT_V(6); PG8_BAR;
    for (;;) {
        const bool has_next = S.next(ui + 1, nxt);
        const char* nA = has_next ? (const char*)g.A + (size_t)nxt.pm * tstep + S.aoff(nxt) : cA; int rn0 = 0, rn1 = 0; if (has_next) S.brow(nxt, rn0, rn1);
        const char* nB = has_next ? (const char*)g.Bt + (size_t)rn0 * (K * 2) + (size_t)nxt.br * B_BR : cB; const char* nBh = has_next ? (const char*)g.Bt + (size_t)rn1 * (K * 2) + (size_t)nxt.br * B_BR : cBh;
        for (int t = 0; t < nt; t += 2) {
            const bool last = (t == nt - 2);
            const char* a1 = cA + (size_t)(t + 1) * kstep;
            const char* a2 = last ? nA : cA + (size_t)(t + 2) * kstep; const char* b2 = last ? nB : cB + (size_t)(t + 2) * kstep; const char* b2h = last ? nBh : cBh + (size_t)(t + 2) * kstep;
            const char* a3 = a2 + kstep; const char* b3 = b2 + kstep; const char* b3h = b2h + kstep;
            PG8_LDB(B0, 0, 0); PG8_SCHED; PG8_LDA(At, 0, 0); PG8_STAGE(PG8_SA(1, 1), a1 + hstep, voffA);
            PG8_WAIT_L(8); PG8_BAR; PG8_WAIT_L(0); PG8_MMA(0, 0, At, B0); PG8_BAR; PG8_SCHED;
            PG8_LDB(B1, 0, 1); PG8_STAGE(PG8_SB(0, 0), b2, voffB);
            PG8_BAR; PG8_WAIT_L(0); PG8_MMA(0, 1, At, B1); PG8_BAR;
            PG8_LDA(At, 0, 1); PG8_STAGE(PG8_SA(0, 0), a2, voffA);
            PG8_BAR; PG8_WAIT_L(0); PG8_MMA(1, 0, At, B0); PG8_BAR; PG8_SCHED;
            PG8_STAGE(PG8_SB(0, 1), b2h, voffB);
            PG8_WAIT_V(6); PG8_BAR; PG8_MMA(1, 1, At, B1); PG8_BAR;
            PG8_LDB(B0, 1, 0); PG8_SCHED; PG8_LDA(At, 1, 0); PG8_STAGE(PG8_SA(0, 1), a2 + hstep, voffA);
            PG8_WAIT_L(8); PG8_BAR; PG8_WAIT_L(0); PG8_MMA(0, 0, At, B0); PG8_BAR; PG8_SCHED;
            PG8_LDB(B1, 1, 1); PG8_STAGE(PG8_SB(1, 0), b3, voffB);
            PG8_BAR; PG8_WAIT_L(0); PG8_MMA(0, 1, At, B1); PG8_BAR;
            PG8_LDA(At, 1, 1); PG8_STAGE(PG8_SA(1, 0), a3, voffA);
            PG8_BAR; PG8_WAIT_L(0); PG8_MMA(1, 0, At, B0); PG8_BAR; PG8_SCHED;
            PG8_STAGE(PG8_SB(1, 1), b3h, voffB);
            PG8_WAIT_V(6); PG8_BAR; PG8_MMA(1, 1, At, B1); PG8_BAR;
        }
        { const int t2_ = otid(wid0) & 63; E(acc, cur, wr, wc, t2_ & 15, t2_ >> 4); }
        if (!has_next) break;
        if (Epi::zero_after(cur))
#pragma unroll
        for (int a = 0; a < 2; ++a)
#pragma unroll
            for (int b = 0; b < 2; ++b)
#pragma unroll
                for (int m = 0; m < 4; ++m)
#pragma unroll
                    for (int n = 0; n < 2; ++n) acc[a][b][m][n] = (f32x4){0.f, 0.f, 0.f, 0.f};
        cur = nxt; cA = nA; cB = nB; cBh = nBh; ++ui;
        PG8_SETUP();
    }
    PG8_WAIT_V(0);
    if (wr == 0) PG8_BAR;
    PG8_BAR;
#undef PG8_SETUP
#undef PG8_SA
#undef PG8_SB
#undef PG8_STAGE
#undef PG8_LDA
#undef PG8_LDB
#undef PG8_MMA
#undef PG8_WAIT_V
#undef PG8_WAIT_L
#undef PG8_BAR
#undef PG8_SCHED
}
}

__device__ void phase_norm_bf16(int wid0, const float* __restrict__ xin, const bf16_t* __restrict__ xin16, const float* __restrict__ g, bf16_t* __restrict__ h, unsigned char* __restrict__ h8, int rows);
struct TJob { const float* src; bf16_t* dst; unsigned char* dst8; int R, C, tr, tc; float scale; };
__device__ __forceinline__ TJob prep_job(const Params& p, int i) {
    bf16_t* win = (bf16_t*)(p.ws + p.o_win); bf16_t* wb = (bf16_t*)(p.ws + p.o_wb); bf16_t* wo = (bf16_t*)(p.ws + p.o_wo); bf16_t* pw = (bf16_t*)(p.ws + p.o_pw);
    constexpr int T_WIN = 16 * 160, T_WB = 8 * 16, T_WO = 16 * 16, T_PW = 4;
    constexpr int N0 = DEPTH * T_WIN, N1 = N0 + 8 * T_WB, N2 = N1 + DEPTH * T_WO;
    TJob j; j.scale = 1.0f; j.dst8 = nullptr;
    if (i < N0) { const int l = i / T_WIN, t = i % T_WIN; j.src = p.in[2] + (size_t)l * DM * INC; j.dst = win + (size_t)l * DM * WINR; j.R = DM; j.C = INC; j.tr = t / 160; j.tc = t % 160;
        const int piece = j.tc >> 3; j.scale = (piece >= 12 || piece == 3 || piece == 7 || piece == 11) ? -1.4426950408889634f : (piece == 5 || piece == 8) ? -0.6931471805599453f : 1.0f;
        if (piece >= 12) { j.dst = nullptr; j.dst8 = p.ws + p.o_wg8 + (size_t)l * 4096 * DM + (size_t)(j.tc - 96) * 64 * DM; j.scale *= 32.0f; } }
    else if (i < N1) { const int k = i - N0, m = k / T_WB, t = k % T_WB; j.src = p.in[14] + (size_t)m * BWID * DM; j.dst = wb + (size_t)m * BWID * DM; j.R = BWID; j.C = DM; j.tr = t / 16; j.tc = t % 16; }
    else if (i < N2) { const int k = i - N1, l = k / T_WO, t = k % T_WO; j.src = p.in[15] + (size_t)l * DM * DM; j.dst = wo + (size_t)l * DM * DM; j.R = DM; j.C = DM; j.tr = t / 16; j.tc = t % 16; }
    else { const int k = i - N2, m = k / T_PW, t = k % T_PW; j.src = p.in[3] + (size_t)m * 128 * 128; j.dst = pw + (size_t)m * 128 * 128; j.R = 128; j.C = 128; j.tr = t / 2; j.tc = t % 2; }
    return j;
}
__device__ void phase_prep(int wid0, const Params& p, LAS unsigned char* lds) {
    LAS float* sm = (LAS float*)lds;
    const int tid = otid(wid0);
    constexpr int NT = DEPTH * 16 * 160 + 8 * 8 * 16 + DEPTH * 16 * 16 + 8 * 4;
    const int lr = tid >> 4, lc = (tid & 15) * 4;
    f32x4 v0, v1;
    int i = blockIdx.x;
    if (i < NT) { const TJob j = prep_job(p, i); const float* sp = j.src + (size_t)(j.tr * 64 + lr) * j.C + j.tc * 64 + lc; v0 = *(const f32x4*)sp; v1 = *(const f32x4*)(sp + (size_t)32 * j.C); }
    for (; i < NT; i += gridDim.x) {
        const TJob j = prep_job(p, i);
#pragma unroll
        for (int e = 0; e < 4; ++e) { sm[lr * 65 + lc + e] = v0[e]; sm[(lr + 32) * 65 + lc + e] = v1[e]; }
        __syncthreads();
        const int in = i + gridDim.x;
        if (in < NT) { const TJob jn = prep_job(p, in); const float* sp = jn.src + (size_t)(jn.tr * 64 + lr) * jn.C + jn.tc * 64 + lc; v0 = *(const f32x4*)sp; v1 = *(const f32x4*)(sp + (size_t)32 * jn.C); }
        { const int c = tid >> 3, r8 = (tid & 7) * 8; float o[8];
#pragma unroll
          for (int e = 0; e < 8; ++e) o[e] = sm[(r8 + e) * 65 + c] * j.scale;
          if (j.dst8) { unsigned w0 = 0u, w1 = 0u; w0 = __builtin_amdgcn_cvt_pk_fp8_f32(o[0], o[1], w0, false); w0 = __builtin_amdgcn_cvt_pk_fp8_f32(o[2], o[3], w0, true); w1 = __builtin_amdgcn_cvt_pk_fp8_f32(o[4], o[5], w1, false); w1 = __builtin_amdgcn_cvt_pk_fp8_f32(o[6], o[7], w1, true);
              *(u32x2*)(j.dst8 + (size_t)c * DM + j.tr * 64 + r8) = (u32x2){w0, w1}; }
          else *(u32x4*)(j.dst + (size_t)(j.tc * 64 + c) * j.R + j.tr * 64 + r8) = pack8(o); }
        __syncthreads();
    }
    const float* sgw = p.in[11]; bf16_t* sw = (bf16_t*)(p.ws + p.o_sw);
    for (int k = blockIdx.x * 512 + tid; k < DEPTH * 4 * 128 * 128; k += gridDim.x * 512) { const int s_ = k & 127, t = (k >> 7) & 127; sw[k] = (s_ <= t) ? f2bf(sgw[k]) : (bf16_t)0; }
    {
        float* sd = (float*)(p.ws + p.o_small); const int gt = blockIdx.x * 512 + tid, gs = gridDim.x * 512;
#define CPY(K, OFF, N) for (int k = gt; k < (N); k += gs) sd[(OFF) + k] = p.in[K][k];
        CPY(1, SM1, 2048) CPY(4, SM4, 1024) CPY(5, SM5, 31744) CPY(6, SM6, 1024) CPY(7, SM7, 1024) CPY(8, SM8, 1024) CPY(9, SM9, 1024) CPY(10, SM10, 1024) CPY(12, SM12, 1024) CPY(13, SM13, 3072) CPY(16, SM16, 1024)
#undef CPY
    }
    phase_norm_bf16(wid0, p.in[0], nullptr, p.in[1], (bf16_t*)(p.ws + p.o_h), p.ws + p.o_h8, NTOK);
}

__device__ void phase_norm_bf16(int wid0, const float* __restrict__ xin, const bf16_t* __restrict__ xin16, const float* __restrict__ g, bf16_t* __restrict__ h, unsigned char* __restrict__ h8, int rows) {
    const int tid = otid(wid0), lane = tid & 63, w = tid >> 6;
    float gv[2][8];
    load8f(g + 8 * lane, gv[0]); load8f(g + 512 + 8 * lane, gv[1]);
    for (int row = blockIdx.x * 8 + w; row < rows; row += gridDim.x * 8) {
        float v[2][8];
        if (xin16) { const bf16_t* xr = xin16 + (size_t)row * DM + 8 * lane; unpack8(*(const u32x4*)xr, v[0]); unpack8(*(const u32x4*)(xr + 512), v[1]); }
        else { const float* xr = xin + (size_t)row * DM + 8 * lane; load8f(xr, v[0]); load8f(xr + 512, v[1]); }
        float ss = 0.f;
#pragma unroll
        for (int i = 0; i < 2; ++i)
#pragma unroll
            for (int j = 0; j < 8; ++j) ss += v[i][j] * v[i][j];
        ss = wave_sum(wid0, ss);
        const float r = rsqrtf(ss * (1.0f / 1024.0f) + 1e-6f);
#pragma unroll
        for (int i = 0; i < 2; ++i) { float o[8];
#pragma unroll
            for (int j = 0; j < 8; ++j) o[j] = v[i][j] * r * gv[i][j];
            *(u32x4*)(h + (size_t)row * DM + 512 * i + 8 * lane) = pack8(o);
            unsigned w0 = 0u, w1 = 0u; w0 = __builtin_amdgcn_cvt_pk_fp8_f32(o[0], o[1], w0, false); w0 = __builtin_amdgcn_cvt_pk_fp8_f32(o[2], o[3], w0, true); w1 = __builtin_amdgcn_cvt_pk_fp8_f32(o[4], o[5], w1, false); w1 = __builtin_amdgcn_cvt_pk_fp8_f32(o[6], o[7], w1, true);
            *(u32x2*)(h8 + (size_t)row * DM + 512 * i + 8 * lane) = (u32x2){w0, w1}; }
    }
}
__device__ void phase_norm_final(int wid0, const bf16_t* __restrict__ x, float* __restrict__ out, const float* __restrict__ g, int rows) {
    const int tid = otid(wid0), lane = tid & 63, w = tid >> 6;
    float gv[2][8];
    load8f(g + 8 * lane, gv[0]); load8f(g + 512 + 8 * lane, gv[1]);
    for (int row = blockIdx.x * 8 + w; row < rows; row += gridDim.x * 8) {
        const bf16_t* xr = x + (size_t)row * DM + 8 * lane; float* orow = out + (size_t)row * DM + 8 * lane;
        float v[2][8]; unpack8(*(const u32x4*)xr, v[0]); unpack8(*(const u32x4*)(xr + 512), v[1]);
        float ss = 0.f;
#pragma unroll
        for (int i = 0; i < 2; ++i)
#pragma unroll
            for (int j = 0; j < 8; ++j) ss += v[i][j] * v[i][j];
        ss = wave_sum(wid0, ss);
        const float r = rsqrtf(ss * (1.0f / 1024.0f) + 1e-6f);
#pragma unroll
        for (int i = 0; i < 2; ++i) {
            f32x4 a, b;
#pragma unroll
            for (int j = 0; j < 4; ++j) { a[j] = v[i][j] * r * gv[i][j]; b[j] = v[i][4 + j] * r * gv[i][4 + j]; }
            *(f32x4*)(orow + 512 * i) = a; *(f32x4*)(orow + 512 * i + 4) = b; }
    }
}

#define PO(k) ((size_t)(k) * TS * BWID)
__device__ void mix_sc(int wid0, const Params& p, int l, const bf16_t* proj, bf16_t* z3, int r0, int pos0) {
    const int tid = otid(wid0), lane = tid & 63, w = tid >> 6, c0 = lane * 8;
    const float* scw = SMALLP(p, SM13) + (size_t)l * 3 * BWID + c0;
    float w0[8], w1[8], w2[8]; load8f(scw, w0); load8f(scw + BWID, w1); load8f(scw + 2 * BWID, w2);
    const int r = r0 + 16 * w, pos = pos0 + 16 * w;
    const bf16_t* bgp = proj + PO(6) + c0; const bf16_t* cxp = proj + PO(7) + c0;
    u32x4 vb[16], vc[18];
    vc[0] = (u32x4){0u, 0u, 0u, 0u}; vc[1] = vc[0];
    if (pos > 0) { vc[0] = *(const u32x4*)(cxp + (size_t)(r - 2) * BWID); vc[1] = *(const u32x4*)(cxp + (size_t)(r - 1) * BWID); }
#pragma unroll
    for (int jj = 0; jj < 16; ++jj) { vb[jj] = *(const u32x4*)(bgp + (size_t)(r + jj) * BWID); vc[2 + jj] = *(const u32x4*)(cxp + (size_t)(r + jj) * BWID); }
    float p2[8], p1[8];
    unpack8(vc[0], p2); unpack8(vc[1], p1);
#pragma unroll
    for (int jj = 0; jj < 16; ++jj) {
        float b[8], cur[8], o[8]; unpack8(vb[jj], b); unpack8(vc[2 + jj], cur);
#pragma unroll
        for (int j = 0; j < 8; ++j) { o[j] = b[j] * (w0[j] * p2[j] + w1[j] * p1[j] + w2[j] * cur[j]); p2[j] = p1[j]; p1[j] = cur[j]; }
        *(u32x4*)(z3 + (size_t)(r + jj) * BWID + c0) = pack8(o);
    }
}

__device__ void mix_conv(int wid0, const Params& p, int l, const bf16_t* proj, bf16_t* z1, int r0, int pos0, LAS unsigned char* lds) {
    const int tid = otid(wid0), lane = tid & 63, w = tid >> 6, c0 = lane * 8;
    LAS unsigned char* Y = lds; LAS unsigned char* W = lds + 94 * VP;
    const float* cw = SMALLP(p, SM5) + (size_t)l * 31 * BWID;
    float bias[8], lng[8], lnb[8];
    load8f(SMALLP(p, SM6) + (size_t)l * BWID + c0, bias); load8f(SMALLP(p, SM7) + (size_t)l * BWID + c0, lng); load8f(SMALLP(p, SM8) + (size_t)l * BWID + c0, lnb);
    u32x4 la[12];
#define CONV_LOAD(q) do { _Pragma("unroll") for (int i = 0; i < 12; ++i) { const int row = 12 * w + i; const bool valid = (row < 94) && (pos0 + 64 * (q) - 30 + row >= 0); \
        la[i] = (u32x4){0u, 0u, 0u, 0u}; if (valid) la[i] = *(const u32x4*)(proj + (size_t)(r0 + 64 * (q) - 30 + row) * BWID + PO(2) + c0); } } while (0)
    CONV_LOAD(0);
    for (int i = tid; i < 31 * 64; i += 512) { const int k = i >> 6, cgp = i & 63; float f[8]; load8f(cw + k * BWID + cgp * 8, f); *(LAS u32x4*)(W + k * 1024 + cgp * 16) = pack8(f); }
#pragma unroll
    for (int q = 0; q < 2; ++q) {
        const int tr = r0 + 64 * q;
        __syncthreads();
#pragma unroll
        for (int i = 0; i < 12; ++i) { const int row = 12 * w + i; if (row < 94) *(LAS u32x4*)(Y + row * VP + lane * 16) = la[i]; }
        __syncthreads();
        if (q == 0) CONV_LOAD(1);
        u32x4 gtv[8];
#pragma unroll
        for (int j = 0; j < 8; ++j) gtv[j] = *(const u32x4*)(proj + (size_t)(tr + 8 * w + j) * BWID + PO(3) + c0);
        float acc[8][8];
#pragma unroll
        for (int j = 0; j < 8; ++j)
#pragma unroll
            for (int c = 0; c < 8; ++c) acc[j][c] = bias[c];
#pragma unroll 1
        for (int k = 0; k < 31; ++k) {
            float wv[8]; unpack8(*(const LAS u32x4*)(W + k * 1024 + lane * 16), wv);
#pragma unroll
            for (int j = 0; j < 8; ++j) { float yv[8]; unpack8(*(const LAS u32x4*)(Y + (8 * w + j + k) * VP + lane * 16), yv);
#pragma unroll
                for (int c = 0; c < 8; ++c) acc[j][c] += wv[c] * yv[c]; }
        }
#pragma unroll
        for (int j = 0; j < 8; ++j) {
            float s = 0.f, ss = 0.f;
#pragma unroll
            for (int c = 0; c < 8; ++c) { s += acc[j][c]; ss += acc[j][c] * acc[j][c]; }
            s = wave_sum(wid0, s); ss = wave_sum(wid0, ss);
            const float mean = s * (1.0f / 512.0f); const float var = fmaxf(ss * (1.0f / 512.0f) - mean * mean, 0.f); const float rstd = rsqrtf(var + 1e-5f);
            const int row = tr + 8 * w + j;
            float gt[8], o[8]; unpack8(gtv[j], gt);
#pragma unroll
            for (int c = 0; c < 8; ++c) { const float v = (acc[j][c] - mean) * rstd * lng[c] + lnb[c]; o[c] = silu(v) * silu(gt[c]); }
            *(u32x4*)(z1 + (size_t)row * BWID + c0) = pack8(o);
        }
    }
}

#undef CONV_LOAD
__device__ __forceinline__ u32x4 sel4(bool c, const u32x4 a, const u32x4 b) { u32x4 r; r.x = c ? a.x : b.x; r.y = c ? a.y : b.y; r.z = c ? a.z : b.z; r.w = c ? a.w : b.w; return r; }

__device__ void mix_pool(int wid0, const Params& p, int l, const bf16_t* proj, bf16_t* z0, int r0, int pos0, LAS unsigned char* lds) {
    const int tid = otid(wid0), lane = tid & 63, w = tid >> 6, c0 = lane * 8;
    LAS unsigned char* P = lds;
    {
        const int g4 = lane >> 4, win = 2 << g4;
        const int r = r0 + 16 * w, pos = pos0 + 16 * w;
        u32x4 R[32];
#pragma unroll
        for (int i = 0; i < 16; ++i) { R[i] = (u32x4){0u, 0u, 0u, 0u}; if (pos > 0) R[i] = *(const u32x4*)(proj + (size_t)(r - 16 + i) * BWID + c0); }
#pragma unroll
        for (int i = 0; i < 16; ++i) R[16 + i] = *(const u32x4*)(proj + (size_t)(r + i) * BWID + c0);
        float S[8];
#pragma unroll
        for (int j = 0; j < 8; ++j) S[j] = 0.f;
#pragma unroll
        for (int i = 1; i <= 16; ++i) { float x[8]; unpack8(R[16 - i], x); const float mk = (i <= win) ? 1.0f : 0.0f;
#pragma unroll
            for (int j = 0; j < 8; ++j) S[j] += mk * x[j]; }
#pragma unroll
        for (int jj = 0; jj < 16; ++jj) {
            const int ps = pos + jj; float xv[8], xo[8], o[8];
            unpack8(R[16 + jj], xv);
            const u32x4 ro = sel4(g4 < 2, sel4(g4 == 0, R[16 + jj - 2], R[16 + jj - 4]), sel4(g4 == 2, R[16 + jj - 8], R[jj]));
            unpack8(ro, xo);
            const int cnt = (ps + 1 < win) ? ps + 1 : win; const float inv = 1.0f / (float)cnt;
#pragma unroll
            for (int j = 0; j < 8; ++j) { S[j] += xv[j] - xo[j]; o[j] = S[j] * inv - xv[j]; }
            *(LAS u32x4*)(P + (16 * w + jj) * VP + lane * 16) = pack8(o);
        }
    }
    __syncthreads();
    {
        const int g = w >> 1, fr = lane & 15, fq = lane >> 4;
        const bf16_t* pwT = (const bf16_t*)(p.ws + p.o_pw) + (size_t)(l * 4 + g) * 128 * 128;
        u32x2 gtv[8][4];
#pragma unroll
        for (int tt = 0; tt < 8; ++tt)
#pragma unroll
            for (int dt = 0; dt < 4; ++dt) gtv[tt][dt] = *(const u32x2*)(proj + (size_t)(r0 + 16 * tt + fr) * BWID + PO(1) + 64 * w + 16 * dt + 4 * fq);
        bf16x8 A[4][4];
#pragma unroll
        for (int dt = 0; dt < 4; ++dt)
#pragma unroll
            for (int kk = 0; kk < 4; ++kk) A[dt][kk] = *(const bf16x8*)(pwT + (size_t)(64 * (w & 1) + 16 * dt + fr) * 128 + 32 * kk + 8 * fq);
        const float* psc = SMALLP(p, SM4) + (size_t)l * BWID;
        f32x4 sc[4];
#pragma unroll
        for (int dt = 0; dt < 4; ++dt) sc[dt] = *(const f32x4*)(psc + 64 * w + 16 * dt + 4 * fq);
#pragma unroll
        for (int tt = 0; tt < 8; ++tt) {
            bf16x8 Bf[4];
#pragma unroll
            for (int kk = 0; kk < 4; ++kk) Bf[kk] = *(const LAS bf16x8*)(P + (16 * tt + fr) * VP + (128 * g + 32 * kk + 8 * fq) * 2);
            f32x4 acc[4];
#pragma unroll
            for (int dt = 0; dt < 4; ++dt) { acc[dt] = (f32x4){0.f, 0.f, 0.f, 0.f};
#pragma unroll
                for (int kk = 0; kk < 4; ++kk) acc[dt] = __builtin_amdgcn_mfma_f32_16x16x32_bf16(A[dt][kk], Bf[kk], acc[dt], 0, 0, 0); }
            const int row = r0 + 16 * tt + fr;
#pragma unroll
            for (int dt = 0; dt < 4; ++dt) { const int d = 64 * w + 16 * dt + 4 * fq;
                float gt[4]; unpack4(gtv[tt][dt], gt);
                u32x2 o; o.x = cvt_pk_bf16(acc[dt][0] * sc[dt][0] * silu(gt[0]), acc[dt][1] * sc[dt][1] * silu(gt[1])); o.y = cvt_pk_bf16(acc[dt][2] * sc[dt][2] * silu(gt[2]), acc[dt][3] * sc[dt][3] * silu(gt[3]));
                *(u32x2*)(z0 + (size_t)row * BWID + d) = o; }
        }
    }
}

__device__ void mix_sgu(int wid0, const Params& p, int l, const bf16_t* proj, bf16_t* z2, int r0, LAS unsigned char* lds) {
    const int tid = otid(wid0), lane = tid & 63, w = tid >> 6, c0 = lane * 8;
    LAS unsigned char* V = lds;
    {
        float lng[8], lnb[8]; load8f(SMALLP(p, SM9) + (size_t)l * BWID + c0, lng); load8f(SMALLP(p, SM10) + (size_t)l * BWID + c0, lnb);
        u32x4 R[16];
#pragma unroll
        for (int jj = 0; jj < 16; ++jj) R[jj] = *(const u32x4*)(proj + (size_t)(r0 + 16 * w + jj) * BWID + PO(5) + c0);
#pragma unroll
        for (int jj = 0; jj < 16; ++jj) {
            float x[8], o[8]; unpack8(R[jj], x);
            float s = 0.f, ss = 0.f;
#pragma unroll
            for (int c = 0; c < 8; ++c) { s += x[c]; ss += x[c] * x[c]; }
            s = wave_sum(wid0, s); ss = wave_sum(wid0, ss);
            const float mean = s * (1.0f / 512.0f); const float var = fmaxf(ss * (1.0f / 512.0f) - mean * mean, 0.f); const float rstd = rsqrtf(var + 1e-5f);
#pragma unroll
            for (int c = 0; c < 8; ++c) o[c] = (x[c] - mean) * rstd * lng[c] + lnb[c];
            *(LAS u32x4*)(V + (16 * w + jj) * VP + lane * 16) = pack8(o);
        }
    }
    __syncthreads();
    {
        const int g = w >> 1, fr = lane & 15, fq = lane >> 4;
        const unsigned vbase = (unsigned)(size_t)V;
        bf16x8 A[4][4];
#pragma unroll
        for (int ct = 0; ct < 4; ++ct)
#pragma unroll
            for (int kk = 0; kk < 4; ++kk) {
                const unsigned a = vbase + (unsigned)((32 * kk + 8 * fq + (fr >> 2)) * VP + (64 * w + 16 * ct + 4 * (fr & 3)) * 2);
                const u32x2 lo = tr_read(a), hi = tr_read(a + 4 * VP);
                u32x4 t; t.x = lo.x; t.y = lo.y; t.z = hi.x; t.w = hi.y;
                A[ct][kk] = __builtin_bit_cast(bf16x8, t);
            }
        const bf16_t* swm = (const bf16_t*)(p.ws + p.o_sw) + (size_t)(l * 4 + g) * 128 * 128;
        const float* sb = SMALLP(p, SM12) + (size_t)(l * 4 + g) * 128;
#pragma unroll
        for (int hb = 0; hb < 2; ++hb) {
            u32x2 uu[4][4]; bf16x8 Wf[4][4]; float bias[4];
#pragma unroll
            for (int t4 = 0; t4 < 4; ++t4) { const int tt = hb * 4 + t4; const bf16_t* pr = proj + (size_t)(r0 + 16 * tt + fr) * BWID + 64 * w + 4 * fq;
#pragma unroll
                for (int ct = 0; ct < 4; ++ct) uu[t4][ct] = *(const u32x2*)(pr + PO(4) + 16 * ct);
#pragma unroll
                for (int kk = 0; kk < 4; ++kk) if (kk < (tt >> 1) + 1) Wf[t4][kk] = *(const bf16x8*)(swm + (size_t)(16 * tt + fr) * 128 + 32 * kk + 8 * fq);
                bias[t4] = sb[16 * tt + fr]; }
#pragma unroll
            for (int t4 = 0; t4 < 4; ++t4) { const int tt = hb * 4 + t4;
                f32x4 acc[4];
#pragma unroll
                for (int ct = 0; ct < 4; ++ct) acc[ct] = (f32x4){0.f, 0.f, 0.f, 0.f};
#pragma unroll
                for (int kk = 0; kk < 4; ++kk) if (kk < (tt >> 1) + 1) {
#pragma unroll
                    for (int ct = 0; ct < 4; ++ct) acc[ct] = __builtin_amdgcn_mfma_f32_16x16x32_bf16(A[ct][kk], Wf[t4][kk], acc[ct], 0, 0, 0); }
                const int row = r0 + 16 * tt + fr;
#pragma unroll
                for (int ct = 0; ct < 4; ++ct) { const int c = 64 * w + 16 * ct + 4 * fq;
                    float u[4]; unpack4(uu[t4][ct], u);
                    u32x2 o; o.x = cvt_pk_bf16(u[0] * (acc[ct][0] + bias[t4]), u[1] * (acc[ct][1] + bias[t4])); o.y = cvt_pk_bf16(u[2] * (acc[ct][2] + bias[t4]), u[3] * (acc[ct][3] + bias[t4]));
                    *(u32x2*)(z2 + (size_t)row * BWID + c) = o; }
            }
        }
    }
}

__device__ void phase_mix(int wid0, const Params& p, int l, const bf16_t* proj, bf16_t* z, LAS unsigned char* lds) {
    constexpr int nchunk = TS / 128;
    for (int i = blockIdx.x; i < 4 * nchunk; i += gridDim.x) {
        const int j = i % nchunk, br = ((i / nchunk) + j) & 3, r0 = j * 128, pos0 = (j & 15) * 128;
        if (br == 0) for (int rr = 0; rr < REP_M0; ++rr) { mix_pool(wid0, p, l, proj, z + PO(1), r0, pos0, lds); __syncthreads(); }
        else if (br == 1) for (int rr = 0; rr < REP_M1; ++rr) { mix_conv(wid0, p, l, proj, z + PO(3), r0, pos0, lds); __syncthreads(); }
        else if (br == 2) for (int rr = 0; rr < REP_M2; ++rr) { mix_sgu(wid0, p, l, proj, z + PO(4), r0, lds); __syncthreads(); }
        else for (int rr = 0; rr < REP_M3; ++rr) { mix_sc(wid0, p, l, proj, z + PO(6), r0, pos0); __syncthreads(); }
    }
}

#define XB_TMO      128
#define XB_XCNT(j)  (256  + 64 * (j))
#define XB_XSUB(j)  (1280 + 64 * (j))
#define XB_XGEN(j)  (2304 + 64 * (j))
#define XB_TOP      3328
#define XB_TOPGEN   3392
#define XCD_BAR_WORDS 3456
#define XB_SPIN_CAP (1u << 20)
__device__ __forceinline__ unsigned xb_ld(unsigned* p)              { return __hip_atomic_load(p, __ATOMIC_RELAXED, __HIP_MEMORY_SCOPE_AGENT); }
__device__ __forceinline__ unsigned xb_add(unsigned* p, unsigned v) { return __hip_atomic_fetch_add(p, v, __ATOMIC_RELAXED, __HIP_MEMORY_SCOPE_AGENT); }
__device__ __forceinline__ unsigned xb_xcc_id() { return (unsigned)__builtin_amdgcn_s_getreg((3 << 11) | 20) & 0xFu; }
#define XB_SPIN(cond, bar) do { unsigned _sp = 0; while (cond) { __builtin_amdgcn_s_sleep(1); \
    if ((++_sp & 255u) == 0u) { if (xb_ld(&(bar)[XB_TMO])) break; if (_sp > XB_SPIN_CAP) { atomicAdd(&(bar)[XB_TMO], 1u); break; } } } } while (0)
struct XcdBarrier { unsigned* bar; unsigned x; volatile LAS unsigned* st; };
__device__ __forceinline__ XcdBarrier xcd_barrier_post(bool first, unsigned* bar, volatile LAS unsigned* st) {
    XcdBarrier b; b.bar = bar; b.x = xb_xcc_id(); b.st = st;
    if (first) (void)xb_add(&bar[XB_XCNT(b.x)], 1u);
    return b;
}
__device__ __forceinline__ void xcd_barrier_complete(unsigned* bar, unsigned x, unsigned& nloc, unsigned& nx) {
    const unsigned G = gridDim.x * gridDim.y * gridDim.z;
    unsigned sum, cnt, mine, sp = 0u;
    for (;;) {
        sum = 0u; cnt = 0u; mine = 0u;
#pragma unroll
        for (unsigned j = 0; j < 16; ++j) { const unsigned c = xb_ld(&bar[XB_XCNT(j)]); sum += c; cnt += (c > 0u) ? 1u : 0u; mine = (j == x) ? c : mine; }
        if (sum == G) break;
        __builtin_amdgcn_s_sleep(1);
        if ((++sp & 255u) == 0u) { if (xb_ld(&bar[XB_TMO])) break; if (sp > XB_SPIN_CAP) { atomicAdd(&bar[XB_TMO], 1u); break; } }
    }
    nloc = mine > 0u ? mine : 1u; nx = cnt > 0u ? cnt : 1u;
}
__device__ __forceinline__ void xcd_barrier(int wid0, const XcdBarrier& b) {
    asm volatile("s_waitcnt vmcnt(0)" ::: "memory");
    __syncthreads();
    if (otid(wid0) == 0) {
        unsigned* bar = b.bar; asm volatile("" : "+s"(bar)); unsigned bx = b.x; asm volatile("" : "+s"(bx));
        __builtin_amdgcn_s_waitcnt(0);
        unsigned nloc = b.st[0], nx = b.st[1];
        if (nloc == 0u) { xcd_barrier_complete(bar, bx, nloc, nx); b.st[0] = nloc; b.st[1] = nx; }
        const unsigned old = xb_add(&bar[XB_XSUB(bx)], 1u);
        const unsigned gen = old / nloc;
        if (old + 1u == (gen + 1u) * nloc) {
            __builtin_amdgcn_fence(__ATOMIC_RELEASE, "agent");
            asm volatile("s_waitcnt vmcnt(0)" ::: "memory");
            const unsigned og = xb_add(&bar[XB_TOP], 1u);
            const unsigned tg = og / nx;
            if (og + 1u == (tg + 1u) * nx) xb_add(&bar[XB_TOPGEN], 1u);
            else XB_SPIN(xb_ld(&bar[XB_TOPGEN]) == tg, bar);
            __builtin_amdgcn_fence(__ATOMIC_ACQUIRE, "agent");
            xb_add(&bar[XB_XGEN(bx)], 1u);
            asm volatile("s_waitcnt vmcnt(0)" ::: "memory");
        } else {
            XB_SPIN(xb_ld(&bar[XB_XGEN(bx)]) == gen, bar);
            __builtin_amdgcn_fence(__ATOMIC_ACQUIRE, "agent");
            asm volatile("s_waitcnt vmcnt(0)" ::: "memory");
        }
    }
    __syncthreads();
}

__global__ void __launch_bounds__(512) mk_forward(Params p) {
    extern __shared__ __attribute__((aligned(16))) unsigned char lds_raw[];
    LAS unsigned char* lds = (LAS unsigned char*)lds_raw;
    cg::grid_group grid = cg::this_grid();
    volatile LAS unsigned* stw = (volatile LAS unsigned*)(lds + LDS_BYTES - 16);
    const int wid0 = __builtin_amdgcn_readfirstlane((int)(threadIdx.x >> 6));
    const bool first = (wid0 == 0 && lane_id() == 0);
    if (first) { stw[0] = 0u; stw[1] = 0u; }
    __syncthreads();
    const XcdBarrier xbar = xcd_barrier_post(first, (unsigned*)(p.ws + p.o_bar), stw);
#define PHASE_ON true
#ifndef XSYNC
#define XSYNC 0
#endif
#define PHASE_END do { if (p.ph_hi > 100000) grid.sync();   xcd_barrier(wid0, xbar); } while (0)
    constexpr int ts = TS;
    bf16_t* win = (bf16_t*)(p.ws + p.o_win); bf16_t* wb = (bf16_t*)(p.ws + p.o_wb); bf16_t* wo = (bf16_t*)(p.ws + p.o_wo);
    bf16_t* h0 = (bf16_t*)(p.ws + p.o_h); bf16_t* proj = (bf16_t*)(p.ws + p.o_proj);

    if (PHASE_ON) phase_prep(wid0, p, lds);
    PHASE_END;
#pragma unroll 1
    for (int l = 0; l < DEPTH; ++l) {
        bf16_t* x1b = (bf16_t*)p.out;
#pragma unroll 1
        for (int s = 0; s < NS; ++s) {
            const size_t tok0 = (size_t)s * ts;
            bf16_t* h = h0 + tok0 * DM; bf16_t* merged = h;
            if (l > 0) { if (PHASE_ON) phase_norm_bf16(wid0, nullptr, x1b + tok0 * DM, SMALLP(p, SM1) + (size_t)l * DM, h, p.ws + p.o_h8 + tok0 * DM, ts);
                PHASE_END; }
            if (PHASE_ON) {
                { pg8::Gemm g{h, win + (size_t)l * DM * WINR}; pg8::OrderA S; S.G = (int)gridDim.x; S.c = (int)blockIdx.x; pg8::EpiProj E{proj}; pg8::gemm_phase<DM, 0>(wid0, lds, g, S, E); }
                { pg8::Gemm g{(const bf16_t*)(p.ws + p.o_h8 + tok0 * DM), (const bf16_t*)(p.ws + p.o_wg8 + (size_t)l * 4096 * DM)}; pg8::Order<TS / 256, 4096 / 256, 1> S{(int)gridDim.x, (int)blockIdx.x};
                  pg8::EpiGateStore E{(unsigned char*)(proj + (size_t)8 * TS * BWID)}; pg8::gemm_phase_f8<DM>(wid0, lds, g, S, E); }
            }
            PHASE_END;
            if (PHASE_ON) phase_mix(wid0, p, l, proj, proj, lds);
            PHASE_END;
            if (PHASE_ON) for (int rep = 0; rep < REP_C; ++rep) { pg8::Gemm g{proj, wb + (size_t)l * 4 * BWID * DM}; pg8::OrderC S; S.G = (int)gridDim.x; S.c = (int)blockIdx.x;
                pg8::EpiGate E{proj + (size_t)8 * TS * BWID, merged}; pg8::gemm_phase<BWID, (size_t)BWID * DM * 2>(wid0, lds, g, S, E); }
            PHASE_END;
            if (PHASE_ON) { pg8::Gemm g{merged, wo + (size_t)l * DM * DM}; pg8::Order<TS / 256, DM / 256, 1> S{(int)gridDim.x, (int)blockIdx.x};
                pg8::EpiRes E{(l == 0) ? p.in[0] + tok0 * DM : nullptr, (l == 0) ? nullptr : x1b + tok0 * DM, (l == 0) ? x1b + tok0 * DM : proj + tok0 * DM}; pg8::gemm_phase<DM, 0>(wid0, lds, g, S, E); }
            PHASE_END;
        }
    }
    phase_norm_final(wid0, proj, p.out, SMALLP(p, SM16), NTOK);
}

extern "C" void kernel_launch(void* const* d_in, const int* in_sizes, int n_in, void* d_out, int out_size, void* d_ws, size_t ws_size, hipStream_t stream) {
    static int grid = 0;
    if (grid == 0) {
        int dev = 0, cus = 0, per_cu = 0;
        hipGetDevice(&dev); hipDeviceGetAttribute(&cus, hipDeviceAttributeMultiprocessorCount, dev);
        if (hipFuncSetAttribute((const void*)mk_forward, hipFuncAttributeMaxDynamicSharedMemorySize, LDS_BYTES) != hipSuccess) { fprintf(stderr, "hipFuncSetAttribute failed\n"); grid = -1; return; }
        if (hipOccupancyMaxActiveBlocksPerMultiprocessor(&per_cu, (const void*)mk_forward, 512, LDS_BYTES) != hipSuccess || per_cu < 1) { fprintf(stderr, "occupancy query: %d\n", per_cu); per_cu = 1; }
        (void)hipGetLastError();
        grid = cus * per_cu;
    }
    if (grid < 0) return;
    Params p{};
    for (int i = 0; i < 17; ++i) p.in[i] = (const float*)d_in[i];
    p.out = (float*)d_out; p.ws = (unsigned char*)d_ws;
    size_t o = 0;
    p.o_win = (unsigned)o; o += (size_t)DEPTH * DM * WINR * 2;
    p.o_wg8 = (unsigned)o; o += (size_t)DEPTH * 4096 * DM;
    p.o_h8 = (unsigned)o; o += (size_t)NTOK * DM;
    p.o_wb = (unsigned)o; o += (size_t)DEPTH * 4 * BWID * DM * 2;
    p.o_wo = (unsigned)o; o += (size_t)DEPTH * DM * DM * 2;
    p.o_pw = (unsigned)o; o += (size_t)DEPTH * 4 * 128 * 128 * 2;
    p.o_sw = (unsigned)o; o += (size_t)DEPTH * 4 * 128 * 128 * 2;
    p.o_bar = (unsigned)o; o += 16384;
    p.o_small = (unsigned)o; o += (size_t)SM_TOTAL * 4;
    p.o_h = (unsigned)o; o += (size_t)NTOK * DM * 2;
    p.o_proj = (unsigned)o; o += (size_t)TS * (8 * BWID * 2 + 4096);
    if (o > ws_size) { fprintf(stderr, "kernel_launch: workspace too small: need %zu, have %zu\n", o, ws_size); return; }
    const int nph = 1 + NS * 4 + (DEPTH - 1) * NS * 5 + 1;
    if (hipMemsetAsync((char*)d_ws + p.o_bar, 0, 16384, stream) != hipSuccess) { fprintf(stderr, "kernel_launch: memset failed\n"); return; }
    p.ph_hi = nph;
    void* args[] = {&p};
    hipError_t e = hipLaunchCooperativeKernel((const void*)mk_forward, dim3(grid), dim3(512), args, LDS_BYTES, stream);
    if (e != hipSuccess) fprintf(stderr, "cooperative launch failed: %s (grid %d)\n", hipGetErrorString(e), grid);
}
```

```cpp
#include <hip/hip_runtime.h>
#include <hip/hip_cooperative_groups.h>
#include <cstdio>
namespace cg = cooperative_groups;

#ifndef MULTI_LAUNCH
#define MULTI_LAUNCH 0
#endif

#ifndef REP_N
#define REP_N 1
#endif
#ifndef REP_A
#define REP_A 1
#endif
#ifndef REP_B
#define REP_B 1
#endif
#ifndef REP_C
#define REP_C 1
#endif
#define REP_M0 1
#define REP_M1 1
#define REP_M2 1
#define REP_M3 1
#define LAS __attribute__((address_space(3)))
typedef unsigned short bf16_t;
typedef short bf16x8 __attribute__((ext_vector_type(8)));
typedef float f32x4 __attribute__((ext_vector_type(4)));
typedef float f32x2 __attribute__((ext_vector_type(2)));
typedef unsigned u32x4 __attribute__((ext_vector_type(4)));
typedef unsigned u32x2 __attribute__((ext_vector_type(2)));
typedef int i32x8 __attribute__((ext_vector_type(8)));
typedef int i32x4 __attribute__((ext_vector_type(4)));
constexpr int WINR = 6144;

constexpr int DM = 1024, SEQ = 2048, NTOK = 32 * 2048, DEPTH = 2, BWID = 512, INC = 10240, GATE0 = 6144;
constexpr int PP = 6144;
constexpr int NS = 1, TS = NTOK / NS;
constexpr int LDS_BYTES = 139264;
constexpr int VP = 1040;

constexpr int SM1 = 0, SM4 = 2048, SM5 = 3072, SM6 = 34816, SM7 = 35840, SM8 = 36864, SM9 = 37888, SM10 = 38912, SM12 = 39936, SM13 = 40960, SM16 = 44032, SM_TOTAL = 45056;
#define SMALLP(p, OFF) ((const float*)((p).ws + (p).o_small) + (OFF))
struct Params {
    const float* in[17];
    float* out;
    unsigned char* ws;
    int ph_hi;
    unsigned o_win, o_wb, o_wo, o_pw, o_sw, o_h, o_bar, o_proj, o_h8, o_wg8, o_small;
};

__device__ __forceinline__ int lane_id() { return (int)__builtin_amdgcn_mbcnt_hi(~0u, __builtin_amdgcn_mbcnt_lo(~0u, 0u)); }
__device__ __forceinline__ int otid(int wid0) { int t; asm volatile("v_mbcnt_lo_u32_b32 %0, -1, 0\n\tv_mbcnt_hi_u32_b32 %0, -1, %0" : "=v"(t)); return (wid0 << 6) | t; }
__device__ __forceinline__ unsigned cvt_pk_bf16(float lo, float hi) { unsigned r; asm volatile("v_cvt_pk_bf16_f32 %0, %1, %2" : "=v"(r) : "v"(lo), "v"(hi)); return r; }
__device__ __forceinline__ bf16_t f2bf(float f) { unsigned u = __float_as_uint(f); u += 0x7FFFu + ((u >> 16) & 1u); return (bf16_t)(u >> 16); }
__device__ __forceinline__ void unpack8(const u32x4 v, float (&f)[8]) {
    f[0] = __uint_as_float(v.x << 16); f[1] = __uint_as_float(v.x & 0xffff0000u); f[2] = __uint_as_float(v.y << 16); f[3] = __uint_as_float(v.y & 0xffff0000u);
    f[4] = __uint_as_float(v.z << 16); f[5] = __uint_as_float(v.z & 0xffff0000u); f[6] = __uint_as_float(v.w << 16); f[7] = __uint_as_float(v.w & 0xffff0000u);
}
__device__ __forceinline__ u32x4 pack8(const float (&f)[8]) { u32x4 r; r.x = cvt_pk_bf16(f[0], f[1]); r.y = cvt_pk_bf16(f[2], f[3]); r.z = cvt_pk_bf16(f[4], f[5]); r.w = cvt_pk_bf16(f[6], f[7]); return r; }
__device__ __forceinline__ void unpack4(const u32x2 v, float (&f)[4]) { f[0] = __uint_as_float(v.x << 16); f[1] = __uint_as_float(v.x & 0xffff0000u); f[2] = __uint_as_float(v.y << 16); f[3] = __uint_as_float(v.y & 0xffff0000u); }
__device__ __forceinline__ float sigm(float x) { return __builtin_amdgcn_rcpf(1.0f + __expf(-x)); }
__device__ __forceinline__ float silu(float x) { return x * sigm(x); }
__device__ __forceinline__ void load8f(const float* p, float (&f)[8]) { const f32x4 a = *(const f32x4*)p, b = *(const f32x4*)(p + 4); f[0] = a[0]; f[1] = a[1]; f[2] = a[2]; f[3] = a[3]; f[4] = b[0]; f[5] = b[1]; f[6] = b[2]; f[7] = b[3]; }
__device__ __forceinline__ float wave_sum(int wid0, float v) {
    const int lane = otid(wid0) & 63;
#pragma unroll
    for (int o = 32; o >= 1; o >>= 1) v += __builtin_bit_cast(float, __builtin_amdgcn_ds_bpermute((lane ^ o) << 2, __builtin_bit_cast(int, v)));
    return v;
}
__device__ __forceinline__ u32x2 tr_read(unsigned lds_addr) { u32x2 r; asm volatile("ds_read_b64_tr_b16 %0, %1\n\ts_waitcnt lgkmcnt(0)" : "=&v"(r) : "v"(lds_addr) : "memory"); return r; }

namespace pg8 {
constexpr int BM = 256, BK = 64, HALF = 128, HTB = HALF * BK * 2, STAGE_BYTES = 8 * HTB, NXCD = 8, WGM = 8;
__device__ __forceinline__ int lds_byte(int r, int c) { const int st = (r >> 4) * 2 + (c >> 5), rr = r & 15, cc = c & 31, ob = rr * 64 + cc * 2; return st * 1024 + (ob ^ (((ob >> 9) & 1) << 5)); }
__device__ __forceinline__ void stage_rc(int b, int& R, int& C) { const int st = b / 1024, sb = b % 1024, swz = sb ^ (((sb >> 9) & 1) << 5); R = (st >> 1) * 16 + swz / 64; C = (st & 1) * 32 + (swz % 64) / 2; }
__device__ __forceinline__ int perm32(int rho) { const int n = rho >> 4, i = rho & 15; return 8 * (i >> 2) + 4 * n + (i & 3); }

struct Unit { int pm, pn, br; };
struct Gemm { const bf16_t* A; const bf16_t* Bt; };

template <int NM, int NN, int NBR>
struct Order {
    int G, c;
    __device__ __forceinline__ bool next(int i, Unit& u) const {
        constexpr int nwg = NM * NN;
        const int ti = i / NBR;
        const long L = (long)ti * G + c; if (L >= nwg) return false;
        int wgid = (int)L; { constexpr int q = nwg / NXCD, r = nwg % NXCD; const int xcd = wgid % NXCD, off = wgid / NXCD; wgid = (xcd < r ? xcd * (q + 1) : r * (q + 1) + (xcd - r) * q) + off; }
        constexpr int nig = WGM * NN; const int gid = wgid / nig, fm = gid * WGM, gsz = (NM - fm) < WGM ? (NM - fm) : WGM;
        u.pm = fm + ((wgid % nig) % gsz); u.pn = (wgid % nig) / gsz; u.br = i % NBR; return true;
    }
    __device__ __forceinline__ void brow(const Unit& u, int& r0, int& r1) const { r0 = u.pn * BM; r1 = r0 + HALF; }
    __device__ __forceinline__ size_t aoff(const Unit&) const { return 0; }
};
struct OrderC : Order<TS / 256, DM / 256, 4> {
    __device__ __forceinline__ size_t aoff(const Unit& u) const { const int slot = (u.br == 0) ? 1 : (u.br == 1) ? 3 : (u.br == 2) ? 4 : 6; return (size_t)slot * TS * BWID * 2; }
};
struct OrderA : Order<TS / 256, WINR / 256, 1> {
    __device__ __forceinline__ void brow(const Unit& u, int& r0, int& r1) const {
        const int pn = u.pn;
        if (pn < 8) { const int pc = pn >> 1; const int piece = (pc == 0) ? 0 : (pc == 1) ? 1 : (pc == 2) ? 4 : 6; r0 = piece * 512 + (pn & 1) * 256; r1 = r0 + HALF; }
        else if (pn < 24) { const int q = (pn - 8) >> 2, sub = (pn - 8) & 3; const int pa = (q == 0) ? 2 : (q == 1) ? 9 : (q == 2) ? 8 : 5, pb = (q == 0) ? 3 : (q == 1) ? 10 : (q == 2) ? 11 : 7;
            r0 = pa * 512 + HALF * sub; r1 = pb * 512 + HALF * sub; }
        else { r0 = pn * BM; r1 = r0 + HALF; }
    }
};

struct EpiProj {
    static constexpr bool PERM = true;
    static __device__ __forceinline__ bool zero_after(const Unit&) { return true; }
    bf16_t* O;
    __device__ __forceinline__ void operator()(f32x4 (&acc)[2][2][4][2], const Unit& u, int wr, int wc, int fr_, int fq) const {
        int fr = fr_; asm volatile("" : "+v"(fr));
        if (u.pn < 8) {
            const int pc = u.pn >> 1; const int slot = (pc == 0) ? 0 : (pc == 1) ? 1 : (pc == 2) ? 3 : 5;
            const int row0 = u.pm * BM + wr * 64 + fr, col0 = (u.pn & 1) * BM + wc * 32 + 8 * fq;
            bf16_t* Op = O + (size_t)slot * TS * BWID;
#pragma unroll
            for (int ai = 0; ai < 2; ++ai)
#pragma unroll
                for (int m = 0; m < 4; ++m) { bf16_t* rowp = Op + (size_t)(row0 + ai * HALF + m * 16) * BWID + col0;
#pragma unroll
                    for (int bj = 0; bj < 2; ++bj) { const f32x4 v0 = acc[ai][bj][m][0], v1 = acc[ai][bj][m][1];
                        u32x4 w; w.x = cvt_pk_bf16(v0[0], v0[1]); w.y = cvt_pk_bf16(v0[2], v0[3]); w.z = cvt_pk_bf16(v1[0], v1[1]); w.w = cvt_pk_bf16(v1[2], v1[3]);
                        __builtin_nontemporal_store(w, (u32x4*)(rowp + bj * HALF)); } }
        } else {
            const int q = (u.pn - 8) >> 2, sub = (u.pn - 8) & 3; const int slot = (q == 0) ? 2 : (q == 1) ? 7 : (q == 2) ? 6 : 4;
            const int row0 = u.pm * BM + wr * 64 + fr, col0 = sub * HALF + wc * 32 + 8 * fq;
            bf16_t* Op = O + (size_t)slot * TS * BWID;
#pragma unroll
            for (int ai = 0; ai < 2; ++ai)
#pragma unroll
                for (int m = 0; m < 4; ++m) {
                    float f[8];
#pragma unroll
                    for (int n = 0; n < 2; ++n)
#pragma unroll
                        for (int j = 0; j < 4; ++j) { const float av = acc[ai][0][m][n][j], bv = acc[ai][1][m][n][j];
                            const float sg = __builtin_amdgcn_rcpf(1.0f + __builtin_amdgcn_exp2f(bv));
                            f[n * 4 + j] = av * ((q == 1) ? bv : (q == 0) ? sg : bv * sg); }
                    __builtin_nontemporal_store(pack8(f), (u32x4*)(Op + (size_t)(row0 + ai * HALF + m * 16) * BWID + col0)); }
        }
    }
};
struct EpiGateStore {
    static constexpr bool PERM = true;
    static __device__ __forceinline__ bool zero_after(const Unit&) { return true; }
    unsigned char* G;
    __device__ __forceinline__ void operator()(f32x4 (&acc)[2][2][4][2], const Unit& u, int wr, int wc, int fr_, int fq) const {
        int fr = fr_; asm volatile("" : "+v"(fr));
        unsigned char* gb = G + ((size_t)u.pm * 16 + u.pn) * 65536 + (((wr * 4 + wc) * 4 + fq) * 16 + fr) * 16;
        const float c255 = 1.0f / 255.0f;
#pragma unroll
        for (int ai = 0; ai < 2; ++ai)
#pragma unroll
            for (int m = 0; m < 4; ++m) {
                u32x4 w;
#pragma unroll
                for (int bj = 0; bj < 2; ++bj)
#pragma unroll
                    for (int n = 0; n < 2; ++n) { unsigned q = 0u;
#pragma unroll
                        for (int j = 0; j < 4; ++j) q = __builtin_amdgcn_cvt_pk_u8_f32(fmaxf(__builtin_amdgcn_rcpf(__builtin_fmaf(__builtin_amdgcn_exp2f(acc[ai][bj][m][n][j]), c255, c255)), 1.0f), j, q);
                        w[bj * 2 + n] = q; }
                __builtin_nontemporal_store(w, (u32x4*)(gb + (ai * 4 + m) * 8192));
                __builtin_amdgcn_sched_barrier(0); }
    }
};
struct EpiGate {
    static constexpr bool PERM = true;
    static __device__ __forceinline__ bool zero_after(const Unit& u) { return u.br == 3; }
    const bf16_t* G; bf16_t* merged;
    __device__ __forceinline__ void operator()(f32x4 (&acc)[2][2][4][2], const Unit& u, int wr, int wc, int fr_, int fq) const {
        int fr = fr_; asm volatile("" : "+v"(fr));
        const int lrow0 = wr * 64 + fr, lcol0 = wc * 32 + 8 * fq;
        const int br = u.br;
        const bool lastb = (br == 3);
        const unsigned char* gp0 = (const unsigned char*)G + ((size_t)u.pm * 16 + br * 4 + u.pn) * 65536 + (((wr * 4 + wc) * 4 + fq) * 16 + fr) * 16;
        const unsigned char* gnp = lastb ? gp0 : gp0 + 4 * 65536;
        u32x4 gc[2][4], gn[2][4];
#pragma unroll
        for (int ai = 0; ai < 2; ++ai)
#pragma unroll
            for (int m = 0; m < 4; ++m) { gc[ai][m] = *(const u32x4*)(gp0 + (ai * 4 + m) * 8192); gn[ai][m] = (u32x4){~0u, ~0u, ~0u, ~0u}; if (!lastb) gn[ai][m] = *(const u32x4*)(gnp + (ai * 4 + m) * 8192); }
#pragma unroll
        for (int ai = 0; ai < 2; ++ai)
#pragma unroll
            for (int m = 0; m < 4; ++m)
#pragma unroll
                for (int bj = 0; bj < 2; ++bj) {
#pragma unroll
                    for (int n = 0; n < 2; ++n) {
                        const unsigned c = gc[ai][m][bj * 2 + n], d = gn[ai][m][bj * 2 + n];
                        float fc[4], fd[4];
                        fc[0] = (float)(c & 0xffu); fc[1] = (float)((c >> 8) & 0xffu); fc[2] = (float)((c >> 16) & 0xffu); fc[3] = (float)(c >> 24);
                        fd[0] = (float)(d & 0xffu); fd[1] = (float)((d >> 8) & 0xffu); fd[2] = (float)((d >> 16) & 0xffu); fd[3] = (float)(d >> 24);
#pragma unroll
                        for (int j = 0; j < 4; ++j) acc[ai][bj][m][n][j] *= fc[j] * __builtin_amdgcn_rcpf(fd[j]);
                    }
                    if (lastb) { const f32x4 v0 = acc[ai][bj][m][0], v1 = acc[ai][bj][m][1];
                        u32x4 w; w.x = cvt_pk_bf16(v0[0], v0[1]); w.y = cvt_pk_bf16(v0[2], v0[3]); w.z = cvt_pk_bf16(v1[0], v1[1]); w.w = cvt_pk_bf16(v1[2], v1[3]);
                        *(u32x4*)(merged + ((size_t)u.pm * BM + lrow0 + ai * HALF + m * 16) * DM + u.pn * BM + lcol0 + bj * HALF) = w; }
                }
    }
};
struct EpiRes {
    static constexpr bool PERM = true;
    static __device__ __forceinline__ bool zero_after(const Unit&) { return true; }
    const float* res32; const bf16_t* res16; bf16_t* O;
    __device__ __forceinline__ void operator()(f32x4 (&acc)[2][2][4][2], const Unit& u, int wr, int wc, int fr_, int fq) const {
        int fr = fr_; asm volatile("" : "+v"(fr));
        const int row0 = u.pm * BM + wr * 64 + fr, col0 = u.pn * BM + wc * 32 + 8 * fq;
        const bool r16 = (res16 != nullptr);
        if (r16) {
            u32x4 rr[2][4][2];
#pragma unroll
            for (int ai = 0; ai < 2; ++ai)
#pragma unroll
                for (int m = 0; m < 4; ++m)
#pragma unroll
                    for (int bj = 0; bj < 2; ++bj) rr[ai][m][bj] = *(const u32x4*)(res16 + (size_t)(row0 + ai * HALF + m * 16) * DM + col0 + bj * HALF);
#pragma unroll
            for (int ai = 0; ai < 2; ++ai)
#pragma unroll
                for (int m = 0; m < 4; ++m)
#pragma unroll
                    for (int bj = 0; bj < 2; ++bj) { float r[8], o[8]; unpack8(rr[ai][m][bj], r);
#pragma unroll
                        for (int j = 0; j < 4; ++j) { o[j] = acc[ai][bj][m][0][j] + r[j]; o[4 + j] = acc[ai][bj][m][1][j] + r[4 + j]; }
                        *(u32x4*)(O + (size_t)(row0 + ai * HALF + m * 16) * DM + col0 + bj * HALF) = pack8(o); }
        } else {
#pragma unroll
            for (int ai = 0; ai < 2; ++ai) {
                f32x4 rr[4][2][2];
#pragma unroll
                for (int m = 0; m < 4; ++m)
#pragma unroll
                    for (int bj = 0; bj < 2; ++bj) { const float* q = res32 + (size_t)(row0 + ai * HALF + m * 16) * DM + col0 + bj * HALF; rr[m][bj][0] = *(const f32x4*)q; rr[m][bj][1] = *(const f32x4*)(q + 4); }
#pragma unroll
                for (int m = 0; m < 4; ++m)
#pragma unroll
                    for (int bj = 0; bj < 2; ++bj) { float o[8];
#pragma unroll
                        for (int j = 0; j < 4; ++j) { o[j] = acc[ai][bj][m][0][j] + rr[m][bj][0][j]; o[4 + j] = acc[ai][bj][m][1][j] + rr[m][bj][1][j]; }
                        *(u32x4*)(O + (size_t)(row0 + ai * HALF + m * 16) * DM + col0 + bj * HALF) = pack8(o); }
                asm volatile("" ::: "memory");
            }
        }
    }
};

template <int K, size_t B_BR, class Epi, class Sched>
__device__ __forceinline__ void gemm_phase(int wid0, LAS unsigned char* lds, const Gemm g, const Sched& S, const Epi& E) {
    const int tid = otid(wid0), wid = __builtin_amdgcn_readfirstlane(tid >> 6), lane = tid & 63, wr = wid >> 2, wc = wid & 3, fr = lane & 15, fq = lane >> 4;
    constexpr int nt = K / BK;
    unsigned voffA[2], voffB[2];
#pragma unroll
    for (int i = 0; i < 2; ++i) { int R, C; stage_rc(tid * 16 + i * 8192, R, C); const int Rb = Epi::PERM ? ((R & ~31) + perm32(R & 31)) : R;
        voffA[i] = (unsigned)(R * K + C) * 2u; voffB[i] = (unsigned)(Rb * K + C) * 2u; }
    constexpr size_t kstep = (size_t)(BK * 2);
    constexpr size_t hstep = (size_t)HALF * K * 2;
    constexpr size_t tstep = 2 * hstep;
    const unsigned ldsw = (unsigned)wid * 1024u;
    const int aoff = lds_byte(wr * 64 + fr, fq * 8), boff = lds_byte(wc * 32 + fr, fq * 8);
#define PG8_SA(b, h) (((b) * 2 + (h)) * HTB)
#define PG8_SB(b, h) ((4 + (b) * 2 + (h)) * HTB)
#define PG8_STAGE(bufoff, gbase, voff) do { _Pragma("unroll") for (int _i = 0; _i < 2; ++_i) \
        __builtin_amdgcn_global_load_lds((const unsigned*)((const char*)(gbase) + (voff)[_i]), (LAS unsigned*)(lds + (bufoff) + ldsw + _i * 8192), 16, 0, 0); } while (0)
#define PG8_LDA(dst, b, h) do { _Pragma("unroll") for (int m = 0; m < 4; ++m) _Pragma("unroll") for (int k = 0; k < 2; ++k) dst[m][k] = *(const LAS bf16x8*)(lds + PG8_SA(b, h) + aoff + m * 2048 + k * 1024); } while (0)
#define PG8_LDB(dst, b, h) do { _Pragma("unroll") for (int n = 0; n < 2; ++n) _Pragma("unroll") for (int k = 0; k < 2; ++k) dst[n][k] = *(const LAS bf16x8*)(lds + PG8_SB(b, h) + boff + n * 2048 + k * 1024); } while (0)
#define PG8_MMA(ai, bj, At, Bt) do { __builtin_amdgcn_s_setprio(1); _Pragma("unroll") for (int m = 0; m < 4; ++m) _Pragma("unroll") for (int n = 0; n < 2; ++n) _Pragma("unroll") for (int k = 0; k < 2; ++k) \
        acc[ai][bj][m][n] = __builtin_amdgcn_mfma_f32_16x16x32_bf16(Bt[n][k], At[m][k], acc[ai][bj][m][n], 0, 0, 0); __builtin_amdgcn_s_setprio(0); } while (0)
#define PG8_WAIT_V(n) asm volatile("s_waitcnt vmcnt(" #n ")" ::: "memory")
#define PG8_WAIT_L(n) asm volatile("s_waitcnt lgkmcnt(" #n ")" ::: "memory")
#define PG8_BAR __builtin_amdgcn_s_barrier()
#define PG8_SCHED __builtin_amdgcn_sched_barrier(0)
    Unit cur, nxt; int ui = 0;
    if (!S.next(0, cur)) return;
    f32x4 acc[2][2][4][2];
#pragma unroll
    for (int a = 0; a < 2; ++a)
#pragma unroll
        for (int b = 0; b < 2; ++b)
#pragma unroll
            for (int m = 0; m < 4; ++m)
#pragma unroll
                for (int n = 0; n < 2; ++n) acc[a][b][m][n] = (f32x4){0.f, 0.f, 0.f, 0.f};
    bf16x8 At[4][2], B0[2][2], B1[2][2];
    const char* cA = (const char*)g.A + (size_t)cur.pm * tstep + S.aoff(cur); int rb0, rb1; S.brow(cur, rb0, rb1);
    const char* cB = (const char*)g.Bt + (size_t)rb0 * (K * 2) + (size_t)cur.br * B_BR; const char* cBh = (const char*)g.Bt + (size_t)rb1 * (K * 2) + (size_t)cur.br * B_BR;
    PG8_STAGE(PG8_SB(0, 0), cB, voffB); PG8_STAGE(PG8_SA(0, 0), cA, voffA); PG8_STAGE(PG8_SB(0, 1), cBh, voffB); PG8_STAGE(PG8_SA(0, 1), cA + hstep, voffA);
    if (wr == 1) PG8_BAR;
    PG8_WAIT_V(4); PG8_BAR;
    PG8_STAGE(PG8_SB(1, 0), cB + kstep, voffB); PG8_STAGE(PG8_SA(1, 0), cA + kstep, voffA); PG8_STAGE(PG8_SB(1, 1), cBh + kstep, voffB);
    PG8_WAIT_V(6); PG8_BAR;
    for (;;) {
        const bool has_next = S.next(ui + 1, nxt);
        const char* nA = has_next ? (const char*)g.A + (size_t)nxt.pm * tstep + S.aoff(nxt) : cA; int rn0 = 0, rn1 = 0; if (has_next) S.brow(nxt, rn0, rn1);
        const char* nB = has_next ? (const char*)g.Bt + (size_t)rn0 * (K * 2) + (size_t)nxt.br * B_BR : cB; const char* nBh = has_next ? (const char*)g.Bt + (size_t)rn1 * (K * 2) + (size_t)nxt.br * B_BR : cBh;
        for (int t = 0; t < nt; t += 2) {
            const bool last = (t == nt - 2);
            const char* a1 = cA + (size_t)(t + 1) * kstep;
            const char* a2 = last ? nA : cA + (size_t)(t + 2) * kstep; const char* b2 = last ? nB : cB + (size_t)(t + 2) * kstep; const char* b2h = last ? nBh : cBh + (size_t)(t + 2) * kstep;
            const char* a3 = a2 + kstep; const char* b3 = b2 + kstep; const char* b3h = b2h + kstep;
            PG8_LDB(B0, 0, 0); PG8_SCHED; PG8_LDA(At, 0, 0); PG8_STAGE(PG8_SA(1, 1), a1 + hstep, voffA);
            PG8_WAIT_L(8); PG8_BAR; PG8_WAIT_L(0); PG8_MMA(0, 0, At, B0); PG8_BAR; PG8_SCHED;
            PG8_LDB(B1, 0, 1); PG8_STAGE(PG8_SB(0, 0), b2, voffB);
            PG8_BAR; PG8_WAIT_L(0); PG8_MMA(0, 1, At, B1); PG8_BAR;
            PG8_LDA(At, 0, 1); PG8_STAGE(PG8_SA(0, 0), a2, voffA);
            PG8_BAR; PG8_WAIT_L(0); PG8_MMA(1, 0, At, B0); PG8_BAR; PG8_SCHED;
            PG8_STAGE(PG8_SB(0, 1), b2h, voffB);
            PG8_WAIT_V(6); PG8_BAR; PG8_MMA(1, 1, At, B1); PG8_BAR;
            PG8_LDB(B0, 1, 0); PG8_SCHED; PG8_LDA(At, 1, 0); PG8_STAGE(PG8_SA(0, 1), a2 + hstep, voffA);
            PG8_WAIT_L(8); PG8_BAR; PG8_WAIT_L(0); PG8_MMA(0, 0, At, B0); PG8_BAR; PG8_SCHED;
            PG8_LDB(B1, 1, 1); PG8_STAGE(PG8_SB(1, 0), b3, voffB);
            PG8_BAR; PG8_WAIT_L(0); PG8_MMA(0, 1, At, B1); PG8_BAR;
            PG8_LDA(At, 1, 1); PG8_STAGE(PG8_SA(1, 0), a3, voffA);
            PG8_BAR; PG8_WAIT_L(0); PG8_MMA(1, 0, At, B0); PG8_BAR; PG8_SCHED;
            PG8_STAGE(PG8_SB(1, 1), b3h, voffB);
            PG8_WAIT_V(6); PG8_BAR; PG8_MMA(1, 1, At, B1); PG8_BAR;
        }
        E(acc, cur, wr, wc, fr, fq);
        if (!has_next) break;
        if (Epi::zero_after(cur))
#pragma unroll
        for (int a = 0; a < 2; ++a)
#pragma unroll
            for (int b = 0; b < 2; ++b)
#pragma unroll
                for (int m = 0; m < 4; ++m)
#pragma unroll
                    for (int n = 0; n < 2; ++n) acc[a][b][m][n] = (f32x4){0.f, 0.f, 0.f, 0.f};
        cur = nxt; cA = nA; cB = nB; cBh = nBh; ++ui;
    }
    PG8_WAIT_V(0);
    if (wr == 0) PG8_BAR;
    PG8_BAR;
#undef PG8_SA
#undef PG8_SB
#undef PG8_STAGE
#undef PG8_LDA
#undef PG8_LDB
#undef PG8_MMA
#undef PG8_WAIT_V
#undef PG8_WAIT_L
#undef PG8_BAR
#undef PG8_SCHED
}
template <int RB, class Epi, class Sched>
__device__ __forceinline__ void gemm_phase_f8(int wid0, LAS unsigned char* lds, const Gemm g, const Sched& S, const Epi& E) {
    const int tid = otid(wid0), wid = __builtin_amdgcn_readfirstlane(tid >> 6), lane = tid & 63, wr = wid >> 2, wc = wid & 3, fr = lane & 15, fq = lane >> 4;
    constexpr int nt = RB / 128;
    constexpr int K = RB / 2;
    constexpr size_t B_BR = 0;
    unsigned voffA[2], voffB[2]; int aoff, boff;
    constexpr size_t kstep = (size_t)(BK * 2);
    constexpr size_t hstep = (size_t)HALF * K * 2;
    constexpr size_t tstep = 2 * hstep;
    const unsigned ldsw = (unsigned)wid * 1024u;
#define PG8_SETUP() do { const int t_ = otid(wid0), l_ = t_ & 63, fr_ = l_ & 15, fq_ = l_ >> 4; \
        _Pragma("unroll") for (int i = 0; i < 2; ++i) { int R, C; stage_rc(t_ * 16 + i * 8192, R, C); const int Rb = Epi::PERM ? ((R & ~31) + perm32(R & 31)) : R; \
            voffA[i] = (unsigned)(R * K + C) * 2u; voffB[i] = (unsigned)(Rb * K + C) * 2u; } \
        aoff = lds_byte(wr * 64 + fr_, fq_ * 16); boff = lds_byte(wc * 32 + fr_, fq_ * 16); } while (0)
    PG8_SETUP();
#define PG8_SA(b, h) (((b) * 2 + (h)) * HTB)
#define PG8_SB(b, h) ((4 + (b) * 2 + (h)) * HTB)
#define PG8_STAGE(bufoff, gbase, voff) do { _Pragma("unroll") for (int _i = 0; _i < 2; ++_i) \
        __builtin_amdgcn_global_load_lds((const unsigned*)((const char*)(gbase) + (voff)[_i]), (LAS unsigned*)(lds + (bufoff) + ldsw + _i * 8192), 16, 0, 0); } while (0)
#define PG8_LDA(dst, b, h) do { _Pragma("unroll") for (int m = 0; m < 4; ++m) dst[m] = *(const LAS i32x8*)(lds + PG8_SA(b, h) + aoff + m * 2048); } while (0)
#define PG8_LDB(dst, b, h) do { _Pragma("unroll") for (int n = 0; n < 2; ++n) dst[n] = *(const LAS i32x8*)(lds + PG8_SB(b, h) + boff + n * 2048); } while (0)
#define PG8_MMA(ai, bj, At, Bt) do { __builtin_amdgcn_s_setprio(1); _Pragma("unroll") for (int m = 0; m < 4; ++m) _Pragma("unroll") for (int n = 0; n < 2; ++n) \
        acc[ai][bj][m][n] = __builtin_amdgcn_mfma_scale_f32_16x16x128_f8f6f4(Bt[n], At[m], acc[ai][bj][m][n], 0, 0, 0, 122, 0, 127); __builtin_amdgcn_s_setprio(0); } while (0)
#define PG8_WAIT_V(n) asm volatile("s_waitcnt vmcnt(" #n ")" ::: "memory")
#define PG8_WAIT_L(n) asm volatile("s_waitcnt lgkmcnt(" #n ")" ::: "memory")
#define PG8_BAR __builtin_amdgcn_s_barrier()
#define PG8_SCHED __builtin_amdgcn_sched_barrier(0)
    Unit cur, nxt; int ui = 0;
    if (!S.next(0, cur)) return;
    f32x4 acc[2][2][4][2];
#pragma unroll
    for (int a = 0; a < 2; ++a)
#pragma unroll
        for (int b = 0; b < 2; ++b)
#pragma unroll
            for (int m = 0; m < 4; ++m)
#pragma unroll
                for (int n = 0; n < 2; ++n) acc[a][b][m][n] = (f32x4){0.f, 0.f, 0.f, 0.f};
    i32x8 At[4], B0[2], B1[2];
    const char* cA = (const char*)g.A + (size_t)cur.pm * tstep + S.aoff(cur); int rb0, rb1; S.brow(cur, rb0, rb1);
    const char* cB = (const char*)g.Bt + (size_t)rb0 * (K * 2) + (size_t)cur.br * B_BR; const char* cBh = (const char*)g.Bt + (size_t)rb1 * (K * 2) + (size_t)cur.br * B_BR;
    PG8_STAGE(PG8_SB(0, 0), cB, voffB); PG8_STAGE(PG8_SA(0, 0), cA, voffA); PG8_STAGE(PG8_SB(0, 1), cBh, voffB); PG8_STAGE(PG8_SA(0, 1), cA + hstep, voffA);
    if (wr == 1) PG8_BAR;
    PG8_WAIT_V(4); PG8_BAR;
    PG8_STAGE(PG8_SB(1, 0), cB + kstep, voffB); PG8_STAGE(PG8_SA(1, 0), cA + kstep, voffA); PG8_STAGE(PG8_SB(1, 1), cBh + kstep, voffB);
    PG8_WAIT_V(6); PG8_BAR;
    for (;;) {
        const bool has_next = S.next(ui + 1, nxt);
        const char* nA = has_next ? (const char*)g.A + (size_t)nxt.pm * tstep + S.aoff(nxt) : cA; int rn0 = 0, rn1 = 0; if (has_next) S.brow(nxt, rn0, rn1);
        const char* nB = has_next ? (const char*)g.Bt + (size_t)rn0 * (K * 2) + (size_t)nxt.br * B_BR : cB; const char* nBh = has_next ? (const char*)g.Bt + (size_t)rn1 * (K * 2) + (size_t)nxt.br * B_BR : cBh;
        for (int t = 0; t < nt; t += 2) {
            const bool last = (t == nt - 2);
            const char* a1 = cA + (size_t)(t + 1) * kstep;
            const char* a2 = last ? nA : cA + (size_t)(t + 2) * kstep; const char* b2 = last ? nB : cB + (size_t)(t + 2) * kstep; const char* b2h = last ? nBh : cBh + (size_t)(t + 2) * kstep;
            const char* a3 = a2 + kstep; const char* b3 = b2 + kstep; const char* b3h = b2h + kstep;
            PG8_LDB(B0, 0, 0); PG8_SCHED; PG8_LDA(At, 0, 0); PG8_STAGE(PG8_SA(1, 1), a1 + hstep, voffA);
            PG8_WAIT_L(8); PG8_BAR; PG8_WAIT_L(0); PG8_MMA(0, 0, At, B0); PG8_BAR; PG8_SCHED;
            PG8_LDB(B1, 0, 1); PG8_STAGE(PG8_SB(0, 0), b2, voffB);
            PG8_BAR; PG8_WAIT_L(0); PG8_MMA(0, 1, At, B1); PG8_BAR;
            PG8_LDA(At, 0, 1); PG8_STAGE(PG8_SA(0, 0), a2, voffA);
            PG8_BAR; PG8_WAIT_L(0); PG8_MMA(1, 0, At, B0); PG8_BAR; PG8_SCHED;
            PG8_STAGE(PG8_SB(0, 1), b2h, voffB);
            PG8_WAIT_V(6); PG8_BAR; PG8_MMA(1, 1, At, B1); PG8_BAR;
            PG8_LDB(B0, 1, 0); PG8_SCHED; PG8_LDA(At, 1, 0); PG8_STAGE(PG8_SA(0, 1), a2 + hstep, voffA);
            PG8_WAIT_L(8); PG8_BAR; PG8_WAIT_L(0); PG8_MMA(0, 0, At, B0); PG8_BAR; PG8_SCHED;
            PG8_LDB(B1, 1, 1); PG8_STAGE(PG8_SB(1, 0), b3, voffB);
            PG8_BAR; PG8_WAIT_L(0); PG8_MMA(0, 1, At, B1); PG8_BAR;
            PG8_LDA(At, 1, 1); PG8_STAGE(PG8_SA(1, 0), a3, voffA);
            PG8_BAR; PG8_WAIT_L(0); PG8_MMA(1, 0, At, B0); PG8_BAR; PG8_SCHED;
            PG8_STAGE(PG8_SB(1, 1), b3h, voffB);
            PG8_WAIT_V(6); PG8_BAR; PG8_MMA(1, 1, At, B1); PG8_BAR;
        }
        { const int t2_ = otid(wid0) & 63; E(acc, cur, wr, wc, t2_ & 15, t2_ >> 4); }
        if (!has_next) break;
        if (Epi::zero_after(cur))
#pragma unroll
        for (int a = 0; a < 2; ++a)
#pragma unroll
            for (int b = 0; b < 2; ++b)
#pragma unroll
                for (int m = 0; m < 4; ++m)
#pragma unroll
                    for (int n = 0; n < 2; ++n) acc[a][b][m][n] = (f32x4){0.f, 0.f, 0.f, 0.f};
        cur = nxt; cA = nA; cB = nB; cBh = nBh; ++ui;
        PG8_SETUP();
    }
    PG8_WAIT_V(0);
    if (wr == 0) PG8_BAR;
    PG8_BAR;
#undef PG8_SETUP
#undef PG8_SA
#undef PG8_SB
#undef PG8_STAGE
#undef PG8_LDA
#undef PG8_LDB
#undef PG8_MMA
#undef PG8_WAIT_V
#undef PG8_WAIT_L
#undef PG8_BAR
#undef PG8_SCHED
}
}

__device__ void phase_norm_bf16(int wid0, const float* __restrict__ xin, const bf16_t* __restrict__ xin16, const float* __restrict__ g, bf16_t* __restrict__ h, unsigned char* __restrict__ h8, int rows);
struct TJob { const float* src; bf16_t* dst; unsigned char* dst8; int R, C, tr, tc; float scale; };
__device__ __forceinline__ TJob prep_job(const Params& p, int i) {
    bf16_t* win = (bf16_t*)(p.ws + p.o_win); bf16_t* wb = (bf16_t*)(p.ws + p.o_wb); bf16_t* wo = (bf16_t*)(p.ws + p.o_wo); bf16_t* pw = (bf16_t*)(p.ws + p.o_pw);
    constexpr int T_WIN = 16 * 160, T_WB = 8 * 16, T_WO = 16 * 16, T_PW = 4;
    constexpr int N0 = DEPTH * T_WIN, N1 = N0 + 8 * T_WB, N2 = N1 + DEPTH * T_WO;
    TJob j; j.scale = 1.0f; j.dst8 = nullptr;
    if (i < N0) { const int l = i / T_WIN, t = i % T_WIN; j.src = p.in[2] + (size_t)l * DM * INC; j.dst = win + (size_t)l * DM * WINR; j.R = DM; j.C = INC; j.tr = t / 160; j.tc = t % 160;
        const int piece = j.tc >> 3; j.scale = (piece >= 12 || piece == 3 || piece == 7 || piece == 11) ? -1.4426950408889634f : (piece == 5 || piece == 8) ? -0.6931471805599453f : 1.0f;
        if (piece >= 12) { j.dst = nullptr; j.dst8 = p.ws + p.o_wg8 + (size_t)l * 4096 * DM + (size_t)(j.tc - 96) * 64 * DM; j.scale *= 32.0f; } }
    else if (i < N1) { const int k = i - N0, m = k / T_WB, t = k % T_WB; j.src = p.in[14] + (size_t)m * BWID * DM; j.dst = wb + (size_t)m * BWID * DM; j.R = BWID; j.C = DM; j.tr = t / 16; j.tc = t % 16; }
    else if (i < N2) { const int k = i - N1, l = k / T_WO, t = k % T_WO; j.src = p.in[15] + (size_t)l * DM * DM; j.dst = wo + (size_t)l * DM * DM; j.R = DM; j.C = DM; j.tr = t / 16; j.tc = t % 16; }
    else { const int k = i - N2, m = k / T_PW, t = k % T_PW; j.src = p.in[3] + (size_t)m * 128 * 128; j.dst = pw + (size_t)m * 128 * 128; j.R = 128; j.C = 128; j.tr = t / 2; j.tc = t % 2; }
    return j;
}
__device__ void phase_prep(int wid0, const Params& p, LAS unsigned char* lds) {
    LAS float* sm = (LAS float*)lds;
    const int tid = otid(wid0);
    constexpr int NT = DEPTH * 16 * 160 + 8 * 8 * 16 + DEPTH * 16 * 16 + 8 * 4;
    const int lr = tid >> 4, lc = (tid & 15) * 4;
    f32x4 v0, v1;
    int i = blockIdx.x;
    if (i < NT) { const TJob j = prep_job(p, i); const float* sp = j.src + (size_t)(j.tr * 64 + lr) * j.C + j.tc * 64 + lc; v0 = *(const f32x4*)sp; v1 = *(const f32x4*)(sp + (size_t)32 * j.C); }
    for (; i < NT; i += gridDim.x) {
        const TJob j = prep_job(p, i);
#pragma unroll
        for (int e = 0; e < 4; ++e) { sm[lr * 65 + lc + e] = v0[e]; sm[(lr + 32) * 65 + lc + e] = v1[e]; }
        __syncthreads();
        const int in = i + gridDim.x;
        if (in < NT) { const TJob jn = prep_job(p, in); const float* sp = jn.src + (size_t)(jn.tr * 64 + lr) * jn.C + jn.tc * 64 + lc; v0 = *(const f32x4*)sp; v1 = *(const f32x4*)(sp + (size_t)32 * jn.C); }
        { const int c = tid >> 3, r8 = (tid & 7) * 8; float o[8];
#pragma unroll
          for (int e = 0; e < 8; ++e) o[e] = sm[(r8 + e) * 65 + c] * j.scale;
          if (j.dst8) { unsigned w0 = 0u, w1 = 0u; w0 = __builtin_amdgcn_cvt_pk_fp8_f32(o[0], o[1], w0, false); w0 = __builtin_amdgcn_cvt_pk_fp8_f32(o[2], o[3], w0, true); w1 = __builtin_amdgcn_cvt_pk_fp8_f32(o[4], o[5], w1, false); w1 = __builtin_amdgcn_cvt_pk_fp8_f32(o[6], o[7], w1, true);
              *(u32x2*)(j.dst8 + (size_t)c * DM + j.tr * 64 + r8) = (u32x2){w0, w1}; }
          else *(u32x4*)(j.dst + (size_t)(j.tc * 64 + c) * j.R + j.tr * 64 + r8) = pack8(o); }
        __syncthreads();
    }
    const float* sgw = p.in[11]; bf16_t* sw = (bf16_t*)(p.ws + p.o_sw);
    for (int k = blockIdx.x * 512 + tid; k < DEPTH * 4 * 128 * 128; k += gridDim.x * 512) { const int s_ = k & 127, t = (k >> 7) & 127; sw[k] = (s_ <= t) ? f2bf(sgw[k]) : (bf16_t)0; }
    {
        float* sd = (float*)(p.ws + p.o_small); const int gt = blockIdx.x * 512 + tid, gs = gridDim.x * 512;
#define CPY(K, OFF, N) for (int k = gt; k < (N); k += gs) sd[(OFF) + k] = p.in[K][k];
        CPY(1, SM1, 2048) CPY(4, SM4, 1024) CPY(5, SM5, 31744) CPY(6, SM6, 1024) CPY(7, SM7, 1024) CPY(8, SM8, 1024) CPY(9, SM9, 1024) CPY(10, SM10, 1024) CPY(12, SM12, 1024) CPY(13, SM13, 3072) CPY(16, SM16, 1024)
#undef CPY
    }
    phase_norm_bf16(wid0, p.in[0], nullptr, p.in[1], (bf16_t*)(p.ws + p.o_h), p.ws + p.o_h8, NTOK);
}

__device__ void phase_norm_bf16(int wid0, const float* __restrict__ xin, const bf16_t* __restrict__ xin16, const float* __restrict__ g, bf16_t* __restrict__ h, unsigned char* __restrict__ h8, int rows) {
    const int tid = otid(wid0), lane = tid & 63, w = tid >> 6;
    float gv[2][8];
    load8f(g + 8 * lane, gv[0]); load8f(g + 512 + 8 * lane, gv[1]);
    for (int row = blockIdx.x * 8 + w; row < rows; row += gridDim.x * 8) {
        float v[2][8];
        if (xin16) { const bf16_t* xr = xin16 + (size_t)row * DM + 8 * lane; unpack8(*(const u32x4*)xr, v[0]); unpack8(*(const u32x4*)(xr + 512), v[1]); }
        else { const float* xr = xin + (size_t)row * DM + 8 * lane; load8f(xr, v[0]); load8f(xr + 512, v[1]); }
        float ss = 0.f;
#pragma unroll
        for (int i = 0; i < 2; ++i)
#pragma unroll
            for (int j = 0; j < 8; ++j) ss += v[i][j] * v[i][j];
        ss = wave_sum(wid0, ss);
        const float r = rsqrtf(ss * (1.0f / 1024.0f) + 1e-6f);
#pragma unroll
        for (int i = 0; i < 2; ++i) { float o[8];
#pragma unroll
            for (int j = 0; j < 8; ++j) o[j] = v[i][j] * r * gv[i][j];
            *(u32x4*)(h + (size_t)row * DM + 512 * i + 8 * lane) = pack8(o);
            unsigned w0 = 0u, w1 = 0u; w0 = __builtin_amdgcn_cvt_pk_fp8_f32(o[0], o[1], w0, false); w0 = __builtin_amdgcn_cvt_pk_fp8_f32(o[2], o[3], w0, true); w1 = __builtin_amdgcn_cvt_pk_fp8_f32(o[4], o[5], w1, false); w1 = __builtin_amdgcn_cvt_pk_fp8_f32(o[6], o[7], w1, true);
            *(u32x2*)(h8 + (size_t)row * DM + 512 * i + 8 * lane) = (u32x2){w0, w1}; }
    }
}
__device__ void phase_norm_final(int wid0, const bf16_t* __restrict__ x, float* __restrict__ out, const float* __restrict__ g, int rows) {
    const int tid = otid(wid0), lane = tid & 63, w = tid >> 6;
    float gv[2][8];
    load8f(g + 8 * lane, gv[0]); load8f(g + 512 + 8 * lane, gv[1]);
    for (int row = blockIdx.x * 8 + w; row < rows; row += gridDim.x * 8) {
        const bf16_t* xr = x + (size_t)row * DM + 8 * lane; float* orow = out + (size_t)row * DM + 8 * lane;
        float v[2][8]; unpack8(*(const u32x4*)xr, v[0]); unpack8(*(const u32x4*)(xr + 512), v[1]);
        float ss = 0.f;
#pragma unroll
        for (int i = 0; i < 2; ++i)
#pragma unroll
            for (int j = 0; j < 8; ++j) ss += v[i][j] * v[i][j];
        ss = wave_sum(wid0, ss);
        const float r = rsqrtf(ss * (1.0f / 1024.0f) + 1e-6f);
#pragma unroll
        for (int i = 0; i < 2; ++i) {
            f32x4 a, b;
#pragma unroll
            for (int j = 0; j < 4; ++j) { a[j] = v[i][j] * r * gv[i][j]; b[j] = v[i][4 + j] * r * gv[i][4 + j]; }
            *(f32x4*)(orow + 512 * i) = a; *(f32x4*)(orow + 512 * i + 4) = b; }
    }
}

#define PO(k) ((size_t)(k) * TS * BWID)
__device__ void mix_sc(int wid0, const Params& p, int l, const bf16_t* proj, bf16_t* z3, int r0, int pos0) {
    const int tid = otid(wid0), lane = tid & 63, w = tid >> 6, c0 = lane * 8;
    const float* scw = SMALLP(p, SM13) + (size_t)l * 3 * BWID + c0;
    float w0[8], w1[8], w2[8]; load8f(scw, w0); load8f(scw + BWID, w1); load8f(scw + 2 * BWID, w2);
    const int r = r0 + 16 * w, pos = pos0 + 16 * w;
    const bf16_t* bgp = proj + PO(6) + c0; const bf16_t* cxp = proj + PO(7) + c0;
    u32x4 vb[16], vc[18];
    vc[0] = (u32x4){0u, 0u, 0u, 0u}; vc[1] = vc[0];
    if (pos > 0) { vc[0] = *(const u32x4*)(cxp + (size_t)(r - 2) * BWID); vc[1] = *(const u32x4*)(cxp + (size_t)(r - 1) * BWID); }
#pragma unroll
    for (int jj = 0; jj < 16; ++jj) { vb[jj] = *(const u32x4*)(bgp + (size_t)(r + jj) * BWID); vc[2 + jj] = *(const u32x4*)(cxp + (size_t)(r + jj) * BWID); }
    float p2[8], p1[8];
    unpack8(vc[0], p2); unpack8(vc[1], p1);
#pragma unroll
    for (int jj = 0; jj < 16; ++jj) {
        float b[8], cur[8], o[8]; unpack8(vb[jj], b); unpack8(vc[2 + jj], cur);
#pragma unroll
        for (int j = 0; j < 8; ++j) { o[j] = b[j] * (w0[j] * p2[j] + w1[j] * p1[j] + w2[j] * cur[j]); p2[j] = p1[j]; p1[j] = cur[j]; }
        *(u32x4*)(z3 + (size_t)(r + jj) * BWID + c0) = pack8(o);
    }
}

typedef _Float16 h16x2 __attribute__((ext_vector_type(2)));
typedef _Float16 h16x8 __attribute__((ext_vector_type(8)));
__device__ __forceinline__ unsigned pk_f16(float a, float b) { return __builtin_bit_cast(unsigned, __builtin_amdgcn_cvt_pkrtz(a, b)); }
__device__ __forceinline__ u32x4 bf8_to_f16x8(const u32x4 v) { float f[8]; unpack8(v, f); u32x4 r; r.x = pk_f16(f[0], f[1]); r.y = pk_f16(f[2], f[3]); r.z = pk_f16(f[4], f[5]); r.w = pk_f16(f[6], f[7]); return r; }
__device__ void mix_conv(int wid0, const Params& p, int l, const bf16_t* proj, bf16_t* z1, int r0, int pos0, LAS unsigned char* lds) {
    const int tid = otid(wid0), lane = tid & 63, w = tid >> 6, c0 = lane * 8;
    LAS unsigned char* Y = lds; LAS unsigned char* W = lds + 94 * VP;
    const float* cw = SMALLP(p, SM5) + (size_t)l * 31 * BWID;
    float bias[8], lng[8], lnb[8];
    load8f(SMALLP(p, SM6) + (size_t)l * BWID + c0, bias); load8f(SMALLP(p, SM7) + (size_t)l * BWID + c0, lng); load8f(SMALLP(p, SM8) + (size_t)l * BWID + c0, lnb);
    u32x4 la[12];
#define CONV_LOAD(q) do { _Pragma("unroll") for (int i = 0; i < 12; ++i) { const int row = 12 * w + i; const bool valid = (row < 94) && (pos0 + 64 * (q) - 30 + row >= 0); \
        la[i] = (u32x4){0u, 0u, 0u, 0u}; if (valid) la[i] = *(const u32x4*)(proj + (size_t)(r0 + 64 * (q) - 30 + row) * BWID + PO(2) + c0); } } while (0)
    CONV_LOAD(0);
    for (int i = tid; i < 31 * 64; i += 512) { const int k = i >> 6, cgp = i & 63; float f[8]; load8f(cw + k * BWID + cgp * 8, f);
        u32x4 o; { h16x2 t0 = {(_Float16)f[0], (_Float16)f[1]}, t1 = {(_Float16)f[2], (_Float16)f[3]}, t2 = {(_Float16)f[4], (_Float16)f[5]}, t3 = {(_Float16)f[6], (_Float16)f[7]};
            o.x = __builtin_bit_cast(unsigned, t0); o.y = __builtin_bit_cast(unsigned, t1); o.z = __builtin_bit_cast(unsigned, t2); o.w = __builtin_bit_cast(unsigned, t3); }
        *(LAS u32x4*)(W + k * 1024 + cgp * 16) = o; }
#pragma unroll
    for (int q = 0; q < 2; ++q) {
        const int tr = r0 + 64 * q;
        __syncthreads();
#pragma unroll
        for (int i = 0; i < 12; ++i) { const int row = 12 * w + i; if (row < 94) *(LAS u32x4*)(Y + row * VP + lane * 16) = bf8_to_f16x8(la[i]); }
        __syncthreads();
        if (q == 0) CONV_LOAD(1);
        u32x4 gtv[8];
#pragma unroll
        for (int j = 0; j < 8; ++j) gtv[j] = *(const u32x4*)(proj + (size_t)(tr + 8 * w + j) * BWID + PO(3) + c0);
        h16x8 hacc[8];
#pragma unroll
        for (int j = 0; j < 8; ++j) hacc[j] = (h16x8){0, 0, 0, 0, 0, 0, 0, 0};
#pragma unroll 1
        for (int k = 0; k < 31; ++k) {
            const h16x8 wq = __builtin_bit_cast(h16x8, *(const LAS u32x4*)(W + k * 1024 + lane * 16));
#pragma unroll
            for (int j = 0; j < 8; ++j) hacc[j] = wq * __builtin_bit_cast(h16x8, *(const LAS u32x4*)(Y + (8 * w + j + k) * VP + lane * 16)) + hacc[j];
        }
        float acc[8][8];
#pragma unroll
        for (int j = 0; j < 8; ++j)
#pragma unroll
            for (int c = 0; c < 8; ++c) acc[j][c] = (float)hacc[j][c] + bias[c];
#pragma unroll
        for (int j = 0; j < 8; ++j) {
            float s = 0.f, ss = 0.f;
#pragma unroll
            for (int c = 0; c < 8; ++c) { s += acc[j][c]; ss += acc[j][c] * acc[j][c]; }
            s = wave_sum(wid0, s); ss = wave_sum(wid0, ss);
            const float mean = s * (1.0f / 512.0f); const float var = fmaxf(ss * (1.0f / 512.0f) - mean * mean, 0.f); const float rstd = rsqrtf(var + 1e-5f);
            const int row = tr + 8 * w + j;
            float gt[8], o[8]; unpack8(gtv[j], gt);
#pragma unroll
            for (int c = 0; c < 8; ++c) { const float v = (acc[j][c] - mean) * rstd * lng[c] + lnb[c]; o[c] = silu(v) * silu(gt[c]); }
            *(u32x4*)(z1 + (size_t)row * BWID + c0) = pack8(o);
        }
    }
}

#undef CONV_LOAD
__device__ __forceinline__ u32x4 sel4(bool c, const u32x4 a, const u32x4 b) { u32x4 r; r.x = c ? a.x : b.x; r.y = c ? a.y : b.y; r.z = c ? a.z : b.z; r.w = c ? a.w : b.w; return r; }

__device__ void mix_pool(int wid0, const Params& p, int l, const bf16_t* proj, bf16_t* z0, int r0, int pos0, LAS unsigned char* lds) {
    const int tid = otid(wid0), lane = tid & 63, w = tid >> 6, c0 = lane * 8;
    LAS unsigned char* P = lds;
    {
        const int g4 = lane >> 4, win = 2 << g4;
        const int r = r0 + 16 * w, pos = pos0 + 16 * w;
        u32x4 R[32];
#pragma unroll
        for (int i = 0; i < 16; ++i) { R[i] = (u32x4){0u, 0u, 0u, 0u}; if (pos > 0) R[i] = *(const u32x4*)(proj + (size_t)(r - 16 + i) * BWID + c0); }
#pragma unroll
        for (int i = 0; i < 16; ++i) R[16 + i] = *(const u32x4*)(proj + (size_t)(r + i) * BWID + c0);
        float S[8];
#pragma unroll
        for (int j = 0; j < 8; ++j) S[j] = 0.f;
#pragma unroll
        for (int i = 1; i <= 16; ++i) { float x[8]; unpack8(R[16 - i], x); const float mk = (i <= win) ? 1.0f : 0.0f;
#pragma unroll
            for (int j = 0; j < 8; ++j) S[j] += mk * x[j]; }
#pragma unroll
        for (int jj = 0; jj < 16; ++jj) {
            const int ps = pos + jj; float xv[8], xo[8], o[8];
            unpack8(R[16 + jj], xv);
            const u32x4 ro = sel4(g4 < 2, sel4(g4 == 0, R[16 + jj - 2], R[16 + jj - 4]), sel4(g4 == 2, R[16 + jj - 8], R[jj]));
            unpack8(ro, xo);
            const int cnt = (ps + 1 < win) ? ps + 1 : win; const float inv = 1.0f / (float)cnt;
#pragma unroll
            for (int j = 0; j < 8; ++j) { S[j] += xv[j] - xo[j]; o[j] = S[j] * inv - xv[j]; }
            *(LAS u32x4*)(P + (16 * w + jj) * VP + lane * 16) = pack8(o);
        }
    }
    __syncthreads();
    {
        const int g = w >> 1, fr = lane & 15, fq = lane >> 4;
        const bf16_t* pwT = (const bf16_t*)(p.ws + p.o_pw) + (size_t)(l * 4 + g) * 128 * 128;
        u32x2 gtv[8][4];
#pragma unroll
        for (int tt = 0; tt < 8; ++tt)
#pragma unroll
            for (int dt = 0; dt < 4; ++dt) gtv[tt][dt] = *(const u32x2*)(proj + (size_t)(r0 + 16 * tt + fr) * BWID + PO(1) + 64 * w + 16 * dt + 4 * fq);
        bf16x8 A[4][4];
#pragma unroll
        for (int dt = 0; dt < 4; ++dt)
#pragma unroll
            for (int kk = 0; kk < 4; ++kk) A[dt][kk] = *(const bf16x8*)(pwT + (size_t)(64 * (w & 1) + 16 * dt + fr) * 128 + 32 * kk + 8 * fq);
        const float* psc = SMALLP(p, SM4) + (size_t)l * BWID;
        f32x4 sc[4];
#pragma unroll
        for (int dt = 0; dt < 4; ++dt) sc[dt] = *(const f32x4*)(psc + 64 * w + 16 * dt + 4 * fq);
#pragma unroll
        for (int tt = 0; tt < 8; ++tt) {
            bf16x8 Bf[4];
#pragma unroll
            for (int kk = 0; kk < 4; ++kk) Bf[kk] = *(const LAS bf16x8*)(P + (16 * tt + fr) * VP + (128 * g + 32 * kk + 8 * fq) * 2);
            f32x4 acc[4];
#pragma unroll
            for (int dt = 0; dt < 4; ++dt) { acc[dt] = (f32x4){0.f, 0.f, 0.f, 0.f};
#pragma unroll
                for (int kk = 0; kk < 4; ++kk) acc[dt] = __builtin_amdgcn_mfma_f32_16x16x32_bf16(A[dt][kk], Bf[kk], acc[dt], 0, 0, 0); }
            const int row = r0 + 16 * tt + fr;
#pragma unroll
            for (int dt = 0; dt < 4; ++dt) { const int d = 64 * w + 16 * dt + 4 * fq;
                float gt[4]; unpack4(gtv[tt][dt], gt);
                u32x2 o; o.x = cvt_pk_bf16(acc[dt][0] * sc[dt][0] * silu(gt[0]), acc[dt][1] * sc[dt][1] * silu(gt[1])); o.y = cvt_pk_bf16(acc[dt][2] * sc[dt][2] * silu(gt[2]), acc[dt][3] * sc[dt][3] * silu(gt[3]));
                *(u32x2*)(z0 + (size_t)row * BWID + d) = o; }
        }
    }
}

__device__ void mix_sgu(int wid0, const Params& p, int l, const bf16_t* proj, bf16_t* z2, int r0, LAS unsigned char* lds) {
    const int tid = otid(wid0), lane = tid & 63, w = tid >> 6, c0 = lane * 8;
    LAS unsigned char* V = lds;
    {
        float lng[8], lnb[8]; load8f(SMALLP(p, SM9) + (size_t)l * BWID + c0, lng); load8f(SMALLP(p, SM10) + (size_t)l * BWID + c0, lnb);
        u32x4 R[16];
#pragma unroll
        for (int jj = 0; jj < 16; ++jj) R[jj] = *(const u32x4*)(proj + (size_t)(r0 + 16 * w + jj) * BWID + PO(5) + c0);
#pragma unroll
        for (int jj = 0; jj < 16; ++jj) {
            float x[8], o[8]; unpack8(R[jj], x);
            float s = 0.f, ss = 0.f;
#pragma unroll
            for (int c = 0; c < 8; ++c) { s += x[c]; ss += x[c] * x[c]; }
            s = wave_sum(wid0, s); ss = wave_sum(wid0, ss);
            const float mean = s * (1.0f / 512.0f); const float var = fmaxf(ss * (1.0f / 512.0f) - mean * mean, 0.f); const float rstd = rsqrtf(var + 1e-5f);
#pragma unroll
            for (int c = 0; c < 8; ++c) o[c] = (x[c] - mean) * rstd * lng[c] + lnb[c];
            *(LAS u32x4*)(V + (16 * w + jj) * VP + lane * 16) = pack8(o);
        }
    }
    __syncthreads();
    {
        const int g = w >> 1, fr = lane & 15, fq = lane >> 4;
        const unsigned vbase = (unsigned)(size_t)V;
        bf16x8 A[4][4];
#pragma unroll
        for (int ct = 0; ct < 4; ++ct)
#pragma unroll
            for (int kk = 0; kk < 4; ++kk) {
                const unsigned a = vbase + (unsigned)((32 * kk + 8 * fq + (fr >> 2)) * VP + (64 * w + 16 * ct + 4 * (fr & 3)) * 2);
                const u32x2 lo = tr_read(a), hi = tr_read(a + 4 * VP);
                u32x4 t; t.x = lo.x; t.y = lo.y; t.z = hi.x; t.w = hi.y;
                A[ct][kk] = __builtin_bit_cast(bf16x8, t);
            }
        const bf16_t* swm = (const bf16_t*)(p.ws + p.o_sw) + (size_t)(l * 4 + g) * 128 * 128;
        const float* sb = SMALLP(p, SM12) + (size_t)(l * 4 + g) * 128;
#pragma unroll
        for (int hb = 0; hb < 2; ++hb) {
            u32x2 uu[4][4]; bf16x8 Wf[4][4]; float bias[4];
#pragma unroll
            for (int t4 = 0; t4 < 4; ++t4) { const int tt = hb * 4 + t4; const bf16_t* pr = proj + (size_t)(r0 + 16 * tt + fr) * BWID + 64 * w + 4 * fq;
#pragma unroll
                for (int ct = 0; ct < 4; ++ct) uu[t4][ct] = *(const u32x2*)(pr + PO(4) + 16 * ct);
#pragma unroll
                for (int kk = 0; kk < 4; ++kk) if (kk < (tt >> 1) + 1) Wf[t4][kk] = *(const bf16x8*)(swm + (size_t)(16 * tt + fr) * 128 + 32 * kk + 8 * fq);
                bias[t4] = sb[16 * tt + fr]; }
#pragma unroll
            for (int t4 = 0; t4 < 4; ++t4) { const int tt = hb * 4 + t4;
                f32x4 acc[4];
#pragma unroll
                for (int ct = 0; ct < 4; ++ct) acc[ct] = (f32x4){0.f, 0.f, 0.f, 0.f};
#pragma unroll
                for (int kk = 0; kk < 4; ++kk) if (kk < (tt >> 1) + 1) {
#pragma unroll
                    for (int ct = 0; ct < 4; ++ct) acc[ct] = __builtin_amdgcn_mfma_f32_16x16x32_bf16(A[ct][kk], Wf[t4][kk], acc[ct], 0, 0, 0); }
                const int row = r0 + 16 * tt + fr;
#pragma unroll
                for (int ct = 0; ct < 4; ++ct) { const int c = 64 * w + 16 * ct + 4 * fq;
                    float u[4]; unpack4(uu[t4][ct], u);
                    u32x2 o; o.x = cvt_pk_bf16(u[0] * (acc[ct][0] + bias[t4]), u[1] * (acc[ct][1] + bias[t4])); o.y = cvt_pk_bf16(u[2] * (acc[ct][2] + bias[t4]), u[3] * (acc[ct][3] + bias[t4]));
                    *(u32x2*)(z2 + (size_t)row * BWID + c) = o; }
            }
        }
    }
}

__device__ void phase_mix(int wid0, const Params& p, int l, const bf16_t* proj, bf16_t* z, LAS unsigned char* lds) {
    constexpr int nchunk = TS / 128;
    for (int i = blockIdx.x; i < 4 * nchunk; i += gridDim.x) {
        const int j = i % nchunk, br = ((i / nchunk) + j) & 3, r0 = j * 128, pos0 = (j & 15) * 128;
        if (br == 0) for (int rr = 0; rr < REP_M0; ++rr) { mix_pool(wid0, p, l, proj, z + PO(1), r0, pos0, lds); __syncthreads(); }
        else if (br == 1) for (int rr = 0; rr < REP_M1; ++rr) { mix_conv(wid0, p, l, proj, z + PO(3), r0, pos0, lds); __syncthreads(); }
        else if (br == 2) for (int rr = 0; rr < REP_M2; ++rr) { mix_sgu(wid0, p, l, proj, z + PO(4), r0, lds); __syncthreads(); }
        else for (int rr = 0; rr < REP_M3; ++rr) { mix_sc(wid0, p, l, proj, z + PO(6), r0, pos0); __syncthreads(); }
    }
}

#define XB_TMO      128
#define XB_XCNT(j)  (256  + 64 * (j))
#define XB_XSUB(j)  (1280 + 64 * (j))
#define XB_XGEN(j)  (2304 + 64 * (j))
#define XB_TOP      3328
#define XB_TOPGEN   3392
#define XCD_BAR_WORDS 3456
#define XB_SPIN_CAP (1u << 20)
__device__ __forceinline__ unsigned xb_ld(unsigned* p)              { return __hip_atomic_load(p, __ATOMIC_RELAXED, __HIP_MEMORY_SCOPE_AGENT); }
__device__ __forceinline__ unsigned xb_add(unsigned* p, unsigned v) { return __hip_atomic_fetch_add(p, v, __ATOMIC_RELAXED, __HIP_MEMORY_SCOPE_AGENT); }
__device__ __forceinline__ unsigned xb_xcc_id() { return (unsigned)__builtin_amdgcn_s_getreg((3 << 11) | 20) & 0xFu; }
#define XB_SPIN(cond, bar) do { unsigned _sp = 0; while (cond) { __builtin_amdgcn_s_sleep(1); \
    if ((++_sp & 255u) == 0u) { if (xb_ld(&(bar)[XB_TMO])) break; if (_sp > XB_SPIN_CAP) { atomicAdd(&(bar)[XB_TMO], 1u); break; } } } } while (0)
struct XcdBarrier { unsigned* bar; unsigned x; volatile LAS unsigned* st; };
__device__ __forceinline__ XcdBarrier xcd_barrier_post(bool first, unsigned* bar, volatile LAS unsigned* st) {
    XcdBarrier b; b.bar = bar; b.x = xb_xcc_id(); b.st = st;
    if (first) (void)xb_add(&bar[XB_XCNT(b.x)], 1u);
    return b;
}
__device__ __forceinline__ void xcd_barrier_complete(unsigned* bar, unsigned x, unsigned& nloc, unsigned& nx) {
    const unsigned G = gridDim.x * gridDim.y * gridDim.z;
    unsigned sum, cnt, mine, sp = 0u;
    for (;;) {
        sum = 0u; cnt = 0u; mine = 0u;
#pragma unroll
        for (unsigned j = 0; j < 16; ++j) { const unsigned c = xb_ld(&bar[XB_XCNT(j)]); sum += c; cnt += (c > 0u) ? 1u : 0u; mine = (j == x) ? c : mine; }
        if (sum == G) break;
        __builtin_amdgcn_s_sleep(1);
        if ((++sp & 255u) == 0u) { if (xb_ld(&bar[XB_TMO])) break; if (sp > XB_SPIN_CAP) { atomicAdd(&bar[XB_TMO], 1u); break; } }
    }
    nloc = mine > 0u ? mine : 1u; nx = cnt > 0u ? cnt : 1u;
}
__device__ __forceinline__ void xcd_barrier(int wid0, const XcdBarrier& b) {
    asm volatile("s_waitcnt vmcnt(0)" ::: "memory");
    __syncthreads();
    if (otid(wid0) == 0) {
        unsigned* bar = b.bar; asm volatile("" : "+s"(bar)); unsigned bx = b.x; asm volatile("" : "+s"(bx));
        __builtin_amdgcn_s_waitcnt(0);
        unsigned nloc = b.st[0], nx = b.st[1];
        if (nloc == 0u) { xcd_barrier_complete(bar, bx, nloc, nx); b.st[0] = nloc; b.st[1] = nx; }
        const unsigned old = xb_add(&bar[XB_XSUB(bx)], 1u);
        const unsigned gen = old / nloc;
        if (old + 1u == (gen + 1u) * nloc) {
            __builtin_amdgcn_fence(__ATOMIC_RELEASE, "agent");
            asm volatile("s_waitcnt vmcnt(0)" ::: "memory");
            const unsigned og = xb_add(&bar[XB_TOP], 1u);
            const unsigned tg = og / nx;
            if (og + 1u == (tg + 1u) * nx) xb_add(&bar[XB_TOPGEN], 1u);
            else XB_SPIN(xb_ld(&bar[XB_TOPGEN]) == tg, bar);
            __builtin_amdgcn_fence(__ATOMIC_ACQUIRE, "agent");
            xb_add(&bar[XB_XGEN(bx)], 1u);
            asm volatile("s_waitcnt vmcnt(0)" ::: "memory");
        } else {
            XB_SPIN(xb_ld(&bar[XB_XGEN(bx)]) == gen, bar);
            __builtin_amdgcn_fence(__ATOMIC_ACQUIRE, "agent");
            asm volatile("s_waitcnt vmcnt(0)" ::: "memory");
        }
    }
    __syncthreads();
}

__global__ void __launch_bounds__(512) mk_forward(Params p) {
    extern __shared__ __attribute__((aligned(16))) unsigned char lds_raw[];
    LAS unsigned char* lds = (LAS unsigned char*)lds_raw;
    cg::grid_group grid = cg::this_grid();
    volatile LAS unsigned* stw = (volatile LAS unsigned*)(lds + LDS_BYTES - 16);
    const int wid0 = __builtin_amdgcn_readfirstlane((int)(threadIdx.x >> 6));
    const bool first = (wid0 == 0 && lane_id() == 0);
    if (first) { stw[0] = 0u; stw[1] = 0u; }
    __syncthreads();
    const XcdBarrier xbar = xcd_barrier_post(first, (unsigned*)(p.ws + p.o_bar), stw);
#define PHASE_ON true
#ifndef XSYNC
#define XSYNC 0
#endif
#define PHASE_END do { if (p.ph_hi > 100000) grid.sync();   xcd_barrier(wid0, xbar); } while (0)
    constexpr int ts = TS;
    bf16_t* win = (bf16_t*)(p.ws + p.o_win); bf16_t* wb = (bf16_t*)(p.ws + p.o_wb); bf16_t* wo = (bf16_t*)(p.ws + p.o_wo);
    bf16_t* h0 = (bf16_t*)(p.ws + p.o_h); bf16_t* proj = (bf16_t*)(p.ws + p.o_proj);

    if (PHASE_ON) phase_prep(wid0, p, lds);
    PHASE_END;
#pragma unroll 1
    for (int l = 0; l < DEPTH; ++l) {
        bf16_t* x1b = (bf16_t*)p.out;
#pragma unroll 1
        for (int s = 0; s < NS; ++s) {
            const size_t tok0 = (size_t)s * ts;
            bf16_t* h = h0 + tok0 * DM; bf16_t* merged = h;
            if (l > 0) { if (PHASE_ON) phase_norm_bf16(wid0, nullptr, x1b + tok0 * DM, SMALLP(p, SM1) + (size_t)l * DM, h, p.ws + p.o_h8 + tok0 * DM, ts);
                PHASE_END; }
            if (PHASE_ON) {
                { pg8::Gemm g{h, win + (size_t)l * DM * WINR}; pg8::OrderA S; S.G = (int)gridDim.x; S.c = (int)blockIdx.x; pg8::EpiProj E{proj}; pg8::gemm_phase<DM, 0>(wid0, lds, g, S, E); }
                { pg8::Gemm g{(const bf16_t*)(p.ws + p.o_h8 + tok0 * DM), (const bf16_t*)(p.ws + p.o_wg8 + (size_t)l * 4096 * DM)}; pg8::Order<TS / 256, 4096 / 256, 1> S{(int)gridDim.x, (int)blockIdx.x};
                  pg8::EpiGateStore E{(unsigned char*)(proj + (size_t)8 * TS * BWID)}; pg8::gemm_phase_f8<DM>(wid0, lds, g, S, E); }
            }
            PHASE_END;
            if (PHASE_ON) phase_mix(wid0, p, l, proj, proj, lds);
            PHASE_END;
            if (PHASE_ON) for (int rep = 0; rep < REP_C; ++rep) { pg8::Gemm g{proj, wb + (size_t)l * 4 * BWID * DM}; pg8::OrderC S; S.G = (int)gridDim.x; S.c = (int)blockIdx.x;
                pg8::EpiGate E{proj + (size_t)8 * TS * BWID, merged}; pg8::gemm_phase<BWID, (size_t)BWID * DM * 2>(wid0, lds, g, S, E); }
            PHASE_END;
            if (PHASE_ON) { pg8::Gemm g{merged, wo + (size_t)l * DM * DM}; pg8::Order<TS / 256, DM / 256, 1> S{(int)gridDim.x, (int)blockIdx.x};
                pg8::EpiRes E{(l == 0) ? p.in[0] + tok0 * DM : nullptr, (l == 0) ? nullptr : x1b + tok0 * DM, (l == 0) ? x1b + tok0 * DM : proj + tok0 * DM}; pg8::gemm_phase<DM, 0>(wid0, lds, g, S, E); }
            PHASE_END;
        }
    }
    phase_norm_final(wid0, proj, p.out, SMALLP(p, SM16), NTOK);
}

extern "C" void kernel_launch(void* const* d_in, const int* in_sizes, int n_in, void* d_out, int out_size, void* d_ws, size_t ws_size, hipStream_t stream) {
    static int grid = 0;
    if (grid == 0) {
        int dev = 0, cus = 0, per_cu = 0;
        hipGetDevice(&dev); hipDeviceGetAttribute(&cus, hipDeviceAttributeMultiprocessorCount, dev);
        if (hipFuncSetAttribute((const void*)mk_forward, hipFuncAttributeMaxDynamicSharedMemorySize, LDS_BYTES) != hipSuccess) { fprintf(stderr, "hipFuncSetAttribute failed\n"); grid = -1; return; }
        if (hipOccupancyMaxActiveBlocksPerMultiprocessor(&per_cu, (const void*)mk_forward, 512, LDS_BYTES) != hipSuccess || per_cu < 1) { fprintf(stderr, "occupancy query: %d\n", per_cu); per_cu = 1; }
        (void)hipGetLastError();
        grid = cus * per_cu;
    }
    if (grid < 0) return;
    Params p{};
    for (int i = 0; i < 17; ++i) p.in[i] = (const float*)d_in[i];
    p.out = (float*)d_out; p.ws = (unsigned char*)d_ws;
    size_t o = 0;
    p.o_win = (unsigned)o; o += (size_t)DEPTH * DM * WINR * 2;
    p.o_wg8 = (unsigned)o; o += (size_t)DEPTH * 4096 * DM;
    p.o_h8 = (unsigned)o; o += (size_t)NTOK * DM;
    p.o_wb = (unsigned)o; o += (size_t)DEPTH * 4 * BWID * DM * 2;
    p.o_wo = (unsigned)o; o += (size_t)DEPTH * DM * DM * 2;
    p.o_pw = (unsigned)o; o += (size_t)DEPTH * 4 * 128 * 128 * 2;
    p.o_sw = (unsigned)o; o += (size_t)DEPTH * 4 * 128 * 128 * 2;
    p.o_bar = (unsigned)o; o += 16384;
    p.o_small = (unsigned)o; o += (size_t)SM_TOTAL * 4;
    p.o_h = (unsigned)o; o += (size_t)NTOK * DM * 2;
    p.o_proj = (unsigned)o; o += (size_t)TS * (8 * BWID * 2 + 4096);
    if (o > ws_size) { fprintf(stderr, "kernel_launch: workspace too small: need %zu, have %zu\n", o, ws_size); return; }
    const int nph = 1 + NS * 4 + (DEPTH - 1) * NS * 5 + 1;
    if (hipMemsetAsync((char*)d_ws + p.o_bar, 0, 16384, stream) != hipSuccess) { fprintf(stderr, "kernel_launch: memset failed\n"); return; }
    p.ph_hi = nph;
    void* args[] = {&p};
    hipError_t e = hipLaunchCooperativeKernel((const void*)mk_forward, dim3(grid), dim3(512), args, LDS_BYTES, stream);
    if (e != hipSuccess) fprintf(stderr, "cooperative launch failed: %s (grid %d)\n", hipGetErrorString(e), grid);
}
```
